# Optimizing an MI355X kernel written in HIP

```python
import jax, jax.numpy as jnp
from jax import lax
import numpy as np

D_MODEL = 1024
BATCH = 8
SEQ = 4096
DEPTH = 4

N_MIXERS = 3
EPS = 1e-6
A_CHUNK = 128
A_WIDTH = 2 * D_MODEL
A_GROUPS = 8
A_GROUP_DIM = A_WIDTH // A_GROUPS
B_HEADS = 4
B_KEY_DIM = D_MODEL // 2
B_VAL_DIM = D_MODEL
B_HK = B_KEY_DIM // B_HEADS
B_HV = B_VAL_DIM // B_HEADS
B_GATE_RANK = 16
B_TAU = 16.0
B_CHUNK = 64
C_HEADS = 8
C_HEAD_DIM = D_MODEL // C_HEADS
C_BLOCK = 128
FFN_DIM = 7 * D_MODEL // 2
N_EXPERTS = 8
TOP_K = 2
N_A = (DEPTH + 2) // 3
N_B = (DEPTH + 1) // 3
N_C = DEPTH // 3
N_DENSE = (DEPTH + 1) // 2
N_MOE = DEPTH // 2

kernel_name = "hybrid_gmlp_gla_fox_moe_trunk"


def rmsnorm(x, g):
    xf = x.astype(jnp.float32)
    y = xf * lax.rsqrt(jnp.mean(xf * xf, axis=-1, keepdims=True) + EPS)
    return (y * g.astype(jnp.float32)).astype(x.dtype)


def gmlp_mixer(h, w_in, v_g, w_s, b_s, w_out):
    bsz, s, _ = h.shape
    z = jax.nn.gelu(h @ w_in)
    u, v = jnp.split(z, 2, axis=-1)
    v = rmsnorm(v, v_g)
    nc = s // A_CHUNK
    v = v.reshape(bsz, nc, A_CHUNK, A_GROUPS, A_GROUP_DIM)
    mask = jnp.tril(jnp.ones((A_CHUNK, A_CHUNK), dtype=bool))
    w = jnp.where(mask[None], w_s, 0.0).astype(v.dtype)
    mixed = jnp.einsum('gts,bnsgd->bntgd', w, v) + b_s.T.astype(v.dtype)[None, None, :, :, None]
    y = u * mixed.reshape(bsz, s, A_WIDTH)
    return y @ w_out


def gla_mixer(h, w_in, w_gate2, gate_bias, o_g, w_out):
    bsz, s, _ = h.shape
    dt = h.dtype
    proj = h @ w_in
    q, k, v, r, g_low = jnp.split(
        proj, np.cumsum([B_KEY_DIM, B_KEY_DIM, B_VAL_DIM, B_VAL_DIM]).tolist(), axis=-1)
    log_a = jax.nn.log_sigmoid((g_low @ w_gate2 + gate_bias).astype(jnp.float32)) / B_TAU
    nc = s // B_CHUNK

    def to_chunks(t, hd):
        return t.astype(jnp.float32).reshape(bsz, nc, B_CHUNK, B_HEADS, hd).transpose(0, 3, 1, 2, 4)

    q = to_chunks(q, B_HK) * (B_HK ** -0.5)
    k = to_chunks(k, B_HK)
    v = to_chunks(v, B_HV)
    la = to_chunks(log_a, B_HK)
    bcum = jnp.cumsum(la, axis=3)
    b_last = bcum[:, :, :, -1:, :]
    q_d = q * jnp.exp(bcum)
    k_d = k * jnp.exp(-bcum)
    k_end = k * jnp.exp(b_last - bcum)
    dec = jnp.exp(b_last[:, :, :, 0, :])
    att = jnp.einsum('bhntk,bhnsk->bhnts', q_d, k_d)
    cmask = jnp.tril(jnp.ones((B_CHUNK, B_CHUNK), dtype=bool))
    att = jnp.where(cmask, att, 0.0)
    o_intra = jnp.einsum('bhnts,bhnsv->bhntv', att, v)

    def step(state, xs):
        qd_n, ke_n, v_n, dec_n = xs
        o_n = jnp.einsum('bhtk,bhkv->bhtv', qd_n, state)
        state = dec_n[..., None] * state + jnp.einsum('bhsk,bhsv->bhkv', ke_n, v_n)
        return state, o_n

    state0 = jnp.zeros((bsz, B_HEADS, B_HK, B_HV), jnp.float32)
    _, o_inter = lax.scan(step, state0, (jnp.moveaxis(q_d, 2, 0), jnp.moveaxis(k_end, 2, 0),
                                         jnp.moveaxis(v, 2, 0), jnp.moveaxis(dec, 2, 0)))
    o = o_intra + jnp.moveaxis(o_inter, 0, 2)
    o = o.transpose(0, 2, 3, 1, 4).reshape(bsz, s, B_HEADS, B_HV)
    o = rmsnorm(o, o_g).reshape(bsz, s, B_VAL_DIM).astype(dt)
    return (o * jax.nn.silu(r)) @ w_out


def fox_mixer(h, w_in, f_bias, w_out):
    bsz, s, _ = h.shape
    proj = h @ w_in
    q, k, v, f_logit = jnp.split(proj, [D_MODEL, 2 * D_MODEL, 3 * D_MODEL], axis=-1)

    def heads(t):
        return t.reshape(bsz, s, C_HEADS, C_HEAD_DIM).transpose(0, 2, 1, 3)

    q, k, v = heads(q), heads(k), heads(v)
    log_f = jax.nn.log_sigmoid(f_logit.astype(jnp.float32) + f_bias.astype(jnp.float32))
    c = jnp.cumsum(log_f, axis=1).transpose(0, 2, 1)
    nb = s // C_BLOCK
    q_blocks = q.reshape(bsz, C_HEADS, nb, C_BLOCK, C_HEAD_DIM).transpose(2, 0, 1, 3, 4)
    c_blocks = c.reshape(bsz, C_HEADS, nb, C_BLOCK).transpose(2, 0, 1, 3)
    key_pos = jnp.arange(s)
    scale = C_HEAD_DIM ** -0.5

    def block(args):
        qb, cb, i = args
        logits = jnp.einsum('bhtd,bhsd->bhts', qb, k, preferred_element_type=jnp.float32) * scale
        logits = logits + cb[..., None] - c[:, :, None, :]
        qpos = i * C_BLOCK + jnp.arange(C_BLOCK)
        mask = key_pos[None, :] <= qpos[:, None]
        logits = jnp.where(mask, logits, -jnp.inf)
        p = jax.nn.softmax(logits, axis=-1)
        return jnp.einsum('bhts,bhsd->bhtd', p.astype(v.dtype), v)

    o = lax.map(block, (q_blocks, c_blocks, jnp.arange(nb)))
    o = o.transpose(1, 0, 3, 2, 4).reshape(bsz, s, D_MODEL)
    return o @ w_out


def swiglu(h, w_in, w_out):
    g, u = jnp.split(h @ w_in, 2, axis=-1)
    return (jax.nn.silu(g) * u) @ w_out


def moe_ffn(h, router, w_in, w_out):
    bsz, s, d = h.shape
    t = h.reshape(-1, d)
    logits = (t @ router).astype(jnp.float32)
    top_v, top_i = lax.top_k(logits, TOP_K)
    gates = jax.nn.softmax(top_v, axis=-1)
    y = jnp.zeros_like(t)
    for e in range(N_EXPERTS):
        w_e = jnp.sum(jnp.where(top_i == e, gates, 0.0), axis=-1).astype(t.dtype)
        y = y + w_e[:, None] * swiglu(t, w_in[e], w_out[e])
    return y.reshape(bsz, s, d)


def setup_inputs(seed: int = 0) -> dict:
    key = jax.random.key(seed)
    ks = iter(jax.random.split(key, 32))

    def nrm(shape, fan_in):
        return jax.random.normal(next(ks), shape, jnp.float32) * (fan_in ** -0.5)

    def gain(shape):
        return 1.0 + 0.02 * jax.random.normal(next(ks), shape, jnp.float32)

    def small(shape):
        return 0.02 * jax.random.normal(next(ks), shape, jnp.float32)

    x = jax.random.normal(next(ks), (BATCH, SEQ, D_MODEL), jnp.float32)
    return {
        "x": x,
        "norm1_g": gain((DEPTH, D_MODEL)),
        "norm2_g": gain((DEPTH, D_MODEL)),
        "a_w_in": nrm((N_A, D_MODEL, 2 * A_WIDTH), D_MODEL),
        "a_vnorm_g": gain((N_A, A_WIDTH)),
        "a_w_s": nrm((N_A, A_GROUPS, A_CHUNK, A_CHUNK), A_CHUNK),
        "a_b_s": gain((N_A, A_GROUPS, A_CHUNK)),
        "a_w_out": nrm((N_A, A_WIDTH, D_MODEL), A_WIDTH),
        "b_w_in": nrm((N_B, D_MODEL, 2 * B_KEY_DIM + 2 * B_VAL_DIM + B_GATE_RANK), D_MODEL),
        "b_w_gate2": nrm((N_B, B_GATE_RANK, B_KEY_DIM), B_GATE_RANK),
        "b_gate_bias": small((N_B, B_KEY_DIM)),
        "b_onorm_g": gain((N_B, B_HV)),
        "b_w_out": nrm((N_B, B_VAL_DIM, D_MODEL), B_VAL_DIM),
        "c_w_in": nrm((N_C, D_MODEL, 3 * D_MODEL + C_HEADS), D_MODEL),
        "c_f_bias": 3.0 + 0.1 * jax.random.normal(next(ks), (N_C, C_HEADS), jnp.float32),
        "c_w_out": nrm((N_C, D_MODEL, D_MODEL), D_MODEL),
        "ffn_w_in": nrm((N_DENSE, D_MODEL, 2 * FFN_DIM), D_MODEL),
        "ffn_w_out": nrm((N_DENSE, FFN_DIM, D_MODEL), FFN_DIM),
        "moe_router": nrm((N_MOE, D_MODEL, N_EXPERTS), D_MODEL),
        "moe_w_in": nrm((N_MOE, N_EXPERTS, D_MODEL, 2 * FFN_DIM), D_MODEL),
        "moe_w_out": nrm((N_MOE, N_EXPERTS, FFN_DIM, D_MODEL), FFN_DIM),
        "final_g": gain((D_MODEL,)),
    }


def reference(x, norm1_g, norm2_g, a_w_in, a_vnorm_g, a_w_s, a_b_s, a_w_out,
              b_w_in, b_w_gate2, b_gate_bias, b_onorm_g, b_w_out,
              c_w_in, c_f_bias, c_w_out, ffn_w_in, ffn_w_out,
              moe_router, moe_w_in, moe_w_out, final_g):
    for i in range(DEPTH):
        h = rmsnorm(x, norm1_g[i])
        m, j = i % N_MIXERS, i // N_MIXERS
        if m == 0:
            x = x + gmlp_mixer(h, a_w_in[j], a_vnorm_g[j], a_w_s[j], a_b_s[j], a_w_out[j])
        elif m == 1:
            x = x + gla_mixer(h, b_w_in[j], b_w_gate2[j], b_gate_bias[j], b_onorm_g[j], b_w_out[j])
        else:
            x = x + fox_mixer(h, c_w_in[j], c_f_bias[j], c_w_out[j])
        h = rmsnorm(x, norm2_g[i])
        if i % 2 == 0:
            x = x + swiglu(h, ffn_w_in[i // 2], ffn_w_out[i // 2])
        else:
            x = x + moe_ffn(h, moe_router[i // 2], moe_w_in[i // 2], moe_w_out[i // 2])
    return rmsnorm(x, final_g)
```

```cpp
#include <hip/hip_runtime.h>
#include <cstdio>
#include <cstdint>
namespace pg8 {
#define PG8_LAS __attribute__((address_space(3)))
typedef unsigned short bf16_t;
typedef short bf16x8 __attribute__((ext_vector_type(8)));
typedef float f32x4 __attribute__((ext_vector_type(4)));
typedef unsigned u32x4 __attribute__((ext_vector_type(4)));
constexpr int BM = 256, BK = 64, HALF = 128, HTB = HALF * BK * 2  , STAGE_BYTES = 8 * HTB, NXCD = 8, WGM = 8;

__host__ __device__ __forceinline__ int lds_byte(int r, int c) { const int st = (r >> 4) * 2 + (c >> 5), rr = r & 15, cc = c & 31, ob = rr * 64 + cc * 2; return st * 1024 + (ob ^ (((ob >> 9) & 1) << 5)); }
__host__ __device__ __forceinline__ void stage_rc(int b, int& R, int& C) { const int st = b / 1024, sb = b % 1024, swz = sb ^ (((sb >> 9) & 1) << 5); R = (st >> 1) * 16 + swz / 64; C = (st & 1) * 32 + (swz % 64) / 2; }
__host__ __device__ __forceinline__ int perm32(int rho) { const int n = rho >> 4, i = rho & 15; return 8 * (i >> 2) + 4 * n + (i & 3); }

struct Unit { int pm, pn; };
struct Gemm { const bf16_t* A; const bf16_t* Bt; int M, N, K; };

struct StaticOrder {
    int nM, nN, nwg, G, c;
    __host__ __device__ void init(int M, int N, int G_, int c_) { nM = M / BM; nN = N / BM; nwg = nM * nN; G = G_; c = c_; }
    __host__ __device__ bool next(int i, Unit& u) const {
        const long L = (long)i * G + c; if (L >= nwg) return false;
        int wgid = (int)L; { const int q = nwg / NXCD, r = nwg % NXCD, xcd = wgid % NXCD, off = wgid / NXCD; wgid = (xcd < r ? xcd * (q + 1) : r * (q + 1) + (xcd - r) * q) + off; }
        const int nig = WGM * nN, gid = wgid / nig, fm = gid * WGM, gsz = (nM - fm) < WGM ? (nM - fm) : WGM;
        u.pm = fm + ((wgid % nig) % gsz); u.pn = (wgid % nig) / gsz; return true;
    }
    __device__ __forceinline__ void a_ready(const Unit&) const {}
    __device__ __forceinline__ void done(const Unit&) const {}
};

struct GroupedOrder {
    int nN, nM, nwg, G, c; int s1, s2, s3, s4, s5, s6, s7;
    __device__ __forceinline__ void init(const unsigned* cnt, int nN_, int G_, int c_) {
        nN = nN_; G = G_; c = c_; int t = 0;
        t += (int)((cnt[0] + 255u) >> 8); s1 = t; t += (int)((cnt[1] + 255u) >> 8); s2 = t; t += (int)((cnt[2] + 255u) >> 8); s3 = t; t += (int)((cnt[3] + 255u) >> 8); s4 = t;
        t += (int)((cnt[4] + 255u) >> 8); s5 = t; t += (int)((cnt[5] + 255u) >> 8); s6 = t; t += (int)((cnt[6] + 255u) >> 8); s7 = t; t += (int)((cnt[7] + 255u) >> 8);
        nM = t; nwg = nM * nN;
    }
    __device__ __forceinline__ bool next(int i, Unit& u) const {
        const long L = (long)i * G + c; if (L >= nwg) return false;
        int wgid = (int)L; { const int q = nwg / NXCD, r = nwg % NXCD, xcd = wgid % NXCD, off = wgid / NXCD; wgid = (xcd < r ? xcd * (q + 1) : r * (q + 1) + (xcd - r) * q) + off; }
        const int nig = WGM * nN, gid = wgid / nig, fm = gid * WGM, gsz = (nM - fm) < WGM ? (nM - fm) : WGM;
        const int pm = fm + ((wgid % nig) % gsz), pnl = (wgid % nig) / gsz;
        const int e = (pm >= s1) + (pm >= s2) + (pm >= s3) + (pm >= s4) + (pm >= s5) + (pm >= s6) + (pm >= s7);
        u.pm = pm; u.pn = e * nN + pnl; return true;
    }
    __device__ __forceinline__ void a_ready(const Unit&) const {}
    __device__ __forceinline__ void done(const Unit&) const {}
};

__device__ __forceinline__ unsigned cvt_pk_bf16(float lo, float hi) { unsigned r; asm volatile("v_cvt_pk_bf16_f32 %0, %1, %2" : "=v"(r) : "v"(lo), "v"(hi)); return r; }
typedef unsigned u32x2 __attribute__((ext_vector_type(2)));
constexpr float RMS_EPS = 1e-6f;
__device__ __forceinline__ float rs16(const float* ssq, int row) {
    const f32x4* p = (const f32x4*)(ssq + (size_t)row * 16);
    const f32x4 a = p[0], b = p[1], c = p[2], d = p[3];
    const float s = (((a[0] + a[1]) + (a[2] + a[3])) + ((b[0] + b[1]) + (b[2] + b[3]))) + (((c[0] + c[1]) + (c[2] + c[3])) + ((d[0] + d[1]) + (d[2] + d[3])));
    return __builtin_amdgcn_rsqf(s * (1.0f / 1024.0f) + RMS_EPS);
}
__device__ __forceinline__ float gelu_t(float x) {
    const float t = x * (1.0f + 0.044715f * x * x);
    return x * __builtin_amdgcn_rcpf(1.0f + __builtin_amdgcn_exp2f(-2.302208198f * t));
}
__device__ __forceinline__ float silu_f(float x) { return x * __builtin_amdgcn_rcpf(1.0f + __builtin_amdgcn_exp2f(-1.4426950409f * x)); }

struct EpiAin {
    static constexpr bool PERM = true, AFTER_DRAIN = false;
    const float* ssq; bf16_t* U; bf16_t* V; float* vssq;
    __device__ __forceinline__ void operator()(const f32x4 (&acc)[2][2][4][2], const Unit& u, int wr, int wc, int fr, int fq) const {
        const bool isv = u.pn >= 8; bf16_t* base = isv ? V : U;
        const int row0 = u.pm * BM + wr * 64 + fr, col0 = (u.pn & 7) * BM + wc * 32 + 8 * fq;
#pragma unroll
        for (int ai = 0; ai < 2; ++ai)
#pragma unroll
            for (int m = 0; m < 4; ++m) { const int row = row0 + ai * HALF + m * 16; const float rs = rs16(ssq, row); float sq = 0.f; bf16_t* rowp = base + (size_t)row * 2048 + col0;
#pragma unroll
                for (int bj = 0; bj < 2; ++bj) { f32x4 v0 = acc[ai][bj][m][0] * rs, v1 = acc[ai][bj][m][1] * rs;
#pragma unroll
                    for (int j = 0; j < 4; ++j) { v0[j] = gelu_t(v0[j]); v1[j] = gelu_t(v1[j]); sq += v0[j] * v0[j] + v1[j] * v1[j]; }
                    u32x4 w; w.x = cvt_pk_bf16(v0[0], v0[1]); w.y = cvt_pk_bf16(v0[2], v0[3]); w.z = cvt_pk_bf16(v1[0], v1[1]); w.w = cvt_pk_bf16(v1[2], v1[3]);
                    *(u32x4*)(rowp + bj * HALF) = w; }
                if (isv) { sq += __shfl_xor(sq, 16); sq += __shfl_xor(sq, 32); if (fq == 0) vssq[(size_t)row * 32 + (u.pn - 8) * 4 + wc] = sq; } }
    }
};
struct EpiRow {
    static constexpr bool PERM = true, AFTER_DRAIN = false;
    const float* ssq; bf16_t* O; int ldc;
    __device__ __forceinline__ void operator()(const f32x4 (&acc)[2][2][4][2], const Unit& u, int wr, int wc, int fr, int fq) const {
        const int row0 = u.pm * BM + wr * 64 + fr, col0 = u.pn * BM + wc * 32 + 8 * fq;
#pragma unroll
        for (int ai = 0; ai < 2; ++ai)
#pragma unroll
            for (int m = 0; m < 4; ++m) { const int row = row0 + ai * HALF + m * 16; const float rs = rs16(ssq, row); bf16_t* rowp = O + (size_t)row * ldc + col0;
#pragma unroll
                for (int bj = 0; bj < 2; ++bj) { const f32x4 v0 = acc[ai][bj][m][0] * rs, v1 = acc[ai][bj][m][1] * rs;
                    u32x4 w; w.x = cvt_pk_bf16(v0[0], v0[1]); w.y = cvt_pk_bf16(v0[2], v0[3]); w.z = cvt_pk_bf16(v1[0], v1[1]); w.w = cvt_pk_bf16(v1[2], v1[3]);
                    *(u32x4*)(rowp + bj * HALF) = w; } }
    }
};
struct EpiResid {
    static constexpr bool PERM = false, AFTER_DRAIN = false;
    const float* xin; float* xout; bf16_t* xb; float* ssq;
    __device__ __forceinline__ void operator()(const f32x4 (&acc)[2][2][4][2], const Unit& u, int wr, int wc, int fr, int fq) const {
        const int row0 = u.pm * BM + wr * 64 + fr, col0 = u.pn * BM + wc * 32 + 4 * fq;
#pragma unroll
        for (int ai = 0; ai < 2; ++ai)
#pragma unroll
            for (int m = 0; m < 4; ++m) { const int row = row0 + ai * HALF + m * 16; const size_t off = (size_t)row * 1024 + col0; float sq = 0.f;
#pragma unroll
                for (int bj = 0; bj < 2; ++bj)
#pragma unroll
                    for (int n = 0; n < 2; ++n) { const size_t o = off + bj * HALF + n * 16; const f32x4 v = *(const f32x4*)(xin + o) + acc[ai][bj][m][n];
                        *(f32x4*)(xout + o) = v; u32x2 w; w.x = cvt_pk_bf16(v[0], v[1]); w.y = cvt_pk_bf16(v[2], v[3]); *(u32x2*)(xb + o) = w;
                        sq += (v[0] * v[0] + v[1] * v[1]) + (v[2] * v[2] + v[3] * v[3]); }
                sq += __shfl_xor(sq, 16); sq += __shfl_xor(sq, 32); if (fq == 0) ssq[(size_t)row * 16 + u.pn * 4 + wc] = sq;
                asm volatile("" ::: "memory"); }
    }
};
template <int MODE> struct EpiSwiGLU {
    static constexpr bool PERM = true, AFTER_DRAIN = false;
    const float* ssq; bf16_t* H;
    __device__ __forceinline__ void operator()(const f32x4 (&acc)[2][2][4][2], const Unit& u, int wr, int wc, int fr, int fq) const {
        const int row0 = u.pm * BM + wr * 64 + fr, col0 = (u.pn % 28) * HALF + wc * 32 + 8 * fq;
#pragma unroll
        for (int ai = 0; ai < 2; ++ai)
#pragma unroll
            for (int m = 0; m < 4; ++m) { const int row = row0 + ai * HALF + m * 16; const float rs = MODE == 0 ? rs16(ssq, row) : ssq[row];
                const f32x4 g0 = acc[ai][0][m][0] * rs, g1 = acc[ai][0][m][1] * rs, u0 = acc[ai][1][m][0] * rs, u1 = acc[ai][1][m][1] * rs;
                f32x4 h0, h1;
#pragma unroll
                for (int j = 0; j < 4; ++j) { h0[j] = silu_f(g0[j]) * u0[j]; h1[j] = silu_f(g1[j]) * u1[j]; }
                u32x4 w; w.x = cvt_pk_bf16(h0[0], h0[1]); w.y = cvt_pk_bf16(h0[2], h0[3]); w.z = cvt_pk_bf16(h1[0], h1[1]); w.w = cvt_pk_bf16(h1[2], h1[3]);
                *(u32x4*)(H + (size_t)row * 3584 + col0) = w; }
    }
};
struct EpiMoeOut {
    static constexpr bool PERM = true, AFTER_DRAIN = false;
    const int* rtok; const float* rgate; bf16_t* OS; int M;
    __device__ __forceinline__ void operator()(const f32x4 (&acc)[2][2][4][2], const Unit& u, int wr, int wc, int fr, int fq) const {
        const int row0 = u.pm * BM + wr * 64 + fr, col0 = (u.pn & 3) * BM + wc * 32 + 8 * fq;
#pragma unroll
        for (int ai = 0; ai < 2; ++ai)
#pragma unroll
            for (int m = 0; m < 4; ++m) { const int row = row0 + ai * HALF + m * 16; const int tk = rtok[row]; const float gt = rgate[row];
                if (tk >= 0) { bf16_t* rowp = OS + ((size_t)(tk & 1) * M + (tk >> 1)) * 1024 + col0;
#pragma unroll
                    for (int bj = 0; bj < 2; ++bj) { const f32x4 v0 = acc[ai][bj][m][0] * gt, v1 = acc[ai][bj][m][1] * gt;
                        u32x4 w; w.x = cvt_pk_bf16(v0[0], v0[1]); w.y = cvt_pk_bf16(v0[2], v0[3]); w.z = cvt_pk_bf16(v1[0], v1[1]); w.w = cvt_pk_bf16(v1[2], v1[3]);
                        *(u32x4*)(rowp + bj * HALF) = w; } } }
    }
};

template <class Epi, class Sched, bool ALIGN_EPI = false, bool SP2 = false>
__device__ __forceinline__ void gemm_phase(PG8_LAS unsigned char* lds, const Gemm g, const Sched& S, const Epi& E) {
    const int tid = threadIdx.x, wid = __builtin_amdgcn_readfirstlane(tid >> 6), lane = tid & 63, wr = wid >> 2, wc = wid & 3, fr = lane & 15, fq = lane >> 4;
    const int K = g.K, nt = K / BK;
    unsigned voffA[2], voffB[2];
#pragma unroll
    for (int i = 0; i < 2; ++i) { int R, C; stage_rc(tid * 16 + i * 8192, R, C); const int Rb = Epi::PERM ? ((R & ~31) + perm32(R & 31)) : R;
        voffA[i] = (unsigned)(R * K + C) * 2u; voffB[i] = (unsigned)(Rb * K + C) * 2u; }
    const size_t kstep = (size_t)(BK * 2);
    const size_t hstep = (size_t)HALF * K * 2;
    const size_t tstep = 2 * hstep;
    const unsigned ldsw = (unsigned)wid * 1024u;
    const int aoff = lds_byte(wr * 64 + fr, fq * 8), boff = lds_byte(wc * 32 + fr, fq * 8);
#define PG8_SA(b, h) (((b) * 2 + (h)) * HTB)
#define PG8_SB(b, h) ((4 + (b) * 2 + (h)) * HTB)
#define PG8_STAGE(bufoff, gbase, voff) do { _Pragma("unroll") for (int _i = 0; _i < 2; ++_i) \
        __builtin_amdgcn_global_load_lds((const unsigned*)((const char*)(gbase) + (voff)[_i]), (PG8_LAS unsigned*)(lds + (bufoff) + ldsw + _i * 8192), 16, 0, 0); } while (0)
#define PG8_LDA(dst, b, h) do { _Pragma("unroll") for (int m = 0; m < 4; ++m) _Pragma("unroll") for (int k = 0; k < 2; ++k) dst[m][k] = *(const PG8_LAS bf16x8*)(lds + PG8_SA(b, h) + aoff + m * 2048 + k * 1024); } while (0)
#define PG8_LDB(dst, b, h) do { _Pragma("unroll") for (int n = 0; n < 2; ++n) _Pragma("unroll") for (int k = 0; k < 2; ++k) dst[n][k] = *(const PG8_LAS bf16x8*)(lds + PG8_SB(b, h) + boff + n * 2048 + k * 1024); } while (0)
#define PG8_MMA(ai, bj, At, Bt) do { __builtin_amdgcn_s_setprio(1); _Pragma("unroll") for (int m = 0; m < 4; ++m) _Pragma("unroll") for (int n = 0; n < 2; ++n) _Pragma("unroll") for (int k = 0; k < 2; ++k) \
        acc[ai][bj][m][n] = __builtin_amdgcn_mfma_f32_16x16x32_bf16(Bt[n][k], At[m][k], acc[ai][bj][m][n], 0, 0, 0); __builtin_amdgcn_s_setprio(0); } while (0)
#define PG8_WAIT_V(n) asm volatile("s_waitcnt vmcnt(" #n ")" ::: "memory")
#define PG8_WAIT_L(n) asm volatile("s_waitcnt lgkmcnt(" #n ")" ::: "memory")
#define PG8_BAR __builtin_amdgcn_s_barrier()
#define PG8_SCHED __builtin_amdgcn_sched_barrier(0)
    Unit cur, nxt; int ui = 0;
    if (!S.next(0, cur)) return;
    f32x4 acc[2][2][4][2];
#pragma unroll
    for (int a = 0; a < 2; ++a)
#pragma unroll
        for (int b = 0; b < 2; ++b)
#pragma unroll
            for (int m = 0; m < 4; ++m)
#pragma unroll
                for (int n = 0; n < 2; ++n) acc[a][b][m][n] = (f32x4){0.f, 0.f, 0.f, 0.f};
    bf16x8 At[4][2], B0[2][2], B1[2][2];
    const char* cA = (const char*)g.A + (size_t)cur.pm * tstep; const char* cB = (const char*)g.Bt + (size_t)cur.pn * tstep;
    S.a_ready(cur);
    if constexpr (SP2) {
        PG8_STAGE(PG8_SB(0, 0), cB, voffB); PG8_STAGE(PG8_SB(0, 1), cB + hstep, voffB); PG8_STAGE(PG8_SA(0, 0), cA, voffA); PG8_STAGE(PG8_SA(0, 1), cA + hstep, voffA);
        if (wr == 1) PG8_BAR;
        PG8_WAIT_V(2); PG8_BAR;
        PG8_STAGE(PG8_SB(1, 0), cB + kstep, voffB); PG8_STAGE(PG8_SA(1, 0), cA + kstep, voffA); PG8_STAGE(PG8_SB(1, 1), cB + hstep + kstep, voffB);
        PG8_WAIT_V(6); PG8_BAR;
    } else {
        PG8_STAGE(PG8_SB(0, 0), cB, voffB); PG8_STAGE(PG8_SA(0, 0), cA, voffA); PG8_STAGE(PG8_SB(0, 1), cB + hstep, voffB); PG8_STAGE(PG8_SA(0, 1), cA + hstep, voffA);
        if (wr == 1) PG8_BAR;
        PG8_WAIT_V(4); PG8_BAR;
        PG8_STAGE(PG8_SB(1, 0), cB + kstep, voffB); PG8_STAGE(PG8_SA(1, 0), cA + kstep, voffA); PG8_STAGE(PG8_SB(1, 1), cB + hstep + kstep, voffB);
        PG8_WAIT_V(6); PG8_BAR;
    }
    for (;;) {
        const bool has_next = S.next(ui + 1, nxt);
        const char* nA = has_next ? (const char*)g.A + (size_t)nxt.pm * tstep : cA; const char* nB = has_next ? (const char*)g.Bt + (size_t)nxt.pn * tstep : cB;
        for (int t = 0; t < nt; t += 2) {
            const bool last = (t == nt - 2);
            const char* a1 = cA + (size_t)(t + 1) * kstep;
            const char* a2 = last ? nA : cA + (size_t)(t + 2) * kstep; const char* b2 = last ? nB : cB + (size_t)(t + 2) * kstep;
            const char* a3 = a2 + kstep; const char* b3 = b2 + kstep;
            if (last && has_next) S.a_ready(nxt);
            if constexpr (SP2) {
            PG8_LDB(B0, 0, 0); PG8_LDB(B1, 0, 1); PG8_SCHED; PG8_LDA(At, 0, 0); PG8_STAGE(PG8_SA(1, 1), a1 + hstep, voffA);
            PG8_WAIT_V(8); PG8_WAIT_L(0); PG8_BAR; PG8_MMA(0, 0, At, B0); PG8_MMA(0, 1, At, B1); PG8_BAR; PG8_SCHED;
            PG8_LDA(At, 0, 1); PG8_STAGE(PG8_SB(0, 0), b2, voffB); PG8_STAGE(PG8_SB(0, 1), b2 + hstep, voffB); PG8_STAGE(PG8_SA(0, 0), a2, voffA);
            PG8_WAIT_V(8); PG8_WAIT_L(0); PG8_BAR; PG8_MMA(1, 0, At, B0); PG8_MMA(1, 1, At, B1); PG8_BAR; PG8_SCHED;
            PG8_LDB(B0, 1, 0); PG8_LDB(B1, 1, 1); PG8_SCHED; PG8_LDA(At, 1, 0); PG8_STAGE(PG8_SA(0, 1), a2 + hstep, voffA);
            PG8_WAIT_V(8); PG8_WAIT_L(0); PG8_BAR; PG8_MMA(0, 0, At, B0); PG8_MMA(0, 1, At, B1); PG8_BAR; PG8_SCHED;
            PG8_LDA(At, 1, 1); PG8_STAGE(PG8_SB(1, 0), b3, voffB); PG8_STAGE(PG8_SB(1, 1), b3 + hstep, voffB); PG8_STAGE(PG8_SA(1, 0), a3, voffA);
            PG8_WAIT_V(8); PG8_WAIT_L(0); PG8_BAR; PG8_MMA(1, 0, At, B0); PG8_MMA(1, 1, At, B1); PG8_BAR; PG8_SCHED;
            } else {
            PG8_LDB(B0, 0, 0); PG8_SCHED; PG8_LDA(At, 0, 0); PG8_STAGE(PG8_SA(1, 1), a1 + hstep, voffA);
            PG8_WAIT_L(8); PG8_BAR; PG8_WAIT_L(0); PG8_MMA(0, 0, At, B0); PG8_BAR; PG8_SCHED;
            PG8_LDB(B1, 0, 1); PG8_STAGE(PG8_SB(0, 0), b2, voffB);
            PG8_BAR; PG8_WAIT_L(0); PG8_MMA(0, 1, At, B1); PG8_BAR;
            PG8_LDA(At, 0, 1); PG8_STAGE(PG8_SA(0, 0), a2, voffA);
            PG8_BAR; PG8_WAIT_L(0); PG8_MMA(1, 0, At, B0); PG8_BAR; PG8_SCHED;
            PG8_STAGE(PG8_SB(0, 1), b2 + hstep, voffB);
            PG8_WAIT_V(6); PG8_BAR; PG8_MMA(1, 1, At, B1); PG8_BAR;
            PG8_LDB(B0, 1, 0); PG8_SCHED; PG8_LDA(At, 1, 0); PG8_STAGE(PG8_SA(0, 1), a2 + hstep, voffA);
            PG8_WAIT_L(8); PG8_BAR; PG8_WAIT_L(0); PG8_MMA(0, 0, At, B0); PG8_BAR; PG8_SCHED;
            PG8_LDB(B1, 1, 1); PG8_STAGE(PG8_SB(1, 0), b3, voffB);
            PG8_BAR; PG8_WAIT_L(0); PG8_MMA(0, 1, At, B1); PG8_BAR;
            PG8_LDA(At, 1, 1); PG8_STAGE(PG8_SA(1, 0), a3, voffA);
            PG8_BAR; PG8_WAIT_L(0); PG8_MMA(1, 0, At, B0); PG8_BAR; PG8_SCHED;
            PG8_STAGE(PG8_SB(1, 1), b3 + hstep, voffB);
            PG8_WAIT_V(6); PG8_BAR; PG8_MMA(1, 1, At, B1); PG8_BAR;
            }
        }
        if constexpr (ALIGN_EPI) { if (wr == 0) PG8_BAR; }
        if constexpr (!Epi::AFTER_DRAIN) { E(acc, cur, wr, wc, fr, fq); S.done(cur); }
        if (!has_next) break;
#pragma unroll
        for (int a = 0; a < 2; ++a)
#pragma unroll
            for (int b = 0; b < 2; ++b)
#pragma unroll
                for (int m = 0; m < 4; ++m)
#pragma unroll
                    for (int n = 0; n < 2; ++n) acc[a][b][m][n] = (f32x4){0.f, 0.f, 0.f, 0.f};
        cur = nxt; cA = nA; cB = nB; ++ui;
        if constexpr (ALIGN_EPI) { if (wr == 1) PG8_BAR; }
    }
    PG8_WAIT_V(0);
    if constexpr (!ALIGN_EPI) { if (wr == 0) PG8_BAR; }
    PG8_BAR;
    if constexpr (Epi::AFTER_DRAIN) { E.fused(acc, cur, wr, wc, fr, fq, lds, wid, lane); S.done(cur); }
#undef PG8_SA
#undef PG8_SB
#undef PG8_STAGE
#undef PG8_LDA
#undef PG8_LDB
#undef PG8_MMA
#undef PG8_WAIT_V
#undef PG8_WAIT_L
#undef PG8_BAR
#undef PG8_SCHED
}
}

constexpr int NWAVES = 8;
constexpr int BATCH = 8, SEQ = 4096, D = 1024, M = BATCH * SEQ;
constexpr int AW = 2048, FF = 3584, NE = 8;
constexpr int MROWS = 2 * M + NE * 256;
constexpr float EPS = 1e-6f;
#ifndef MK_ONE_LAUNCH
#define MK_ONE_LAUNCH 1
#endif
#ifndef MK_LAYERS
#define MK_LAYERS 4
#endif

constexpr size_t MiB = 1u << 20;
constexpr size_t WS_CTL = 0, CTL_ZERO_BYTES = 1 * MiB;
constexpr size_t WS_WA_IN = 2 * MiB, WS_WA_OUT = 18 * MiB, WS_WB_IN = 26 * MiB, WS_WB_OUT = 32 * MiB, WS_WC_IN = 34 * MiB, WS_WC_OUT = 40 * MiB;
constexpr size_t WS_WF_IN = 42 * MiB, WS_WF_OUT = 70 * MiB, WS_WM_IN = 84 * MiB, WS_WM_OUT = 308 * MiB;
constexpr size_t WS_X = 420 * MiB, WS_XB = 548 * MiB, WS_SSQ = 612 * MiB, WS_VSSQ = 614 * MiB, WS_GLOW = 618 * MiB, WS_LOGF = 620 * MiB, WS_OSSQ = 621 * MiB, WS_DEC = 629 * MiB;
constexpr size_t WS_TOKE = 630 * MiB, WS_TOKP = WS_TOKE + 256 * 1024, WS_TOKG = WS_TOKP + 256 * 1024, WS_TOKRS = WS_TOKG + 256 * 1024, WS_BLKB = WS_TOKRS + 128 * 1024;
constexpr size_t WS_ROWT = 632 * MiB, WS_ROWG = WS_ROWT + 512 * 1024, WS_ROWRS = WS_ROWG + 512 * 1024;
constexpr size_t WS_ACT = 640 * MiB;
constexpr size_t WS_U = WS_ACT, WS_V = WS_ACT + 128 * MiB, WS_Y = WS_ACT + 256 * MiB;
constexpr size_t WS_HF = WS_ACT;
constexpr size_t WS_QKVR = WS_ACT, WS_QD = WS_ACT + 192 * MiB, WS_KD = WS_ACT + 224 * MiB, WS_KET = WS_ACT + 256 * MiB, WS_VT = WS_ACT + 288 * MiB, WS_GO = WS_ACT + 352 * MiB, WS_GG = WS_ACT + 416 * MiB;
constexpr size_t WS_AO = WS_ACT + 192 * MiB;
constexpr size_t WS_XS = WS_ACT, WS_HM = WS_ACT + 132 * MiB, WS_OS = WS_ACT + 594 * MiB;
constexpr size_t WS_END = WS_ACT + 722 * MiB;
static_assert((size_t)MROWS * 1024 * 2 <= 132 * MiB && (size_t)MROWS * FF * 2 <= 462 * MiB, "MoE buffers");
constexpr int CW_TMO = 0, CW_CODE = 1, CW_BAR = 4096, CW_CNT = 8192;

constexpr int RING_OFF = 0, RING_BYTES = 131072;
constexpr int LDSCTL_OFF = RING_BYTES, MISC_OFF = LDSCTL_OFF + 320;
constexpr int LDS_BYTES = 147456;
static_assert(MISC_OFF + 128 <= LDS_BYTES, "LDS map");

#define GAS __attribute__((address_space(1)))
#define LAS __attribute__((address_space(3)))
#define DI __device__ __forceinline__
typedef unsigned short bf16;
typedef unsigned v4u __attribute__((ext_vector_type(4)));
typedef unsigned v2u __attribute__((ext_vector_type(2)));
typedef float f32x4 __attribute__((ext_vector_type(4)));
typedef short bf16x8 __attribute__((ext_vector_type(8)));
typedef short bf16x4 __attribute__((ext_vector_type(4)));
typedef GAS unsigned gu32;
#define RLX_AGENT __ATOMIC_RELAXED, __HIP_MEMORY_SCOPE_AGENT
#define LDS_WAIT() asm volatile("s_waitcnt lgkmcnt(0)" ::: "memory")
#define VM_WAIT() asm volatile("s_waitcnt vmcnt(0)" ::: "memory")
DI unsigned f2bf(float f) { unsigned u = __builtin_bit_cast(unsigned, f); return (u + 0x7fffu + ((u >> 16) & 1u)) >> 16; }
DI unsigned pk2(float lo, float hi) { return f2bf(lo) | (f2bf(hi) << 16); }
DI float bflo(unsigned w) { return __builtin_bit_cast(float, w << 16); }
DI float bfhi(unsigned w) { return __builtin_bit_cast(float, w & 0xffff0000u); }
DI float bf2f(bf16 h) { return __builtin_bit_cast(float, ((unsigned)h) << 16); }
DI float wave_sum(float v) {
#pragma unroll
    for (int o = 1; o < 64; o <<= 1) v += __shfl_xor(v, o);
    return v;
}
DI float logsig(float z) { return fminf(z, 0.f) - log1pf(__expf(-fabsf(z))); }
#define MFMA16(a, b, c) __builtin_amdgcn_mfma_f32_16x16x32_bf16((a), (b), (c), 0, 0, 0)
DI bf16x8 ldsfrag(LAS const unsigned char* p) { return *(LAS const bf16x8*)p; }
#define XB_TMO      128
#define XB_XCNT(j)  (256  + 64 * (j))
#define XB_XSUB(j)  (1280 + 64 * (j))
#define XB_XGEN(j)  (2304 + 64 * (j))
#define XB_TOP      3328
#define XB_TOPGEN   3392
#define XCD_BAR_WORDS 3456
#define XB_SPIN_CAP (1u << 18)

__device__ __forceinline__ unsigned xb_ld(unsigned* p)              { return __hip_atomic_load(p, __ATOMIC_RELAXED, __HIP_MEMORY_SCOPE_AGENT); }
__device__ __forceinline__ unsigned xb_add(unsigned* p, unsigned v) { return __hip_atomic_fetch_add(p, v, __ATOMIC_RELAXED, __HIP_MEMORY_SCOPE_AGENT); }
__device__ __forceinline__ unsigned xb_xcc_id() { return (unsigned)__builtin_amdgcn_s_getreg((3 << 11) | 20) & 0xFu; }
#define XB_SPIN(cond, bar) do { unsigned _sp = 0; while (cond) { __builtin_amdgcn_s_sleep(1); \
    if ((++_sp & 255u) == 0u) { if (xb_ld(&(bar)[XB_TMO])) break; if (_sp > XB_SPIN_CAP) { atomicAdd(&(bar)[XB_TMO], 1u); break; } } } } while (0)

struct XcdBarrier {
    unsigned* bar; unsigned x;
    volatile LAS unsigned* st;
};

__device__ __forceinline__ XcdBarrier xcd_barrier_post(unsigned* bar, volatile LAS unsigned* st) {
    XcdBarrier b; b.bar = bar; b.x = xb_xcc_id(); b.st = st;
    if (threadIdx.x == 0) (void)xb_add(&bar[XB_XCNT(b.x)], 1u);
    return b;
}
__device__ __forceinline__ void xcd_barrier_complete(unsigned* bar, unsigned x, unsigned& nloc, unsigned& nx) {
    const unsigned G = gridDim.x * gridDim.y * gridDim.z;
    unsigned sum, cnt, mine, sp = 0u;
    for (;;) {
        sum = 0u; cnt = 0u; mine = 0u;
#pragma unroll
        for (unsigned j = 0; j < 16; ++j) { const unsigned c = xb_ld(&bar[XB_XCNT(j)]); sum += c; cnt += (c > 0u) ? 1u : 0u; mine = (j == x) ? c : mine; }
        if (sum == G) break;
        __builtin_amdgcn_s_sleep(1);
        if ((++sp & 255u) == 0u) { if (xb_ld(&bar[XB_TMO])) break; if (sp > XB_SPIN_CAP) { atomicAdd(&bar[XB_TMO], 1u); break; } }
    }
    nloc = mine > 0u ? mine : 1u; nx = cnt > 0u ? cnt : 1u;
}

__device__ __forceinline__ void xcd_barrier(const XcdBarrier& b) {
    asm volatile("s_waitcnt vmcnt(0)" ::: "memory");
    __syncthreads();
    if (threadIdx.x == 0) {
        unsigned* bar = b.bar;
        __builtin_amdgcn_s_waitcnt(0);
        unsigned nloc = b.st[0], nx = b.st[1];
        if (nloc == 0u) { xcd_barrier_complete(bar, b.x, nloc, nx); b.st[0] = nloc; b.st[1] = nx; }
        const unsigned old = xb_add(&bar[XB_XSUB(b.x)], 1u);
        const unsigned gen = old / nloc;
        if (old + 1u == (gen + 1u) * nloc) {
            __builtin_amdgcn_fence(__ATOMIC_RELEASE, "agent");
            asm volatile("s_waitcnt vmcnt(0)" ::: "memory");
            const unsigned og = xb_add(&bar[XB_TOP], 1u);
            const unsigned tg = og / nx;
            if (og + 1u == (tg + 1u) * nx) xb_add(&bar[XB_TOPGEN], 1u);
            else XB_SPIN(xb_ld(&bar[XB_TOPGEN]) == tg, bar);
            __builtin_amdgcn_fence(__ATOMIC_ACQUIRE, "agent");
            xb_add(&bar[XB_XGEN(b.x)], 1u);
            asm volatile("s_waitcnt vmcnt(0)" ::: "memory");
        } else {
            XB_SPIN(xb_ld(&bar[XB_XGEN(b.x)]) == gen, bar);
            __builtin_amdgcn_fence(__ATOMIC_ACQUIRE, "agent");
            asm volatile("s_waitcnt vmcnt(0)" ::: "memory");
        }
    }
    __syncthreads();
}

struct Frame {
    LAS unsigned char* lds;
    volatile LAS unsigned* MISC;
    gu32* ctl;
    int tid, lane, wave;
    int vcu, G;
    float* out; unsigned char* ws;
};
template <class T> DI T* wsp(const Frame& F, size_t off) { return (T*)(F.ws + off); }

struct MatDesc { const float* W; int ldw, K, N; bf16* WT; int mode; const float* gain; };
template <class A> DI MatDesc get_mat(const Frame& F, const A& P, int idx) {
    MatDesc d;
    if (idx < 2)        { const int j = idx;      d.W = P.in[3] + (size_t)j * 1024 * 4096; d.ldw = 4096; d.K = 1024; d.N = 4096; d.WT = wsp<bf16>(F, WS_WA_IN) + (size_t)j * 4096 * 1024; d.mode = 0; d.gain = P.in[1] + (j ? 3 : 0) * 1024; }
    else if (idx < 4)   { const int j = idx - 2;  d.W = P.in[7] + (size_t)j * 2048 * 1024; d.ldw = 1024; d.K = 2048; d.N = 1024; d.WT = wsp<bf16>(F, WS_WA_OUT) + (size_t)j * 1024 * 2048; d.mode = 0; d.gain = nullptr; }
    else if (idx == 4)  { d.W = P.in[8];  d.ldw = 3088; d.K = 1024; d.N = 3072; d.WT = wsp<bf16>(F, WS_WB_IN);  d.mode = 0; d.gain = P.in[1] + 1 * 1024; }
    else if (idx == 5)  { d.W = P.in[12]; d.ldw = 1024; d.K = 1024; d.N = 1024; d.WT = wsp<bf16>(F, WS_WB_OUT); d.mode = 0; d.gain = nullptr; }
    else if (idx == 6)  { d.W = P.in[13]; d.ldw = 3080; d.K = 1024; d.N = 3072; d.WT = wsp<bf16>(F, WS_WC_IN);  d.mode = 0; d.gain = P.in[1] + 2 * 1024; }
    else if (idx == 7)  { d.W = P.in[15]; d.ldw = 1024; d.K = 1024; d.N = 1024; d.WT = wsp<bf16>(F, WS_WC_OUT); d.mode = 0; d.gain = nullptr; }
    else if (idx < 10)  { const int i = idx - 8;  d.W = P.in[16] + (size_t)i * 1024 * 7168; d.ldw = 7168; d.K = 1024; d.N = 7168; d.WT = wsp<bf16>(F, WS_WF_IN) + (size_t)i * 7168 * 1024; d.mode = 1; d.gain = P.in[2] + (2 * i) * 1024; }
    else if (idx < 12)  { const int i = idx - 10; d.W = P.in[17] + (size_t)i * 3584 * 1024; d.ldw = 1024; d.K = 3584; d.N = 1024; d.WT = wsp<bf16>(F, WS_WF_OUT) + (size_t)i * 1024 * 3584; d.mode = 0; d.gain = nullptr; }
    else if (idx < 28)  { const int q = idx - 12; d.W = P.in[19] + (size_t)q * 1024 * 7168; d.ldw = 7168; d.K = 1024; d.N = 7168; d.WT = wsp<bf16>(F, WS_WM_IN) + (size_t)q * 7168 * 1024; d.mode = 1; d.gain = P.in[2] + (2 * (q >> 3) + 1) * 1024; }
    else                { const int q = idx - 28; d.W = P.in[20] + (size_t)q * 3584 * 1024; d.ldw = 1024; d.K = 3584; d.N = 1024; d.WT = wsp<bf16>(F, WS_WM_OUT) + (size_t)q * 1024 * 3584; d.mode = 0; d.gain = nullptr; }
    return d;
}
constexpr int NMATS = 44;
DI void p0_transpose_item(const MatDesc& d, LAS float* scr, int item, int lane) {
    const int nblk = d.N / 32, kb = item / nblk, nb = item % nblk, k0 = 64 * kb, n0 = 32 * nb;
#pragma unroll 8
    for (int i = 0; i < 32; ++i) { const int kk = 2 * i + (lane >> 5); const float g = d.gain ? d.gain[k0 + kk] : 1.0f; scr[kk * 33 + (lane & 31)] = g * d.W[(size_t)(k0 + kk) * d.ldw + n0 + (lane & 31)]; }
    LDS_WAIT(); asm volatile("" ::: "memory");
    const int c = lane & 7;
    int drow0 = n0;
    if (d.mode == 1) { if (n0 < FF) drow0 = (n0 >> 7) * 256 + (n0 & 127); else { const int f = n0 - FF; drow0 = (f >> 7) * 256 + 128 + (f & 127); } }
#pragma unroll
    for (int j = 0; j < 4; ++j) { const int n = (lane >> 3) + 8 * j; const LAS float* s = scr + (8 * c) * 33 + n;
        v4u o; o.x = pk2(s[0 * 33], s[1 * 33]); o.y = pk2(s[2 * 33], s[3 * 33]); o.z = pk2(s[4 * 33], s[5 * 33]); o.w = pk2(s[6 * 33], s[7 * 33]);
        *(v4u*)(d.WT + (size_t)(drow0 + n) * d.K + k0 + 8 * c) = o; }
    LDS_WAIT(); asm volatile("" ::: "memory");
}
template <class A> DI void p0_prologue(Frame& F, const A& P) {
    LAS float* scr = (LAS float*)(F.lds + RING_OFF + F.wave * 16384);
    const int gw = F.vcu * NWAVES + F.wave, NGW = F.G * NWAVES;
    { const float* x = P.in[0]; bf16* xb = wsp<bf16>(F, WS_XB); float* ssq = wsp<float>(F, WS_SSQ);
      for (int m = gw; m < M; m += NGW) {
        const f32x4* xr = (const f32x4*)(x + (size_t)m * D) + F.lane; f32x4 v[4]; float s = 0.f;
#pragma unroll
        for (int j = 0; j < 4; ++j) { v[j] = xr[64 * j]; s += (v[j][0] * v[j][0] + v[j][1] * v[j][1]) + (v[j][2] * v[j][2] + v[j][3] * v[j][3]); }
        s = wave_sum(s);
        v2u* o8 = (v2u*)(xb + (size_t)m * D) + F.lane;
#pragma unroll
        for (int j = 0; j < 4; ++j) { v2u w; w.x = pk2(v[j][0], v[j][1]); w.y = pk2(v[j][2], v[j][3]); o8[64 * j] = w; }
        if (F.lane < 4) { f32x4 z = {0.f, 0.f, 0.f, 0.f}; if (F.lane == 0) z[0] = s; *((f32x4*)(ssq + (size_t)m * 16) + F.lane) = z; }
      } }
    int base = 0;
    for (int mi = 0; mi < NMATS; ++mi) {
        const MatDesc d = get_mat(F, P, mi);
        const int nitems = (d.K / 64) * (d.N / 32);
        int first = (gw - base) % NGW; if (first < 0) first += NGW;
        for (int it = first; it < nitems; it += NGW) p0_transpose_item(d, scr, it, F.lane);
        base = (base + nitems) % NGW;
    }
}

template <int NOUT> DI void thin_stage(Frame& F, const float* gain, const float* W, int ldw, int c0) {
    LAS float* wl = (LAS float*)(F.lds);
    for (int i = F.tid; i < 1024 * NOUT; i += NWAVES * 64) { const int k = i / NOUT, j = i % NOUT; wl[k * (NOUT + 4) + j] = gain[k] * W[(size_t)k * ldw + c0 + j]; }
    __syncthreads();
}
template <int NOUT> DI void thin_row(const float* xrow, LAS const float* wl, int lane, float& ss, float (&acc)[NOUT]) {
    float xv[16];
#pragma unroll
    for (int i = 0; i < 16; ++i) xv[i] = xrow[lane + 64 * i];
    ss = 0.f;
#pragma unroll
    for (int j = 0; j < NOUT; ++j) acc[j] = 0.f;
#pragma unroll
    for (int i = 0; i < 16; ++i) { ss += xv[i] * xv[i]; const LAS f32x4* wr = (const LAS f32x4*)(wl + (lane + 64 * i) * (NOUT + 4));
#pragma unroll
        for (int q = 0; q < NOUT / 4; ++q) { const f32x4 w = wr[q];
#pragma unroll
            for (int e = 0; e < 4; ++e) acc[4 * q + e] += xv[i] * w[e]; }
        __builtin_amdgcn_sched_barrier(0); }
    ss = wave_sum(ss);
#pragma unroll
    for (int j = 0; j < NOUT; ++j) acc[j] = wave_sum(acc[j]);
}
DI void glow_phase(Frame& F, const float* x, const float* gain, const float* Wb) {
    thin_stage<16>(F, gain, Wb, 3088, 3072);
    float* glow = wsp<float>(F, WS_GLOW);
    const int gw = F.vcu * NWAVES + F.wave, NGW = F.G * NWAVES;
    for (int row = gw; row < M; row += NGW) { float ss, acc[16]; thin_row<16>(x + (size_t)row * D, (LAS const float*)F.lds, F.lane, ss, acc);
        const float rs = 1.0f / sqrtf(ss * (1.0f / D) + EPS);
        if (F.lane == 0) {
#pragma unroll
            for (int q = 0; q < 4; ++q) { f32x4 o = {acc[4 * q] * rs, acc[4 * q + 1] * rs, acc[4 * q + 2] * rs, acc[4 * q + 3] * rs}; *((f32x4*)(glow + (size_t)row * 16) + q) = o; } } }
    __syncthreads();
}
DI void logf_phase(Frame& F, const float* x, const float* gain, const float* Wc, const float* fb) {
    thin_stage<8>(F, gain, Wc, 3080, 3072);
    float* logf = wsp<float>(F, WS_LOGF);
    const int gw = F.vcu * NWAVES + F.wave, NGW = F.G * NWAVES;
    for (int row = gw; row < M; row += NGW) { float ss, acc[8]; thin_row<8>(x + (size_t)row * D, (LAS const float*)F.lds, F.lane, ss, acc);
        const float rs = 1.0f / sqrtf(ss * (1.0f / D) + EPS);
        if (F.lane == 0) {
#pragma unroll
            for (int q = 0; q < 2; ++q) { f32x4 o;
#pragma unroll
                for (int e = 0; e < 4; ++e) o[e] = logsig(acc[4 * q + e] * rs + fb[4 * q + e]);
                *((f32x4*)(logf + (size_t)row * 8) + q) = o; } } }
    __syncthreads();
}
DI void router_phase(Frame& F, const float* x, const float* gain, const float* Wr, unsigned* gcnt) {
    thin_stage<8>(F, gain, Wr, 8, 0);
    LAS unsigned* lcnt = (LAS unsigned*)(F.lds + 65536);
    if (F.tid < 8) lcnt[F.tid] = 0u;
    __syncthreads();
    int* tok_e = wsp<int>(F, WS_TOKE); int* tok_p = wsp<int>(F, WS_TOKP); float* tok_g = wsp<float>(F, WS_TOKG); float* tok_rs = wsp<float>(F, WS_TOKRS); int* blkb = wsp<int>(F, WS_BLKB);
    const int gw = F.vcu * NWAVES + F.wave, NGW = F.G * NWAVES;
    for (int row = gw; row < M; row += NGW) { float ss, acc[8]; thin_row<8>(x + (size_t)row * D, (LAS const float*)F.lds, F.lane, ss, acc);
        const float rs = 1.0f / sqrtf(ss * (1.0f / D) + EPS);
        float v1 = acc[0] * rs; int i1 = 0;
#pragma unroll
        for (int e = 1; e < 8; ++e) { const float v = acc[e] * rs; if (v > v1) { v1 = v; i1 = e; } }
        float v2 = -3.0e38f; int i2 = 0;
#pragma unroll
        for (int e = 0; e < 8; ++e) { const float v = acc[e] * rs; if (e != i1 && v > v2) { v2 = v; i2 = e; } }
        const float g1 = 1.0f / (1.0f + __expf(v2 - v1)), g2 = 1.0f - g1;
        if (F.lane == 0) {
            const unsigned p1 = __hip_atomic_fetch_add(lcnt + i1, 1u, __ATOMIC_RELAXED, __HIP_MEMORY_SCOPE_WORKGROUP);
            const unsigned p2 = __hip_atomic_fetch_add(lcnt + i2, 1u, __ATOMIC_RELAXED, __HIP_MEMORY_SCOPE_WORKGROUP);
            tok_e[2 * row] = i1; tok_e[2 * row + 1] = i2; tok_p[2 * row] = (int)p1; tok_p[2 * row + 1] = (int)p2; tok_g[2 * row] = g1; tok_g[2 * row + 1] = g2; tok_rs[row] = rs; } }
    __syncthreads();
    if (F.tid < 8) { const unsigned b = __hip_atomic_fetch_add(gcnt + F.tid, lcnt[F.tid], __ATOMIC_RELAXED, __HIP_MEMORY_SCOPE_AGENT); blkb[F.vcu * 8 + F.tid] = (int)b; }
    __syncthreads();
}
DI void gather_phase(Frame& F, const unsigned* gcnt) {
    LAS int* seg = (LAS int*)(F.lds); LAS int* cntl = seg + 16;
    if (F.tid == 0) { int t = 0; for (int e = 0; e < 8; ++e) { const int c = (int)gcnt[e]; seg[e] = t; cntl[e] = c; t += (c + 255) & ~255; } seg[8] = t; }
    __syncthreads();
    const int* tok_e = wsp<int>(F, WS_TOKE); const int* tok_p = wsp<int>(F, WS_TOKP); const float* tok_g = wsp<float>(F, WS_TOKG); const float* tok_rs = wsp<float>(F, WS_TOKRS); const int* blkb = wsp<int>(F, WS_BLKB);
    int* rtok = wsp<int>(F, WS_ROWT); float* rgate = wsp<float>(F, WS_ROWG); float* rrs = wsp<float>(F, WS_ROWRS);
    const bf16* xb = wsp<bf16>(F, WS_XB); bf16* XS = wsp<bf16>(F, WS_XS);
    const int gw = F.vcu * NWAVES + F.wave, NGW = F.G * NWAVES;
    for (int row = gw; row < M; row += NGW) { const int owner = (row % NGW) / NWAVES;
        const v4u* src = (const v4u*)(xb + (size_t)row * D); const v4u a = src[F.lane], b = src[64 + F.lane];
#pragma unroll
        for (int slot = 0; slot < 2; ++slot) { const int e = tok_e[2 * row + slot]; const int r = seg[e] + blkb[owner * 8 + e] + tok_p[2 * row + slot];
            v4u* dst = (v4u*)(XS + (size_t)r * D); dst[F.lane] = a; dst[64 + F.lane] = b;
            if (F.lane == 0) { rtok[r] = 2 * row + slot; rgate[r] = tok_g[2 * row + slot]; rrs[r] = tok_rs[row]; } } }
    if (F.vcu == 0) { for (int e = 0; e < 8; ++e) for (int r = seg[e] + cntl[e] + F.tid; r < seg[e + 1]; r += NWAVES * 64) rtok[r] = -1; }
    __syncthreads();
}
DI void combine_phase(Frame& F, bool fin, const float* fg) {
    float* x = wsp<float>(F, WS_X); bf16* xb = wsp<bf16>(F, WS_XB); float* ssq = wsp<float>(F, WS_SSQ); const bf16* OS = wsp<bf16>(F, WS_OS);
    const int gw = F.vcu * NWAVES + F.wave, NGW = F.G * NWAVES;
    for (int m = gw; m < M; m += NGW) {
        const f32x4* xr = (const f32x4*)(x + (size_t)m * D) + F.lane; const v2u* o0 = (const v2u*)(OS + (size_t)m * D) + F.lane; const v2u* o1 = (const v2u*)(OS + ((size_t)M + m) * D) + F.lane;
        f32x4 v[4]; float s = 0.f;
#pragma unroll
        for (int j = 0; j < 4; ++j) { v[j] = xr[64 * j]; const v2u a = o0[64 * j], b = o1[64 * j];
            v[j][0] += bflo(a.x) + bflo(b.x); v[j][1] += bfhi(a.x) + bfhi(b.x); v[j][2] += bflo(a.y) + bflo(b.y); v[j][3] += bfhi(a.y) + bfhi(b.y);
            s += (v[j][0] * v[j][0] + v[j][1] * v[j][1]) + (v[j][2] * v[j][2] + v[j][3] * v[j][3]); }
        s = wave_sum(s);
        if (!fin) {
            f32x4* xw = (f32x4*)(x + (size_t)m * D) + F.lane; v2u* o8 = (v2u*)(xb + (size_t)m * D) + F.lane;
#pragma unroll
            for (int j = 0; j < 4; ++j) { xw[64 * j] = v[j]; v2u w; w.x = pk2(v[j][0], v[j][1]); w.y = pk2(v[j][2], v[j][3]); o8[64 * j] = w; }
            if (F.lane < 4) { f32x4 z = {0.f, 0.f, 0.f, 0.f}; if (F.lane == 0) z[0] = s; *((f32x4*)(ssq + (size_t)m * 16) + F.lane) = z; }
        } else {
            const float rs = 1.0f / sqrtf(s * (1.0f / D) + EPS); f32x4* ow = (f32x4*)(F.out + (size_t)m * D) + F.lane; const f32x4* g4 = (const f32x4*)fg + F.lane;
#pragma unroll
            for (int j = 0; j < 4; ++j) { const f32x4 g = g4[64 * j]; ow[64 * j] = v[j] * rs * g; }
        }
    }
}
DI void final_norm_phase(Frame& F, const float* x, const float* fg) {
    const int gw = F.vcu * NWAVES + F.wave, NGW = F.G * NWAVES;
    for (int m = gw; m < M; m += NGW) {
        const f32x4* xr = (const f32x4*)(x + (size_t)m * D) + F.lane; f32x4 v[4]; float s = 0.f;
#pragma unroll
        for (int j = 0; j < 4; ++j) { v[j] = xr[64 * j]; s += (v[j][0] * v[j][0] + v[j][1] * v[j][1]) + (v[j][2] * v[j][2] + v[j][3] * v[j][3]); }
        s = wave_sum(s);
        const float rs = 1.0f / sqrtf(s * (1.0f / D) + EPS); f32x4* ow = (f32x4*)(F.out + (size_t)m * D) + F.lane; const f32x4* g4 = (const f32x4*)fg + F.lane;
#pragma unroll
        for (int j = 0; j < 4; ++j) { const f32x4 g = g4[64 * j]; ow[64 * j] = v[j] * rs * g; }
    }
}

DI void mix_phase(Frame& F, const float* ws_, const float* bs, const float* vg) {
    constexpr int WT_OFF = 0, WT_ST = 272, VT_OFF = 34816, VT_ST = 272, RS_OFF = 104448;
    const bf16* U = wsp<bf16>(F, WS_U); const bf16* V = wsp<bf16>(F, WS_V); bf16* Y = wsp<bf16>(F, WS_Y); const float* vssq = wsp<float>(F, WS_VSSQ);
    LAS unsigned char* lds = F.lds; LAS float* rsv = (LAS float*)(lds + RS_OFF);
    const int tid = F.tid, lane = F.lane, w = F.wave, fr = lane & 15, fq = lane >> 4;
    for (int uidx = F.vcu; uidx < 2048; uidx += F.G) {
        const int c = uidx >> 3, g = uidx & 7; const int tok0 = c * 128;
        if (tid < 128) { const f32x4* p = (const f32x4*)(vssq + (size_t)(tok0 + tid) * 32); float s = 0.f;
#pragma unroll
            for (int q = 0; q < 8; ++q) { const f32x4 a = p[q]; s += (a[0] + a[1]) + (a[2] + a[3]); }
            rsv[tid] = 1.0f / sqrtf(s * (1.0f / AW) + EPS); }
        __syncthreads();
#pragma unroll
        for (int it = 0; it < 8; ++it) { const int idx = it * 512 + tid, t = idx >> 5, s4 = (idx & 31) * 4;
            const f32x4 wv = *(const f32x4*)(ws_ + ((size_t)g * 128 + t) * 128 + s4);
            float a0 = (s4 + 0 <= t) ? wv[0] * rsv[s4 + 0] : 0.f, a1 = (s4 + 1 <= t) ? wv[1] * rsv[s4 + 1] : 0.f, a2 = (s4 + 2 <= t) ? wv[2] * rsv[s4 + 2] : 0.f, a3 = (s4 + 3 <= t) ? wv[3] * rsv[s4 + 3] : 0.f;
            v2u o; o.x = pk2(a0, a1); o.y = pk2(a2, a3); *(LAS v2u*)(lds + WT_OFF + t * WT_ST + s4 * 2) = o; }
#pragma unroll
        for (int it = 0; it < 8; ++it) { const int idx = it * 512 + tid, s = (idx & 15) + 16 * (idx >> 9), d8 = ((idx >> 4) & 31) * 8;
            const v4u vv = *(const v4u*)(V + (size_t)(tok0 + s) * AW + g * 256 + d8);
            LAS unsigned short* p = (LAS unsigned short*)(lds + VT_OFF + d8 * VT_ST + s * 2);
            p[0 * (VT_ST / 2)] = (unsigned short)(vv.x & 0xffffu); p[1 * (VT_ST / 2)] = (unsigned short)(vv.x >> 16); p[2 * (VT_ST / 2)] = (unsigned short)(vv.y & 0xffffu); p[3 * (VT_ST / 2)] = (unsigned short)(vv.y >> 16);
            p[4 * (VT_ST / 2)] = (unsigned short)(vv.z & 0xffffu); p[5 * (VT_ST / 2)] = (unsigned short)(vv.z >> 16); p[6 * (VT_ST / 2)] = (unsigned short)(vv.w & 0xffffu); p[7 * (VT_ST / 2)] = (unsigned short)(vv.w >> 16); }
        __syncthreads();
        f32x4 acc[8][2];
#pragma unroll
        for (int mt = 0; mt < 8; ++mt) { acc[mt][0] = (f32x4){0.f, 0.f, 0.f, 0.f}; acc[mt][1] = (f32x4){0.f, 0.f, 0.f, 0.f}; }
#pragma unroll
        for (int ks = 0; ks < 4; ++ks) {
            const bf16x8 b0 = ldsfrag(lds + VT_OFF + (32 * w + fr) * VT_ST + (32 * ks + 8 * fq) * 2), b1 = ldsfrag(lds + VT_OFF + (32 * w + 16 + fr) * VT_ST + (32 * ks + 8 * fq) * 2);
#pragma unroll
            for (int mt = 0; mt < 8; ++mt) { if (32 * ks > 16 * mt + 15) continue;
                const bf16x8 a = ldsfrag(lds + WT_OFF + (16 * mt + fr) * WT_ST + (32 * ks + 8 * fq) * 2);
                acc[mt][0] = MFMA16(b0, a, acc[mt][0]); acc[mt][1] = MFMA16(b1, a, acc[mt][1]); } }
#pragma unroll
        for (int mt = 0; mt < 8; ++mt) { const int t = 16 * mt + fr; const float bt = bs[g * 128 + t];
#pragma unroll
            for (int n2 = 0; n2 < 2; ++n2) { const int col = g * 256 + 32 * w + 16 * n2 + 4 * fq; const size_t o = (size_t)(tok0 + t) * AW + col;
                const v2u uu = *(const v2u*)(U + o); const f32x4 gg = *(const f32x4*)(vg + col); const f32x4 a = acc[mt][n2];
                v2u r; r.x = pk2(bflo(uu.x) * (a[0] * gg[0] + bt), bfhi(uu.x) * (a[1] * gg[1] + bt)); r.y = pk2(bflo(uu.y) * (a[2] * gg[2] + bt), bfhi(uu.y) * (a[3] * gg[3] + bt));
                *(v2u*)(Y + o) = r; } }
        __syncthreads();
    }
}

DI void gla_prep_phase(Frame& F, const float* wg2, const float* gb) {
    const bf16* QKVR = wsp<bf16>(F, WS_QKVR); const float* glow = wsp<float>(F, WS_GLOW);
    bf16* QD = wsp<bf16>(F, WS_QD); bf16* KD = wsp<bf16>(F, WS_KD); bf16* KET = wsp<bf16>(F, WS_KET); bf16* VT = wsp<bf16>(F, WS_VT); float* DEC = wsp<float>(F, WS_DEC);
    LAS float* gl = (LAS float*)(F.lds); LAS float* segs = (LAS float*)(F.lds + 4096);
    const int tid = F.tid;
    for (int uidx = F.vcu; uidx < 2048; uidx += F.G) {
        const int h = uidx & 3, n = (uidx >> 2) & 63, b = uidx >> 8; const int t0 = b * SEQ + n * 64; const int bhn = (b * 4 + h) * 64 + n;
        if (tid < 256) *((LAS f32x4*)gl + tid) = *((const f32x4*)(glow + (size_t)t0 * 16) + tid);
        const int k = tid & 127, tq = tid >> 7;
        float wv[16];
#pragma unroll
        for (int r = 0; r < 16; ++r) wv[r] = wg2[r * 512 + h * 128 + k];
        const float bias = gb[h * 128 + k];
        __syncthreads();
        float bc[16]; float cum = 0.f;
#pragma unroll
        for (int i = 0; i < 16; ++i) { const LAS f32x4* gp = (const LAS f32x4*)(gl + (tq * 16 + i) * 16); float z = bias;
#pragma unroll
            for (int q = 0; q < 4; ++q) { const f32x4 g4 = gp[q]; z += g4[0] * wv[4 * q] + g4[1] * wv[4 * q + 1] + g4[2] * wv[4 * q + 2] + g4[3] * wv[4 * q + 3]; }
            cum += logsig(z) * (1.0f / 16.0f); bc[i] = cum; }
        segs[tq * 128 + k] = cum;
        __syncthreads();
        const float s0 = segs[k], s1 = segs[128 + k], s2 = segs[256 + k], s3 = segs[384 + k];
        const float offs = (tq > 0 ? s0 : 0.f) + (tq > 1 ? s1 : 0.f) + (tq > 2 ? s2 : 0.f); const float blast = (s0 + s1) + (s2 + s3);
        unsigned kep[8];
#pragma unroll
        for (int i = 0; i < 16; i += 2) { float ke2[2];
#pragma unroll
            for (int e = 0; e < 2; ++e) { const int ii = i + e; const size_t tok = (size_t)(t0 + tq * 16 + ii); const float bcum = bc[ii] + offs;
                const float qv = bf2f(QKVR[tok * 3072 + h * 128 + k]), kv = bf2f(QKVR[tok * 3072 + 512 + h * 128 + k]);
                QD[tok * 512 + h * 128 + k] = (bf16)f2bf(qv * 0.08838834764831845f * __expf(bcum));
                KD[tok * 512 + h * 128 + k] = (bf16)f2bf(kv * __expf(-bcum));
                ke2[e] = kv * __expf(blast - bcum); }
            kep[i >> 1] = pk2(ke2[0], ke2[1]); }
        { v4u* dst = (v4u*)(KET + ((size_t)bhn * 128 + k) * 64 + tq * 16); v4u o0 = {kep[0], kep[1], kep[2], kep[3]}, o1 = {kep[4], kep[5], kep[6], kep[7]}; dst[0] = o0; dst[1] = o1; }
        if (tq == 0) DEC[(size_t)bhn * 128 + k] = __expf(blast);
        { const int dv = tid & 255, sh = tid >> 8; unsigned vp[16];
#pragma unroll
          for (int i = 0; i < 32; i += 2) { const unsigned lo = QKVR[(size_t)(t0 + sh * 32 + i) * 3072 + 1024 + h * 256 + dv], hi = QKVR[(size_t)(t0 + sh * 32 + i + 1) * 3072 + 1024 + h * 256 + dv]; vp[i >> 1] = lo | (hi << 16); }
          v4u* dst = (v4u*)(VT + ((size_t)bhn * 256 + dv) * 64 + sh * 32);
#pragma unroll
          for (int q = 0; q < 4; ++q) { v4u o = {vp[4 * q], vp[4 * q + 1], vp[4 * q + 2], vp[4 * q + 3]}; dst[q] = o; } }
        __syncthreads();
    }
}

DI void gla_scan_phase(Frame& F) {
    constexpr int QD_OFF = 0, KD_OFF = 17408, KET_OFF = 34816, VT_OFF = 53248, ATT_OFF = 57856, ST_OFF = 67072, ST272 = 272, ST144 = 144;
    const bf16* QD = wsp<bf16>(F, WS_QD); const bf16* KD = wsp<bf16>(F, WS_KD); const bf16* KET = wsp<bf16>(F, WS_KET); const bf16* VT = wsp<bf16>(F, WS_VT); const float* DEC = wsp<float>(F, WS_DEC);
    bf16* GO = wsp<bf16>(F, WS_GO); float* ossq = wsp<float>(F, WS_OSSQ);
    LAS unsigned char* lds = F.lds;
    const int tid = F.tid, lane = F.lane, w = F.wave, fr = lane & 15, fq = lane >> 4;
    for (int uidx = F.vcu; uidx < 256; uidx += F.G) {
        const int vb = uidx & 7, h = (uidx >> 3) & 3, b = uidx >> 5;
        for (int i = tid; i < (32 * ST272) / 4; i += NWAVES * 64) ((LAS unsigned*)(lds + ST_OFF))[i] = 0u;
        f32x4 st[2] = {(f32x4){0.f, 0.f, 0.f, 0.f}, (f32x4){0.f, 0.f, 0.f, 0.f}};
        v4u pq[2], pk[2], pe[2], pv; float pdec;
#define GLA_LOAD(nn) do { const int bhn_ = (b * 4 + h) * 64 + (nn); const size_t t0_ = (size_t)b * SEQ + (size_t)(nn) * 64; \
            _Pragma("unroll") for (int i_ = 0; i_ < 2; ++i_) { const int c_ = tid + 512 * i_; const int r_ = c_ >> 4, ch_ = c_ & 15; \
                pq[i_] = *(const v4u*)(QD + (t0_ + r_) * 512 + h * 128 + ch_ * 8); pk[i_] = *(const v4u*)(KD + (t0_ + r_) * 512 + h * 128 + ch_ * 8); \
                pe[i_] = *(const v4u*)(KET + (size_t)bhn_ * 8192 + (size_t)c_ * 8); } \
            if (tid < 256) pv = *(const v4u*)(VT + ((size_t)bhn_ * 256 + vb * 32) * 64 + (size_t)tid * 8); \
            pdec = DEC[(size_t)bhn_ * 128 + 16 * w + fr]; } while (0)
        GLA_LOAD(0);
        for (int n = 0; n < 64; ++n) {
#pragma unroll
            for (int i = 0; i < 2; ++i) { const int c = tid + 512 * i; const int r = c >> 4, ch = c & 15;
                *(LAS v4u*)(lds + QD_OFF + r * ST272 + ch * 16) = pq[i]; *(LAS v4u*)(lds + KD_OFF + r * ST272 + ch * 16) = pk[i];
                const int rk = c >> 3, ck = c & 7; *(LAS v4u*)(lds + KET_OFF + rk * ST144 + ck * 16) = pe[i]; }
            if (tid < 256) { const int rv = tid >> 3, cv = tid & 7; *(LAS v4u*)(lds + VT_OFF + rv * ST144 + cv * 16) = pv; }
            const float dec = pdec;
            __syncthreads();
            if (n + 1 < 64) GLA_LOAD(n + 1);
            const int mt = w & 3, nt = w >> 2;
            const size_t tok0 = (size_t)b * SEQ + (size_t)n * 64;
            f32x4 oacc = {0.f, 0.f, 0.f, 0.f};
#pragma unroll
            for (int ks = 0; ks < 4; ++ks) { const bf16x8 a = ldsfrag(lds + QD_OFF + (16 * mt + fr) * ST272 + (32 * ks + 8 * fq) * 2), bb = ldsfrag(lds + ST_OFF + (16 * nt + fr) * ST272 + (32 * ks + 8 * fq) * 2);
                oacc = MFMA16(bb, a, oacc); }
#pragma unroll
            for (int q = 0; q < 2; ++q) { const int stile = 2 * nt + q; f32x4 sacc = {0.f, 0.f, 0.f, 0.f};
                if (stile <= mt) {
#pragma unroll
                    for (int ks = 0; ks < 4; ++ks) { const bf16x8 a = ldsfrag(lds + QD_OFF + (16 * mt + fr) * ST272 + (32 * ks + 8 * fq) * 2), bb = ldsfrag(lds + KD_OFF + (16 * stile + fr) * ST272 + (32 * ks + 8 * fq) * 2);
                        sacc = MFMA16(bb, a, sacc); } }
                const int t = 16 * mt + fr, s0 = 16 * stile + 4 * fq;
                const float a0 = (s0 + 0 <= t) ? sacc[0] : 0.f, a1 = (s0 + 1 <= t) ? sacc[1] : 0.f, a2 = (s0 + 2 <= t) ? sacc[2] : 0.f, a3 = (s0 + 3 <= t) ? sacc[3] : 0.f;
                v2u o; o.x = pk2(a0, a1); o.y = pk2(a2, a3); *(LAS v2u*)(lds + ATT_OFF + t * ST144 + s0 * 2) = o; }
#pragma unroll
            for (int vt = 0; vt < 2; ++vt) { st[vt] = st[vt] * dec;
#pragma unroll
                for (int ks = 0; ks < 2; ++ks) { const bf16x8 a = ldsfrag(lds + VT_OFF + (16 * vt + fr) * ST144 + (32 * ks + 8 * fq) * 2), bb = ldsfrag(lds + KET_OFF + (16 * w + fr) * ST144 + (32 * ks + 8 * fq) * 2);
                    st[vt] = MFMA16(a, bb, st[vt]); } }
            __syncthreads();
#pragma unroll
            for (int vt = 0; vt < 2; ++vt)
#pragma unroll
                for (int j = 0; j < 4; ++j) *(LAS unsigned short*)(lds + ST_OFF + (16 * vt + 4 * fq + j) * ST272 + (16 * w + fr) * 2) = (unsigned short)f2bf(st[vt][j]);
#pragma unroll
            for (int ks = 0; ks < 2; ++ks) { const bf16x8 a = ldsfrag(lds + ATT_OFF + (16 * mt + fr) * ST144 + (32 * ks + 8 * fq) * 2), bb = ldsfrag(lds + VT_OFF + (16 * nt + fr) * ST144 + (32 * ks + 8 * fq) * 2);
                oacc = MFMA16(bb, a, oacc); }
            { const size_t tok = tok0 + 16 * mt + fr; const int col = h * 256 + vb * 32 + 16 * nt + 4 * fq;
              v2u o; o.x = pk2(oacc[0], oacc[1]); o.y = pk2(oacc[2], oacc[3]); *(v2u*)(GO + tok * 1024 + col) = o;
              float sq = (oacc[0] * oacc[0] + oacc[1] * oacc[1]) + (oacc[2] * oacc[2] + oacc[3] * oacc[3]); sq += __shfl_xor(sq, 16); sq += __shfl_xor(sq, 32);
              if (fq == 0) ossq[(tok * 4 + h) * 16 + vb * 2 + nt] = sq; }
            __syncthreads();
        }
#undef GLA_LOAD
    }
}
DI void gla_gate_phase(Frame& F, const float* og) {
    const bf16* GO = wsp<bf16>(F, WS_GO); const bf16* QKVR = wsp<bf16>(F, WS_QKVR); const float* ossq = wsp<float>(F, WS_OSSQ); bf16* GG = wsp<bf16>(F, WS_GG);
    const int gw = F.vcu * NWAVES + F.wave, NGW = F.G * NWAVES, lane = F.lane;
    const int c0 = 16 * lane, hh = lane >> 4;
    f32x4 g4[4];
#pragma unroll
    for (int q = 0; q < 4; ++q) g4[q] = *(const f32x4*)(og + (c0 & 255) + 4 * q);
    for (int m = gw; m < M; m += NGW) {
        const f32x4* sp = (const f32x4*)(ossq + ((size_t)m * 4 + hh) * 16); float s = 0.f;
#pragma unroll
        for (int q = 0; q < 4; ++q) { const f32x4 a = sp[q]; s += (a[0] + a[1]) + (a[2] + a[3]); }
        const float rs = 1.0f / sqrtf(s * (1.0f / 256.0f) + EPS);
        const v4u* op = (const v4u*)(GO + (size_t)m * 1024 + c0); const v4u* rp = (const v4u*)(QKVR + (size_t)m * 3072 + 2048 + c0);
        v4u* dp = (v4u*)(GG + (size_t)m * 1024 + c0);
#pragma unroll
        for (int q = 0; q < 2; ++q) { const v4u o = op[q], r = rp[q]; v4u d; const f32x4 ga = g4[2 * q], gb = g4[2 * q + 1];
            d.x = pk2(bflo(o.x) * rs * ga[0] * pg8::silu_f(bflo(r.x)), bfhi(o.x) * rs * ga[1] * pg8::silu_f(bfhi(r.x)));
            d.y = pk2(bflo(o.y) * rs * ga[2] * pg8::silu_f(bflo(r.y)), bfhi(o.y) * rs * ga[3] * pg8::silu_f(bfhi(r.y)));
            d.z = pk2(bflo(o.z) * rs * gb[0] * pg8::silu_f(bflo(r.z)), bfhi(o.z) * rs * gb[1] * pg8::silu_f(bfhi(r.z)));
            d.w = pk2(bflo(o.w) * rs * gb[2] * pg8::silu_f(bflo(r.w)), bfhi(o.w) * rs * gb[3] * pg8::silu_f(bfhi(r.w)));
            dp[q] = d; }
    }
}

DI void fox_attn_phase(Frame& F) {
    constexpr int K_OFF = 0, KST = 272, V_OFF = 17408, VST = 144, C_OFF = 35840, WS_OFF = 52224;
    const bf16* QKV = wsp<bf16>(F, WS_QKVR); const float* logf = wsp<float>(F, WS_LOGF); bf16* AO = wsp<bf16>(F, WS_AO);
    LAS unsigned char* lds = F.lds; LAS float* cl = (LAS float*)(lds + C_OFF); LAS float* wsum = (LAS float*)(lds + WS_OFF);
    const int tid = F.tid, lane = F.lane, w = F.wave, fr = lane & 15, fq = lane >> 4;
    constexpr float SC2 = 0.08838834764831845f * 1.4426950408889634f, L2E = 1.4426950408889634f;
    for (int U = F.vcu; U < 1024; U += F.G) {
        const int r_ = U >> 8, v_ = U & 255, bh = v_ >> 2, i_ = v_ & 3; const int b = bh >> 3, h = bh & 7;
        const int qt = (r_ == 0) ? i_ : (r_ == 1) ? 7 - i_ : (r_ == 2) ? 8 + i_ : 15 - i_;
        const int nkeys = (qt + 1) * 256;
        { float v8[8]; float tot = 0.f; const int p0 = tid * 8;
#pragma unroll
          for (int e = 0; e < 8; ++e) { v8[e] = (p0 < nkeys) ? logf[((size_t)b * SEQ + p0 + e) * 8 + h] : 0.f; tot += v8[e]; v8[e] = tot; }
          float inc = tot;
#pragma unroll
          for (int o = 1; o < 64; o <<= 1) { const float t = __shfl_up(inc, o); if (lane >= o) inc += t; }
          if (lane == 63) wsum[w] = inc;
          __syncthreads();
          float woff = 0.f;
#pragma unroll
          for (int q = 0; q < 8; ++q) woff += (q < w) ? wsum[q] : 0.f;
          const float excl = woff + inc - tot;
          if (p0 < nkeys) {
#pragma unroll
              for (int e = 0; e < 8; ++e) cl[p0 + e] = excl + v8[e]; }
          __syncthreads(); }
        const int q0 = qt * 256 + 32 * w;
        bf16x8 qf[2][4]; float cq[2], mrow[2], lrow[2]; f32x4 oacc[2][8];
#pragma unroll
        for (int mt = 0; mt < 2; ++mt) { const size_t tok = (size_t)b * SEQ + q0 + 16 * mt + fr;
#pragma unroll
            for (int ks = 0; ks < 4; ++ks) qf[mt][ks] = *(const bf16x8*)(QKV + tok * 3072 + h * 128 + 32 * ks + 8 * fq);
            cq[mt] = cl[q0 + 16 * mt + fr] * L2E; mrow[mt] = -1.0e30f; lrow[mt] = 0.f;
#pragma unroll
            for (int dt = 0; dt < 8; ++dt) oacc[mt][dt] = (f32x4){0.f, 0.f, 0.f, 0.f}; }
        const int ntiles = 4 * (qt + 1);
        v4u pk_[2], pv_[2];
#define FOX_LOAD(jj) do { _Pragma("unroll") for (int i2 = 0; i2 < 2; ++i2) { const int c2 = tid + 512 * i2; \
            pk_[i2] = *(const v4u*)(QKV + ((size_t)b * SEQ + 64 * (jj) + (c2 >> 4)) * 3072 + 1024 + h * 128 + (c2 & 15) * 8); \
            pv_[i2] = *(const v4u*)(QKV + ((size_t)b * SEQ + 64 * (jj) + (c2 & 63)) * 3072 + 2048 + h * 128 + (c2 >> 6) * 8); } } while (0)
        FOX_LOAD(0);
        for (int j = 0; j < ntiles; ++j) {
#pragma unroll
            for (int i2 = 0; i2 < 2; ++i2) { const int c2 = tid + 512 * i2;
                *(LAS v4u*)(lds + K_OFF + (c2 >> 4) * KST + (c2 & 15) * 16) = pk_[i2];
                LAS unsigned short* p = (LAS unsigned short*)(lds + V_OFF + ((c2 >> 6) * 8) * VST + (c2 & 63) * 2); const v4u vv = pv_[i2];
                p[0 * (VST / 2)] = (unsigned short)(vv.x & 0xffffu); p[1 * (VST / 2)] = (unsigned short)(vv.x >> 16); p[2 * (VST / 2)] = (unsigned short)(vv.y & 0xffffu); p[3 * (VST / 2)] = (unsigned short)(vv.y >> 16);
                p[4 * (VST / 2)] = (unsigned short)(vv.z & 0xffffu); p[5 * (VST / 2)] = (unsigned short)(vv.z >> 16); p[6 * (VST / 2)] = (unsigned short)(vv.w & 0xffffu); p[7 * (VST / 2)] = (unsigned short)(vv.w >> 16); }
            __syncthreads();
            if (j + 1 < ntiles) FOX_LOAD(j + 1);
            const int key0 = 64 * j;
            if (key0 <= q0 + 31) {
                f32x4 sacc[4][2];
#pragma unroll
                for (int nt = 0; nt < 4; ++nt) { sacc[nt][0] = (f32x4){0.f, 0.f, 0.f, 0.f}; sacc[nt][1] = (f32x4){0.f, 0.f, 0.f, 0.f}; }
#pragma unroll
                for (int ks = 0; ks < 4; ++ks)
#pragma unroll
                    for (int nt = 0; nt < 4; ++nt) { const bf16x8 a = ldsfrag(lds + K_OFF + (16 * nt + fr) * KST + (32 * ks + 8 * fq) * 2);
                        sacc[nt][0] = MFMA16(a, qf[0][ks], sacc[nt][0]); sacc[nt][1] = MFMA16(a, qf[1][ks], sacc[nt][1]); }
                const bool diag = (key0 + 63 > q0);
                float mx[2] = {-__builtin_inff(), -__builtin_inff()};
#pragma unroll
                for (int nt = 0; nt < 4; ++nt) { const f32x4 ck = *(const LAS f32x4*)(cl + key0 + 16 * nt + 4 * fq);
#pragma unroll
                    for (int mt = 0; mt < 2; ++mt)
#pragma unroll
                        for (int e = 0; e < 4; ++e) { float v = sacc[nt][mt][e] * SC2 + (cq[mt] - ck[e] * L2E);
                            if (diag && (key0 + 16 * nt + 4 * fq + e > q0 + 16 * mt + fr)) v = -__builtin_inff();
                            sacc[nt][mt][e] = v; mx[mt] = fmaxf(mx[mt], v); } }
                bf16x8 pf[2][2];
#pragma unroll
                for (int mt = 0; mt < 2; ++mt) { float m_ = mx[mt]; m_ = fmaxf(m_, __shfl_xor(m_, 16)); m_ = fmaxf(m_, __shfl_xor(m_, 32));
                    const float mnew = fmaxf(mrow[mt], m_); const float alpha = __builtin_amdgcn_exp2f(mrow[mt] - mnew); mrow[mt] = mnew;
                    float ls = 0.f; unsigned pw[8];
#pragma unroll
                    for (int nt = 0; nt < 4; ++nt) { float p0 = __builtin_amdgcn_exp2f(sacc[nt][mt][0] - mnew), p1 = __builtin_amdgcn_exp2f(sacc[nt][mt][1] - mnew), p2 = __builtin_amdgcn_exp2f(sacc[nt][mt][2] - mnew), p3 = __builtin_amdgcn_exp2f(sacc[nt][mt][3] - mnew);
                        ls += (p0 + p1) + (p2 + p3); pw[2 * nt] = pk2(p0, p1); pw[2 * nt + 1] = pk2(p2, p3); }
                    lrow[mt] = lrow[mt] * alpha + ls;
#pragma unroll
                    for (int dt = 0; dt < 8; ++dt) oacc[mt][dt] = oacc[mt][dt] * alpha;
                    { v4u t0 = {pw[0], pw[1], pw[2], pw[3]}, t1 = {pw[4], pw[5], pw[6], pw[7]}; pf[mt][0] = __builtin_bit_cast(bf16x8, t0); pf[mt][1] = __builtin_bit_cast(bf16x8, t1); } }
#pragma unroll
                for (int ks2 = 0; ks2 < 2; ++ks2)
#pragma unroll
                    for (int dt = 0; dt < 8; ++dt) { const LAS unsigned char* vp = lds + V_OFF + (16 * dt + fr) * VST + (32 * ks2 + 4 * fq) * 2;
                        const v2u lo = *(const LAS v2u*)vp, hi = *(const LAS v2u*)(vp + 32); v4u av = {lo.x, lo.y, hi.x, hi.y}; const bf16x8 a = __builtin_bit_cast(bf16x8, av);
                        oacc[0][dt] = MFMA16(a, pf[0][ks2], oacc[0][dt]); oacc[1][dt] = MFMA16(a, pf[1][ks2], oacc[1][dt]); }
            }
            __syncthreads();
        }
#undef FOX_LOAD
#pragma unroll
        for (int mt = 0; mt < 2; ++mt) { float l = lrow[mt]; l += __shfl_xor(l, 16); l += __shfl_xor(l, 32); const float inv = 1.0f / l;
            const size_t tok = (size_t)b * SEQ + q0 + 16 * mt + fr;
#pragma unroll
            for (int dt = 0; dt < 8; ++dt) { const f32x4 o = oacc[mt][dt] * inv; v2u r; r.x = pk2(o[0], o[1]); r.y = pk2(o[2], o[3]); *(v2u*)(AO + tok * 1024 + h * 128 + 16 * dt + 4 * fq) = r; } }
        __syncthreads();
    }
}

constexpr int N_PHASES = 2 + 10 * MK_LAYERS;
__host__ __device__ constexpr bool phase_active(int id) {
    if (id == 0) return true;
    if (id == 1 + 10 * MK_LAYERS) return (MK_LAYERS % 2) == 1;
    const int l = (id - 1) / 10, s = (id - 1) % 10, mixer = l % 3; const bool moe = (l % 2) == 1;
    if (s == 0 || s == 1 || s == 4) return true;
    if (s == 2 || s == 3) return mixer == 1;
    if (s == 5 || s == 6) return true;
    return moe;
}
struct Args { const float* in[22]; float* out; unsigned char* ws; int ph_lo, ph_hi; };
#define IN(k) (lo <= (k) && (k) < hi)
#define SEAM(k) do { if ((k) + 1 < hi) xcd_barrier(bar); } while (0)
template <int L> DI void run_layer(Frame& F, const Args& args, const XcdBarrier& bar, const int lo, const int hi) {
    constexpr int l = L, mixer = L % 3, jm = L / 3, fi = L / 2, pb = 1 + 10 * L; constexpr bool moe = (L & 1) != 0;
    float* X = wsp<float>(F, WS_X); bf16* XB = wsp<bf16>(F, WS_XB); float* SSQ = wsp<float>(F, WS_SSQ);
    if (IN(pb + 0)) {
        if constexpr (mixer == 0) {
            pg8::Gemm g{XB, wsp<bf16>(F, WS_WA_IN) + (size_t)jm * 4096 * 1024, M, 4096, D}; pg8::StaticOrder S; S.init(M, 4096, F.G, (int)blockIdx.x);
            pg8::EpiAin E{SSQ, wsp<bf16>(F, WS_U), wsp<bf16>(F, WS_V), wsp<float>(F, WS_VSSQ)};
            pg8::gemm_phase<pg8::EpiAin, pg8::StaticOrder, true, true>(F.lds + RING_OFF, g, S, E);
        } else {
            if constexpr (mixer == 1) glow_phase(F, X, args.in[1] + l * 1024, args.in[8]); else logf_phase(F, X, args.in[1] + l * 1024, args.in[13], args.in[14]);
            pg8::Gemm g{XB, mixer == 1 ? wsp<bf16>(F, WS_WB_IN) : wsp<bf16>(F, WS_WC_IN), M, 3072, D}; pg8::StaticOrder S; S.init(M, 3072, F.G, (int)blockIdx.x);
            pg8::EpiRow E{SSQ, wsp<bf16>(F, WS_QKVR), 3072};
            pg8::gemm_phase<pg8::EpiRow, pg8::StaticOrder, true, true>(F.lds + RING_OFF, g, S, E);
        }
        SEAM(pb + 0);
    }
    if (IN(pb + 1)) {
        if constexpr (mixer == 0) mix_phase(F, args.in[5] + (size_t)jm * 8 * 128 * 128, args.in[6] + (size_t)jm * 8 * 128, args.in[4] + (size_t)jm * AW);
        else if constexpr (mixer == 1) gla_prep_phase(F, args.in[9], args.in[10]);
        else fox_attn_phase(F);
        SEAM(pb + 1); }
    if constexpr (mixer == 1) {
        if (IN(pb + 2)) { gla_scan_phase(F); SEAM(pb + 2); }
        if (IN(pb + 3)) { gla_gate_phase(F, args.in[11]); SEAM(pb + 3); }
    }
    if (IN(pb + 4)) {
        const bf16* A = mixer == 0 ? wsp<bf16>(F, WS_Y) : mixer == 1 ? wsp<bf16>(F, WS_GG) : wsp<bf16>(F, WS_AO);
        const bf16* Bt = mixer == 0 ? wsp<bf16>(F, WS_WA_OUT) + (size_t)jm * 1024 * 2048 : mixer == 1 ? wsp<bf16>(F, WS_WB_OUT) : wsp<bf16>(F, WS_WC_OUT);
        pg8::Gemm g{A, Bt, M, D, mixer == 0 ? 2048 : 1024}; pg8::StaticOrder S; S.init(M, D, F.G, (int)blockIdx.x);
        pg8::EpiResid E{l == 0 ? args.in[0] : (const float*)X, X, XB, SSQ};
        pg8::gemm_phase<pg8::EpiResid, pg8::StaticOrder, true, true>(F.lds + RING_OFF, g, S, E);
        SEAM(pb + 4);
    }
    if constexpr (!moe) {
        if (IN(pb + 5)) {
            pg8::Gemm g{XB, wsp<bf16>(F, WS_WF_IN) + (size_t)fi * 7168 * 1024, M, 7168, D}; pg8::StaticOrder S; S.init(M, 7168, F.G, (int)blockIdx.x);
            pg8::EpiSwiGLU<0> E{SSQ, wsp<bf16>(F, WS_HF)};
            pg8::gemm_phase<pg8::EpiSwiGLU<0>, pg8::StaticOrder, true, true>(F.lds + RING_OFF, g, S, E);
            SEAM(pb + 5);
        }
        if (IN(pb + 6)) {
            pg8::Gemm g{wsp<bf16>(F, WS_HF), wsp<bf16>(F, WS_WF_OUT) + (size_t)fi * 1024 * 3584, M, D, FF}; pg8::StaticOrder S; S.init(M, D, F.G, (int)blockIdx.x);
            pg8::EpiResid E{X, X, XB, SSQ};
            pg8::gemm_phase<pg8::EpiResid, pg8::StaticOrder, true, true>(F.lds + RING_OFF, g, S, E);
            SEAM(pb + 6);
        }
    } else {
        unsigned* gcnt = (unsigned*)(F.ctl + CW_CNT + 64 * l);
        if (IN(pb + 5)) { router_phase(F, X, args.in[2] + l * 1024, args.in[18] + (size_t)fi * 1024 * 8, gcnt); SEAM(pb + 5); }
        if (IN(pb + 6)) { gather_phase(F, gcnt); SEAM(pb + 6); }
        if (IN(pb + 7)) {
            pg8::Gemm g{wsp<bf16>(F, WS_XS), wsp<bf16>(F, WS_WM_IN) + (size_t)fi * 8 * 7168 * 1024, MROWS, 7168, D}; pg8::GroupedOrder S; S.init(gcnt, 28, F.G, (int)blockIdx.x);
            pg8::EpiSwiGLU<1> E{wsp<float>(F, WS_ROWRS), wsp<bf16>(F, WS_HM)};
            pg8::gemm_phase<pg8::EpiSwiGLU<1>, pg8::GroupedOrder, true, true>(F.lds + RING_OFF, g, S, E);
            SEAM(pb + 7);
        }
        if (IN(pb + 8)) {
            pg8::Gemm g{wsp<bf16>(F, WS_HM), wsp<bf16>(F, WS_WM_OUT) + (size_t)fi * 8 * 1024 * 3584, MROWS, D, FF}; pg8::GroupedOrder S; S.init(gcnt, 4, F.G, (int)blockIdx.x);
            pg8::EpiMoeOut E{wsp<int>(F, WS_ROWT), wsp<float>(F, WS_ROWG), wsp<bf16>(F, WS_OS), M};
            pg8::gemm_phase<pg8::EpiMoeOut, pg8::GroupedOrder, true, true>(F.lds + RING_OFF, g, S, E);
            SEAM(pb + 8);
        }
        if (IN(pb + 9)) { combine_phase(F, l == MK_LAYERS - 1, args.in[21]); SEAM(pb + 9); }
    }
}
__global__ void __launch_bounds__(NWAVES * 64, 2) trunk_fwd(Args args) {
    extern __shared__ __attribute__((aligned(16))) unsigned char lds[];
    Frame F;
    F.lds = (LAS unsigned char*)lds;
    F.MISC = (volatile LAS unsigned*)(F.lds + MISC_OFF);
    F.tid = threadIdx.x; F.lane = F.tid & 63; F.wave = __builtin_amdgcn_readfirstlane(F.tid >> 6);
    F.G = gridDim.x; { const int bx = blockIdx.x; F.vcu = (F.G % 8 == 0) ? (bx % 8) * (F.G / 8) + bx / 8 : bx; }
    F.out = args.out; F.ws = args.ws;
    F.ctl = (gu32*)(args.ws + WS_CTL);
    for (int u = F.tid; u < (LDS_BYTES - LDSCTL_OFF) / 4; u += NWAVES * 64) ((LAS unsigned*)(F.lds + LDSCTL_OFF))[u] = 0u;
    __syncthreads();
    XcdBarrier bar = xcd_barrier_post((unsigned*)(F.ctl + CW_BAR), F.MISC + 8);
    const int lo = args.ph_lo, hi = args.ph_hi;
    if (IN(0)) { p0_prologue(F, args); SEAM(0); }
    run_layer<0>(F, args, bar, lo, hi);
    if constexpr (MK_LAYERS > 1) run_layer<1>(F, args, bar, lo, hi);
    if constexpr (MK_LAYERS > 2) run_layer<2>(F, args, bar, lo, hi);
    if constexpr (MK_LAYERS > 3) run_layer<3>(F, args, bar, lo, hi);
    if ((MK_LAYERS % 2) == 1 && IN(1 + 10 * MK_LAYERS)) final_norm_phase(F, wsp<float>(F, WS_X), args.in[21]);
}
#undef IN
#undef SEAM

extern "C" void kernel_launch(void* const* d_in, const int* in_sizes, int n_in, void* d_out, int out_size, void* d_ws, size_t ws_size, hipStream_t stream) {
    static int grid = 0;
    if (grid == 0) {
        if (n_in != 22 || in_sizes[0] != M * D || out_size != M * D || ws_size < WS_END) { fprintf(stderr, "kernel_launch: unexpected shapes / workspace (n_in %d, in0 %d, out %d, ws %zu, need %zu)\n", n_in, n_in > 0 ? in_sizes[0] : -1, out_size, ws_size, (size_t)WS_END); grid = -1; return; }
        int dev = 0, cus = 0, per_cu = 0;
        if (hipGetDevice(&dev) != hipSuccess || hipDeviceGetAttribute(&cus, hipDeviceAttributeMultiprocessorCount, dev) != hipSuccess) { grid = -1; return; }
        if (hipFuncSetAttribute((const void*)trunk_fwd, hipFuncAttributeMaxDynamicSharedMemorySize, LDS_BYTES) != hipSuccess) { fprintf(stderr, "kernel_launch: hipFuncSetAttribute failed\n"); grid = -1; return; }
        if (hipOccupancyMaxActiveBlocksPerMultiprocessor(&per_cu, (const void*)trunk_fwd, NWAVES * 64, LDS_BYTES) != hipSuccess || per_cu < 1) { fprintf(stderr, "kernel_launch: occupancy query reports %d workgroups per CU\n", per_cu); }
        (void)hipGetLastError();
        grid = cus;
    }
    if (grid < 0) return;
    if (hipMemsetAsync((char*)d_ws + WS_CTL, 0, CTL_ZERO_BYTES, stream) != hipSuccess) return;
    Args a{};
    for (int i = 0; i < 22; ++i) a.in[i] = (const float*)d_in[i];
    a.out = (float*)d_out; a.ws = (unsigned char*)d_ws;
#if MK_ONE_LAUNCH
    a.ph_lo = 0; a.ph_hi = N_PHASES;
    hipLaunchKernelGGL(trunk_fwd, dim3(grid), dim3(NWAVES * 64), LDS_BYTES, stream, a);
#else
    for (int p = 0; p < N_PHASES; ++p) { if (!phase_active(p)) continue; a.ph_lo = p; a.ph_hi = p + 1; hipLaunchKernelGGL(trunk_fwd, dim3(grid), dim3(NWAVES * 64), LDS_BYTES, stream, a); }
#endif
}
```

```cpp
#include <hip/hip_runtime.h>
#include <cstdio>
#include <cstdint>
namespace pg8 {
#define PG8_LAS __attribute__((address_space(3)))
typedef unsigned short bf16_t;
typedef short bf16x8 __attribute__((ext_vector_type(8)));
typedef float f32x4 __attribute__((ext_vector_type(4)));
typedef unsigned u32x4 __attribute__((ext_vector_type(4)));
constexpr int BM = 256, BK = 64, HALF = 128, HTB = HALF * BK * 2  , STAGE_BYTES = 8 * HTB, NXCD = 8, WGM = 8;

__host__ __device__ __forceinline__ int lds_byte(int r, int c) { const int st = (r >> 4) * 2 + (c >> 5), rr = r & 15, cc = c & 31, ob = rr * 64 + cc * 2; return st * 1024 + (ob ^ (((ob >> 9) & 1) << 5)); }
__host__ __device__ __forceinline__ void stage_rc(int b, int& R, int& C) { const int st = b / 1024, sb = b % 1024, swz = sb ^ (((sb >> 9) & 1) << 5); R = (st >> 1) * 16 + swz / 64; C = (st & 1) * 32 + (swz % 64) / 2; }
__host__ __device__ __forceinline__ int perm32(int rho) { const int n = rho >> 4, i = rho & 15; return 8 * (i >> 2) + 4 * n + (i & 3); }

struct Unit { int pm, pn; };
struct Gemm { const bf16_t* A; const bf16_t* Bt; int M, N, K; };

struct StaticOrder {
    int nM, nN, nwg, G, c;
    __host__ __device__ void init(int M, int N, int G_, int c_) { nM = M / BM; nN = N / BM; nwg = nM * nN; G = G_; c = c_; }
    __host__ __device__ bool next(int i, Unit& u) const {
        const long L = (long)i * G + c; if (L >= nwg) return false;
        int wgid = (int)L; { const int q = nwg / NXCD, r = nwg % NXCD, xcd = wgid % NXCD, off = wgid / NXCD; wgid = (xcd < r ? xcd * (q + 1) : r * (q + 1) + (xcd - r) * q) + off; }
        const int nig = WGM * nN, gid = wgid / nig, fm = gid * WGM, gsz = (nM - fm) < WGM ? (nM - fm) : WGM;
        u.pm = fm + ((wgid % nig) % gsz); u.pn = (wgid % nig) / gsz; return true;
    }
    __device__ __forceinline__ void a_ready(const Unit&) const {}
    __device__ __forceinline__ void done(const Unit&) const {}
};

struct GroupedOrder {
    int nN, nM, nwg, G, c; int s1, s2, s3, s4, s5, s6, s7;
    __device__ __forceinline__ void init(const unsigned* cnt, int nN_, int G_, int c_) {
        nN = nN_; G = G_; c = c_; int t = 0;
        t += (int)((cnt[0] + 255u) >> 8); s1 = t; t += (int)((cnt[1] + 255u) >> 8); s2 = t; t += (int)((cnt[2] + 255u) >> 8); s3 = t; t += (int)((cnt[3] + 255u) >> 8); s4 = t;
        t += (int)((cnt[4] + 255u) >> 8); s5 = t; t += (int)((cnt[5] + 255u) >> 8); s6 = t; t += (int)((cnt[6] + 255u) >> 8); s7 = t; t += (int)((cnt[7] + 255u) >> 8);
        nM = t; nwg = nM * nN;
    }
    __device__ __forceinline__ bool next(int i, Unit& u) const {
        const long L = (long)i * G + c; if (L >= nwg) return false;
        int wgid = (int)L; { const int q = nwg / NXCD, r = nwg % NXCD, xcd = wgid % NXCD, off = wgid / NXCD; wgid = (xcd < r ? xcd * (q + 1) : r * (q + 1) + (xcd - r) * q) + off; }
        const int nig = WGM * nN, gid = wgid / nig, fm = gid * WGM, gsz = (nM - fm) < WGM ? (nM - fm) : WGM;
        const int pm = fm + ((wgid % nig) % gsz), pnl = (wgid % nig) / gsz;
        const int e = (pm >= s1) + (pm >= s2) + (pm >= s3) + (pm >= s4) + (pm >= s5) + (pm >= s6) + (pm >= s7);
        u.pm = pm; u.pn = e * nN + pnl; return true;
    }
    __device__ __forceinline__ void a_ready(const Unit&) const {}
    __device__ __forceinline__ void done(const Unit&) const {}
};

__device__ __forceinline__ unsigned cvt_pk_bf16(float lo, float hi) { unsigned r; asm volatile("v_cvt_pk_bf16_f32 %0, %1, %2" : "=v"(r) : "v"(lo), "v"(hi)); return r; }
typedef unsigned u32x2 __attribute__((ext_vector_type(2)));
constexpr float RMS_EPS = 1e-6f;
__device__ __forceinline__ float rs16(const float* ssq, int row) {
    const f32x4* p = (const f32x4*)(ssq + (size_t)row * 16);
    const f32x4 a = p[0], b = p[1], c = p[2], d = p[3];
    const float s = (((a[0] + a[1]) + (a[2] + a[3])) + ((b[0] + b[1]) + (b[2] + b[3]))) + (((c[0] + c[1]) + (c[2] + c[3])) + ((d[0] + d[1]) + (d[2] + d[3])));
    return __builtin_amdgcn_rsqf(s * (1.0f / 1024.0f) + RMS_EPS);
}
__device__ __forceinline__ float gelu_t(float x) {
    const float t = x * (1.0f + 0.044715f * x * x);
    return x * __builtin_amdgcn_rcpf(1.0f + __builtin_amdgcn_exp2f(-2.302208198f * t));
}
__device__ __forceinline__ float silu_f(float x) { return x * __builtin_amdgcn_rcpf(1.0f + __builtin_amdgcn_exp2f(-1.4426950409f * x)); }

struct EpiAin {
    static constexpr bool PERM = true, AFTER_DRAIN = false;
    const float* ssq; bf16_t* U; bf16_t* V; float* vssq;
    __device__ __forceinline__ void operator()(const f32x4 (&acc)[2][2][4][2], const Unit& u, int wr, int wc, int fr, int fq) const {
        const bool isv = u.pn >= 8; bf16_t* base = isv ? V : U;
        const int row0 = u.pm * BM + wr * 64 + fr, col0 = (u.pn & 7) * BM + wc * 32 + 8 * fq;
#pragma unroll
        for (int ai = 0; ai < 2; ++ai)
#pragma unroll
            for (int m = 0; m < 4; ++m) { const int row = row0 + ai * HALF + m * 16; const float rs = rs16(ssq, row); float sq = 0.f; bf16_t* rowp = base + (size_t)row * 2048 + col0;
#pragma unroll
                for (int bj = 0; bj < 2; ++bj) { f32x4 v0 = acc[ai][bj][m][0] * rs, v1 = acc[ai][bj][m][1] * rs;
#pragma unroll
                    for (int j = 0; j < 4; ++j) { v0[j] = gelu_t(v0[j]); v1[j] = gelu_t(v1[j]); sq += v0[j] * v0[j] + v1[j] * v1[j]; }
                    u32x4 w; w.x = cvt_pk_bf16(v0[0], v0[1]); w.y = cvt_pk_bf16(v0[2], v0[3]); w.z = cvt_pk_bf16(v1[0], v1[1]); w.w = cvt_pk_bf16(v1[2], v1[3]);
                    *(u32x4*)(rowp + bj * HALF) = w; }
                if (isv) { sq += __shfl_xor(sq, 16); sq += __shfl_xor(sq, 32); if (fq == 0) vssq[(size_t)row * 32 + (u.pn - 8) * 4 + wc] = sq; } }
    }
};
struct EpiRow {
    static constexpr bool PERM = true, AFTER_DRAIN = false;
    const float* ssq; bf16_t* O; int ldc;
    __device__ __forceinline__ void operator()(const f32x4 (&acc)[2][2][4][2], const Unit& u, int wr, int wc, int fr, int fq) const {
        const int row0 = u.pm * BM + wr * 64 + fr, col0 = u.pn * BM + wc * 32 + 8 * fq;
#pragma unroll
        for (int ai = 0; ai < 2; ++ai)
#pragma unroll
            for (int m = 0; m < 4; ++m) { const int row = row0 + ai * HALF + m * 16; const float rs = rs16(ssq, row); bf16_t* rowp = O + (size_t)row * ldc + col0;
#pragma unroll
                for (int bj = 0; bj < 2; ++bj) { const f32x4 v0 = acc[ai][bj][m][0] * rs, v1 = acc[ai][bj][m][1] * rs;
                    u32x4 w; w.x = cvt_pk_bf16(v0[0], v0[1]); w.y = cvt_pk_bf16(v0[2], v0[3]); w.z = cvt_pk_bf16(v1[0], v1[1]); w.w = cvt_pk_bf16(v1[2], v1[3]);
                    *(u32x4*)(rowp + bj * HALF) = w; } }
    }
};
template <bool F32IN> struct EpiResid {
    static constexpr bool PERM = true, AFTER_DRAIN = false;
    const void* xin; bf16_t* xb; float* ssq;
    __device__ __forceinline__ void operator()(const f32x4 (&acc)[2][2][4][2], const Unit& u, int wr, int wc, int fr, int fq) const {
        const int row0 = u.pm * BM + wr * 64 + fr, col0 = u.pn * BM + wc * 32 + 8 * fq;
#pragma unroll
        for (int ai = 0; ai < 2; ++ai)
#pragma unroll
            for (int m = 0; m < 4; ++m) { const int row = row0 + ai * HALF + m * 16; const size_t off = (size_t)row * 1024 + col0; float sq = 0.f;
#pragma unroll
                for (int bj = 0; bj < 2; ++bj) { const size_t o = off + bj * HALF; f32x4 v0, v1;
                    if constexpr (F32IN) { v0 = *(const f32x4*)((const float*)xin + o); v1 = *(const f32x4*)((const float*)xin + o + 4); }
                    else { const u32x4 xw = *(const u32x4*)((const bf16_t*)xin + o);
                        v0 = (f32x4){__builtin_bit_cast(float, xw.x << 16), __builtin_bit_cast(float, xw.x & 0xffff0000u), __builtin_bit_cast(float, xw.y << 16), __builtin_bit_cast(float, xw.y & 0xffff0000u)};
                        v1 = (f32x4){__builtin_bit_cast(float, xw.z << 16), __builtin_bit_cast(float, xw.z & 0xffff0000u), __builtin_bit_cast(float, xw.w << 16), __builtin_bit_cast(float, xw.w & 0xffff0000u)}; }
                    v0 += acc[ai][bj][m][0]; v1 += acc[ai][bj][m][1];
                    u32x4 w; w.x = cvt_pk_bf16(v0[0], v0[1]); w.y = cvt_pk_bf16(v0[2], v0[3]); w.z = cvt_pk_bf16(v1[0], v1[1]); w.w = cvt_pk_bf16(v1[2], v1[3]);
                    *(u32x4*)(xb + o) = w;
                    sq += ((v0[0] * v0[0] + v0[1] * v0[1]) + (v0[2] * v0[2] + v0[3] * v0[3])) + ((v1[0] * v1[0] + v1[1] * v1[1]) + (v1[2] * v1[2] + v1[3] * v1[3])); }
                sq += __shfl_xor(sq, 16); sq += __shfl_xor(sq, 32); if (fq == 0) ssq[(size_t)row * 16 + u.pn * 4 + wc] = sq;
                asm volatile("" ::: "memory"); }
    }
};
template <int MODE> struct EpiSwiGLU {
    static constexpr bool PERM = true, AFTER_DRAIN = false;
    const float* ssq; bf16_t* H;
    __device__ __forceinline__ void operator()(const f32x4 (&acc)[2][2][4][2], const Unit& u, int wr, int wc, int fr, int fq) const {
        const int row0 = u.pm * BM + wr * 64 + fr, col0 = (u.pn % 28) * HALF + wc * 32 + 8 * fq;
#pragma unroll
        for (int ai = 0; ai < 2; ++ai)
#pragma unroll
            for (int m = 0; m < 4; ++m) { const int row = row0 + ai * HALF + m * 16; const float rs = MODE == 0 ? rs16(ssq, row) : ssq[row];
                const f32x4 g0 = acc[ai][0][m][0] * rs, g1 = acc[ai][0][m][1] * rs, u0 = acc[ai][1][m][0] * rs, u1 = acc[ai][1][m][1] * rs;
                f32x4 h0, h1;
#pragma unroll
                for (int j = 0; j < 4; ++j) { h0[j] = silu_f(g0[j]) * u0[j]; h1[j] = silu_f(g1[j]) * u1[j]; }
                u32x4 w; w.x = cvt_pk_bf16(h0[0], h0[1]); w.y = cvt_pk_bf16(h0[2], h0[3]); w.z = cvt_pk_bf16(h1[0], h1[1]); w.w = cvt_pk_bf16(h1[2], h1[3]);
                *(u32x4*)(H + (size_t)row * 3584 + col0) = w; }
    }
};
struct EpiMoeOut {
    static constexpr bool PERM = true, AFTER_DRAIN = false;
    const int* rtok; const float* rgate; bf16_t* OS; int M;
    __device__ __forceinline__ void operator()(const f32x4 (&acc)[2][2][4][2], const Unit& u, int wr, int wc, int fr, int fq) const {
        const int row0 = u.pm * BM + wr * 64 + fr, col0 = (u.pn & 3) * BM + wc * 32 + 8 * fq;
#pragma unroll
        for (int ai = 0; ai < 2; ++ai)
#pragma unroll
            for (int m = 0; m < 4; ++m) { const int row = row0 + ai * HALF + m * 16; const int tk = rtok[row]; const float gt = rgate[row];
                if (tk >= 0) { bf16_t* rowp = OS + ((size_t)(tk & 1) * M + (tk >> 1)) * 1024 + col0;
#pragma unroll
                    for (int bj = 0; bj < 2; ++bj) { const f32x4 v0 = acc[ai][bj][m][0] * gt, v1 = acc[ai][bj][m][1] * gt;
                        u32x4 w; w.x = cvt_pk_bf16(v0[0], v0[1]); w.y = cvt_pk_bf16(v0[2], v0[3]); w.z = cvt_pk_bf16(v1[0], v1[1]); w.w = cvt_pk_bf16(v1[2], v1[3]);
                        *(u32x4*)(rowp + bj * HALF) = w; } } }
    }
};

template <class Epi, class Sched, bool ALIGN_EPI = false, bool SP2 = false>
__device__ __forceinline__ void gemm_phase(PG8_LAS unsigned char* lds, const Gemm g, const Sched& S, const Epi& E) {
    const int tid = threadIdx.x, wid = __builtin_amdgcn_readfirstlane(tid >> 6), lane = tid & 63, wr = wid >> 2, wc = wid & 3, fr = lane & 15, fq = lane >> 4;
    const int K = g.K, nt = K / BK;
    unsigned voffA[2], voffB[2];
#pragma unroll
    for (int i = 0; i < 2; ++i) { int R, C; stage_rc(tid * 16 + i * 8192, R, C); const int Rb = Epi::PERM ? ((R & ~31) + perm32(R & 31)) : R;
        voffA[i] = (unsigned)(R * K + C) * 2u; voffB[i] = (unsigned)(Rb * K + C) * 2u; }
    const size_t kstep = (size_t)(BK * 2);
    const size_t hstep = (size_t)HALF * K * 2;
    const size_t tstep = 2 * hstep;
    const unsigned ldsw = (unsigned)wid * 1024u;
    const int aoff = lds_byte(wr * 64 + fr, fq * 8), boff = lds_byte(wc * 32 + fr, fq * 8);
#define PG8_SA(b, h) (((b) * 2 + (h)) * HTB)
#define PG8_SB(b, h) ((4 + (b) * 2 + (h)) * HTB)
#define PG8_STAGE(bufoff, gbase, voff) do { _Pragma("unroll") for (int _i = 0; _i < 2; ++_i) \
        __builtin_amdgcn_global_load_lds((const unsigned*)((const char*)(gbase) + (voff)[_i]), (PG8_LAS unsigned*)(lds + (bufoff) + ldsw + _i * 8192), 16, 0, 0); } while (0)
#define PG8_LDA(dst, b, h) do { _Pragma("unroll") for (int m = 0; m < 4; ++m) _Pragma("unroll") for (int k = 0; k < 2; ++k) dst[m][k] = *(const PG8_LAS bf16x8*)(lds + PG8_SA(b, h) + aoff + m * 2048 + k * 1024); } while (0)
#define PG8_LDB(dst, b, h) do { _Pragma("unroll") for (int n = 0; n < 2; ++n) _Pragma("unroll") for (int k = 0; k < 2; ++k) dst[n][k] = *(const PG8_LAS bf16x8*)(lds + PG8_SB(b, h) + boff + n * 2048 + k * 1024); } while (0)
#define PG8_MMA(ai, bj, At, Bt) do { __builtin_amdgcn_s_setprio(1); _Pragma("unroll") for (int m = 0; m < 4; ++m) _Pragma("unroll") for (int n = 0; n < 2; ++n) _Pragma("unroll") for (int k = 0; k < 2; ++k) \
        acc[ai][bj][m][n] = __builtin_amdgcn_mfma_f32_16x16x32_bf16(Bt[n][k], At[m][k], acc[ai][bj][m][n], 0, 0, 0); __builtin_amdgcn_s_setprio(0); } while (0)
#define PG8_WAIT_V(n) asm volatile("s_waitcnt vmcnt(" #n ")" ::: "memory")
#define PG8_WAIT_L(n) asm volatile("s_waitcnt lgkmcnt(" #n ")" ::: "memory")
#define PG8_BAR __builtin_amdgcn_s_barrier()
#define PG8_SCHED __builtin_amdgcn_sched_barrier(0)
    Unit cur, nxt; int ui = 0;
    if (!S.next(0, cur)) return;
    f32x4 acc[2][2][4][2];
#pragma unroll
    for (int a = 0; a < 2; ++a)
#pragma unroll
        for (int b = 0; b < 2; ++b)
#pragma unroll
            for (int m = 0; m < 4; ++m)
#pragma unroll
                for (int n = 0; n < 2; ++n) acc[a][b][m][n] = (f32x4){0.f, 0.f, 0.f, 0.f};
    bf16x8 At[4][2], B0[2][2], B1[2][2];
    const char* cA = (const char*)g.A + (size_t)cur.pm * tstep; const char* cB = (const char*)g.Bt + (size_t)cur.pn * tstep;
    S.a_ready(cur);
    if constexpr (SP2) {
        PG8_STAGE(PG8_SB(0, 0), cB, voffB); PG8_STAGE(PG8_SB(0, 1), cB + hstep, voffB); PG8_STAGE(PG8_SA(0, 0), cA, voffA); PG8_STAGE(PG8_SA(0, 1), cA + hstep, voffA);
        if (wr == 1) PG8_BAR;
        PG8_WAIT_V(2); PG8_BAR;
        PG8_STAGE(PG8_SB(1, 0), cB + kstep, voffB); PG8_STAGE(PG8_SA(1, 0), cA + kstep, voffA); PG8_STAGE(PG8_SB(1, 1), cB + hstep + kstep, voffB);
        PG8_WAIT_V(6); PG8_BAR;
    } else {
        PG8_STAGE(PG8_SB(0, 0), cB, voffB); PG8_STAGE(PG8_SA(0, 0), cA, voffA); PG8_STAGE(PG8_SB(0, 1), cB + hstep, voffB); PG8_STAGE(PG8_SA(0, 1), cA + hstep, voffA);
        if (wr == 1) PG8_BAR;
        PG8_WAIT_V(4); PG8_BAR;
        PG8_STAGE(PG8_SB(1, 0), cB + kstep, voffB); PG8_STAGE(PG8_SA(1, 0), cA + kstep, voffA); PG8_STAGE(PG8_SB(1, 1), cB + hstep + kstep, voffB);
        PG8_WAIT_V(6); PG8_BAR;
    }
    for (;;) {
        const bool has_next = S.next(ui + 1, nxt);
        const char* nA = has_next ? (const char*)g.A + (size_t)nxt.pm * tstep : cA; const char* nB = has_next ? (const char*)g.Bt + (size_t)nxt.pn * tstep : cB;
        for (int t = 0; t < nt; t += 2) {
            const bool last = (t == nt - 2);
            const char* a1 = cA + (size_t)(t + 1) * kstep;
            const char* a2 = last ? nA : cA + (size_t)(t + 2) * kstep; const char* b2 = last ? nB : cB + (size_t)(t + 2) * kstep;
            const char* a3 = a2 + kstep; const char* b3 = b2 + kstep;
            if (last && has_next) S.a_ready(nxt);
            if constexpr (SP2) {
            PG8_LDB(B0, 0, 0); PG8_LDB(B1, 0, 1); PG8_SCHED; PG8_LDA(At, 0, 0); PG8_STAGE(PG8_SA(1, 1), a1 + hstep, voffA);
            PG8_WAIT_V(8); PG8_WAIT_L(0); PG8_BAR; PG8_MMA(0, 0, At, B0); PG8_MMA(0, 1, At, B1); PG8_BAR; PG8_SCHED;
            PG8_LDA(At, 0, 1); PG8_STAGE(PG8_SB(0, 0), b2, voffB); PG8_STAGE(PG8_SB(0, 1), b2 + hstep, voffB); PG8_STAGE(PG8_SA(0, 0), a2, voffA);
            PG8_WAIT_V(8); PG8_WAIT_L(0); PG8_BAR; PG8_MMA(1, 0, At, B0); PG8_MMA(1, 1, At, B1); PG8_BAR; PG8_SCHED;
            PG8_LDB(B0, 1, 0); PG8_LDB(B1, 1, 1); PG8_SCHED; PG8_LDA(At, 1, 0); PG8_STAGE(PG8_SA(0, 1), a2 + hstep, voffA);
            PG8_WAIT_V(8); PG8_WAIT_L(0); PG8_BAR; PG8_MMA(0, 0, At, B0); PG8_MMA(0, 1, At, B1); PG8_BAR; PG8_SCHED;
            PG8_LDA(At, 1, 1); PG8_STAGE(PG8_SB(1, 0), b3, voffB); PG8_STAGE(PG8_SB(1, 1), b3 + hstep, voffB); PG8_STAGE(PG8_SA(1, 0), a3, voffA);
            PG8_WAIT_V(8); PG8_WAIT_L(0); PG8_BAR; PG8_MMA(1, 0, At, B0); PG8_MMA(1, 1, At, B1); PG8_BAR; PG8_SCHED;
            } else {
            PG8_LDB(B0, 0, 0); PG8_SCHED; PG8_LDA(At, 0, 0); PG8_STAGE(PG8_SA(1, 1), a1 + hstep, voffA);
            PG8_WAIT_L(8); PG8_BAR; PG8_WAIT_L(0); PG8_MMA(0, 0, At, B0); PG8_BAR; PG8_SCHED;
            PG8_LDB(B1, 0, 1); PG8_STAGE(PG8_SB(0, 0), b2, voffB);
            PG8_BAR; PG8_WAIT_L(0); PG8_MMA(0, 1, At, B1); PG8_BAR;
            PG8_LDA(At, 0, 1); PG8_STAGE(PG8_SA(0, 0), a2, voffA);
            PG8_BAR; PG8_WAIT_L(0); PG8_MMA(1, 0, At, B0); PG8_BAR; PG8_SCHED;
            PG8_STAGE(PG8_SB(0, 1), b2 + hstep, voffB);
            PG8_WAIT_V(6); PG8_BAR; PG8_MMA(1, 1, At, B1); PG8_BAR;
            PG8_LDB(B0, 1, 0); PG8_SCHED; PG8_LDA(At, 1, 0); PG8_STAGE(PG8_SA(0, 1), a2 + hstep, voffA);
            PG8_WAIT_L(8); PG8_BAR; PG8_WAIT_L(0); PG8_MMA(0, 0, At, B0); PG8_BAR; PG8_SCHED;
            PG8_LDB(B1, 1, 1); PG8_STAGE(PG8_SB(1, 0), b3, voffB);
            PG8_BAR; PG8_WAIT_L(0); PG8_MMA(0, 1, At, B1); PG8_BAR;
            PG8_LDA(At, 1, 1); PG8_STAGE(PG8_SA(1, 0), a3, voffA);
            PG8_BAR; PG8_WAIT_L(0); PG8_MMA(1, 0, At, B0); PG8_BAR; PG8_SCHED;
            PG8_STAGE(PG8_SB(1, 1), b3 + hstep, voffB);
            PG8_WAIT_V(6); PG8_BAR; PG8_MMA(1, 1, At, B1); PG8_BAR;
            }
        }
        if constexpr (ALIGN_EPI) { if (wr == 0) PG8_BAR; }
        if constexpr (!Epi::AFTER_DRAIN) { E(acc, cur, wr, wc, fr, fq); S.done(cur); }
        if (!has_next) break;
#pragma unroll
        for (int a = 0; a < 2; ++a)
#pragma unroll
            for (int b = 0; b < 2; ++b)
#pragma unroll
                for (int m = 0; m < 4; ++m)
#pragma unroll
                    for (int n = 0; n < 2; ++n) acc[a][b][m][n] = (f32x4){0.f, 0.f, 0.f, 0.f};
        cur = nxt; cA = nA; cB = nB; ++ui;
        if constexpr (ALIGN_EPI) { if (wr == 1) PG8_BAR; }
    }
    PG8_WAIT_V(0);
    if constexpr (!ALIGN_EPI) { if (wr == 0) PG8_BAR; }
    PG8_BAR;
    if constexpr (Epi::AFTER_DRAIN) { E.fused(acc, cur, wr, wc, fr, fq, lds, wid, lane); S.done(cur); }
#undef PG8_SA
#undef PG8_SB
#undef PG8_STAGE
#undef PG8_LDA
#undef PG8_LDB
#undef PG8_MMA
#undef PG8_WAIT_V
#undef PG8_WAIT_L
#undef PG8_BAR
#undef PG8_SCHED
}
}

constexpr int NWAVES = 8;
constexpr int BATCH = 8, SEQ = 4096, D = 1024, M = BATCH * SEQ;
constexpr int AW = 2048, FF = 3584, NE = 8;
constexpr int MROWS = 2 * M + NE * 256;
constexpr float EPS = 1e-6f;
#ifndef MK_ONE_LAUNCH
#define MK_ONE_LAUNCH 1
#endif
#ifndef MK_LAYERS
#define MK_LAYERS 4
#endif

constexpr size_t MiB = 1u << 20;
constexpr size_t WS_CTL = 0, CTL_ZERO_BYTES = 1 * MiB;
constexpr size_t WS_WA_IN = 2 * MiB, WS_WA_OUT = 18 * MiB, WS_WB_IN = 26 * MiB, WS_WB_OUT = 32 * MiB, WS_WC_IN = 34 * MiB, WS_WC_OUT = 40 * MiB;
constexpr size_t WS_WF_IN = 42 * MiB, WS_WF_OUT = 70 * MiB, WS_WM_IN = 84 * MiB, WS_WM_OUT = 308 * MiB;
constexpr size_t WS_X = 420 * MiB, WS_XB = 548 * MiB, WS_SSQ = 612 * MiB, WS_VSSQ = 614 * MiB, WS_GLOW = 618 * MiB, WS_LOGF = 620 * MiB, WS_OSSQ = 621 * MiB, WS_DEC = 629 * MiB;
constexpr size_t WS_TOKE = 630 * MiB, WS_TOKP = WS_TOKE + 256 * 1024, WS_TOKG = WS_TOKP + 256 * 1024, WS_TOKRS = WS_TOKG + 256 * 1024, WS_BLKB = WS_TOKRS + 128 * 1024;
constexpr size_t WS_ROWT = 632 * MiB, WS_ROWG = WS_ROWT + 512 * 1024, WS_ROWRS = WS_ROWG + 512 * 1024;
constexpr size_t WS_ACT = 640 * MiB;
constexpr size_t WS_U = WS_ACT, WS_V = WS_ACT + 128 * MiB, WS_Y = WS_ACT + 256 * MiB;
constexpr size_t WS_HF = WS_ACT;
constexpr size_t WS_QKVR = WS_ACT, WS_QD = WS_ACT + 192 * MiB, WS_KD = WS_ACT + 224 * MiB, WS_KET = WS_ACT + 256 * MiB, WS_VT = WS_ACT + 288 * MiB, WS_GO = WS_ACT + 352 * MiB, WS_GG = WS_ACT + 416 * MiB;
constexpr size_t WS_AO = WS_ACT + 192 * MiB;
constexpr size_t WS_XS = WS_ACT, WS_HM = WS_ACT + 132 * MiB, WS_OS = WS_ACT + 594 * MiB;
constexpr size_t WS_END = WS_ACT + 722 * MiB;
static_assert((size_t)MROWS * 1024 * 2 <= 132 * MiB && (size_t)MROWS * FF * 2 <= 462 * MiB, "MoE buffers");
constexpr int CW_TMO = 0, CW_CODE = 1, CW_BAR = 4096, CW_CNT = 8192;

constexpr int RING_OFF = 0, RING_BYTES = 131072;
constexpr int LDSCTL_OFF = RING_BYTES, MISC_OFF = LDSCTL_OFF + 320;
constexpr int LDS_BYTES = 147456;
static_assert(MISC_OFF + 128 <= LDS_BYTES, "LDS map");

#define GAS __attribute__((address_space(1)))
#define LAS __attribute__((address_space(3)))
#define DI __device__ __forceinline__
typedef unsigned short bf16;
typedef unsigned v4u __attribute__((ext_vector_type(4)));
typedef unsigned v2u __attribute__((ext_vector_type(2)));
typedef float f32x4 __attribute__((ext_vector_type(4)));
typedef short bf16x8 __attribute__((ext_vector_type(8)));
typedef short bf16x4 __attribute__((ext_vector_type(4)));
typedef GAS unsigned gu32;
#define RLX_AGENT __ATOMIC_RELAXED, __HIP_MEMORY_SCOPE_AGENT
#define LDS_WAIT() asm volatile("s_waitcnt lgkmcnt(0)" ::: "memory")
#define VM_WAIT() asm volatile("s_waitcnt vmcnt(0)" ::: "memory")
DI unsigned f2bf(float f) { unsigned u = __builtin_bit_cast(unsigned, f); return (u + 0x7fffu + ((u >> 16) & 1u)) >> 16; }
DI unsigned pk2(float lo, float hi) { return f2bf(lo) | (f2bf(hi) << 16); }
DI float bflo(unsigned w) { return __builtin_bit_cast(float, w << 16); }
DI float bfhi(unsigned w) { return __builtin_bit_cast(float, w & 0xffff0000u); }
DI float bf2f(bf16 h) { return __builtin_bit_cast(float, ((unsigned)h) << 16); }
DI float wave_sum(float v) {
#pragma unroll
    for (int o = 1; o < 64; o <<= 1) v += __shfl_xor(v, o);
    return v;
}
DI float logsig(float z) { return fminf(z, 0.f) - log1pf(__expf(-fabsf(z))); }
#define MFMA16(a, b, c) __builtin_amdgcn_mfma_f32_16x16x32_bf16((a), (b), (c), 0, 0, 0)
DI bf16x8 ldsfrag(LAS const unsigned char* p) { return *(LAS const bf16x8*)p; }
#define XB_TMO      128
#define XB_XCNT(j)  (256  + 64 * (j))
#define XB_XSUB(j)  (1280 + 64 * (j))
#define XB_XGEN(j)  (2304 + 64 * (j))
#define XB_TOP      3328
#define XB_TOPGEN   3392
#define XCD_BAR_WORDS 3456
#define XB_SPIN_CAP (1u << 18)

__device__ __forceinline__ unsigned xb_ld(unsigned* p)              { return __hip_atomic_load(p, __ATOMIC_RELAXED, __HIP_MEMORY_SCOPE_AGENT); }
__device__ __forceinline__ unsigned xb_add(unsigned* p, unsigned v) { return __hip_atomic_fetch_add(p, v, __ATOMIC_RELAXED, __HIP_MEMORY_SCOPE_AGENT); }
__device__ __forceinline__ unsigned xb_xcc_id() { return (unsigned)__builtin_amdgcn_s_getreg((3 << 11) | 20) & 0xFu; }
#define XB_SPIN(cond, bar) do { unsigned _sp = 0; while (cond) { __builtin_amdgcn_s_sleep(1); \
    if ((++_sp & 255u) == 0u) { if (xb_ld(&(bar)[XB_TMO])) break; if (_sp > XB_SPIN_CAP) { atomicAdd(&(bar)[XB_TMO], 1u); break; } } } } while (0)

struct XcdBarrier {
    unsigned* bar; unsigned x;
    volatile LAS unsigned* st;
};

__device__ __forceinline__ XcdBarrier xcd_barrier_post(unsigned* bar, volatile LAS unsigned* st) {
    XcdBarrier b; b.bar = bar; b.x = xb_xcc_id(); b.st = st;
    if (threadIdx.x == 0) (void)xb_add(&bar[XB_XCNT(b.x)], 1u);
    return b;
}
__device__ __forceinline__ void xcd_barrier_complete(unsigned* bar, unsigned x, unsigned& nloc, unsigned& nx) {
    const unsigned G = gridDim.x * gridDim.y * gridDim.z;
    unsigned sum, cnt, mine, sp = 0u;
    for (;;) {
        sum = 0u; cnt = 0u; mine = 0u;
#pragma unroll
        for (unsigned j = 0; j < 16; ++j) { const unsigned c = xb_ld(&bar[XB_XCNT(j)]); sum += c; cnt += (c > 0u) ? 1u : 0u; mine = (j == x) ? c : mine; }
        if (sum == G) break;
        __builtin_amdgcn_s_sleep(1);
        if ((++sp & 255u) == 0u) { if (xb_ld(&bar[XB_TMO])) break; if (sp > XB_SPIN_CAP) { atomicAdd(&bar[XB_TMO], 1u); break; } }
    }
    nloc = mine > 0u ? mine : 1u; nx = cnt > 0u ? cnt : 1u;
}

__device__ __forceinline__ void xcd_barrier(const XcdBarrier& b) {
    asm volatile("s_waitcnt vmcnt(0)" ::: "memory");
    __syncthreads();
    if (threadIdx.x == 0) {
        unsigned* bar = b.bar;
        __builtin_amdgcn_s_waitcnt(0);
        unsigned nloc = b.st[0], nx = b.st[1];
        if (nloc == 0u) { xcd_barrier_complete(bar, b.x, nloc, nx); b.st[0] = nloc; b.st[1] = nx; }
        const unsigned old = xb_add(&bar[XB_XSUB(b.x)], 1u);
        const unsigned gen = old / nloc;
        if (old + 1u == (gen + 1u) * nloc) {
            __builtin_amdgcn_fence(__ATOMIC_RELEASE, "agent");
            asm volatile("s_waitcnt vmcnt(0)" ::: "memory");
            const unsigned og = xb_add(&bar[XB_TOP], 1u);
            const unsigned tg = og / nx;
            if (og + 1u == (tg + 1u) * nx) xb_add(&bar[XB_TOPGEN], 1u);
            else XB_SPIN(xb_ld(&bar[XB_TOPGEN]) == tg, bar);
            __builtin_amdgcn_fence(__ATOMIC_ACQUIRE, "agent");
            xb_add(&bar[XB_XGEN(b.x)], 1u);
            asm volatile("s_waitcnt vmcnt(0)" ::: "memory");
        } else {
            XB_SPIN(xb_ld(&bar[XB_XGEN(b.x)]) == gen, bar);
            __builtin_amdgcn_fence(__ATOMIC_ACQUIRE, "agent");
            asm volatile("s_waitcnt vmcnt(0)" ::: "memory");
        }
    }
    __syncthreads();
}

struct Frame {
    LAS unsigned char* lds;
    volatile LAS unsigned* MISC;
    gu32* ctl;
    int tid, lane, wave;
    int vcu, G;
    float* out; unsigned char* ws;
};
template <class T> DI T* wsp(const Frame& F, size_t off) { return (T*)(F.ws + off); }

struct MatDesc { const float* W; int ldw, K, N; bf16* WT; int mode; const float* gain; };
template <class A> DI MatDesc get_mat(const Frame& F, const A& P, int idx) {
    MatDesc d;
    if (idx < 2)        { const int j = idx;      d.W = P.in[3] + (size_t)j * 1024 * 4096; d.ldw = 4096; d.K = 1024; d.N = 4096; d.WT = wsp<bf16>(F, WS_WA_IN) + (size_t)j * 4096 * 1024; d.mode = 0; d.gain = P.in[1] + (j ? 3 : 0) * 1024; }
    else if (idx < 4)   { const int j = idx - 2;  d.W = P.in[7] + (size_t)j * 2048 * 1024; d.ldw = 1024; d.K = 2048; d.N = 1024; d.WT = wsp<bf16>(F, WS_WA_OUT) + (size_t)j * 1024 * 2048; d.mode = 0; d.gain = nullptr; }
    else if (idx == 4)  { d.W = P.in[8];  d.ldw = 3088; d.K = 1024; d.N = 3072; d.WT = wsp<bf16>(F, WS_WB_IN);  d.mode = 0; d.gain = P.in[1] + 1 * 1024; }
    else if (idx == 5)  { d.W = P.in[12]; d.ldw = 1024; d.K = 1024; d.N = 1024; d.WT = wsp<bf16>(F, WS_WB_OUT); d.mode = 0; d.gain = nullptr; }
    else if (idx == 6)  { d.W = P.in[13]; d.ldw = 3080; d.K = 1024; d.N = 3072; d.WT = wsp<bf16>(F, WS_WC_IN);  d.mode = 0; d.gain = P.in[1] + 2 * 1024; }
    else if (idx == 7)  { d.W = P.in[15]; d.ldw = 1024; d.K = 1024; d.N = 1024; d.WT = wsp<bf16>(F, WS_WC_OUT); d.mode = 0; d.gain = nullptr; }
    else if (idx < 10)  { const int i = idx - 8;  d.W = P.in[16] + (size_t)i * 1024 * 7168; d.ldw = 7168; d.K = 1024; d.N = 7168; d.WT = wsp<bf16>(F, WS_WF_IN) + (size_t)i * 7168 * 1024; d.mode = 1; d.gain = P.in[2] + (2 * i) * 1024; }
    else if (idx < 12)  { const int i = idx - 10; d.W = P.in[17] + (size_t)i * 3584 * 1024; d.ldw = 1024; d.K = 3584; d.N = 1024; d.WT = wsp<bf16>(F, WS_WF_OUT) + (size_t)i * 1024 * 3584; d.mode = 0; d.gain = nullptr; }
    else if (idx < 28)  { const int q = idx - 12; d.W = P.in[19] + (size_t)q * 1024 * 7168; d.ldw = 7168; d.K = 1024; d.N = 7168; d.WT = wsp<bf16>(F, WS_WM_IN) + (size_t)q * 7168 * 1024; d.mode = 1; d.gain = P.in[2] + (2 * (q >> 3) + 1) * 1024; }
    else                { const int q = idx - 28; d.W = P.in[20] + (size_t)q * 3584 * 1024; d.ldw = 1024; d.K = 3584; d.N = 1024; d.WT = wsp<bf16>(F, WS_WM_OUT) + (size_t)q * 1024 * 3584; d.mode = 0; d.gain = nullptr; }
    return d;
}
constexpr int NMATS = 44;
constexpr int P0_ST = 129;
struct P0Dst { bf16* base; int K; };
DI int p0_ntiles(const MatDesc& d) { return (d.K / 128) * (d.N / 128); }
DI P0Dst p0_load(const MatDesc& d, int tile, int tid, f32x4 (&r)[8], float (&g)[8]) {
    const int ntn = d.N / 128, kb = tile / ntn, nb = tile % ntn, k0 = 128 * kb, n0 = 128 * nb;
#pragma unroll
    for (int p = 0; p < 8; ++p) { const int k = k0 + p * 16 + (tid >> 5); r[p] = *(const f32x4*)(d.W + (size_t)k * d.ldw + n0 + 4 * (tid & 31)); g[p] = d.gain ? d.gain[k] : 1.0f; }
    int drow0 = n0;
    if (d.mode == 1) drow0 = (n0 < FF) ? (n0 >> 7) * 256 : ((n0 - FF) >> 7) * 256 + 128;
    P0Dst o; o.base = d.WT + (size_t)drow0 * d.K + k0; o.K = d.K; return o;
}
template <class A> DI void p0_prologue(Frame& F, const A& P) {
    const int gw = F.vcu * NWAVES + F.wave, NGW = F.G * NWAVES;
    { const float* x = P.in[0]; bf16* xb = wsp<bf16>(F, WS_XB); float* ssq = wsp<float>(F, WS_SSQ);
      for (int m = gw; m < M; m += NGW) {
        const f32x4* xr = (const f32x4*)(x + (size_t)m * D) + F.lane; f32x4 v[4]; float s = 0.f;
#pragma unroll
        for (int j = 0; j < 4; ++j) { v[j] = xr[64 * j]; s += (v[j][0] * v[j][0] + v[j][1] * v[j][1]) + (v[j][2] * v[j][2] + v[j][3] * v[j][3]); }
        s = wave_sum(s);
        v2u* o8 = (v2u*)(xb + (size_t)m * D) + F.lane;
#pragma unroll
        for (int j = 0; j < 4; ++j) { v2u w; w.x = pk2(v[j][0], v[j][1]); w.y = pk2(v[j][2], v[j][3]); o8[64 * j] = w; }
        if (F.lane < 4) { f32x4 z = {0.f, 0.f, 0.f, 0.f}; if (F.lane == 0) z[0] = s; *((f32x4*)(ssq + (size_t)m * 16) + F.lane) = z; }
      } }
    LAS unsigned short* S = (LAS unsigned short*)F.lds;
    const int tid = F.tid;
    int mi = 0, base = 0; MatDesc d = get_mat(F, P, 0); int nt = p0_ntiles(d);
    int T = F.vcu;
    f32x4 r[8]; float g[8]; P0Dst dst; dst.base = nullptr; dst.K = 0; bool have = false;
    while (mi < NMATS && T >= base + nt) { base += nt; ++mi; if (mi < NMATS) { d = get_mat(F, P, mi); nt = p0_ntiles(d); } }
    if (mi < NMATS) { dst = p0_load(d, T - base, tid, r, g); have = true; }
    while (have) {
#pragma unroll
        for (int p = 0; p < 8; ++p) { LAS unsigned short* sp = S + (p * 16 + (tid >> 5)) * P0_ST + 4 * (tid & 31);
            sp[0] = (unsigned short)f2bf(r[p][0] * g[p]); sp[1] = (unsigned short)f2bf(r[p][1] * g[p]); sp[2] = (unsigned short)f2bf(r[p][2] * g[p]); sp[3] = (unsigned short)f2bf(r[p][3] * g[p]); }
        const P0Dst cur = dst;
        __syncthreads();
        T += F.G; have = false;
        while (mi < NMATS && T >= base + nt) { base += nt; ++mi; if (mi < NMATS) { d = get_mat(F, P, mi); nt = p0_ntiles(d); } }
        if (mi < NMATS) { dst = p0_load(d, T - base, tid, r, g); have = true; }
#pragma unroll
        for (int j = 0; j < 4; ++j) { const int c = tid + 512 * j, nl = c >> 4, kc = c & 15; const LAS unsigned short* sp = S + (8 * kc) * P0_ST + nl;
            v4u o; o.x = (unsigned)sp[0 * P0_ST] | ((unsigned)sp[1 * P0_ST] << 16); o.y = (unsigned)sp[2 * P0_ST] | ((unsigned)sp[3 * P0_ST] << 16);
            o.z = (unsigned)sp[4 * P0_ST] | ((unsigned)sp[5 * P0_ST] << 16); o.w = (unsigned)sp[6 * P0_ST] | ((unsigned)sp[7 * P0_ST] << 16);
            *(v4u*)(cur.base + (size_t)nl * cur.K + 8 * kc) = o; }
        __syncthreads();
    }
}

template <int NOUT> DI void thin_stage(Frame& F, const float* gain, const float* W, int ldw, int c0) {
    LAS float* wl = (LAS float*)(F.lds);
    for (int i = F.tid; i < 1024 * NOUT; i += NWAVES * 64) { const int k = i / NOUT, j = i % NOUT; wl[k * (NOUT + 4) + j] = gain[k] * W[(size_t)k * ldw + c0 + j]; }
    __syncthreads();
}
template <int NOUT> DI void thin_row(const bf16* xrow, LAS const float* wl, int lane, float& ss, float (&acc)[NOUT]) {
    float xv[16];
#pragma unroll
    for (int i = 0; i < 16; ++i) xv[i] = bf2f(xrow[lane + 64 * i]);
    ss = 0.f;
#pragma unroll
    for (int j = 0; j < NOUT; ++j) acc[j] = 0.f;
#pragma unroll
    for (int i = 0; i < 16; ++i) { ss += xv[i] * xv[i]; const LAS f32x4* wr = (const LAS f32x4*)(wl + (lane + 64 * i) * (NOUT + 4));
#pragma unroll
        for (int q = 0; q < NOUT / 4; ++q) { const f32x4 w = wr[q];
#pragma unroll
            for (int e = 0; e < 4; ++e) acc[4 * q + e] += xv[i] * w[e]; }
        __builtin_amdgcn_sched_barrier(0); }
    ss = wave_sum(ss);
#pragma unroll
    for (int j = 0; j < NOUT; ++j) acc[j] = wave_sum(acc[j]);
}
DI void glow_phase(Frame& F, const bf16* x, const float* gain, const float* Wb) {
    thin_stage<16>(F, gain, Wb, 3088, 3072);
    float* glow = wsp<float>(F, WS_GLOW);
    const int gw = F.vcu * NWAVES + F.wave, NGW = F.G * NWAVES;
    for (int row = gw; row < M; row += NGW) { float ss, acc[16]; thin_row<16>(x + (size_t)row * D, (LAS const float*)F.lds, F.lane, ss, acc);
        const float rs = 1.0f / sqrtf(ss * (1.0f / D) + EPS);
        if (F.lane == 0) {
#pragma unroll
            for (int q = 0; q < 4; ++q) { f32x4 o = {acc[4 * q] * rs, acc[4 * q + 1] * rs, acc[4 * q + 2] * rs, acc[4 * q + 3] * rs}; *((f32x4*)(glow + (size_t)row * 16) + q) = o; } } }
    __syncthreads();
}
DI void logf_phase(Frame& F, const bf16* x, const float* gain, const float* Wc, const float* fb) {
    thin_stage<8>(F, gain, Wc, 3080, 3072);
    float* logf = wsp<float>(F, WS_LOGF);
    const int gw = F.vcu * NWAVES + F.wave, NGW = F.G * NWAVES;
    for (int row = gw; row < M; row += NGW) { float ss, acc[8]; thin_row<8>(x + (size_t)row * D, (LAS const float*)F.lds, F.lane, ss, acc);
        const float rs = 1.0f / sqrtf(ss * (1.0f / D) + EPS);
        if (F.lane == 0) {
#pragma unroll
            for (int q = 0; q < 2; ++q) { f32x4 o;
#pragma unroll
                for (int e = 0; e < 4; ++e) o[e] = logsig(acc[4 * q + e] * rs + fb[4 * q + e]);
                *((f32x4*)(logf + (size_t)row * 8) + q) = o; } } }
    __syncthreads();
}
DI void router_phase(Frame& F, const bf16* x, const float* gain, const float* Wr, unsigned* gcnt) {
    thin_stage<8>(F, gain, Wr, 8, 0);
    LAS unsigned* lcnt = (LAS unsigned*)(F.lds + 65536);
    if (F.tid < 8) lcnt[F.tid] = 0u;
    __syncthreads();
    int* tok_e = wsp<int>(F, WS_TOKE); int* tok_p = wsp<int>(F, WS_TOKP); float* tok_g = wsp<float>(F, WS_TOKG); float* tok_rs = wsp<float>(F, WS_TOKRS); int* blkb = wsp<int>(F, WS_BLKB);
    const int gw = F.vcu * NWAVES + F.wave, NGW = F.G * NWAVES;
    for (int row = gw; row < M; row += NGW) { float ss, acc[8]; thin_row<8>(x + (size_t)row * D, (LAS const float*)F.lds, F.lane, ss, acc);
        const float rs = 1.0f / sqrtf(ss * (1.0f / D) + EPS);
        float v1 = acc[0] * rs; int i1 = 0;
#pragma unroll
        for (int e = 1; e < 8; ++e) { const float v = acc[e] * rs; if (v > v1) { v1 = v; i1 = e; } }
        float v2 = -3.0e38f; int i2 = 0;
#pragma unroll
        for (int e = 0; e < 8; ++e) { const float v = acc[e] * rs; if (e != i1 && v > v2) { v2 = v; i2 = e; } }
        const float g1 = 1.0f / (1.0f + __expf(v2 - v1)), g2 = 1.0f - g1;
        if (F.lane == 0) {
            const unsigned p1 = __hip_atomic_fetch_add(lcnt + i1, 1u, __ATOMIC_RELAXED, __HIP_MEMORY_SCOPE_WORKGROUP);
            const unsigned p2 = __hip_atomic_fetch_add(lcnt + i2, 1u, __ATOMIC_RELAXED, __HIP_MEMORY_SCOPE_WORKGROUP);
            tok_e[2 * row] = i1; tok_e[2 * row + 1] = i2; tok_p[2 * row] = (int)p1; tok_p[2 * row + 1] = (int)p2; tok_g[2 * row] = g1; tok_g[2 * row + 1] = g2; tok_rs[row] = rs; } }
    __syncthreads();
    if (F.tid < 8) { const unsigned b = __hip_atomic_fetch_add(gcnt + F.tid, lcnt[F.tid], __ATOMIC_RELAXED, __HIP_MEMORY_SCOPE_AGENT); blkb[F.vcu * 8 + F.tid] = (int)b; }
    __syncthreads();
}
DI void gather_phase(Frame& F, const unsigned* gcnt) {
    LAS int* seg = (LAS int*)(F.lds); LAS int* cntl = seg + 16;
    if (F.tid == 0) { int t = 0; for (int e = 0; e < 8; ++e) { const int c = (int)gcnt[e]; seg[e] = t; cntl[e] = c; t += (c + 255) & ~255; } seg[8] = t; }
    __syncthreads();
    const int* tok_e = wsp<int>(F, WS_TOKE); const int* tok_p = wsp<int>(F, WS_TOKP); const float* tok_g = wsp<float>(F, WS_TOKG); const float* tok_rs = wsp<float>(F, WS_TOKRS); const int* blkb = wsp<int>(F, WS_BLKB);
    int* rtok = wsp<int>(F, WS_ROWT); float* rgate = wsp<float>(F, WS_ROWG); float* rrs = wsp<float>(F, WS_ROWRS);
    const bf16* xb = wsp<bf16>(F, WS_XB); bf16* XS = wsp<bf16>(F, WS_XS);
    const int gw = F.vcu * NWAVES + F.wave, NGW = F.G * NWAVES;
    for (int row = gw; row < M; row += NGW) { const int owner = (row % NGW) / NWAVES;
        const v4u* src = (const v4u*)(xb + (size_t)row * D); const v4u a = src[F.lane], b = src[64 + F.lane];
#pragma unroll
        for (int slot = 0; slot < 2; ++slot) { const int e = tok_e[2 * row + slot]; const int r = seg[e] + blkb[owner * 8 + e] + tok_p[2 * row + slot];
            v4u* dst = (v4u*)(XS + (size_t)r * D); dst[F.lane] = a; dst[64 + F.lane] = b;
            if (F.lane == 0) { rtok[r] = 2 * row + slot; rgate[r] = tok_g[2 * row + slot]; rrs[r] = tok_rs[row]; } } }
    if (F.vcu == 0) { for (int e = 0; e < 8; ++e) for (int r = seg[e] + cntl[e] + F.tid; r < seg[e + 1]; r += NWAVES * 64) rtok[r] = -1; }
    __syncthreads();
}
DI void combine_phase(Frame& F, bool fin, const float* fg) {
    bf16* xb = wsp<bf16>(F, WS_XB); float* ssq = wsp<float>(F, WS_SSQ); const bf16* OS = wsp<bf16>(F, WS_OS);
    const int gw = F.vcu * NWAVES + F.wave, NGW = F.G * NWAVES;
    for (int m = gw; m < M; m += NGW) {
        const v2u* xr = (const v2u*)(xb + (size_t)m * D) + F.lane; const v2u* o0 = (const v2u*)(OS + (size_t)m * D) + F.lane; const v2u* o1 = (const v2u*)(OS + ((size_t)M + m) * D) + F.lane;
        f32x4 v[4]; float s = 0.f;
#pragma unroll
        for (int j = 0; j < 4; ++j) { const v2u c = xr[64 * j], a = o0[64 * j], b = o1[64 * j];
            v[j][0] = bflo(c.x) + (bflo(a.x) + bflo(b.x)); v[j][1] = bfhi(c.x) + (bfhi(a.x) + bfhi(b.x)); v[j][2] = bflo(c.y) + (bflo(a.y) + bflo(b.y)); v[j][3] = bfhi(c.y) + (bfhi(a.y) + bfhi(b.y));
            s += (v[j][0] * v[j][0] + v[j][1] * v[j][1]) + (v[j][2] * v[j][2] + v[j][3] * v[j][3]); }
        s = wave_sum(s);
        if (!fin) {
            v2u* o8 = (v2u*)(xb + (size_t)m * D) + F.lane;
#pragma unroll
            for (int j = 0; j < 4; ++j) { v2u w; w.x = pk2(v[j][0], v[j][1]); w.y = pk2(v[j][2], v[j][3]); o8[64 * j] = w; }
            if (F.lane < 4) { f32x4 z = {0.f, 0.f, 0.f, 0.f}; if (F.lane == 0) z[0] = s; *((f32x4*)(ssq + (size_t)m * 16) + F.lane) = z; }
        } else {
            const float rs = 1.0f / sqrtf(s * (1.0f / D) + EPS); f32x4* ow = (f32x4*)(F.out + (size_t)m * D) + F.lane; const f32x4* g4 = (const f32x4*)fg + F.lane;
#pragma unroll
            for (int j = 0; j < 4; ++j) { const f32x4 g = g4[64 * j]; ow[64 * j] = v[j] * rs * g; }
        }
    }
}
DI void final_norm_phase(Frame& F, const bf16* x, const float* fg) {
    const int gw = F.vcu * NWAVES + F.wave, NGW = F.G * NWAVES;
    for (int m = gw; m < M; m += NGW) {
        const v2u* xr = (const v2u*)(x + (size_t)m * D) + F.lane; f32x4 v[4]; float s = 0.f;
#pragma unroll
        for (int j = 0; j < 4; ++j) { const v2u c = xr[64 * j]; v[j] = (f32x4){bflo(c.x), bfhi(c.x), bflo(c.y), bfhi(c.y)}; s += (v[j][0] * v[j][0] + v[j][1] * v[j][1]) + (v[j][2] * v[j][2] + v[j][3] * v[j][3]); }
        s = wave_sum(s);
        const float rs = 1.0f / sqrtf(s * (1.0f / D) + EPS); f32x4* ow = (f32x4*)(F.out + (size_t)m * D) + F.lane; const f32x4* g4 = (const f32x4*)fg + F.lane;
#pragma unroll
        for (int j = 0; j < 4; ++j) { const f32x4 g = g4[64 * j]; ow[64 * j] = v[j] * rs * g; }
    }
}

DI void mix_phase(Frame& F, const float* ws_, const float* bs, const float* vg) {
    constexpr int WT_OFF = 0, WT_ST = 272, VT_OFF = 34816, VT_ST = 272, RS_OFF = 104448;
    const bf16* U = wsp<bf16>(F, WS_U); const bf16* V = wsp<bf16>(F, WS_V); bf16* Y = wsp<bf16>(F, WS_Y); const float* vssq = wsp<float>(F, WS_VSSQ);
    LAS unsigned char* lds = F.lds; LAS float* rsv = (LAS float*)(lds + RS_OFF);
    const int tid = F.tid, lane = F.lane, w = F.wave, fr = lane & 15, fq = lane >> 4;
    for (int uidx = F.vcu; uidx < 2048; uidx += F.G) {
        const int c = uidx >> 3, g = uidx & 7; const int tok0 = c * 128;
        if (tid < 128) { const f32x4* p = (const f32x4*)(vssq + (size_t)(tok0 + tid) * 32); float s = 0.f;
#pragma unroll
            for (int q = 0; q < 8; ++q) { const f32x4 a = p[q]; s += (a[0] + a[1]) + (a[2] + a[3]); }
            rsv[tid] = 1.0f / sqrtf(s * (1.0f / AW) + EPS); }
        __syncthreads();
#pragma unroll
        for (int it = 0; it < 8; ++it) { const int idx = it * 512 + tid, t = idx >> 5, s4 = (idx & 31) * 4;
            const f32x4 wv = *(const f32x4*)(ws_ + ((size_t)g * 128 + t) * 128 + s4);
            float a0 = (s4 + 0 <= t) ? wv[0] * rsv[s4 + 0] : 0.f, a1 = (s4 + 1 <= t) ? wv[1] * rsv[s4 + 1] : 0.f, a2 = (s4 + 2 <= t) ? wv[2] * rsv[s4 + 2] : 0.f, a3 = (s4 + 3 <= t) ? wv[3] * rsv[s4 + 3] : 0.f;
            v2u o; o.x = pk2(a0, a1); o.y = pk2(a2, a3); *(LAS v2u*)(lds + WT_OFF + t * WT_ST + s4 * 2) = o; }
#pragma unroll
        for (int it = 0; it < 8; ++it) { const int idx = it * 512 + tid, s = (idx & 15) + 16 * (idx >> 9), d8 = ((idx >> 4) & 31) * 8;
            const v4u vv = *(const v4u*)(V + (size_t)(tok0 + s) * AW + g * 256 + d8);
            LAS unsigned short* p = (LAS unsigned short*)(lds + VT_OFF + d8 * VT_ST + s * 2);
            p[0 * (VT_ST / 2)] = (unsigned short)(vv.x & 0xffffu); p[1 * (VT_ST / 2)] = (unsigned short)(vv.x >> 16); p[2 * (VT_ST / 2)] = (unsigned short)(vv.y & 0xffffu); p[3 * (VT_ST / 2)] = (unsigned short)(vv.y >> 16);
            p[4 * (VT_ST / 2)] = (unsigned short)(vv.z & 0xffffu); p[5 * (VT_ST / 2)] = (unsigned short)(vv.z >> 16); p[6 * (VT_ST / 2)] = (unsigned short)(vv.w & 0xffffu); p[7 * (VT_ST / 2)] = (unsigned short)(vv.w >> 16); }
        __syncthreads();
        f32x4 acc[8][2];
#pragma unroll
        for (int mt = 0; mt < 8; ++mt) { acc[mt][0] = (f32x4){0.f, 0.f, 0.f, 0.f}; acc[mt][1] = (f32x4){0.f, 0.f, 0.f, 0.f}; }
#pragma unroll
        for (int ks = 0; ks < 4; ++ks) {
            const bf16x8 b0 = ldsfrag(lds + VT_OFF + (32 * w + fr) * VT_ST + (32 * ks + 8 * fq) * 2), b1 = ldsfrag(lds + VT_OFF + (32 * w + 16 + fr) * VT_ST + (32 * ks + 8 * fq) * 2);
#pragma unroll
            for (int mt = 0; mt < 8; ++mt) { if (32 * ks > 16 * mt + 15) continue;
                const bf16x8 a = ldsfrag(lds + WT_OFF + (16 * mt + fr) * WT_ST + (32 * ks + 8 * fq) * 2);
                acc[mt][0] = MFMA16(b0, a, acc[mt][0]); acc[mt][1] = MFMA16(b1, a, acc[mt][1]); } }
#pragma unroll
        for (int mt = 0; mt < 8; ++mt) { const int t = 16 * mt + fr; const float bt = bs[g * 128 + t];
#pragma unroll
            for (int n2 = 0; n2 < 2; ++n2) { const int col = g * 256 + 32 * w + 16 * n2 + 4 * fq; const size_t o = (size_t)(tok0 + t) * AW + col;
                const v2u uu = *(const v2u*)(U + o); const f32x4 gg = *(const f32x4*)(vg + col); const f32x4 a = acc[mt][n2];
                v2u r; r.x = pk2(bflo(uu.x) * (a[0] * gg[0] + bt), bfhi(uu.x) * (a[1] * gg[1] + bt)); r.y = pk2(bflo(uu.y) * (a[2] * gg[2] + bt), bfhi(uu.y) * (a[3] * gg[3] + bt));
                *(v2u*)(Y + o) = r; } }
        __syncthreads();
    }
}

DI void gla_prep_phase(Frame& F, const float* wg2, const float* gb) {
    const bf16* QKVR = wsp<bf16>(F, WS_QKVR); const float* glow = wsp<float>(F, WS_GLOW);
    bf16* QD = wsp<bf16>(F, WS_QD); bf16* KD = wsp<bf16>(F, WS_KD); bf16* KET = wsp<bf16>(F, WS_KET); bf16* VT = wsp<bf16>(F, WS_VT); float* DEC = wsp<float>(F, WS_DEC);
    LAS float* gl = (LAS float*)(F.lds); LAS float* segs = (LAS float*)(F.lds + 4096);
    const int tid = F.tid;
    for (int uidx = F.vcu; uidx < 2048; uidx += F.G) {
        const int h = uidx & 3, n = (uidx >> 2) & 63, b = uidx >> 8; const int t0 = b * SEQ + n * 64; const int bhn = (b * 4 + h) * 64 + n;
        if (tid < 256) *((LAS f32x4*)gl + tid) = *((const f32x4*)(glow + (size_t)t0 * 16) + tid);
        const int k = tid & 127, tq = tid >> 7;
        float wv[16];
#pragma unroll
        for (int r = 0; r < 16; ++r) wv[r] = wg2[r * 512 + h * 128 + k];
        const float bias = gb[h * 128 + k];
        __syncthreads();
        float bc[16]; float cum = 0.f;
#pragma unroll
        for (int i = 0; i < 16; ++i) { const LAS f32x4* gp = (const LAS f32x4*)(gl + (tq * 16 + i) * 16); float z = bias;
#pragma unroll
            for (int q = 0; q < 4; ++q) { const f32x4 g4 = gp[q]; z += g4[0] * wv[4 * q] + g4[1] * wv[4 * q + 1] + g4[2] * wv[4 * q + 2] + g4[3] * wv[4 * q + 3]; }
            cum += logsig(z) * (1.0f / 16.0f); bc[i] = cum; }
        segs[tq * 128 + k] = cum;
        __syncthreads();
        const float s0 = segs[k], s1 = segs[128 + k], s2 = segs[256 + k], s3 = segs[384 + k];
        const float offs = (tq > 0 ? s0 : 0.f) + (tq > 1 ? s1 : 0.f) + (tq > 2 ? s2 : 0.f); const float blast = (s0 + s1) + (s2 + s3);
        unsigned kep[8];
#pragma unroll
        for (int i = 0; i < 16; i += 2) { float ke2[2];
#pragma unroll
            for (int e = 0; e < 2; ++e) { const int ii = i + e; const size_t tok = (size_t)(t0 + tq * 16 + ii); const float bcum = bc[ii] + offs;
                const float qv = bf2f(QKVR[tok * 3072 + h * 128 + k]), kv = bf2f(QKVR[tok * 3072 + 512 + h * 128 + k]);
                QD[tok * 512 + h * 128 + k] = (bf16)f2bf(qv * 0.08838834764831845f * __expf(bcum));
                KD[tok * 512 + h * 128 + k] = (bf16)f2bf(kv * __expf(-bcum));
                ke2[e] = kv * __expf(blast - bcum); }
            kep[i >> 1] = pk2(ke2[0], ke2[1]); }
        { v4u* dst = (v4u*)(KET + ((size_t)bhn * 128 + k) * 64 + tq * 16); v4u o0 = {kep[0], kep[1], kep[2], kep[3]}, o1 = {kep[4], kep[5], kep[6], kep[7]}; dst[0] = o0; dst[1] = o1; }
        if (tq == 0) DEC[(size_t)bhn * 128 + k] = __expf(blast);
        { const int dv = tid & 255, sh = tid >> 8; unsigned vp[16];
#pragma unroll
          for (int i = 0; i < 32; i += 2) { const unsigned lo = QKVR[(size_t)(t0 + sh * 32 + i) * 3072 + 1024 + h * 256 + dv], hi = QKVR[(size_t)(t0 + sh * 32 + i + 1) * 3072 + 1024 + h * 256 + dv]; vp[i >> 1] = lo | (hi << 16); }
          v4u* dst = (v4u*)(VT + ((size_t)bhn * 256 + dv) * 64 + sh * 32);
#pragma unroll
          for (int q = 0; q < 4; ++q) { v4u o = {vp[4 * q], vp[4 * q + 1], vp[4 * q + 2], vp[4 * q + 3]}; dst[q] = o; } }
        __syncthreads();
    }
}

DI void gla_scan_phase(Frame& F) {
    constexpr int QD_OFF = 0, KD_OFF = 17408, KET_OFF = 34816, VT_OFF = 53248, ATT_OFF = 57856, ST_OFF = 67072, ST272 = 272, ST144 = 144;
    const bf16* QD = wsp<bf16>(F, WS_QD); const bf16* KD = wsp<bf16>(F, WS_KD); const bf16* KET = wsp<bf16>(F, WS_KET); const bf16* VT = wsp<bf16>(F, WS_VT); const float* DEC = wsp<float>(F, WS_DEC);
    bf16* GO = wsp<bf16>(F, WS_GO); float* ossq = wsp<float>(F, WS_OSSQ);
    LAS unsigned char* lds = F.lds;
    const int tid = F.tid, lane = F.lane, w = F.wave, fr = lane & 15, fq = lane >> 4;
    for (int uidx = F.vcu; uidx < 256; uidx += F.G) {
        const int vb = uidx & 7, h = (uidx >> 3) & 3, b = uidx >> 5;
        for (int i = tid; i < (32 * ST272) / 4; i += NWAVES * 64) ((LAS unsigned*)(lds + ST_OFF))[i] = 0u;
        f32x4 st[2] = {(f32x4){0.f, 0.f, 0.f, 0.f}, (f32x4){0.f, 0.f, 0.f, 0.f}};
        v4u pq[2], pk[2], pe[2], pv; float pdec;
#define GLA_LOAD(nn) do { const int bhn_ = (b * 4 + h) * 64 + (nn); const size_t t0_ = (size_t)b * SEQ + (size_t)(nn) * 64; \
            _Pragma("unroll") for (int i_ = 0; i_ < 2; ++i_) { const int c_ = tid + 512 * i_; const int r_ = c_ >> 4, ch_ = c_ & 15; \
                pq[i_] = *(const v4u*)(QD + (t0_ + r_) * 512 + h * 128 + ch_ * 8); pk[i_] = *(const v4u*)(KD + (t0_ + r_) * 512 + h * 128 + ch_ * 8); \
                pe[i_] = *(const v4u*)(KET + (size_t)bhn_ * 8192 + (size_t)c_ * 8); } \
            if (tid < 256) pv = *(const v4u*)(VT + ((size_t)bhn_ * 256 + vb * 32) * 64 + (size_t)tid * 8); \
            pdec = DEC[(size_t)bhn_ * 128 + 16 * w + fr]; } while (0)
        GLA_LOAD(0);
        for (int n = 0; n < 64; ++n) {
#pragma unroll
            for (int i = 0; i < 2; ++i) { const int c = tid + 512 * i; const int r = c >> 4, ch = c & 15;
                *(LAS v4u*)(lds + QD_OFF + r * ST272 + ch * 16) = pq[i]; *(LAS v4u*)(lds + KD_OFF + r * ST272 + ch * 16) = pk[i];
                const int rk = c >> 3, ck = c & 7; *(LAS v4u*)(lds + KET_OFF + rk * ST144 + ck * 16) = pe[i]; }
            if (tid < 256) { const int rv = tid >> 3, cv = tid & 7; *(LAS v4u*)(lds + VT_OFF + rv * ST144 + cv * 16) = pv; }
            const float dec = pdec;
            __syncthreads();
            if (n + 1 < 64) GLA_LOAD(n + 1);
            const int mt = w & 3, nt = w >> 2;
            const size_t tok0 = (size_t)b * SEQ + (size_t)n * 64;
            f32x4 oacc = {0.f, 0.f, 0.f, 0.f};
#pragma unroll
            for (int ks = 0; ks < 4; ++ks) { const bf16x8 a = ldsfrag(lds + QD_OFF + (16 * mt + fr) * ST272 + (32 * ks + 8 * fq) * 2), bb = ldsfrag(lds + ST_OFF + (16 * nt + fr) * ST272 + (32 * ks + 8 * fq) * 2);
                oacc = MFMA16(bb, a, oacc); }
#pragma unroll
            for (int q = 0; q < 2; ++q) { const int stile = 2 * nt + q; f32x4 sacc = {0.f, 0.f, 0.f, 0.f};
                if (stile <= mt) {
#pragma unroll
                    for (int ks = 0; ks < 4; ++ks) { const bf16x8 a = ldsfrag(lds + QD_OFF + (16 * mt + fr) * ST272 + (32 * ks + 8 * fq) * 2), bb = ldsfrag(lds + KD_OFF + (16 * stile + fr) * ST272 + (32 * ks + 8 * fq) * 2);
                        sacc = MFMA16(bb, a, sacc); } }
                const int t = 16 * mt + fr, s0 = 16 * stile + 4 * fq;
                const float a0 = (s0 + 0 <= t) ? sacc[0] : 0.f, a1 = (s0 + 1 <= t) ? sacc[1] : 0.f, a2 = (s0 + 2 <= t) ? sacc[2] : 0.f, a3 = (s0 + 3 <= t) ? sacc[3] : 0.f;
                v2u o; o.x = pk2(a0, a1); o.y = pk2(a2, a3); *(LAS v2u*)(lds + ATT_OFF + t * ST144 + s0 * 2) = o; }
#pragma unroll
            for (int vt = 0; vt < 2; ++vt) { st[vt] = st[vt] * dec;
#pragma unroll
                for (int ks = 0; ks < 2; ++ks) { const bf16x8 a = ldsfrag(lds + VT_OFF + (16 * vt + fr) * ST144 + (32 * ks + 8 * fq) * 2), bb = ldsfrag(lds + KET_OFF + (16 * w + fr) * ST144 + (32 * ks + 8 * fq) * 2);
                    st[vt] = MFMA16(a, bb, st[vt]); } }
            __syncthreads();
#pragma unroll
            for (int vt = 0; vt < 2; ++vt)
#pragma unroll
                for (int j = 0; j < 4; ++j) *(LAS unsigned short*)(lds + ST_OFF + (16 * vt + 4 * fq + j) * ST272 + (16 * w + fr) * 2) = (unsigned short)f2bf(st[vt][j]);
#pragma unroll
            for (int ks = 0; ks < 2; ++ks) { const bf16x8 a = ldsfrag(lds + ATT_OFF + (16 * mt + fr) * ST144 + (32 * ks + 8 * fq) * 2), bb = ldsfrag(lds + VT_OFF + (16 * nt + fr) * ST144 + (32 * ks + 8 * fq) * 2);
                oacc = MFMA16(bb, a, oacc); }
            { const size_t tok = tok0 + 16 * mt + fr; const int col = h * 256 + vb * 32 + 16 * nt + 4 * fq;
              v2u o; o.x = pk2(oacc[0], oacc[1]); o.y = pk2(oacc[2], oacc[3]); *(v2u*)(GO + tok * 1024 + col) = o;
              float sq = (oacc[0] * oacc[0] + oacc[1] * oacc[1]) + (oacc[2] * oacc[2] + oacc[3] * oacc[3]); sq += __shfl_xor(sq, 16); sq += __shfl_xor(sq, 32);
              if (fq == 0) ossq[(tok * 4 + h) * 16 + vb * 2 + nt] = sq; }
            __syncthreads();
        }
#undef GLA_LOAD
    }
}
DI void gla_gate_phase(Frame& F, const float* og) {
    const bf16* GO = wsp<bf16>(F, WS_GO); const bf16* QKVR = wsp<bf16>(F, WS_QKVR); const float* ossq = wsp<float>(F, WS_OSSQ); bf16* GG = wsp<bf16>(F, WS_GG);
    const int gw = F.vcu * NWAVES + F.wave, NGW = F.G * NWAVES, lane = F.lane;
    const int c0 = 16 * lane, hh = lane >> 4;
    f32x4 g4[4];
#pragma unroll
    for (int q = 0; q < 4; ++q) g4[q] = *(const f32x4*)(og + (c0 & 255) + 4 * q);
    for (int m = gw; m < M; m += NGW) {
        const f32x4* sp = (const f32x4*)(ossq + ((size_t)m * 4 + hh) * 16); float s = 0.f;
#pragma unroll
        for (int q = 0; q < 4; ++q) { const f32x4 a = sp[q]; s += (a[0] + a[1]) + (a[2] + a[3]); }
        const float rs = 1.0f / sqrtf(s * (1.0f / 256.0f) + EPS);
        const v4u* op = (const v4u*)(GO + (size_t)m * 1024 + c0); const v4u* rp = (const v4u*)(QKVR + (size_t)m * 3072 + 2048 + c0);
        v4u* dp = (v4u*)(GG + (size_t)m * 1024 + c0);
#pragma unroll
        for (int q = 0; q < 2; ++q) { const v4u o = op[q], r = rp[q]; v4u d; const f32x4 ga = g4[2 * q], gb = g4[2 * q + 1];
            d.x = pk2(bflo(o.x) * rs * ga[0] * pg8::silu_f(bflo(r.x)), bfhi(o.x) * rs * ga[1] * pg8::silu_f(bfhi(r.x)));
            d.y = pk2(bflo(o.y) * rs * ga[2] * pg8::silu_f(bflo(r.y)), bfhi(o.y) * rs * ga[3] * pg8::silu_f(bfhi(r.y)));
            d.z = pk2(bflo(o.z) * rs * gb[0] * pg8::silu_f(bflo(r.z)), bfhi(o.z) * rs * gb[1] * pg8::silu_f(bfhi(r.z)));
            d.w = pk2(bflo(o.w) * rs * gb[2] * pg8::silu_f(bflo(r.w)), bfhi(o.w) * rs * gb[3] * pg8::silu_f(bfhi(r.w)));
            dp[q] = d; }
    }
}

DI void fox_attn_phase(Frame& F) {
    constexpr int K_OFF = 0, KST = 272, V_OFF = 17408, VST = 144, C_OFF = 35840, WS_OFF = 52224;
    const bf16* QKV = wsp<bf16>(F, WS_QKVR); const float* logf = wsp<float>(F, WS_LOGF); bf16* AO = wsp<bf16>(F, WS_AO);
    LAS unsigned char* lds = F.lds; LAS float* cl = (LAS float*)(lds + C_OFF); LAS float* wsum = (LAS float*)(lds + WS_OFF);
    const int tid = F.tid, lane = F.lane, w = F.wave, fr = lane & 15, fq = lane >> 4;
    constexpr float SC2 = 0.08838834764831845f * 1.4426950408889634f, L2E = 1.4426950408889634f;
    for (int U = F.vcu; U < 1024; U += F.G) {
        const int r_ = U >> 8, v_ = U & 255, bh = v_ >> 2, i_ = v_ & 3; const int b = bh >> 3, h = bh & 7;
        const int qt = (r_ == 0) ? i_ : (r_ == 1) ? 7 - i_ : (r_ == 2) ? 8 + i_ : 15 - i_;
        const int nkeys = (qt + 1) * 256;
        { float v8[8]; float tot = 0.f; const int p0 = tid * 8;
#pragma unroll
          for (int e = 0; e < 8; ++e) { v8[e] = (p0 < nkeys) ? logf[((size_t)b * SEQ + p0 + e) * 8 + h] : 0.f; tot += v8[e]; v8[e] = tot; }
          float inc = tot;
#pragma unroll
          for (int o = 1; o < 64; o <<= 1) { const float t = __shfl_up(inc, o); if (lane >= o) inc += t; }
          if (lane == 63) wsum[w] = inc;
          __syncthreads();
          float woff = 0.f;
#pragma unroll
          for (int q = 0; q < 8; ++q) woff += (q < w) ? wsum[q] : 0.f;
          const float excl = woff + inc - tot;
          if (p0 < nkeys) {
#pragma unroll
              for (int e = 0; e < 8; ++e) cl[p0 + e] = excl + v8[e]; }
          __syncthreads(); }
        const int q0 = qt * 256 + 32 * w;
        bf16x8 qf[2][4]; float cq[2], mrow[2], lrow[2]; f32x4 oacc[2][8];
#pragma unroll
        for (int mt = 0; mt < 2; ++mt) { const size_t tok = (size_t)b * SEQ + q0 + 16 * mt + fr;
#pragma unroll
            for (int ks = 0; ks < 4; ++ks) qf[mt][ks] = *(const bf16x8*)(QKV + tok * 3072 + h * 128 + 32 * ks + 8 * fq);
            cq[mt] = cl[q0 + 16 * mt + fr] * L2E; mrow[mt] = -1.0e30f; lrow[mt] = 0.f;
#pragma unroll
            for (int dt = 0; dt < 8; ++dt) oacc[mt][dt] = (f32x4){0.f, 0.f, 0.f, 0.f}; }
        const int ntiles = 4 * (qt + 1);
        v4u pk_[2], pv_[2];
#define FOX_LOAD(jj) do { _Pragma("unroll") for (int i2 = 0; i2 < 2; ++i2) { const int c2 = tid + 512 * i2; \
            pk_[i2] = *(const v4u*)(QKV + ((size_t)b * SEQ + 64 * (jj) + (c2 >> 4)) * 3072 + 1024 + h * 128 + (c2 & 15) * 8); \
            pv_[i2] = *(const v4u*)(QKV + ((size_t)b * SEQ + 64 * (jj) + (c2 & 63)) * 3072 + 2048 + h * 128 + (c2 >> 6) * 8); } } while (0)
        FOX_LOAD(0);
        for (int j = 0; j < ntiles; ++j) {
#pragma unroll
            for (int i2 = 0; i2 < 2; ++i2) { const int c2 = tid + 512 * i2;
                *(LAS v4u*)(lds + K_OFF + (c2 >> 4) * KST + (c2 & 15) * 16) = pk_[i2];
                LAS unsigned short* p = (LAS unsigned short*)(lds + V_OFF + ((c2 >> 6) * 8) * VST + (c2 & 63) * 2); const v4u vv = pv_[i2];
                p[0 * (VST / 2)] = (unsigned short)(vv.x & 0xffffu); p[1 * (VST / 2)] = (unsigned short)(vv.x >> 16); p[2 * (VST / 2)] = (unsigned short)(vv.y & 0xffffu); p[3 * (VST / 2)] = (unsigned short)(vv.y >> 16);
                p[4 * (VST / 2)] = (unsigned short)(vv.z & 0xffffu); p[5 * (VST / 2)] = (unsigned short)(vv.z >> 16); p[6 * (VST / 2)] = (unsigned short)(vv.w & 0xffffu); p[7 * (VST / 2)] = (unsigned short)(vv.w >> 16); }
            __syncthreads();
            if (j + 1 < ntiles) FOX_LOAD(j + 1);
            const int key0 = 64 * j;
            if (key0 <= q0 + 31) {
                f32x4 sacc[4][2];
#pragma unroll
                for (int nt = 0; nt < 4; ++nt) { sacc[nt][0] = (f32x4){0.f, 0.f, 0.f, 0.f}; sacc[nt][1] = (f32x4){0.f, 0.f, 0.f, 0.f}; }
#pragma unroll
                for (int ks = 0; ks < 4; ++ks)
#pragma unroll
                    for (int nt = 0; nt < 4; ++nt) { const bf16x8 a = ldsfrag(lds + K_OFF + (16 * nt + fr) * KST + (32 * ks + 8 * fq) * 2);
                        sacc[nt][0] = MFMA16(a, qf[0][ks], sacc[nt][0]); sacc[nt][1] = MFMA16(a, qf[1][ks], sacc[nt][1]); }
                const bool diag = (key0 + 63 > q0);
                float mx[2] = {-__builtin_inff(), -__builtin_inff()};
#pragma unroll
                for (int nt = 0; nt < 4; ++nt) { const f32x4 ck = *(const LAS f32x4*)(cl + key0 + 16 * nt + 4 * fq);
#pragma unroll
                    for (int mt = 0; mt < 2; ++mt)
#pragma unroll
                        for (int e = 0; e < 4; ++e) { float v = sacc[nt][mt][e] * SC2 + (cq[mt] - ck[e] * L2E);
                            if (diag && (key0 + 16 * nt + 4 * fq + e > q0 + 16 * mt + fr)) v = -__builtin_inff();
                            sacc[nt][mt][e] = v; mx[mt] = fmaxf(mx[mt], v); } }
                bf16x8 pf[2][2];
#pragma unroll
                for (int mt = 0; mt < 2; ++mt) { float m_ = mx[mt]; m_ = fmaxf(m_, __shfl_xor(m_, 16)); m_ = fmaxf(m_, __shfl_xor(m_, 32));
                    const float mnew = fmaxf(mrow[mt], m_); const float alpha = __builtin_amdgcn_exp2f(mrow[mt] - mnew); mrow[mt] = mnew;
                    float ls = 0.f; unsigned pw[8];
#pragma unroll
                    for (int nt = 0; nt < 4; ++nt) { float p0 = __builtin_amdgcn_exp2f(sacc[nt][mt][0] - mnew), p1 = __builtin_amdgcn_exp2f(sacc[nt][mt][1] - mnew), p2 = __builtin_amdgcn_exp2f(sacc[nt][mt][2] - mnew), p3 = __builtin_amdgcn_exp2f(sacc[nt][mt][3] - mnew);
                        ls += (p0 + p1) + (p2 + p3); pw[2 * nt] = pk2(p0, p1); pw[2 * nt + 1] = pk2(p2, p3); }
                    lrow[mt] = lrow[mt] * alpha + ls;
#pragma unroll
                    for (int dt = 0; dt < 8; ++dt) oacc[mt][dt] = oacc[mt][dt] * alpha;
                    { v4u t0 = {pw[0], pw[1], pw[2], pw[3]}, t1 = {pw[4], pw[5], pw[6], pw[7]}; pf[mt][0] = __builtin_bit_cast(bf16x8, t0); pf[mt][1] = __builtin_bit_cast(bf16x8, t1); } }
#pragma unroll
                for (int ks2 = 0; ks2 < 2; ++ks2)
#pragma unroll
                    for (int dt = 0; dt < 8; ++dt) { const LAS unsigned char* vp = lds + V_OFF + (16 * dt + fr) * VST + (32 * ks2 + 4 * fq) * 2;
                        const v2u lo = *(const LAS v2u*)vp, hi = *(const LAS v2u*)(vp + 32); v4u av = {lo.x, lo.y, hi.x, hi.y}; const bf16x8 a = __builtin_bit_cast(bf16x8, av);
                        oacc[0][dt] = MFMA16(a, pf[0][ks2], oacc[0][dt]); oacc[1][dt] = MFMA16(a, pf[1][ks2], oacc[1][dt]); }
            }
            __syncthreads();
        }
#undef FOX_LOAD
#pragma unroll
        for (int mt = 0; mt < 2; ++mt) { float l = lrow[mt]; l += __shfl_xor(l, 16); l += __shfl_xor(l, 32); const float inv = 1.0f / l;
            const size_t tok = (size_t)b * SEQ + q0 + 16 * mt + fr;
#pragma unroll
            for (int dt = 0; dt < 8; ++dt) { const f32x4 o = oacc[mt][dt] * inv; v2u r; r.x = pk2(o[0], o[1]); r.y = pk2(o[2], o[3]); *(v2u*)(AO + tok * 1024 + h * 128 + 16 * dt + 4 * fq) = r; } }
        __syncthreads();
    }
}

constexpr int N_PHASES = 2 + 10 * MK_LAYERS;
__host__ __device__ constexpr bool phase_active(int id) {
    if (id == 0) return true;
    if (id == 1 + 10 * MK_LAYERS) return (MK_LAYERS % 2) == 1;
    const int l = (id - 1) / 10, s = (id - 1) % 10, mixer = l % 3; const bool moe = (l % 2) == 1;
    if (s == 0 || s == 1 || s == 4) return true;
    if (s == 2 || s == 3) return mixer == 1;
    if (s == 5 || s == 6) return true;
    return moe;
}
struct Args { const float* in[22]; float* out; unsigned char* ws; int ph_lo, ph_hi; };
#define IN(k) (lo <= (k) && (k) < hi)
#ifndef PROBE_MASK
#define PROBE_MASK 0
#endif
#define REPS(bit) _Pragma("unroll 1") for (int r_ = 0; r_ < ((PROBE_MASK & (bit)) ? 2 : 1); ++r_)
#define SEAM(k) do { if ((k) + 1 < hi) xcd_barrier(bar); } while (0)
template <int L> DI void run_layer(Frame& F, const Args& args, const XcdBarrier& bar, const int lo, const int hi) {
    constexpr int l = L, mixer = L % 3, jm = L / 3, fi = L / 2, pb = 1 + 10 * L; constexpr bool moe = (L & 1) != 0;
    bf16* XB = wsp<bf16>(F, WS_XB); float* SSQ = wsp<float>(F, WS_SSQ);
    if (IN(pb + 0)) {
        if constexpr (mixer == 0) { REPS(256) {
            pg8::Gemm g{XB, wsp<bf16>(F, WS_WA_IN) + (size_t)jm * 4096 * 1024, M, 4096, D}; pg8::StaticOrder S; S.init(M, 4096, F.G, (int)blockIdx.x);
            pg8::EpiAin E{SSQ, wsp<bf16>(F, WS_U), wsp<bf16>(F, WS_V), wsp<float>(F, WS_VSSQ)};
            pg8::gemm_phase<pg8::EpiAin, pg8::StaticOrder, true, true>(F.lds + RING_OFF, g, S, E); if (r_ == 0 && (PROBE_MASK & 256)) xcd_barrier(bar); }
        } else {
            REPS(128) { if constexpr (mixer == 1) glow_phase(F, XB, args.in[1] + l * 1024, args.in[8]); else logf_phase(F, XB, args.in[1] + l * 1024, args.in[13], args.in[14]); }
            REPS(512) {
            pg8::Gemm g{XB, mixer == 1 ? wsp<bf16>(F, WS_WB_IN) : wsp<bf16>(F, WS_WC_IN), M, 3072, D}; pg8::StaticOrder S; S.init(M, 3072, F.G, (int)blockIdx.x);
            pg8::EpiRow E{SSQ, wsp<bf16>(F, WS_QKVR), 3072};
            pg8::gemm_phase<pg8::EpiRow, pg8::StaticOrder, true, true>(F.lds + RING_OFF, g, S, E); if (r_ == 0 && (PROBE_MASK & 512)) xcd_barrier(bar); }
        }
        SEAM(pb + 0);
    }
    if (IN(pb + 1)) { REPS(mixer == 0 ? 2 : mixer == 1 ? 4 : 32) {
        if constexpr (mixer == 0) mix_phase(F, args.in[5] + (size_t)jm * 8 * 128 * 128, args.in[6] + (size_t)jm * 8 * 128, args.in[4] + (size_t)jm * AW);
        else if constexpr (mixer == 1) gla_prep_phase(F, args.in[9], args.in[10]);
        else fox_attn_phase(F);
        SEAM(pb + 1); } }
    if constexpr (mixer == 1) {
        if (IN(pb + 2)) { REPS(8) { gla_scan_phase(F); SEAM(pb + 2); } }
        if (IN(pb + 3)) { REPS(16) { gla_gate_phase(F, args.in[11]); SEAM(pb + 3); } }
    }
    if (IN(pb + 4)) { REPS(l == 0 ? 8192 : 0) {
        const bf16* A = mixer == 0 ? wsp<bf16>(F, WS_Y) : mixer == 1 ? wsp<bf16>(F, WS_GG) : wsp<bf16>(F, WS_AO);
        const bf16* Bt = mixer == 0 ? wsp<bf16>(F, WS_WA_OUT) + (size_t)jm * 1024 * 2048 : mixer == 1 ? wsp<bf16>(F, WS_WB_OUT) : wsp<bf16>(F, WS_WC_OUT);
        pg8::Gemm g{A, Bt, M, D, mixer == 0 ? 2048 : 1024}; pg8::StaticOrder S; S.init(M, D, F.G, (int)blockIdx.x);
        pg8::EpiResid<l == 0> E{l == 0 ? (const void*)args.in[0] : (const void*)XB, XB, SSQ};
        pg8::gemm_phase<pg8::EpiResid<l == 0>, pg8::StaticOrder, true, true>(F.lds + RING_OFF, g, S, E);
        SEAM(pb + 4);
    } }
    if constexpr (!moe) {
        if (IN(pb + 5)) { REPS(1024) {
            pg8::Gemm g{XB, wsp<bf16>(F, WS_WF_IN) + (size_t)fi * 7168 * 1024, M, 7168, D}; pg8::StaticOrder S; S.init(M, 7168, F.G, (int)blockIdx.x);
            pg8::EpiSwiGLU<0> E{SSQ, wsp<bf16>(F, WS_HF)};
            pg8::gemm_phase<pg8::EpiSwiGLU<0>, pg8::StaticOrder, true, true>(F.lds + RING_OFF, g, S, E);
            SEAM(pb + 5);
        } }
        if (IN(pb + 6)) {
            pg8::Gemm g{wsp<bf16>(F, WS_HF), wsp<bf16>(F, WS_WF_OUT) + (size_t)fi * 1024 * 3584, M, D, FF}; pg8::StaticOrder S; S.init(M, D, F.G, (int)blockIdx.x);
            pg8::EpiResid<false> E{(const void*)XB, XB, SSQ};
            pg8::gemm_phase<pg8::EpiResid<false>, pg8::StaticOrder, true, true>(F.lds + RING_OFF, g, S, E);
            SEAM(pb + 6);
        }
    } else {
        unsigned* gcnt = (unsigned*)(F.ctl + CW_CNT + 64 * l);
        if (IN(pb + 5)) { router_phase(F, XB, args.in[2] + l * 1024, args.in[18] + (size_t)fi * 1024 * 8, gcnt); SEAM(pb + 5); }
        if (IN(pb + 6)) { REPS(64) { gather_phase(F, gcnt); SEAM(pb + 6); } }
        if (IN(pb + 7)) { REPS(2048) {
            pg8::Gemm g{wsp<bf16>(F, WS_XS), wsp<bf16>(F, WS_WM_IN) + (size_t)fi * 8 * 7168 * 1024, MROWS, 7168, D}; pg8::GroupedOrder S; S.init(gcnt, 28, F.G, (int)blockIdx.x);
            pg8::EpiSwiGLU<1> E{wsp<float>(F, WS_ROWRS), wsp<bf16>(F, WS_HM)};
            pg8::gemm_phase<pg8::EpiSwiGLU<1>, pg8::GroupedOrder, true, true>(F.lds + RING_OFF, g, S, E);
            SEAM(pb + 7);
        } }
        if (IN(pb + 8)) { REPS(4096) {
            pg8::Gemm g{wsp<bf16>(F, WS_HM), wsp<bf16>(F, WS_WM_OUT) + (size_t)fi * 8 * 1024 * 3584, MROWS, D, FF}; pg8::GroupedOrder S; S.init(gcnt, 4, F.G, (int)blockIdx.x);
            pg8::EpiMoeOut E{wsp<int>(F, WS_ROWT), wsp<float>(F, WS_ROWG), wsp<bf16>(F, WS_OS), M};
            pg8::gemm_phase<pg8::EpiMoeOut, pg8::GroupedOrder, true, true>(F.lds + RING_OFF, g, S, E);
            SEAM(pb + 8);
        } }
        if (IN(pb + 9)) { combine_phase(F, l == MK_LAYERS - 1, args.in[21]); if constexpr (l != MK_LAYERS - 1) SEAM(pb + 9); }
    }
}
__global__ void __launch_bounds__(NWAVES * 64, 2) trunk_fwd(Args args) {
    extern __shared__ __attribute__((aligned(16))) unsigned char lds[];
    Frame F;
    F.lds = (LAS unsigned char*)lds;
    F.MISC = (volatile LAS unsigned*)(F.lds + MISC_OFF);
    F.tid = threadIdx.x; F.lane = F.tid & 63; F.wave = __builtin_amdgcn_readfirstlane(F.tid >> 6);
    F.G = gridDim.x; { const int bx = blockIdx.x; F.vcu = (F.G % 8 == 0) ? (bx % 8) * (F.G / 8) + bx / 8 : bx; }
    F.out = args.out; F.ws = args.ws;
    F.ctl = (gu32*)(args.ws + WS_CTL);
    for (int u = F.tid; u < (LDS_BYTES - LDSCTL_OFF) / 4; u += NWAVES * 64) ((LAS unsigned*)(F.lds + LDSCTL_OFF))[u] = 0u;
    __syncthreads();
    XcdBarrier bar = xcd_barrier_post((unsigned*)(F.ctl + CW_BAR), F.MISC + 8);
    const int lo = args.ph_lo, hi = args.ph_hi;
    if (IN(0)) { REPS(1) { p0_prologue(F, args); SEAM(0); } }
    run_layer<0>(F, args, bar, lo, hi);
    if constexpr (MK_LAYERS > 1) run_layer<1>(F, args, bar, lo, hi);
    if constexpr (MK_LAYERS > 2) run_layer<2>(F, args, bar, lo, hi);
    if constexpr (MK_LAYERS > 3) run_layer<3>(F, args, bar, lo, hi);
    if ((MK_LAYERS % 2) == 1 && IN(1 + 10 * MK_LAYERS)) final_norm_phase(F, wsp<bf16>(F, WS_XB), args.in[21]);
}
#undef IN
#undef SEAM

extern "C" void kernel_launch(void* const* d_in, const int* in_sizes, int n_in, void* d_out, int out_size, void* d_ws, size_t ws_size, hipStream_t stream) {
    static int grid = 0;
    if (grid == 0) {
        if (n_in != 22 || in_sizes[0] != M * D || out_size != M * D || ws_size < WS_END) { fprintf(stderr, "kernel_launch: unexpected shapes / workspace (n_in %d, in0 %d, out %d, ws %zu, need %zu)\n", n_in, n_in > 0 ? in_sizes[0] : -1, out_size, ws_size, (size_t)WS_END); grid = -1; return; }
        int dev = 0, cus = 0, per_cu = 0;
        if (hipGetDevice(&dev) != hipSuccess || hipDeviceGetAttribute(&cus, hipDeviceAttributeMultiprocessorCount, dev) != hipSuccess) { grid = -1; return; }
        if (hipFuncSetAttribute((const void*)trunk_fwd, hipFuncAttributeMaxDynamicSharedMemorySize, LDS_BYTES) != hipSuccess) { fprintf(stderr, "kernel_launch: hipFuncSetAttribute failed\n"); grid = -1; return; }
        if (hipOccupancyMaxActiveBlocksPerMultiprocessor(&per_cu, (const void*)trunk_fwd, NWAVES * 64, LDS_BYTES) != hipSuccess || per_cu < 1) { fprintf(stderr, "kernel_launch: occupancy query reports %d workgroups per CU\n", per_cu); }
        (void)hipGetLastError();
        grid = cus;
    }
    if (grid < 0) return;
    if (hipMemsetAsync((char*)d_ws + WS_CTL, 0, CTL_ZERO_BYTES, stream) != hipSuccess) return;
    Args a{};
    for (int i = 0; i < 22; ++i) a.in[i] = (const float*)d_in[i];
    a.out = (float*)d_out; a.ws = (unsigned char*)d_ws;
#if MK_ONE_LAUNCH
    a.ph_lo = 0; a.ph_hi = N_PHASES;
    hipLaunchKernelGGL(trunk_fwd, dim3(grid), dim3(NWAVES * 64), LDS_BYTES, stream, a);
#else
    for (int p = 0; p < N_PHASES; ++p) { if (!phase_active(p)) continue; a.ph_lo = p; a.ph_hi = p + 1; hipLaunchKernelGGL(trunk_fwd, dim3(grid), dim3(NWAVES * 64), LDS_BYTES, stream, a); }
#endif
}
```

```cpp
#include <hip/hip_runtime.h>
#include <cstdio>
#include <cstdint>
namespace pg8 {
#define PG8_LAS __attribute__((address_space(3)))
typedef unsigned short bf16_t;
typedef short bf16x8 __attribute__((ext_vector_type(8)));
typedef float f32x4 __attribute__((ext_vector_type(4)));
typedef unsigned u32x4 __attribute__((ext_vector_type(4)));
typedef int i32x8 __attribute__((ext_vector_type(8)));
constexpr int BM = 256, BK = 64, HALF = 128, HTB = HALF * BK * 2  , STAGE_BYTES = 8 * HTB, NXCD = 8, WGM = 8;

__host__ __device__ __forceinline__ int lds_byte(int r, int c) { const int st = (r >> 4) * 2 + (c >> 5), rr = r & 15, cc = c & 31, ob = rr * 64 + cc * 2; return st * 1024 + (ob ^ (((ob >> 9) & 1) << 5)); }
__host__ __device__ __forceinline__ void stage_rc(int b, int& R, int& C) { const int st = b / 1024, sb = b % 1024, swz = sb ^ (((sb >> 9) & 1) << 5); R = (st >> 1) * 16 + swz / 64; C = (st & 1) * 32 + (swz % 64) / 2; }
__host__ __device__ __forceinline__ int perm32(int rho) { const int n = rho >> 4, i = rho & 15; return 8 * (i >> 2) + 4 * n + (i & 3); }

struct Unit { int pm, pn; };
struct Gemm { const bf16_t* A; const bf16_t* Bt; int M, N, K; const int* rowmap = nullptr; };

struct StaticOrder {
    int nM, nN, nwg, G, c, rev;
    __host__ __device__ void init(int M, int N, int G_, int c_, int rev_ = 0) { nM = M / BM; nN = N / BM; nwg = nM * nN; G = G_; c = c_; rev = rev_; }
    __host__ __device__ bool next(int i, Unit& u) const {
        const long L = (long)i * G + c; if (L >= nwg) return false;
        int wgid = (int)L; { const int q = nwg / NXCD, r = nwg % NXCD, xcd = wgid % NXCD, off = wgid / NXCD; const int cnt = q + (xcd < r ? 1 : 0); wgid = (xcd < r ? xcd * (q + 1) : r * (q + 1) + (xcd - r) * q) + (rev ? cnt - 1 - off : off); }
        const int nig = WGM * nN, gid = wgid / nig, fm = gid * WGM, gsz = (nM - fm) < WGM ? (nM - fm) : WGM;
        u.pm = fm + ((wgid % nig) % gsz); u.pn = (wgid % nig) / gsz; return true;
    }
    __device__ __forceinline__ void a_ready(const Unit&) const {}
    __device__ __forceinline__ void done(const Unit&) const {}
};

struct GroupedOrder {
    int nN, nM, nwg, G, c, rev; int s1, s2, s3, s4, s5, s6, s7;
    __device__ __forceinline__ void init(const unsigned* cnt, int nN_, int G_, int c_, int rev_ = 0) {
        nN = nN_; G = G_; c = c_; rev = rev_; int t = 0;
        t += (int)((cnt[0] + 255u) >> 8); s1 = t; t += (int)((cnt[1] + 255u) >> 8); s2 = t; t += (int)((cnt[2] + 255u) >> 8); s3 = t; t += (int)((cnt[3] + 255u) >> 8); s4 = t;
        t += (int)((cnt[4] + 255u) >> 8); s5 = t; t += (int)((cnt[5] + 255u) >> 8); s6 = t; t += (int)((cnt[6] + 255u) >> 8); s7 = t; t += (int)((cnt[7] + 255u) >> 8);
        nM = t; nwg = nM * nN;
    }
    __device__ __forceinline__ bool next(int i, Unit& u) const {
        const long L = (long)i * G + c; if (L >= nwg) return false;
        int wgid = (int)L; { const int q = nwg / NXCD, r = nwg % NXCD, xcd = wgid % NXCD, off = wgid / NXCD; const int cnt = q + (xcd < r ? 1 : 0); wgid = (xcd < r ? xcd * (q + 1) : r * (q + 1) + (xcd - r) * q) + (rev ? cnt - 1 - off : off); }
        const int nig = WGM * nN, gid = wgid / nig, fm = gid * WGM, gsz = (nM - fm) < WGM ? (nM - fm) : WGM;
        const int pm = fm + ((wgid % nig) % gsz), pnl = (wgid % nig) / gsz;
        const int e = (pm >= s1) + (pm >= s2) + (pm >= s3) + (pm >= s4) + (pm >= s5) + (pm >= s6) + (pm >= s7);
        u.pm = pm; u.pn = e * nN + pnl; return true;
    }
    __device__ __forceinline__ void a_ready(const Unit&) const {}
    __device__ __forceinline__ void done(const Unit&) const {}
};

__device__ __forceinline__ unsigned cvt_pk_bf16(float lo, float hi) { unsigned r; asm volatile("v_cvt_pk_bf16_f32 %0, %1, %2" : "=v"(r) : "v"(lo), "v"(hi)); return r; }
typedef unsigned u32x2 __attribute__((ext_vector_type(2)));
__device__ __forceinline__ float c8(float v) { return __builtin_amdgcn_fmed3f(v, -448.0f, 448.0f); }
constexpr float RMS_EPS = 1e-6f;
__device__ __forceinline__ float rs16(const float* ssq, int row, int fq) {
    const f32x4 a = *(const f32x4*)(ssq + (size_t)row * 16 + 4 * fq);
    float s = (a[0] + a[1]) + (a[2] + a[3]); s += __shfl_xor(s, 16); s += __shfl_xor(s, 32);
    return __builtin_amdgcn_rsqf(s * (1.0f / 1024.0f) + RMS_EPS);
}
__device__ __forceinline__ float gelu_t(float x) {
    const float t = x * (1.0f + 0.044715f * x * x);
    return x * __builtin_amdgcn_rcpf(1.0f + __builtin_amdgcn_exp2f(-2.302208198f * t));
}
__device__ __forceinline__ float silu_f(float x) { return x * __builtin_amdgcn_rcpf(1.0f + __builtin_amdgcn_exp2f(-1.4426950409f * x)); }
__device__ __forceinline__ f32x4 sig4(f32x4 a) {
    f32x4 e; e[0] = __builtin_amdgcn_exp2f(a[0]); e[1] = __builtin_amdgcn_exp2f(a[1]); e[2] = __builtin_amdgcn_exp2f(a[2]); e[3] = __builtin_amdgcn_exp2f(a[3]);
    e = e + 1.0f; f32x4 r; r[0] = __builtin_amdgcn_rcpf(e[0]); r[1] = __builtin_amdgcn_rcpf(e[1]); r[2] = __builtin_amdgcn_rcpf(e[2]); r[3] = __builtin_amdgcn_rcpf(e[3]); return r;
}
__device__ __forceinline__ f32x4 swiglu4(f32x4 g, f32x4 u, float ca, float ch) { return ((g * u) * ch) * sig4(g * ca); }
__device__ __forceinline__ f32x4 gelu4(f32x4 x) { const f32x4 p = (x * x) * (-2.302208198f * 0.044715f) + (-2.302208198f); return x * sig4(x * p); }

struct EpiAin {
    static constexpr bool PERM = true, AFTER_DRAIN = false, RS_LDS = false;
    const float* ssq; bf16_t* U; bf16_t* V; float* vssq; float sc;
    __device__ __forceinline__ void operator()(const f32x4 (&acc)[2][2][4][2], const Unit& u, int wr, int wc, int fr, int fq) const {
        const bool isv = u.pn >= 8; bf16_t* base = isv ? V : U;
        const int row0 = u.pm * BM + wr * 64 + fr, col0 = (u.pn & 7) * BM + wc * 32 + 8 * fq;
#pragma unroll
        for (int ai = 0; ai < 2; ++ai)
#pragma unroll
            for (int m = 0; m < 4; ++m) { const int row = row0 + ai * HALF + m * 16; const float rs = rs16(ssq, row, fq) * sc; float sq = 0.f; bf16_t* rowp = base + (size_t)row * 2048 + col0;
#pragma unroll
                for (int bj = 0; bj < 2; ++bj) { const f32x4 v0 = gelu4(acc[ai][bj][m][0] * rs), v1 = gelu4(acc[ai][bj][m][1] * rs);
                    { const f32x4 q = v0 * v0 + v1 * v1; sq += (q[0] + q[1]) + (q[2] + q[3]); }
                    u32x4 w; w.x = cvt_pk_bf16(v0[0], v0[1]); w.y = cvt_pk_bf16(v0[2], v0[3]); w.z = cvt_pk_bf16(v1[0], v1[1]); w.w = cvt_pk_bf16(v1[2], v1[3]);
                    *(u32x4*)(rowp + bj * HALF) = w; }
                if (isv) { sq += __shfl_xor(sq, 16); sq += __shfl_xor(sq, 32); if (fq == 0) vssq[(size_t)row * 32 + (u.pn - 8) * 4 + wc] = sq; } }
    }
};
template <bool KN> struct EpiRow {
    static constexpr bool PERM = true, AFTER_DRAIN = false, RS_LDS = false;
    const float* ssq; bf16_t* O; int ldc; unsigned* knb; float sc;
    __device__ __forceinline__ void operator()(const f32x4 (&acc)[2][2][4][2], const Unit& u, int wr, int wc, int fr, int fq) const {
        const int row0 = u.pm * BM + wr * 64 + fr, col0 = u.pn * BM + wc * 32 + 8 * fq;
        float kmx0 = 0.f, kmx1 = 0.f;
#pragma unroll
        for (int ai = 0; ai < 2; ++ai)
#pragma unroll
            for (int m = 0; m < 4; ++m) { const int row = row0 + ai * HALF + m * 16; const float rs = rs16(ssq, row, fq) * sc; bf16_t* rowp = O + (size_t)row * ldc + col0;
#pragma unroll
                for (int bj = 0; bj < 2; ++bj) { const f32x4 v0 = acc[ai][bj][m][0] * rs, v1 = acc[ai][bj][m][1] * rs;
                    u32x4 w; w.x = cvt_pk_bf16(v0[0], v0[1]); w.y = cvt_pk_bf16(v0[2], v0[3]); w.z = cvt_pk_bf16(v1[0], v1[1]); w.w = cvt_pk_bf16(v1[2], v1[3]);
                    *(u32x4*)(rowp + bj * HALF) = w;
                    if constexpr (KN) { float sq = ((v0[0] * v0[0] + v0[1] * v0[1]) + (v0[2] * v0[2] + v0[3] * v0[3])) + ((v1[0] * v1[0] + v1[1] * v1[1]) + (v1[2] * v1[2] + v1[3] * v1[3]));
                        sq += __shfl_xor(sq, 16); sq += __shfl_xor(sq, 32); if (bj == 0) kmx0 = fmaxf(kmx0, sq); else kmx1 = fmaxf(kmx1, sq); } } }
        if constexpr (KN) { if (u.pn >= 4 && u.pn < 8) {
#pragma unroll
                for (int o = 1; o < 16; o <<= 1) { kmx0 = fmaxf(kmx0, __shfl_xor(kmx0, o)); kmx1 = fmaxf(kmx1, __shfl_xor(kmx1, o)); }
                if ((threadIdx.x & 63) == 0) { const int bb = (u.pm * BM) >> 12, hd = 2 * (u.pn - 4);
                    __hip_atomic_fetch_max(knb + ((bb * 8 + hd) * 4 + wc), __builtin_bit_cast(unsigned, kmx0), __ATOMIC_RELAXED, __HIP_MEMORY_SCOPE_AGENT);
                    __hip_atomic_fetch_max(knb + ((bb * 8 + hd + 1) * 4 + wc), __builtin_bit_cast(unsigned, kmx1), __ATOMIC_RELAXED, __HIP_MEMORY_SCOPE_AGENT); } } }
    }
};
template <bool F32IN, bool W8 = false> struct EpiResid {
    static constexpr bool PERM = true, AFTER_DRAIN = false, RS_LDS = false;
    const void* xin; bf16_t* xb; float* ssq; unsigned char* x8; float oscale;
    __device__ __forceinline__ void operator()(const f32x4 (&acc)[2][2][4][2], const Unit& u, int wr, int wc, int fr, int fq) const {
        const int row0 = u.pm * BM + wr * 64 + fr, col0 = u.pn * BM + wc * 32 + 8 * fq;
#pragma unroll
        for (int ai = 0; ai < 2; ++ai)
#pragma unroll
            for (int m = 0; m < 4; ++m) { const int row = row0 + ai * HALF + m * 16; const size_t off = (size_t)row * 1024 + col0; float sq = 0.f;
#pragma unroll
                for (int bj = 0; bj < 2; ++bj) { const size_t o = off + bj * HALF; f32x4 v0, v1;
                    if constexpr (F32IN) { v0 = *(const f32x4*)((const float*)xin + o); v1 = *(const f32x4*)((const float*)xin + o + 4); }
                    else { const u32x4 xw = *(const u32x4*)((const bf16_t*)xin + o);
                        v0 = (f32x4){__builtin_bit_cast(float, xw.x << 16), __builtin_bit_cast(float, xw.x & 0xffff0000u), __builtin_bit_cast(float, xw.y << 16), __builtin_bit_cast(float, xw.y & 0xffff0000u)};
                        v1 = (f32x4){__builtin_bit_cast(float, xw.z << 16), __builtin_bit_cast(float, xw.z & 0xffff0000u), __builtin_bit_cast(float, xw.w << 16), __builtin_bit_cast(float, xw.w & 0xffff0000u)}; }
                    v0 += acc[ai][bj][m][0] * oscale; v1 += acc[ai][bj][m][1] * oscale;
                    u32x4 w; w.x = cvt_pk_bf16(v0[0], v0[1]); w.y = cvt_pk_bf16(v0[2], v0[3]); w.z = cvt_pk_bf16(v1[0], v1[1]); w.w = cvt_pk_bf16(v1[2], v1[3]);
                    *(u32x4*)(xb + o) = w;
                    if constexpr (W8) { int p0 = __builtin_amdgcn_cvt_pk_fp8_f32(c8(v0[0]), c8(v0[1]), 0, false); p0 = __builtin_amdgcn_cvt_pk_fp8_f32(c8(v0[2]), c8(v0[3]), p0, true); int p1 = __builtin_amdgcn_cvt_pk_fp8_f32(c8(v1[0]), c8(v1[1]), 0, false); p1 = __builtin_amdgcn_cvt_pk_fp8_f32(c8(v1[2]), c8(v1[3]), p1, true);
                        u32x2 w8; w8.x = (unsigned)p0; w8.y = (unsigned)p1; *(u32x2*)(x8 + o) = w8; }
                    sq += ((v0[0] * v0[0] + v0[1] * v0[1]) + (v0[2] * v0[2] + v0[3] * v0[3])) + ((v1[0] * v1[0] + v1[1] * v1[1]) + (v1[2] * v1[2] + v1[3] * v1[3])); }
                sq += __shfl_xor(sq, 16); sq += __shfl_xor(sq, 32); if (fq == 0) ssq[(size_t)row * 16 + u.pn * 4 + wc] = sq;
                asm volatile("" ::: "memory"); }
    }
};
template <int MODE> struct EpiSwiGLU {
    static constexpr bool PERM = true, AFTER_DRAIN = false, RS_LDS = false;
    const float* ssq; bf16_t* H;
    __device__ __forceinline__ void operator()(const f32x4 (&acc)[2][2][4][2], const Unit& u, int wr, int wc, int fr, int fq) const {
        const int row0 = u.pm * BM + wr * 64 + fr, col0 = (u.pn % 28) * HALF + wc * 32 + 8 * fq;
#pragma unroll
        for (int ai = 0; ai < 2; ++ai)
#pragma unroll
            for (int m = 0; m < 4; ++m) { const int row = row0 + ai * HALF + m * 16; const float rs = MODE == 0 ? rs16(ssq, row, fq) : ssq[row];
                const float ca = rs * -1.4426950409f, ch = rs * rs;
                const f32x4 h0 = swiglu4(acc[ai][0][m][0], acc[ai][1][m][0], ca, ch), h1 = swiglu4(acc[ai][0][m][1], acc[ai][1][m][1], ca, ch);
                u32x4 w; w.x = cvt_pk_bf16(h0[0], h0[1]); w.y = cvt_pk_bf16(h0[2], h0[3]); w.z = cvt_pk_bf16(h1[0], h1[1]); w.w = cvt_pk_bf16(h1[2], h1[3]);
                *(u32x4*)(H + (size_t)row * 3584 + col0) = w; }
    }
};
template <int MODE> struct EpiSwiGLU8 {
    static constexpr bool PERM = true, AFTER_DRAIN = false, RS_LDS = (MODE == 1);
    const float* rrs; unsigned char* H8;
    __device__ __forceinline__ void operator()(const f32x4 (&acc)[2][2][4][2], const Unit& u, int wr, int wc, int fr, int fq, const PG8_LAS float* rsl = nullptr) const {
        const int row0 = u.pm * BM + wr * 64 + fr, col0 = (u.pn % 28) * HALF + wc * 32 + 8 * fq;
#pragma unroll
        for (int ai = 0; ai < 2; ++ai)
#pragma unroll
            for (int m = 0; m < 4; ++m) { const int row = row0 + ai * HALF + m * 16; const float rs = (MODE == 0 ? rs16(rrs, row, fq) : rsl[ai * 64 + m * 16 + fr]) * (1.0f / 64.0f);
                const float ca = rs * -1.4426950409f, ch = rs * rs * 8.0f;
                const f32x4 h0 = swiglu4(acc[ai][0][m][0], acc[ai][1][m][0], ca, ch), h1 = swiglu4(acc[ai][0][m][1], acc[ai][1][m][1], ca, ch);
                int w0 = __builtin_amdgcn_cvt_pk_fp8_f32(c8(h0[0]), c8(h0[1]), 0, false); w0 = __builtin_amdgcn_cvt_pk_fp8_f32(c8(h0[2]), c8(h0[3]), w0, true);
                int w1 = __builtin_amdgcn_cvt_pk_fp8_f32(c8(h1[0]), c8(h1[1]), 0, false); w1 = __builtin_amdgcn_cvt_pk_fp8_f32(c8(h1[2]), c8(h1[3]), w1, true);
                u32x2 w; w.x = (unsigned)w0; w.y = (unsigned)w1; *(u32x2*)(H8 + (size_t)row * 3584 + col0) = w; }
    }
};
struct EpiMoeOut {
    static constexpr bool PERM = true, AFTER_DRAIN = false, RS_LDS = false;
    const int* rtok; const float* rgate; bf16_t* OS; int M; float oscale;
    __device__ __forceinline__ void operator()(const f32x4 (&acc)[2][2][4][2], const Unit& u, int wr, int wc, int fr, int fq) const {
        const int row0 = u.pm * BM + wr * 64 + fr, col0 = (u.pn & 3) * BM + wc * 32 + 8 * fq;
#pragma unroll
        for (int ai = 0; ai < 2; ++ai)
#pragma unroll
            for (int m = 0; m < 4; ++m) { const int row = row0 + ai * HALF + m * 16; const int tk = rtok[row]; const float gt = rgate[row] * oscale;
                if (tk >= 0) { bf16_t* rowp = OS + ((size_t)(tk & 1) * M + (tk >> 1)) * 1024 + col0;
#pragma unroll
                    for (int bj = 0; bj < 2; ++bj) { const f32x4 v0 = acc[ai][bj][m][0] * gt, v1 = acc[ai][bj][m][1] * gt;
                        u32x4 w; w.x = cvt_pk_bf16(v0[0], v0[1]); w.y = cvt_pk_bf16(v0[2], v0[3]); w.z = cvt_pk_bf16(v1[0], v1[1]); w.w = cvt_pk_bf16(v1[2], v1[3]);
                        *(u32x4*)(rowp + bj * HALF) = w; } } }
    }
};

template <class Epi, class Sched, bool ALIGN_EPI = false, bool SP2 = false, bool F8 = false, bool GA = false>
__device__ __forceinline__ void gemm_phase(PG8_LAS unsigned char* lds, const Gemm g, const Sched& S, const Epi& E) {
    static_assert(!GA || SP2, "gathered A rows: SP2 path only");
    const int tid = threadIdx.x, wid = __builtin_amdgcn_readfirstlane(tid >> 6), lane = tid & 63, wr = wid >> 2, wc = wid & 3, fr = lane & 15, fq = lane >> 4;
    const int K = g.K, nt = K / BK;
    unsigned voffA[2], voffB[2];
#pragma unroll
    for (int i = 0; i < 2; ++i) { int R, C; stage_rc(tid * 16 + i * 8192, R, C); const int Rb = Epi::PERM ? ((R & ~31) + perm32(R & 31)) : R;
        voffA[i] = (unsigned)(R * K + C) * 2u; voffB[i] = (unsigned)(Rb * K + C) * 2u; }
    PG8_LAS unsigned char* const rowbuf = lds + STAGE_BYTES + 1024 + wid * 256;
    const unsigned cbA = voffA[0] - (unsigned)(((wid >> 1) * 16 + (lane >> 2)) * K) * 2u;
#define PG8_ROWDMA(u, par) do { const int* rp_ = g.rowmap + (size_t)(u).pm * BM + (lane >> 5) * 128 + ((lane >> 4) & 1) * 64 + (wid >> 1) * 16 + (lane & 15); \
        const unsigned la_ = __builtin_amdgcn_readfirstlane((unsigned)(unsigned long)(rowbuf + (par) * 2048)); unsigned keep_; \
        asm volatile("s_mov_b32 %0, m0\n\ts_mov_b32 m0, %2\n\ts_nop 0\n\tglobal_load_lds_dword %1, off\n\ts_mov_b32 m0, %0" : "=&s"(keep_) : "v"(rp_), "s"(la_) : "memory"); } while (0)
#define PG8_ROWGET(dst, par) do { _Pragma("unroll") for (int h_ = 0; h_ < 2; ++h_) _Pragma("unroll") for (int i_ = 0; i_ < 2; ++i_) { \
        const int t_ = *(const PG8_LAS int*)(rowbuf + (par) * 2048 + ((2 * h_ + i_) * 16 + (lane >> 2)) * 4); dst[h_][i_] = (unsigned)((t_ < 0 ? 0 : t_) >> 1) * (unsigned)(K * 2) + cbA; } } while (0)
    PG8_LAS unsigned char* const rsbuf = lds + STAGE_BYTES + 1024 + 4096 + wid * 512;
#define PG8_RSDMA(u) do { _Pragma("unroll") for (int ai_ = 0; ai_ < 2; ++ai_) { const float* rp_ = E.rrs + (size_t)(u).pm * BM + ai_ * HALF + wr * 64 + lane; \
        const unsigned la_ = __builtin_amdgcn_readfirstlane((unsigned)(unsigned long)(rsbuf + ai_ * 256)); unsigned keep_; \
        asm volatile("s_mov_b32 %0, m0\n\ts_mov_b32 m0, %2\n\ts_nop 0\n\tglobal_load_lds_dword %1, off\n\ts_mov_b32 m0, %0" : "=&s"(keep_) : "v"(rp_), "s"(la_) : "memory"); } } while (0)
    unsigned vGc[2][2], vS[2][2];
    const auto rsA = __builtin_amdgcn_make_buffer_rsrc((void*)g.A, 0, 0x40000000u, 0x00020000);
    const size_t kstep = (size_t)(BK * 2);
    const size_t hstep = (size_t)HALF * K * 2;
    const size_t tstep = 2 * hstep;
    const unsigned ldsw = (unsigned)wid * 1024u;
    const int aoff = lds_byte(wr * 64 + fr, fq * 8), boff = lds_byte(wc * 32 + fr, fq * 8);
#define PG8_SA(b, h) (((b) * 2 + (h)) * HTB)
#define PG8_SB(b, h) ((4 + (b) * 2 + (h)) * HTB)
#define PG8_STAGE(bufoff, gbase, voff) do { _Pragma("unroll") for (int _i = 0; _i < 2; ++_i) \
        __builtin_amdgcn_global_load_lds((const unsigned*)((const char*)(gbase) + (voff)[_i]), (PG8_LAS unsigned*)(lds + (bufoff) + ldsw + _i * 8192), 16, 0, 0); } while (0)
#define PG8_STAGE_A(bufoff, ptr, h, vsel) do { if constexpr (GA) { _Pragma("unroll") for (int _i = 0; _i < 2; ++_i)     \
            __builtin_amdgcn_raw_ptr_buffer_load_lds(rsA, (PG8_LAS void*)(lds + (bufoff) + ldsw + _i * 8192), 16, (int)vsel[h][_i], (int)((ptr) - (const char*)g.A), 0, 0); } \
        else PG8_STAGE(bufoff, (ptr) + ((h) ? hstep : 0), voffA); } while (0)
#define PG8_CAT8(p0_) __builtin_bit_cast(i32x8, __builtin_shufflevector(*(const PG8_LAS bf16x8*)(p0_), *(const PG8_LAS bf16x8*)((p0_) + 1024), 0, 1, 2, 3, 4, 5, 6, 7, 8, 9, 10, 11, 12, 13, 14, 15))
#define PG8_LDA(dst, b, h) do { if constexpr (F8) { _Pragma("unroll") for (int m = 0; m < 4; ++m) dst##8[m] = PG8_CAT8(lds + PG8_SA(b, h) + aoff + m * 2048); } \
        else { _Pragma("unroll") for (int m = 0; m < 4; ++m) _Pragma("unroll") for (int k = 0; k < 2; ++k) dst[m][k] = *(const PG8_LAS bf16x8*)(lds + PG8_SA(b, h) + aoff + m * 2048 + k * 1024); } } while (0)
#define PG8_LDB(dst, b, h) do { if constexpr (F8) { _Pragma("unroll") for (int n = 0; n < 2; ++n) dst##8[n] = PG8_CAT8(lds + PG8_SB(b, h) + boff + n * 2048); } \
        else { _Pragma("unroll") for (int n = 0; n < 2; ++n) _Pragma("unroll") for (int k = 0; k < 2; ++k) dst[n][k] = *(const PG8_LAS bf16x8*)(lds + PG8_SB(b, h) + boff + n * 2048 + k * 1024); } } while (0)
#define PG8_MMA(ai, bj, At, Bt) do { __builtin_amdgcn_s_setprio(1); \
        if constexpr (F8) { _Pragma("unroll") for (int m = 0; m < 4; ++m) _Pragma("unroll") for (int n = 0; n < 2; ++n) \
            asm volatile("v_mfma_scale_f32_16x16x128_f8f6f4 %0, %1, %2, %0, %3, %3 op_sel_hi:[0,0,0]" : "+v"(acc[ai][bj][m][n]) : "v"(Bt##8[n]), "v"(At##8[m]), "v"(f8one)); } \
        else { _Pragma("unroll") for (int m = 0; m < 4; ++m) _Pragma("unroll") for (int n = 0; n < 2; ++n) _Pragma("unroll") for (int k = 0; k < 2; ++k) \
            acc[ai][bj][m][n] = __builtin_amdgcn_mfma_f32_16x16x32_bf16(Bt[n][k], At[m][k], acc[ai][bj][m][n], 0, 0, 0); } \
        __builtin_amdgcn_s_setprio(0); } while (0)
#define PG8_WAIT_V(n) asm volatile("s_waitcnt vmcnt(" #n ")" ::: "memory")
#define PG8_WAIT_L(n) asm volatile("s_waitcnt lgkmcnt(" #n ")" ::: "memory")
#define PG8_BAR __builtin_amdgcn_s_barrier()
#define PG8_SCHED __builtin_amdgcn_sched_barrier(0)
    Unit cur, nxt; int ui = 0;
    if (!S.next(0, cur)) return;
#if defined(PG8_STAGGER_TICKS)
    if ((blockIdx.x >> 3) & 1) { const unsigned long long t0_ = __builtin_amdgcn_s_memrealtime(); while (__builtin_amdgcn_s_memrealtime() - t0_ < PG8_STAGGER_TICKS) __builtin_amdgcn_s_sleep(8); }
#endif
    f32x4 acc[2][2][4][2];
#pragma unroll
    for (int a = 0; a < 2; ++a)
#pragma unroll
        for (int b = 0; b < 2; ++b)
#pragma unroll
            for (int m = 0; m < 4; ++m)
#pragma unroll
                for (int n = 0; n < 2; ++n) acc[a][b][m][n] = (f32x4){0.f, 0.f, 0.f, 0.f};
    const int f8one = 0x7f7f7f7f;
    bf16x8 At[4][2], B0[2][2], B1[2][2]; i32x8 At8[4], B08[2], B18[2];
    const char* cA = GA ? (const char*)g.A : (const char*)g.A + (size_t)cur.pm * tstep; const char* cB = (const char*)g.Bt + (size_t)cur.pn * tstep;
    S.a_ready(cur);
    if constexpr (Epi::RS_LDS) PG8_RSDMA(cur);
    if constexpr (GA) { PG8_ROWDMA(cur, 0); asm volatile("s_waitcnt vmcnt(0)" ::: "memory"); PG8_ROWGET(vGc, 0); }
    if constexpr (SP2) {
        PG8_STAGE(PG8_SB(0, 0), cB, voffB); PG8_STAGE(PG8_SB(0, 1), cB + hstep, voffB); PG8_STAGE_A(PG8_SA(0, 0), cA, 0, vGc); PG8_STAGE_A(PG8_SA(0, 1), cA, 1, vGc);
        if (wr == 1) PG8_BAR;
        PG8_WAIT_V(2); PG8_BAR;
        PG8_STAGE(PG8_SB(1, 0), cB + kstep, voffB); PG8_STAGE_A(PG8_SA(1, 0), cA + kstep, 0, vGc); PG8_STAGE(PG8_SB(1, 1), cB + hstep + kstep, voffB);
        PG8_WAIT_V(6); PG8_BAR;
    } else {
        PG8_STAGE(PG8_SB(0, 0), cB, voffB); PG8_STAGE(PG8_SA(0, 0), cA, voffA); PG8_STAGE(PG8_SB(0, 1), cB + hstep, voffB); PG8_STAGE(PG8_SA(0, 1), cA + hstep, voffA);
        if (wr == 1) PG8_BAR;
        PG8_WAIT_V(4); PG8_BAR;
        PG8_STAGE(PG8_SB(1, 0), cB + kstep, voffB); PG8_STAGE(PG8_SA(1, 0), cA + kstep, voffA); PG8_STAGE(PG8_SB(1, 1), cB + hstep + kstep, voffB);
        PG8_WAIT_V(6); PG8_BAR;
    }
    for (;;) {
        const bool has_next = S.next(ui + 1, nxt);
        const char* nA = GA ? cA : has_next ? (const char*)g.A + (size_t)nxt.pm * tstep : cA; const char* nB = has_next ? (const char*)g.Bt + (size_t)nxt.pn * tstep : cB;
        if constexpr (GA) { if (has_next) PG8_ROWDMA(nxt, (ui + 1) & 1); }
        for (int t = 0; t < nt; t += 2) {
            const bool last = (t == nt - 2);
            const char* a1 = cA + (size_t)(t + 1) * kstep;
            const char* a2 = last ? nA : cA + (size_t)(t + 2) * kstep; const char* b2 = last ? nB : cB + (size_t)(t + 2) * kstep;
            const char* a3 = a2 + kstep; const char* b3 = b2 + kstep;
            if (last && has_next) S.a_ready(nxt);
            if constexpr (GA) { if (last && has_next) PG8_ROWGET(vS, (ui + 1) & 1);
                else { vS[0][0] = vGc[0][0]; vS[0][1] = vGc[0][1]; vS[1][0] = vGc[1][0]; vS[1][1] = vGc[1][1]; } }
            if constexpr (SP2) {
            PG8_LDB(B0, 0, 0); PG8_LDB(B1, 0, 1); PG8_SCHED; PG8_LDA(At, 0, 0); PG8_STAGE_A(PG8_SA(1, 1), a1, 1, vGc);
            PG8_WAIT_V(8); PG8_WAIT_L(0); PG8_BAR; PG8_MMA(0, 0, At, B0); PG8_MMA(0, 1, At, B1); PG8_BAR; PG8_SCHED;
            PG8_LDA(At, 0, 1); PG8_STAGE(PG8_SB(0, 0), b2, voffB); PG8_STAGE(PG8_SB(0, 1), b2 + hstep, voffB); PG8_STAGE_A(PG8_SA(0, 0), a2, 0, vS);
            PG8_WAIT_V(8); PG8_WAIT_L(0); PG8_BAR; PG8_MMA(1, 0, At, B0); PG8_MMA(1, 1, At, B1); PG8_BAR; PG8_SCHED;
            PG8_LDB(B0, 1, 0); PG8_LDB(B1, 1, 1); PG8_SCHED; PG8_LDA(At, 1, 0); PG8_STAGE_A(PG8_SA(0, 1), a2, 1, vS);
            PG8_WAIT_V(8); PG8_WAIT_L(0); PG8_BAR; PG8_MMA(0, 0, At, B0); PG8_MMA(0, 1, At, B1); PG8_BAR; PG8_SCHED;
            PG8_LDA(At, 1, 1); PG8_STAGE(PG8_SB(1, 0), b3, voffB); PG8_STAGE(PG8_SB(1, 1), b3 + hstep, voffB); PG8_STAGE_A(PG8_SA(1, 0), a3, 0, vS);
            PG8_WAIT_V(8); PG8_WAIT_L(0); PG8_BAR; PG8_MMA(1, 0, At, B0); PG8_MMA(1, 1, At, B1); PG8_BAR; PG8_SCHED;
            } else {
            PG8_LDB(B0, 0, 0); PG8_SCHED; PG8_LDA(At, 0, 0); PG8_STAGE(PG8_SA(1, 1), a1 + hstep, voffA);
            PG8_WAIT_L(8); PG8_BAR; PG8_WAIT_L(0); PG8_MMA(0, 0, At, B0); PG8_BAR; PG8_SCHED;
            PG8_LDB(B1, 0, 1); PG8_STAGE(PG8_SB(0, 0), b2, voffB);
            PG8_BAR; PG8_WAIT_L(0); PG8_MMA(0, 1, At, B1); PG8_BAR;
            PG8_LDA(At, 0, 1); PG8_STAGE(PG8_SA(0, 0), a2, voffA);
            PG8_BAR; PG8_WAIT_L(0); PG8_MMA(1, 0, At, B0); PG8_BAR; PG8_SCHED;
            PG8_STAGE(PG8_SB(0, 1), b2 + hstep, voffB);
            PG8_WAIT_V(6); PG8_BAR; PG8_MMA(1, 1, At, B1); PG8_BAR;
            PG8_LDB(B0, 1, 0); PG8_SCHED; PG8_LDA(At, 1, 0); PG8_STAGE(PG8_SA(0, 1), a2 + hstep, voffA);
            PG8_WAIT_L(8); PG8_BAR; PG8_WAIT_L(0); PG8_MMA(0, 0, At, B0); PG8_BAR; PG8_SCHED;
            PG8_LDB(B1, 1, 1); PG8_STAGE(PG8_SB(1, 0), b3, voffB);
            PG8_BAR; PG8_WAIT_L(0); PG8_MMA(0, 1, At, B1); PG8_BAR;
            PG8_LDA(At, 1, 1); PG8_STAGE(PG8_SA(1, 0), a3, voffA);
            PG8_BAR; PG8_WAIT_L(0); PG8_MMA(1, 0, At, B0); PG8_BAR; PG8_SCHED;
            PG8_STAGE(PG8_SB(1, 1), b3 + hstep, voffB);
            PG8_WAIT_V(6); PG8_BAR; PG8_MMA(1, 1, At, B1); PG8_BAR;
            }
        }
        if constexpr (F8) { asm volatile("s_nop 15\n\ts_nop 15" ::: "memory"); }
        if constexpr (ALIGN_EPI) { if (wr == 0) PG8_BAR; }
        if constexpr (!Epi::AFTER_DRAIN) { if constexpr (Epi::RS_LDS) E(acc, cur, wr, wc, fr, fq, (const PG8_LAS float*)rsbuf); else E(acc, cur, wr, wc, fr, fq); S.done(cur); }
        if (!has_next) break;
#pragma unroll
        for (int a = 0; a < 2; ++a)
#pragma unroll
            for (int b = 0; b < 2; ++b)
#pragma unroll
                for (int m = 0; m < 4; ++m)
#pragma unroll
                    for (int n = 0; n < 2; ++n) acc[a][b][m][n] = (f32x4){0.f, 0.f, 0.f, 0.f};
        cur = nxt; cA = nA; cB = nB; ++ui;
        if constexpr (Epi::RS_LDS) PG8_RSDMA(cur);
        if constexpr (GA) { vGc[0][0] = vS[0][0]; vGc[0][1] = vS[0][1]; vGc[1][0] = vS[1][0]; vGc[1][1] = vS[1][1]; }
        if constexpr (ALIGN_EPI) { if (wr == 1) PG8_BAR; }
    }
    PG8_WAIT_V(0);
    if constexpr (!ALIGN_EPI) { if (wr == 0) PG8_BAR; }
    PG8_BAR;
    if constexpr (Epi::AFTER_DRAIN) { E.fused(acc, cur, wr, wc, fr, fq, lds, wid, lane); S.done(cur); }
#undef PG8_SA
#undef PG8_SB
#undef PG8_STAGE
#undef PG8_STAGE_A
#undef PG8_ROWDMA
#undef PG8_RSDMA
#undef PG8_ROWGET
#undef PG8_LDA
#undef PG8_CAT8
#undef PG8_LDB
#undef PG8_MMA
#undef PG8_WAIT_V
#undef PG8_WAIT_L
#undef PG8_BAR
#undef PG8_SCHED
}
}

constexpr int NWAVES = 8;
constexpr int BATCH = 8, SEQ = 4096, D = 1024, M = BATCH * SEQ;
constexpr int AW = 2048, FF = 3584, NE = 8;
constexpr int MROWS = 2 * M + NE * 256;
constexpr float EPS = 1e-6f;
#ifndef MK_ONE_LAUNCH
#define MK_ONE_LAUNCH 1
#endif
#ifndef MK_LAYERS
#define MK_LAYERS 4
#endif
#ifndef MK_AIN_F8
#define MK_AIN_F8 1
#endif
constexpr int AIN_F8 = MK_AIN_F8;
#ifndef MK_AOUT_F8
#define MK_AOUT_F8 2
#endif
constexpr int AOUT_F8 = MK_AOUT_F8;
#ifndef MK_BOUT_F8
#define MK_BOUT_F8 0
#endif
constexpr int BOUT_F8 = MK_BOUT_F8;
#ifndef MK_COUT_F8
#define MK_COUT_F8 1
#endif
constexpr int COUT_F8 = MK_COUT_F8;
#ifndef MK_CIN_F8
#define MK_CIN_F8 1
#endif
constexpr int CIN_F8 = MK_CIN_F8;
#ifndef MK_MOE_F8
#define MK_MOE_F8 1
#endif
#ifndef MK_DENSE_F8
#define MK_DENSE_F8 2
#endif
constexpr int DENSE_F8 = MK_DENSE_F8;
constexpr int MOE_F8 = MK_MOE_F8;

constexpr size_t MiB = 1u << 20;
constexpr size_t WS_CTL = 0, CTL_ZERO_BYTES = 1 * MiB;
constexpr size_t WS_WA_IN = 2 * MiB, WS_WA_OUT = 18 * MiB, WS_WB_IN = 26 * MiB, WS_WB_OUT = 32 * MiB, WS_WC_IN = 34 * MiB, WS_WC_OUT = 40 * MiB;
constexpr size_t WS_WF_IN = 42 * MiB, WS_WF_OUT = 70 * MiB, WS_WM_IN = 84 * MiB, WS_WM_OUT = 308 * MiB;
constexpr size_t WS_X = 420 * MiB, WS_XB = 548 * MiB, WS_SSQ = 612 * MiB, WS_VSSQ = 614 * MiB, WS_GLOW = 618 * MiB, WS_LOGF = 620 * MiB, WS_OSSQ = 621 * MiB, WS_DEC = 629 * MiB;
constexpr size_t WS_TOKE = 630 * MiB, WS_TOKP = WS_TOKE + 256 * 1024, WS_TOKG = WS_TOKP + 256 * 1024, WS_TOKRS = WS_TOKG + 256 * 1024, WS_BLKB = WS_TOKRS + 128 * 1024;
constexpr size_t WS_ROWT = 632 * MiB, WS_ROWG = WS_ROWT + 512 * 1024, WS_ROWRS = WS_ROWG + 512 * 1024;
constexpr size_t WS_ACT = 640 * MiB;
constexpr size_t WS_U = WS_ACT, WS_V = WS_ACT + 128 * MiB, WS_Y = WS_ACT + 256 * MiB;
constexpr size_t WS_X8 = WS_X;
constexpr size_t WS_HF = WS_ACT;
constexpr size_t WS_QKVR = WS_ACT, WS_QD = WS_ACT + 192 * MiB, WS_KD = WS_ACT + 224 * MiB, WS_KET = WS_ACT + 256 * MiB, WS_VT = WS_ACT + 288 * MiB, WS_GO = WS_ACT + 352 * MiB, WS_GG = WS_ACT + 416 * MiB;
constexpr size_t WS_AO = WS_ACT + 192 * MiB;
constexpr size_t WS_XS = WS_ACT, WS_HM = WS_ACT + 132 * MiB, WS_OS = WS_ACT + 594 * MiB;
constexpr size_t WS_END = WS_ACT + 722 * MiB;
static_assert((size_t)MROWS * 1024 * 2 <= 132 * MiB && (size_t)MROWS * FF * 2 <= 462 * MiB, "MoE buffers");
constexpr int CW_TMO = 0, CW_CODE = 1, CW_XMIS = 2, CW_BAR = 4096, CW_CNT = 8192, CW_KNB = 12288;

constexpr int RING_OFF = 0, RING_BYTES = 131072;
constexpr int LDSCTL_OFF = RING_BYTES, MISC_OFF = LDSCTL_OFF + 320;
constexpr int LDS_BYTES = 147456;
static_assert(MISC_OFF + 128 <= LDS_BYTES, "LDS map");

#define GAS __attribute__((address_space(1)))
#define LAS __attribute__((address_space(3)))
#define DI __device__ __forceinline__
typedef unsigned short bf16;
typedef unsigned v4u __attribute__((ext_vector_type(4)));
typedef unsigned v2u __attribute__((ext_vector_type(2)));
typedef float f32x4 __attribute__((ext_vector_type(4)));
typedef short bf16x8 __attribute__((ext_vector_type(8)));
typedef short bf16x4 __attribute__((ext_vector_type(4)));
typedef GAS unsigned gu32;
#define RLX_AGENT __ATOMIC_RELAXED, __HIP_MEMORY_SCOPE_AGENT
#define LDS_WAIT() asm volatile("s_waitcnt lgkmcnt(0)" ::: "memory")
#define VM_WAIT() asm volatile("s_waitcnt vmcnt(0)" ::: "memory")
DI unsigned f2bf(float f) { unsigned u = __builtin_bit_cast(unsigned, f); return (u + 0x7fffu + ((u >> 16) & 1u)) >> 16; }
DI unsigned pk2(float lo, float hi) { return f2bf(lo) | (f2bf(hi) << 16); }
DI float bflo(unsigned w) { return __builtin_bit_cast(float, w << 16); }
DI float bfhi(unsigned w) { return __builtin_bit_cast(float, w & 0xffff0000u); }
DI float bf2f(bf16 h) { return __builtin_bit_cast(float, ((unsigned)h) << 16); }
DI float wave_sum(float v) {
#pragma unroll
    for (int o = 1; o < 64; o <<= 1) v += __shfl_xor(v, o);
    return v;
}
DI float logsig(float z) { return fminf(z, 0.f) - log1pf(__expf(-fabsf(z))); }
#define MFMA16(a, b, c) __builtin_amdgcn_mfma_f32_16x16x32_bf16((a), (b), (c), 0, 0, 0)
DI bf16x8 ldsfrag(LAS const unsigned char* p) { return *(LAS const bf16x8*)p; }
typedef short s16x4 __attribute__((ext_vector_type(4)));
DI bf16x8 tr_frag(LAS const unsigned char* p0, LAS const unsigned char* p1) {
    const s16x4 a = __builtin_amdgcn_ds_read_tr16_b64_v4i16((LAS s16x4*)p0), b = __builtin_amdgcn_ds_read_tr16_b64_v4i16((LAS s16x4*)p1);
    return __builtin_shufflevector(a, b, 0, 1, 2, 3, 4, 5, 6, 7);
}
#define XB_TMO      128
#define XB_XCNT(j)  (256  + 64 * (j))
#define XB_XSUB(j)  (1280 + 64 * (j))
#define XB_XGEN(j)  (2304 + 64 * (j))
#define XB_TOP      3328
#define XB_TOPGEN   3392
#define XCD_BAR_WORDS 3456
#define XB_SPIN_CAP (1u << 18)

__device__ __forceinline__ unsigned xb_ld(unsigned* p)              { return __hip_atomic_load(p, __ATOMIC_RELAXED, __HIP_MEMORY_SCOPE_AGENT); }
__device__ __forceinline__ unsigned xb_add(unsigned* p, unsigned v) { return __hip_atomic_fetch_add(p, v, __ATOMIC_RELAXED, __HIP_MEMORY_SCOPE_AGENT); }
__device__ __forceinline__ unsigned xb_xcc_id() { return (unsigned)__builtin_amdgcn_s_getreg((3 << 11) | 20) & 0xFu; }
#define XB_SPIN(cond, bar) do { unsigned _sp = 0; while (cond) { __builtin_amdgcn_s_sleep(1); \
    if ((++_sp & 255u) == 0u) { if (xb_ld(&(bar)[XB_TMO])) break; if (_sp > XB_SPIN_CAP) { atomicAdd(&(bar)[XB_TMO], 1u); break; } } } } while (0)

struct XcdBarrier {
    unsigned* bar; unsigned x;
    volatile LAS unsigned* st;
};

__device__ __forceinline__ XcdBarrier xcd_barrier_post(unsigned* bar, volatile LAS unsigned* st) {
    XcdBarrier b; b.bar = bar; b.x = xb_xcc_id(); b.st = st;
    if (threadIdx.x == 0) (void)xb_add(&bar[XB_XCNT(b.x)], 1u);
    return b;
}
__device__ __forceinline__ void xcd_barrier_complete(unsigned* bar, unsigned x, unsigned& nloc, unsigned& nx) {
    const unsigned G = gridDim.x * gridDim.y * gridDim.z;
    unsigned sum, cnt, mine, sp = 0u;
    for (;;) {
        sum = 0u; cnt = 0u; mine = 0u;
#pragma unroll
        for (unsigned j = 0; j < 16; ++j) { const unsigned c = xb_ld(&bar[XB_XCNT(j)]); sum += c; cnt += (c > 0u) ? 1u : 0u; mine = (j == x) ? c : mine; }
        if (sum == G) break;
        __builtin_amdgcn_s_sleep(1);
        if ((++sp & 255u) == 0u) { if (xb_ld(&bar[XB_TMO])) break; if (sp > XB_SPIN_CAP) { atomicAdd(&bar[XB_TMO], 1u); break; } }
    }
    nloc = mine > 0u ? mine : 1u; nx = cnt > 0u ? cnt : 1u;
}

__device__ __forceinline__ void xcd_barrier(const XcdBarrier& b) {
    asm volatile("s_waitcnt vmcnt(0)" ::: "memory");
    __syncthreads();
    if (threadIdx.x == 0) {
        unsigned* bar = b.bar;
        __builtin_amdgcn_s_waitcnt(0);
        unsigned nloc = b.st[0], nx = b.st[1];
        if (nloc == 0u) { xcd_barrier_complete(bar, b.x, nloc, nx); b.st[0] = nloc; b.st[1] = nx; }
        const unsigned old = xb_add(&bar[XB_XSUB(b.x)], 1u);
        const unsigned gen = old / nloc;
        if (old + 1u == (gen + 1u) * nloc) {
            __builtin_amdgcn_fence(__ATOMIC_RELEASE, "agent");
            asm volatile("s_waitcnt vmcnt(0)" ::: "memory");
            const unsigned og = xb_add(&bar[XB_TOP], 1u);
            const unsigned tg = og / nx;
            if (og + 1u == (tg + 1u) * nx) xb_add(&bar[XB_TOPGEN], 1u);
            else XB_SPIN(xb_ld(&bar[XB_TOPGEN]) == tg, bar);
            __builtin_amdgcn_fence(__ATOMIC_ACQUIRE, "agent");
            xb_add(&bar[XB_XGEN(b.x)], 1u);
            asm volatile("s_waitcnt vmcnt(0)" ::: "memory");
        } else {
            XB_SPIN(xb_ld(&bar[XB_XGEN(b.x)]) == gen, bar);
            __builtin_amdgcn_fence(__ATOMIC_ACQUIRE, "agent");
            asm volatile("s_waitcnt vmcnt(0)" ::: "memory");
        }
    }
    __syncthreads();
}

__device__ __forceinline__ void xcd_barrier_local(const XcdBarrier& b) {
    asm volatile("s_waitcnt vmcnt(0)" ::: "memory");
    __syncthreads();
    if (threadIdx.x == 0) {
        unsigned* bar = b.bar;
        __builtin_amdgcn_s_waitcnt(0);
        const unsigned nloc = b.st[0];
        const unsigned old = xb_add(&bar[XB_XSUB(b.x)], 1u);
        const unsigned gen = old / nloc;
        if (old + 1u == (gen + 1u) * nloc) xb_add(&bar[XB_XGEN(b.x)], 1u);
        else XB_SPIN(xb_ld(&bar[XB_XGEN(b.x)]) == gen, bar);
        __builtin_amdgcn_fence(__ATOMIC_ACQUIRE, "agent");
        asm volatile("s_waitcnt vmcnt(0)" ::: "memory");
    }
    __syncthreads();
}

struct Frame {
    LAS unsigned char* lds;
    volatile LAS unsigned* MISC;
    gu32* ctl;
    int tid, lane, wave;
    int vcu, G;
    float* out; unsigned char* ws;
};
template <class T> DI T* wsp(const Frame& F, size_t off) { return (T*)(F.ws + off); }

struct MatDesc { const float* W; int ldw, K, N; bf16* WT; int mode; const float* gain; int f8; };
template <class A> DI MatDesc get_mat(const Frame& F, const A& P, int idx) {
    MatDesc d; d.f8 = 0;
    if (idx < 2)        { const int j = idx;      d.W = P.in[3] + (size_t)j * 1024 * 4096; d.ldw = 4096; d.K = 1024; d.N = 4096; d.f8 = (j == 1 && AIN_F8) ? 1 : 0; d.WT = wsp<bf16>(F, WS_WA_IN) + (size_t)j * 4096 * 1024; d.mode = 0; d.gain = P.in[1] + (j ? 3 : 0) * 1024; }
    else if (idx < 4)   { const int j = idx - 2;  d.W = P.in[7] + (size_t)j * 2048 * 1024; d.ldw = 1024; d.K = 2048; d.N = 1024; d.f8 = (AOUT_F8 >> j) & 1; d.WT = wsp<bf16>(F, WS_WA_OUT) + (size_t)j * 1024 * 2048; d.mode = 0; d.gain = nullptr; }
    else if (idx == 4)  { d.W = P.in[8];  d.ldw = 3088; d.K = 1024; d.N = 3072; d.WT = wsp<bf16>(F, WS_WB_IN);  d.mode = 0; d.gain = P.in[1] + 1 * 1024; }
    else if (idx == 5)  { d.W = P.in[12]; d.ldw = 1024; d.K = 1024; d.N = 1024; d.WT = wsp<bf16>(F, WS_WB_OUT); d.mode = 0; d.gain = nullptr; d.f8 = BOUT_F8; }
    else if (idx == 6)  { d.W = P.in[13]; d.ldw = 3080; d.K = 1024; d.N = 3072; d.WT = wsp<bf16>(F, WS_WC_IN);  d.mode = 0; d.gain = P.in[1] + 2 * 1024; d.f8 = CIN_F8; }
    else if (idx == 7)  { d.W = P.in[15]; d.ldw = 1024; d.K = 1024; d.N = 1024; d.WT = wsp<bf16>(F, WS_WC_OUT); d.mode = 0; d.gain = nullptr; d.f8 = COUT_F8; }
    else if (idx < 10)  { const int i = idx - 8;  d.W = P.in[16] + (size_t)i * 1024 * 7168; d.ldw = 7168; d.K = 1024; d.N = 7168; d.f8 = (DENSE_F8 >> i) & 1; d.WT = d.f8 ? (bf16*)(wsp<unsigned char>(F, WS_WF_IN) + (size_t)i * 2 * 7168 * 1024) : wsp<bf16>(F, WS_WF_IN) + (size_t)i * 7168 * 1024; d.mode = 1; d.gain = P.in[2] + (2 * i) * 1024; }
    else if (idx < 12)  { const int i = idx - 10; d.W = P.in[17] + (size_t)i * 3584 * 1024; d.ldw = 1024; d.K = 3584; d.N = 1024; d.f8 = (DENSE_F8 >> i) & 1; d.WT = d.f8 ? (bf16*)(wsp<unsigned char>(F, WS_WF_OUT) + (size_t)i * 2 * 1024 * 3584) : wsp<bf16>(F, WS_WF_OUT) + (size_t)i * 1024 * 3584; d.mode = 0; d.gain = nullptr; }
    else if (idx < 28)  { const int q = idx - 12; d.W = P.in[19] + (size_t)q * 1024 * 7168; d.ldw = 7168; d.K = 1024; d.N = 7168; d.WT = MOE_F8 ? (bf16*)(wsp<unsigned char>(F, WS_WM_IN) + (size_t)q * 7168 * 1024) : wsp<bf16>(F, WS_WM_IN) + (size_t)q * 7168 * 1024; d.mode = 1; d.gain = P.in[2] + (2 * (q >> 3) + 1) * 1024; d.f8 = MOE_F8; }
    else                { const int q = idx - 28; d.W = P.in[20] + (size_t)q * 3584 * 1024; d.ldw = 1024; d.K = 3584; d.N = 1024; d.WT = MOE_F8 ? (bf16*)(wsp<unsigned char>(F, WS_WM_OUT) + (size_t)q * 1024 * 3584) : wsp<bf16>(F, WS_WM_OUT) + (size_t)q * 1024 * 3584; d.mode = 0; d.gain = nullptr; d.f8 = MOE_F8; }
    return d;
}
constexpr int NMATS = 44;
constexpr int P0_ST = 129;
struct P0Dst { bf16* base; int K; int f8; };
DI int p0_ntiles(const MatDesc& d) { return (d.K / 128) * (d.N / 128); }
DI P0Dst p0_load(const MatDesc& d, int tile, int tid, f32x4 (&r)[8], float (&g)[8]) {
    const int ntn = d.N / 128, kb = tile / ntn, nb = tile % ntn, k0 = 128 * kb, n0 = 128 * nb;
#pragma unroll
    for (int p = 0; p < 8; ++p) { const int k = k0 + p * 16 + (tid >> 5); r[p] = *(const f32x4*)(d.W + (size_t)k * d.ldw + n0 + 4 * (tid & 31)); g[p] = d.gain ? d.gain[k] : 1.0f; }
    int drow0 = n0;
    if (d.mode == 1) drow0 = (n0 < FF) ? (n0 >> 7) * 256 : ((n0 - FF) >> 7) * 256 + 128;
    P0Dst o; o.K = d.K; o.f8 = d.f8;
    if (d.f8) { o.base = (bf16*)((unsigned char*)d.WT + (size_t)drow0 * d.K + k0);
#pragma unroll
        for (int p = 0; p < 8; ++p) g[p] *= 64.0f; }
    else o.base = d.WT + (size_t)drow0 * d.K + k0;
    return o;
}
constexpr int N_EARLY = 6;
DI int morder(int i) { return i == 0 ? 0 : i == 1 ? 2 : i == 2 ? 4 : i == 3 ? 5 : i == 4 ? 8 : i == 5 ? 10 : i == 6 ? 1 : i == 7 ? 3 : i == 8 ? 6 : i == 9 ? 7 : i == 10 ? 9 : i == 11 ? 11 : i; }
struct P0State { int mi, i_hi, base, nt, T, stride; MatDesc d; };
template <class A> DI void p0_init(P0State& s, Frame& F, const A& P, int i_lo, int i_hi, int worker, int nworkers) { s.mi = i_lo; s.i_hi = i_hi; s.base = 0; s.T = worker; s.stride = nworkers; s.d = get_mat(F, P, morder(i_lo)); s.nt = p0_ntiles(s.d); }
#define P0_NEXT(st, r, g, dst, have) do { have = false; while (st.mi < st.i_hi && st.T >= st.base + st.nt) { st.base += st.nt; ++st.mi; if (st.mi < st.i_hi) { st.d = get_mat(F, P, morder(st.mi)); st.nt = p0_ntiles(st.d); } } \
        if (st.mi < st.i_hi) { dst = p0_load(st.d, st.T - st.base, tid, r, g); have = true; } st.T += st.stride; } while (0)
constexpr int P0_TST = 272;
#define P0_WRITE(S, r, g, dst) do { \
        _Pragma("unroll") for (int p = 0; p < 8; ++p) { f32x4 v_ = r[p] * g[p]; \
            if (dst.f8) { v_[0] = pg8::c8(v_[0]); v_[1] = pg8::c8(v_[1]); v_[2] = pg8::c8(v_[2]); v_[3] = pg8::c8(v_[3]); } \
            v2u w_; w_.x = pg8::cvt_pk_bf16(v_[0], v_[1]); w_.y = pg8::cvt_pk_bf16(v_[2], v_[3]); \
            *(LAS v2u*)((S) + (p * 16 + (tid >> 5)) * P0_TST + 8 * (tid & 31)) = w_; } \
        } while (0)
#define P0_STORE(S, dst) do { const int w_ = tid >> 6, fr_ = tid & 15, fq_ = (tid >> 4) & 3; \
        LAS const unsigned char* tp_ = (S) + (fr_ >> 2) * P0_TST + (16 * w_ + 4 * (fr_ & 3)) * 2; \
        if (dst.f8) { _Pragma("unroll") for (int kk = 0; kk < 2; ++kk) { const int kb_ = 64 * kk + 16 * fq_; \
            const bf16x8 a0_ = tr_frag(tp_ + kb_ * P0_TST, tp_ + (kb_ + 4) * P0_TST), a1_ = tr_frag(tp_ + (kb_ + 8) * P0_TST, tp_ + (kb_ + 12) * P0_TST); \
            const v4u x0_ = __builtin_bit_cast(v4u, a0_), x1_ = __builtin_bit_cast(v4u, a1_); v4u o; \
            { int q_ = __builtin_amdgcn_cvt_pk_fp8_f32(bflo(x0_.x), bfhi(x0_.x), 0, false); q_ = __builtin_amdgcn_cvt_pk_fp8_f32(bflo(x0_.y), bfhi(x0_.y), q_, true); o.x = (unsigned)q_; } \
            { int q_ = __builtin_amdgcn_cvt_pk_fp8_f32(bflo(x0_.z), bfhi(x0_.z), 0, false); q_ = __builtin_amdgcn_cvt_pk_fp8_f32(bflo(x0_.w), bfhi(x0_.w), q_, true); o.y = (unsigned)q_; } \
            { int q_ = __builtin_amdgcn_cvt_pk_fp8_f32(bflo(x1_.x), bfhi(x1_.x), 0, false); q_ = __builtin_amdgcn_cvt_pk_fp8_f32(bflo(x1_.y), bfhi(x1_.y), q_, true); o.z = (unsigned)q_; } \
            { int q_ = __builtin_amdgcn_cvt_pk_fp8_f32(bflo(x1_.z), bfhi(x1_.z), 0, false); q_ = __builtin_amdgcn_cvt_pk_fp8_f32(bflo(x1_.w), bfhi(x1_.w), q_, true); o.w = (unsigned)q_; } \
            *(v4u*)((unsigned char*)dst.base + (size_t)(16 * w_ + fr_) * dst.K + kb_) = o; } } \
        else { _Pragma("unroll") for (int kk = 0; kk < 4; ++kk) { const int kb_ = 32 * kk + 8 * fq_; \
            const bf16x8 a_ = tr_frag(tp_ + kb_ * P0_TST, tp_ + (kb_ + 4) * P0_TST); \
            *(v4u*)(dst.base + (size_t)(16 * w_ + fr_) * dst.K + kb_) = __builtin_bit_cast(v4u, a_); } } \
        } while (0)
template <class A> DI void p0_convert(Frame& F, const A& P, int i_lo, int i_hi, int worker, int nworkers) {
    LAS unsigned char* S = F.lds;
    const int tid = F.tid;
    P0State st; p0_init(st, F, P, i_lo, i_hi, worker, nworkers);
    f32x4 rA[8], rB[8]; float gA[8], gB[8]; P0Dst dA, dB; dA.base = nullptr; dA.K = 0; dA.f8 = 0; dB = dA; bool hA = false, hB = false;
    P0_NEXT(st, rA, gA, dA, hA);
    while (hA) {
        P0_NEXT(st, rB, gB, dB, hB);
        P0_WRITE(S, rA, gA, dA); __syncthreads(); P0_STORE(S, dA); __syncthreads();
        if (!hB) break;
        P0_NEXT(st, rA, gA, dA, hA);
        P0_WRITE(S, rB, gB, dB); __syncthreads(); P0_STORE(S, dB); __syncthreads();
    }
}
template <class A> DI void p0_prologue(Frame& F, const A& P) {
    const int gw = F.vcu * NWAVES + F.wave, NGW = F.G * NWAVES;
    { const float* x = P.in[0]; bf16* xb = wsp<bf16>(F, WS_XB); float* ssq = wsp<float>(F, WS_SSQ);
      for (int m = gw; m < M; m += NGW) {
        const f32x4* xr = (const f32x4*)(x + (size_t)m * D) + F.lane; f32x4 v[4]; float s = 0.f;
#pragma unroll
        for (int j = 0; j < 4; ++j) { v[j] = xr[64 * j]; s += (v[j][0] * v[j][0] + v[j][1] * v[j][1]) + (v[j][2] * v[j][2] + v[j][3] * v[j][3]); }
        s = wave_sum(s);
        v2u* o8 = (v2u*)(xb + (size_t)m * D) + F.lane;
#pragma unroll
        for (int j = 0; j < 4; ++j) { v2u w; w.x = pk2(v[j][0], v[j][1]); w.y = pk2(v[j][2], v[j][3]); o8[64 * j] = w; }
        if (F.lane < 4) { f32x4 z = {0.f, 0.f, 0.f, 0.f}; if (F.lane == 0) z[0] = s; *((f32x4*)(ssq + (size_t)m * 16) + F.lane) = z; }
      } }
    p0_convert(F, P, 0, N_EARLY, F.vcu, F.G);
}

constexpr int TH_ST = 2064, TH_WL = 16 * TH_ST;
template <int NOUT> DI void thin_stage(Frame& F, const float* gain, const float* W, int ldw, int c0) {
    LAS unsigned char* lds = F.lds;
    for (int i = F.tid; i < 1024 * 16; i += NWAVES * 64) { const int n = i & 15, k = i >> 4; const float v = (n < NOUT) ? gain[k] * W[(size_t)k * ldw + c0 + n] : 0.f;
        const unsigned hi = f2bf(v); const float r = v - __builtin_bit_cast(float, hi << 16);
        *(LAS unsigned short*)(lds + n * TH_ST + k * 2) = (unsigned short)hi; *(LAS unsigned short*)(lds + TH_WL + n * TH_ST + k * 2) = (unsigned short)f2bf(r); }
    __syncthreads();
}
DI void thin_tile(const bf16* x, int row0, LAS const unsigned char* lds, int lane, float& ss, f32x4& out) {
    const int fr = lane & 15, fq = lane >> 4; const bf16* xr = x + (size_t)(row0 + fr) * D + 8 * fq; LAS const unsigned char* wp = lds + fr * TH_ST + 16 * fq;
    f32x4 acc = {0.f, 0.f, 0.f, 0.f}; float s = 0.f;
#pragma unroll 1
    for (int kb = 0; kb < 2; ++kb) { v4u a[16];
#pragma unroll
        for (int i = 0; i < 16; ++i) a[i] = *(const v4u*)(xr + 32 * (16 * kb + i));
#pragma unroll
        for (int i = 0; i < 16; ++i) { const v4u q = a[i];
            s += (bflo(q.x) * bflo(q.x) + bfhi(q.x) * bfhi(q.x)) + (bflo(q.y) * bflo(q.y) + bfhi(q.y) * bfhi(q.y)) + (bflo(q.z) * bflo(q.z) + bfhi(q.z) * bfhi(q.z)) + (bflo(q.w) * bflo(q.w) + bfhi(q.w) * bfhi(q.w));
            const bf16x8 xa = __builtin_bit_cast(bf16x8, q); const bf16x8 wh = ldsfrag(wp + 64 * (16 * kb + i)), wl = ldsfrag(wp + TH_WL + 64 * (16 * kb + i));
            acc = MFMA16(wh, xa, acc); acc = MFMA16(wl, xa, acc); } }
    s += __shfl_xor(s, 16); s += __shfl_xor(s, 32);
    ss = s; out = acc;
}
DI void glow_phase(Frame& F, const bf16* x, const float* gain, const float* Wb) {
    thin_stage<16>(F, gain, Wb, 3088, 3072);
    float* glow = wsp<float>(F, WS_GLOW);
    const int gw = F.vcu * NWAVES + F.wave, NGW = F.G * NWAVES, fr = F.lane & 15, fq = F.lane >> 4;
    for (int t = gw; t < M / 16; t += NGW) { float ss; f32x4 o; thin_tile(x, 16 * t, F.lds, F.lane, ss, o);
        const float rs = 1.0f / sqrtf(ss * (1.0f / D) + EPS);
        *(f32x4*)(glow + (size_t)(16 * t + fr) * 16 + 4 * fq) = o * rs; }
    __syncthreads();
}
DI void logf_phase(Frame& F, const bf16* x, const float* gain, const float* Wc, const float* fb) {
    thin_stage<8>(F, gain, Wc, 3080, 3072);
    float* logf = wsp<float>(F, WS_LOGF);
    const int gw = F.vcu * NWAVES + F.wave, NGW = F.G * NWAVES, fr = F.lane & 15, fq = F.lane >> 4;
    const f32x4 fb4 = *(const f32x4*)(fb + 4 * (fq & 1));
    for (int t = gw; t < M / 16; t += NGW) { float ss; f32x4 o; thin_tile(x, 16 * t, F.lds, F.lane, ss, o);
        const float rs = 1.0f / sqrtf(ss * (1.0f / D) + EPS);
        if (fq < 2) { f32x4 r;
#pragma unroll
            for (int e = 0; e < 4; ++e) r[e] = logsig(o[e] * rs + fb4[e]);
            *(f32x4*)(logf + (size_t)(16 * t + fr) * 8 + 4 * fq) = r; } }
    __syncthreads();
}
DI void router_phase(Frame& F, const bf16* x, const float* gain, const float* Wr, unsigned* gcnt) {
    thin_stage<8>(F, gain, Wr, 8, 0);
    LAS unsigned* lcnt = (LAS unsigned*)(F.lds + 2 * TH_WL);
    if (F.tid < 8) lcnt[F.tid] = 0u;
    __syncthreads();
    int* tok_e = wsp<int>(F, WS_TOKE); int* tok_p = wsp<int>(F, WS_TOKP); float* tok_g = wsp<float>(F, WS_TOKG); float* tok_rs = wsp<float>(F, WS_TOKRS); int* blkb = wsp<int>(F, WS_BLKB);
    const int gw = F.vcu * NWAVES + F.wave, NGW = F.G * NWAVES, fr = F.lane & 15, fq = F.lane >> 4;
    for (int t = gw; t < M / 16; t += NGW) { float ss; f32x4 o; thin_tile(x, 16 * t, F.lds, F.lane, ss, o);
        const float rs = 1.0f / sqrtf(ss * (1.0f / D) + EPS);
        f32x4 o2; o2[0] = __shfl_xor(o[0], 16); o2[1] = __shfl_xor(o[1], 16); o2[2] = __shfl_xor(o[2], 16); o2[3] = __shfl_xor(o[3], 16);
        if (fq == 0) { const int row = 16 * t + fr;
            const float lg[8] = {o[0] * rs, o[1] * rs, o[2] * rs, o[3] * rs, o2[0] * rs, o2[1] * rs, o2[2] * rs, o2[3] * rs};
            float v1 = lg[0]; int i1 = 0;
#pragma unroll
            for (int e = 1; e < 8; ++e) { if (lg[e] > v1) { v1 = lg[e]; i1 = e; } }
            float v2 = -3.0e38f; int i2 = 0;
#pragma unroll
            for (int e = 0; e < 8; ++e) { if (e != i1 && lg[e] > v2) { v2 = lg[e]; i2 = e; } }
            const float g1 = 1.0f / (1.0f + __expf(v2 - v1)), g2 = 1.0f - g1;
            const unsigned p1 = __hip_atomic_fetch_add(lcnt + i1, 1u, __ATOMIC_RELAXED, __HIP_MEMORY_SCOPE_WORKGROUP);
            const unsigned p2 = __hip_atomic_fetch_add(lcnt + i2, 1u, __ATOMIC_RELAXED, __HIP_MEMORY_SCOPE_WORKGROUP);
            tok_e[2 * row] = i1; tok_e[2 * row + 1] = i2; tok_p[2 * row] = (int)p1; tok_p[2 * row + 1] = (int)p2; tok_g[2 * row] = g1; tok_g[2 * row + 1] = g2; tok_rs[row] = rs; } }
    __syncthreads();
    if (F.tid < 8) { const unsigned b = __hip_atomic_fetch_add(gcnt + F.tid, lcnt[F.tid], __ATOMIC_RELAXED, __HIP_MEMORY_SCOPE_AGENT); blkb[F.vcu * 8 + F.tid] = (int)b; }
    __syncthreads();
}
template <bool F8> DI void gather_phase(Frame& F, const unsigned* gcnt) {
    LAS int* seg = (LAS int*)(F.lds); LAS int* cntl = seg + 16;
    if (F.tid == 0) { int t = 0; for (int e = 0; e < 8; ++e) { const int c = (int)gcnt[e]; seg[e] = t; cntl[e] = c; t += (c + 255) & ~255; } seg[8] = t; }
    __syncthreads();
    const int* tok_e = wsp<int>(F, WS_TOKE); const int* tok_p = wsp<int>(F, WS_TOKP); const float* tok_g = wsp<float>(F, WS_TOKG); const float* tok_rs = wsp<float>(F, WS_TOKRS); const int* blkb = wsp<int>(F, WS_BLKB);
    int* rtok = wsp<int>(F, WS_ROWT); float* rgate = wsp<float>(F, WS_ROWG); float* rrs = wsp<float>(F, WS_ROWRS);
    const bf16* xb = wsp<bf16>(F, WS_XB); bf16* XS = wsp<bf16>(F, WS_XS);
    const int gw = F.vcu * NWAVES + F.wave, NGW = F.G * NWAVES;
    for (int row = gw; row < M; row += NGW) { const int owner = ((row >> 4) % NGW) / NWAVES;
        const v4u* src = (const v4u*)(xb + (size_t)row * D); v4u a, b;
        if constexpr (F8) { a = src[2 * F.lane]; b = src[2 * F.lane + 1];
            int w0 = __builtin_amdgcn_cvt_pk_fp8_f32(pg8::c8(bflo(a.x)), pg8::c8(bfhi(a.x)), 0, false); w0 = __builtin_amdgcn_cvt_pk_fp8_f32(pg8::c8(bflo(a.y)), pg8::c8(bfhi(a.y)), w0, true); int w1 = __builtin_amdgcn_cvt_pk_fp8_f32(pg8::c8(bflo(a.z)), pg8::c8(bfhi(a.z)), 0, false); w1 = __builtin_amdgcn_cvt_pk_fp8_f32(pg8::c8(bflo(a.w)), pg8::c8(bfhi(a.w)), w1, true);
            int w2 = __builtin_amdgcn_cvt_pk_fp8_f32(pg8::c8(bflo(b.x)), pg8::c8(bfhi(b.x)), 0, false); w2 = __builtin_amdgcn_cvt_pk_fp8_f32(pg8::c8(bflo(b.y)), pg8::c8(bfhi(b.y)), w2, true); int w3 = __builtin_amdgcn_cvt_pk_fp8_f32(pg8::c8(bflo(b.z)), pg8::c8(bfhi(b.z)), 0, false); w3 = __builtin_amdgcn_cvt_pk_fp8_f32(pg8::c8(bflo(b.w)), pg8::c8(bfhi(b.w)), w3, true);
            a = (v4u){(unsigned)w0, (unsigned)w1, (unsigned)w2, (unsigned)w3}; b = a; }
        else { a = src[F.lane]; b = src[64 + F.lane]; }
#pragma unroll
        for (int slot = 0; slot < 2; ++slot) { const int e = tok_e[2 * row + slot]; const int r = seg[e] + blkb[owner * 8 + e] + tok_p[2 * row + slot];
            if constexpr (F8) { *((v4u*)((unsigned char*)XS + (size_t)r * D) + F.lane) = a; }
            else { v4u* dst = (v4u*)(XS + (size_t)r * D); dst[F.lane] = a; dst[64 + F.lane] = b; }
            if (F.lane == 0) { rtok[r] = 2 * row + slot; rgate[r] = tok_g[2 * row + slot]; rrs[r] = tok_rs[row]; } } }
    if (F.vcu == 0) { for (int e = 0; e < 8; ++e) for (int r = seg[e] + cntl[e] + F.tid; r < seg[e + 1]; r += NWAVES * 64) rtok[r] = -1; }
    __syncthreads();
}
DI void rowtable_phase(Frame& F, const unsigned* gcnt) {
    LAS int* seg = (LAS int*)(F.lds); LAS int* cntl = seg + 16;
    if (F.tid == 0) { int t = 0; for (int e = 0; e < 8; ++e) { const int c = (int)gcnt[e]; seg[e] = t; cntl[e] = c; t += (c + 255) & ~255; } seg[8] = t; }
    __syncthreads();
    const int* tok_e = wsp<int>(F, WS_TOKE); const int* tok_p = wsp<int>(F, WS_TOKP); const float* tok_g = wsp<float>(F, WS_TOKG); const float* tok_rs = wsp<float>(F, WS_TOKRS); const int* blkb = wsp<int>(F, WS_BLKB);
    int* rtok = wsp<int>(F, WS_ROWT); float* rgate = wsp<float>(F, WS_ROWG); float* rrs = wsp<float>(F, WS_ROWRS);
    const int NGW = F.G * NWAVES;
    for (int j = F.vcu * (NWAVES * 64) + F.tid; j < 2 * M; j += F.G * NWAVES * 64) { const int row = j >> 1, owner = ((row >> 4) % NGW) / NWAVES;
        const int e = tok_e[j]; const int r = seg[e] + blkb[owner * 8 + e] + tok_p[j];
        rtok[r] = j; rgate[r] = tok_g[j]; rrs[r] = tok_rs[row]; }
    if (F.vcu == 0) { for (int e = 0; e < 8; ++e) for (int r = seg[e] + cntl[e] + F.tid; r < seg[e + 1]; r += NWAVES * 64) rtok[r] = -1; }
    __syncthreads();
}
DI void combine_phase(Frame& F, bool fin, const float* fg, unsigned char* x8) {
    bf16* xb = wsp<bf16>(F, WS_XB); float* ssq = wsp<float>(F, WS_SSQ); const bf16* OS = wsp<bf16>(F, WS_OS);
    const int gw = F.vcu * NWAVES + F.wave, NGW = F.G * NWAVES;
    constexpr int RB = 2;
    for (int m0 = gw; m0 < M; m0 += RB * NGW) {
        v2u cx[RB][4], ca[RB][4], cb[RB][4];
#pragma unroll
        for (int i = 0; i < RB; ++i) { const int r_ = m0 + i * NGW, m = ((r_ & 2047) >> 8) * 4096 + (r_ & 255) + 256 * (r_ >> 11); if (r_ < M) {
                const v2u* xr = (const v2u*)(xb + (size_t)m * D) + F.lane; const v2u* o0 = (const v2u*)(OS + (size_t)m * D) + F.lane; const v2u* o1 = (const v2u*)(OS + ((size_t)M + m) * D) + F.lane;
#pragma unroll
                for (int j = 0; j < 4; ++j) { cx[i][j] = xr[64 * j]; ca[i][j] = o0[64 * j]; cb[i][j] = o1[64 * j]; } } }
#pragma unroll
        for (int i = 0; i < RB; ++i) { const int r_ = m0 + i * NGW, m = ((r_ & 2047) >> 8) * 4096 + (r_ & 255) + 256 * (r_ >> 11); if (r_ < M) {
        f32x4 v[4]; float s = 0.f;
#pragma unroll
        for (int j = 0; j < 4; ++j) { const v2u c = cx[i][j], a = ca[i][j], b = cb[i][j];
            v[j][0] = bflo(c.x) + (bflo(a.x) + bflo(b.x)); v[j][1] = bfhi(c.x) + (bfhi(a.x) + bfhi(b.x)); v[j][2] = bflo(c.y) + (bflo(a.y) + bflo(b.y)); v[j][3] = bfhi(c.y) + (bfhi(a.y) + bfhi(b.y));
            s += (v[j][0] * v[j][0] + v[j][1] * v[j][1]) + (v[j][2] * v[j][2] + v[j][3] * v[j][3]); }
        s = wave_sum(s);
        if (!fin) {
            v2u* o8 = (v2u*)(xb + (size_t)m * D) + F.lane;
#pragma unroll
            for (int j = 0; j < 4; ++j) { v2u w; w.x = pk2(v[j][0], v[j][1]); w.y = pk2(v[j][2], v[j][3]); o8[64 * j] = w; }
            if (x8) {
#pragma unroll
                for (int j = 0; j < 4; ++j) { int p = __builtin_amdgcn_cvt_pk_fp8_f32(pg8::c8(v[j][0]), pg8::c8(v[j][1]), 0, false); p = __builtin_amdgcn_cvt_pk_fp8_f32(pg8::c8(v[j][2]), pg8::c8(v[j][3]), p, true); *((unsigned*)(x8 + (size_t)m * D) + F.lane + 64 * j) = (unsigned)p; } }
            if (F.lane < 4) { f32x4 z = {0.f, 0.f, 0.f, 0.f}; if (F.lane == 0) z[0] = s; *((f32x4*)(ssq + (size_t)m * 16) + F.lane) = z; }
        } else {
            const float rs = 1.0f / sqrtf(s * (1.0f / D) + EPS); f32x4* ow = (f32x4*)(F.out + (size_t)m * D) + F.lane; const f32x4* g4 = (const f32x4*)fg + F.lane;
#pragma unroll
            for (int j = 0; j < 4; ++j) { const f32x4 g = g4[64 * j]; ow[64 * j] = v[j] * rs * g; }
        } } }
    }
}
DI void final_norm_phase(Frame& F, const bf16* x, const float* fg) {
    const int gw = F.vcu * NWAVES + F.wave, NGW = F.G * NWAVES;
    for (int m = gw; m < M; m += NGW) {
        const v2u* xr = (const v2u*)(x + (size_t)m * D) + F.lane; f32x4 v[4]; float s = 0.f;
#pragma unroll
        for (int j = 0; j < 4; ++j) { const v2u c = xr[64 * j]; v[j] = (f32x4){bflo(c.x), bfhi(c.x), bflo(c.y), bfhi(c.y)}; s += (v[j][0] * v[j][0] + v[j][1] * v[j][1]) + (v[j][2] * v[j][2] + v[j][3] * v[j][3]); }
        s = wave_sum(s);
        const float rs = 1.0f / sqrtf(s * (1.0f / D) + EPS); f32x4* ow = (f32x4*)(F.out + (size_t)m * D) + F.lane; const f32x4* g4 = (const f32x4*)fg + F.lane;
#pragma unroll
        for (int j = 0; j < 4; ++j) { const f32x4 g = g4[64 * j]; ow[64 * j] = v[j] * rs * g; }
    }
}


typedef __amdgpu_buffer_rsrc_t brsrc;
DI brsrc mk_rsrc(const void* p, unsigned bytes) { return __builtin_amdgcn_make_buffer_rsrc((void*)p, 0, bytes, 0x00020000); }
DI v4u bld128(brsrc r, unsigned voff, unsigned soff) { return __builtin_bit_cast(v4u, __builtin_amdgcn_raw_buffer_load_b128(r, voff, soff, 0)); }
DI v2u bld64(brsrc r, unsigned voff, unsigned soff) { return __builtin_bit_cast(v2u, __builtin_amdgcn_raw_buffer_load_b64(r, voff, soff, 0)); }
DI void bst64(brsrc r, unsigned voff, unsigned soff, v2u v) { __builtin_amdgcn_raw_buffer_store_b64(v, r, voff, soff, 0); }

template <bool Y8> DI void mix_phase(Frame& F, const float* ws_, const float* bs, const float* vg) {
    constexpr int WT_OFF = 0, WT_ST = 272, V_OFF = 34816, V_ST = 544, RS_OFF = 104448, BS_OFF = 105472, VG_OFF = 109568;
    const bf16* U = wsp<bf16>(F, WS_U); const bf16* V = wsp<bf16>(F, WS_V); bf16* Y = wsp<bf16>(F, WS_Y); const float* vssq = wsp<float>(F, WS_VSSQ);
    LAS unsigned char* lds = F.lds; LAS float* rsv = (LAS float*)(lds + RS_OFF); LAS float* bsl = (LAS float*)(lds + BS_OFF); LAS float* vgl = (LAS float*)(lds + VG_OFF);
    { const f32x4 b4 = (F.tid < 256) ? *(const f32x4*)(bs + 4 * F.tid) : (f32x4){0.f, 0.f, 0.f, 0.f}; const f32x4 g4 = *(const f32x4*)(vg + 4 * F.tid);
      if (F.tid < 256) *(LAS f32x4*)(bsl + 4 * F.tid) = b4; *(LAS f32x4*)(vgl + 4 * F.tid) = g4; }
    const int tid = F.tid, lane = F.lane, w = F.wave, fr = lane & 15, fq = lane >> 4;
    const int wfo = WT_OFF + fr * WT_ST + fq * 8;
    const int vfo = V_OFF + (4 * fq + (fr >> 2)) * V_ST + (32 * w + 4 * (fr & 3)) * 2;
    const brsrc rW = mk_rsrc(ws_, 8u * 128 * 128 * 4), rV = mk_rsrc(V, (unsigned)M * AW * 2), rU = mk_rsrc(U, (unsigned)M * AW * 2), rY = mk_rsrc(Y, (unsigned)M * AW * 2);
    const unsigned ulo8 = (unsigned)(fr * AW + 32 * w + 4 * fq);
    for (int c = F.vcu; c < 256; c += F.G) {
        const int tok0 = c * 128;
        if (tid < 128) { const f32x4* p = (const f32x4*)(vssq + (size_t)(tok0 + tid) * 32); float s = 0.f;
#pragma unroll
            for (int q = 0; q < 8; ++q) { const f32x4 a = p[q]; s += (a[0] + a[1]) + (a[2] + a[3]); }
            rsv[tid] = 1.0f / sqrtf(s * (1.0f / AW) + EPS); }
        f32x4 wreg[8]; v4u vreg[8];
        const unsigned wlo = (unsigned)((tid >> 5) * 512 + (tid & 31) * 16), vlo = (unsigned)((tid >> 5) * (AW * 2) + (tid & 31) * 16);
#define MIX_LOAD(gg) do { const unsigned ws_o = (unsigned)(gg) * 65536u, vs_o = (unsigned)tok0 * (AW * 2) + (unsigned)(gg) * 512u; \
            _Pragma("unroll") for (int it = 0; it < 8; ++it) { wreg[it] = __builtin_bit_cast(f32x4, bld128(rW, wlo, ws_o + (unsigned)(it * 16 * 512))); vreg[it] = bld128(rV, vlo, vs_o + (unsigned)(it * 16 * AW * 2)); } } while (0)
        MIX_LOAD(0);
        __syncthreads();
#pragma unroll 1
        for (int g = 0; g < 8; ++g) {
            const unsigned us_o = (unsigned)tok0 * (AW * 2) + (unsigned)g * 512u;
            const unsigned ulo = (unsigned)(fr * (AW * 2) + (32 * w + 4 * fq) * 2);
            v2u ureg[2][4][2];
#pragma unroll
            for (int hf = 0; hf < 2; ++hf)
#pragma unroll
                for (int m4 = 0; m4 < 4; ++m4)
#pragma unroll
                    for (int n2 = 0; n2 < 2; ++n2) ureg[hf][m4][n2] = bld64(rU, ulo, us_o + (unsigned)((16 * (4 * hf + m4)) * AW * 2 + 32 * n2));
#pragma unroll
            for (int it = 0; it < 8; ++it) { const int idx = it * 512 + tid, t = idx >> 5, s4 = (idx & 31) * 4; const f32x4 wv = wreg[it];
                const float a0 = (s4 + 0 <= t) ? wv[0] * rsv[s4 + 0] : 0.f, a1 = (s4 + 1 <= t) ? wv[1] * rsv[s4 + 1] : 0.f, a2 = (s4 + 2 <= t) ? wv[2] * rsv[s4 + 2] : 0.f, a3 = (s4 + 3 <= t) ? wv[3] * rsv[s4 + 3] : 0.f;
                v2u o; o.x = pk2(a0, a1); o.y = pk2(a2, a3); *(LAS v2u*)(lds + WT_OFF + t * WT_ST + s4 * 2) = o;
                *(LAS v4u*)(lds + V_OFF + (idx >> 5) * V_ST + (idx & 31) * 16) = vreg[it]; }
            __syncthreads();
            if (g + 1 < 8) MIX_LOAD(g + 1);
#pragma unroll
            for (int hf = 0; hf < 2; ++hf) {
                f32x4 acc[4][2];
#pragma unroll
                for (int m4 = 0; m4 < 4; ++m4) { acc[m4][0] = (f32x4){0.f, 0.f, 0.f, 0.f}; acc[m4][1] = (f32x4){0.f, 0.f, 0.f, 0.f}; }
#pragma unroll
                for (int ks = 0; ks < 4; ++ks) { if (32 * ks > 16 * (4 * hf + 3) + 15) continue;
                    const bf16x8 b0 = tr_frag(lds + vfo + (32 * ks) * V_ST, lds + vfo + (32 * ks + 16) * V_ST), b1 = tr_frag(lds + vfo + (32 * ks) * V_ST + 32, lds + vfo + (32 * ks + 16) * V_ST + 32);
#pragma unroll
                    for (int m4 = 0; m4 < 4; ++m4) { const int mt = 4 * hf + m4; if (32 * ks > 16 * mt + 15) continue;
                        const v2u lo = *(const LAS v2u*)(lds + wfo + mt * 16 * WT_ST + ks * 64), hi = *(const LAS v2u*)(lds + wfo + mt * 16 * WT_ST + ks * 64 + 32);
                        const v4u av = {lo.x, lo.y, hi.x, hi.y}; const bf16x8 a = __builtin_bit_cast(bf16x8, av);
                        acc[m4][0] = MFMA16(b0, a, acc[m4][0]); acc[m4][1] = MFMA16(b1, a, acc[m4][1]); }
                    __builtin_amdgcn_sched_barrier(0); }
#pragma unroll
                for (int m4 = 0; m4 < 4; ++m4) { const int t = 16 * (4 * hf + m4) + fr; const float bt = bsl[g * 128 + t];
#pragma unroll
                    for (int n2 = 0; n2 < 2; ++n2) { const int col = g * 256 + 32 * w + 16 * n2 + 4 * fq;
                        const v2u uu = ureg[hf][m4][n2]; const f32x4 gg = *(const LAS f32x4*)(vgl + col); const f32x4 a = acc[m4][n2];
                        v2u r; r.x = pk2(bflo(uu.x) * (a[0] * gg[0] + bt), bfhi(uu.x) * (a[1] * gg[1] + bt)); r.y = pk2(bflo(uu.y) * (a[2] * gg[2] + bt), bfhi(uu.y) * (a[3] * gg[3] + bt));
                        if constexpr (Y8) { int p8 = __builtin_amdgcn_cvt_pk_fp8_f32(pg8::c8(4.0f * bflo(uu.x) * (a[0] * gg[0] + bt)), pg8::c8(4.0f * bfhi(uu.x) * (a[1] * gg[1] + bt)), 0, false);
                            p8 = __builtin_amdgcn_cvt_pk_fp8_f32(pg8::c8(4.0f * bflo(uu.y) * (a[2] * gg[2] + bt)), pg8::c8(4.0f * bfhi(uu.y) * (a[3] * gg[3] + bt)), p8, true);
                            __builtin_amdgcn_raw_buffer_store_b32((unsigned)p8, rY, ulo8, (unsigned)tok0 * AW + (unsigned)g * 256u + (unsigned)((16 * (4 * hf + m4)) * AW + 16 * n2), 0); }
                        else bst64(rY, ulo, us_o + (unsigned)((16 * (4 * hf + m4)) * AW * 2 + 32 * n2), r); }
                    __builtin_amdgcn_sched_barrier(0); }
            }
            __syncthreads();
        }
#undef MIX_LOAD
    }
}

DI void gla_prep_phase(Frame& F, const float* wg2, const float* gb) {
    constexpr int GL_OFF = 0, SEG_OFF = 4096, OFFS_OFF = 6144, EBL_OFF = 8192, BC_OFF = 8704, KETL_OFF = 41472, VTL_OFF = 59904, TST = 144;
    const bf16* QKVR = wsp<bf16>(F, WS_QKVR); const float* glow = wsp<float>(F, WS_GLOW);
    bf16* QD = wsp<bf16>(F, WS_QD); bf16* KD = wsp<bf16>(F, WS_KD); bf16* KET = wsp<bf16>(F, WS_KET); bf16* VT = wsp<bf16>(F, WS_VT); float* DEC = wsp<float>(F, WS_DEC);
    LAS unsigned char* lds = F.lds;
    LAS float* gl = (LAS float*)(lds + GL_OFF); LAS float* segs = (LAS float*)(lds + SEG_OFF); LAS float* offs = (LAS float*)(lds + OFFS_OFF); LAS float* ebl = (LAS float*)(lds + EBL_OFF); LAS float* bcl = (LAS float*)(lds + BC_OFF);
    const int tid = F.tid;
    const int t2 = tid >> 3, kb = (tid & 7) * 16, dvb = (tid & 7) * 32, k = tid & 127, tq = tid >> 7;
    float wv[16]; float bias = 0.f; int hcur = -1;
    v4u q0, q1, k0, k1, vv[4]; f32x4 gv = {0.f, 0.f, 0.f, 0.f};
#define PREP_LOAD(uu) do { const int h_ = (uu) & 3, n_ = ((uu) >> 2) & 63, b_ = (uu) >> 8; const int t0_ = b_ * SEQ + n_ * 64; const bf16* rowp = QKVR + (size_t)(t0_ + t2) * 3072; \
        q0 = *(const v4u*)(rowp + h_ * 128 + kb); q1 = *(const v4u*)(rowp + h_ * 128 + kb + 8); k0 = *(const v4u*)(rowp + 512 + h_ * 128 + kb); k1 = *(const v4u*)(rowp + 512 + h_ * 128 + kb + 8); \
        _Pragma("unroll") for (int i = 0; i < 4; ++i) vv[i] = *(const v4u*)(rowp + 1024 + h_ * 256 + dvb + 8 * i); \
        if (tid < 256) gv = *((const f32x4*)(glow + (size_t)t0_ * 16) + tid); } while (0)
#define PREP_MAP(s) ((((s) & 255) >> 5) * 256 + ((s) & 31) + 32 * ((s) >> 8))
    if (F.vcu < 2048) PREP_LOAD(PREP_MAP(F.vcu));
    for (int sidx = F.vcu; sidx < 2048; sidx += F.G) { const int uidx = PREP_MAP(sidx);
        const int h = uidx & 3, n = (uidx >> 2) & 63, b = uidx >> 8; const int t0 = b * SEQ + n * 64; const int bhn = (b * 4 + h) * 64 + n;
        if (h != hcur) { hcur = h;
#pragma unroll
            for (int r = 0; r < 16; ++r) wv[r] = wg2[r * 512 + h * 128 + k];
            bias = gb[h * 128 + k]; }
        if (tid < 256) *((LAS f32x4*)gl + tid) = gv;
        __syncthreads();
        { float cum = 0.f;
#pragma unroll
          for (int i = 0; i < 16; ++i) { const LAS f32x4* gp = (const LAS f32x4*)(gl + (tq * 16 + i) * 16); float z = bias;
#pragma unroll
              for (int q = 0; q < 4; ++q) { const f32x4 g4 = gp[q]; z += g4[0] * wv[4 * q] + g4[1] * wv[4 * q + 1] + g4[2] * wv[4 * q + 2] + g4[3] * wv[4 * q + 3]; }
              cum += (fminf(z, 0.f) - __logf(1.0f + __expf(-fabsf(z)))) * (1.0f / 16.0f); bcl[(tq * 16 + i) * 128 + k] = cum; }
          segs[tq * 128 + k] = cum; }
        __syncthreads();
        if (tid < 128) { const float s0 = segs[tid], s1 = segs[128 + tid], s2 = segs[256 + tid], s3 = segs[384 + tid];
            offs[tid] = 0.f; offs[128 + tid] = s0; offs[256 + tid] = s0 + s1; offs[384 + tid] = (s0 + s1) + s2;
            const float eb = __expf(((s0 + s1) + s2) + s3); ebl[tid] = eb; DEC[(size_t)bhn * 128 + tid] = eb; }
        __syncthreads();
        { const int tq2 = t2 >> 4; unsigned qo[8], ko[8]; const unsigned qw[8] = {q0.x, q0.y, q0.z, q0.w, q1.x, q1.y, q1.z, q1.w}, kw[8] = {k0.x, k0.y, k0.z, k0.w, k1.x, k1.y, k1.z, k1.w};
          LAS unsigned short* kt = (LAS unsigned short*)(lds + KETL_OFF); const int rot = ((t2 * 2 + 16 * (tid & 7)) & 127) >> 1;
#pragma unroll
          for (int e = 0; e < 16; e += 2) { float qd2[2], kd2[2];
#pragma unroll
              for (int u = 0; u < 2; ++u) { const int kk = kb + e + u; const float bcum = bcl[t2 * 128 + kk] + offs[tq2 * 128 + kk];
                  const float e1 = __expf(bcum), e2 = __builtin_amdgcn_rcpf(e1);
                  const float qv = u ? bfhi(qw[e >> 1]) : bflo(qw[e >> 1]), kv = u ? bfhi(kw[e >> 1]) : bflo(kw[e >> 1]);
                  qd2[u] = qv * 0.08838834764831845f * e1; kd2[u] = kv * e2;
                  kt[kk * (TST / 2) + rot] = (unsigned short)f2bf(kv * e2 * ebl[kk]); }
              qo[e >> 1] = pk2(qd2[0], qd2[1]); ko[e >> 1] = pk2(kd2[0], kd2[1]); }
          bf16* qdp = QD + (size_t)(t0 + t2) * 512 + h * 128 + kb; bf16* kdp = KD + (size_t)(t0 + t2) * 512 + h * 128 + kb;
          { v4u a = {qo[0], qo[1], qo[2], qo[3]}, c = {qo[4], qo[5], qo[6], qo[7]}; *(v4u*)qdp = a; *(v4u*)(qdp + 8) = c; }
          { v4u a = {ko[0], ko[1], ko[2], ko[3]}, c = {ko[4], ko[5], ko[6], ko[7]}; *(v4u*)kdp = a; *(v4u*)(kdp + 8) = c; }
          LAS unsigned short* vt = (LAS unsigned short*)(lds + VTL_OFF);
#pragma unroll
          for (int i = 0; i < 4; ++i) { const unsigned w4[4] = {vv[i].x, vv[i].y, vv[i].z, vv[i].w};
#pragma unroll
              for (int e = 0; e < 4; ++e) { const int dv = dvb + 8 * i + 2 * e; vt[dv * (TST / 2) + rot] = (unsigned short)(w4[e] & 0xffffu); vt[(dv + 1) * (TST / 2) + rot] = (unsigned short)(w4[e] >> 16); } } }
        if (sidx + F.G < 2048) PREP_LOAD(PREP_MAP(sidx + F.G));
        __syncthreads();
#pragma unroll
        for (int i = 0; i < 2; ++i) { const int c = tid + 512 * i, r = c >> 3, ch = c & 7;
            *(v4u*)(KET + ((size_t)bhn * 128 + r) * 64 + ch * 8) = *(const LAS v4u*)(lds + KETL_OFF + r * TST + (((ch + (r >> 4)) & 7) * 16)); }
#pragma unroll
        for (int i = 0; i < 4; ++i) { const int c = tid + 512 * i, r = c >> 3, ch = c & 7;
            *(v4u*)(VT + ((size_t)bhn * 256 + r) * 64 + ch * 8) = *(const LAS v4u*)(lds + VTL_OFF + r * TST + (((ch + (r >> 5)) & 7) * 16)); }
        __syncthreads();
    }
#undef PREP_LOAD
#undef PREP_MAP
}

template <class A> DI void gla_scan_phase(Frame& F, const A& P) {
    constexpr int QD_OFF = 0, KD_OFF = 17408, KET_OFF = 34816, VT_OFF = 53248, ATT_OFF = 57856, ST_OFF = 67072, ST272 = 272, ST144 = 144;
    const bf16* QD = wsp<bf16>(F, WS_QD); const bf16* KD = wsp<bf16>(F, WS_KD); const bf16* KET = wsp<bf16>(F, WS_KET); const bf16* VT = wsp<bf16>(F, WS_VT); const float* DEC = wsp<float>(F, WS_DEC);
    bf16* GO = wsp<bf16>(F, WS_GO); float* ossq = wsp<float>(F, WS_OSSQ);
    LAS unsigned char* lds = F.lds;
    const int tid = F.tid, lane = F.lane, w = F.wave, fr = lane & 15, fq = lane >> 4;
    LAS unsigned char* SC = lds + 76800;
    P0State cst; p0_init(cst, F, P, N_EARLY, NMATS, F.vcu, F.G);
    f32x4 rC[8]; float gC[8]; P0Dst dC; dC.base = nullptr; dC.K = 0; dC.f8 = 0; bool hC = false;
    P0_NEXT(cst, rC, gC, dC, hC);
    for (int uidx = F.vcu; uidx < 256; uidx += F.G) {
        const int vb = uidx & 7, h = (uidx >> 3) & 3, b = uidx >> 5;
        for (int i = tid; i < (32 * ST272) / 4; i += NWAVES * 64) ((LAS unsigned*)(lds + ST_OFF))[i] = 0u;
        f32x4 st[2] = {(f32x4){0.f, 0.f, 0.f, 0.f}, (f32x4){0.f, 0.f, 0.f, 0.f}};
        v4u pq[2], pk[2], pe[2], pv; float pdec;
#define GLA_LOAD(nn) do { const int bhn_ = (b * 4 + h) * 64 + (nn); const size_t t0_ = (size_t)b * SEQ + (size_t)(nn) * 64; \
            _Pragma("unroll") for (int i_ = 0; i_ < 2; ++i_) { const int c_ = tid + 512 * i_; const int r_ = c_ >> 4, ch_ = c_ & 15; \
                pq[i_] = *(const v4u*)(QD + (t0_ + r_) * 512 + h * 128 + ch_ * 8); pk[i_] = *(const v4u*)(KD + (t0_ + r_) * 512 + h * 128 + ch_ * 8); \
                pe[i_] = *(const v4u*)(KET + (size_t)bhn_ * 8192 + (size_t)c_ * 8); } \
            if (tid < 256) pv = *(const v4u*)(VT + ((size_t)bhn_ * 256 + vb * 32) * 64 + (size_t)tid * 8); \
            pdec = DEC[(size_t)bhn_ * 128 + 16 * w + fr]; } while (0)
        GLA_LOAD(0);
        for (int n = 0; n < 64; ++n) {
#pragma unroll
            for (int i = 0; i < 2; ++i) { const int c = tid + 512 * i; const int r = c >> 4, ch = c & 15;
                *(LAS v4u*)(lds + QD_OFF + r * ST272 + ch * 16) = pq[i]; *(LAS v4u*)(lds + KD_OFF + r * ST272 + ch * 16) = pk[i];
                const int rk = c >> 3, ck = c & 7; *(LAS v4u*)(lds + KET_OFF + rk * ST144 + ck * 16) = pe[i]; }
            if (tid < 256) { const int rv = tid >> 3, cv = tid & 7; *(LAS v4u*)(lds + VT_OFF + rv * ST144 + cv * 16) = pv; }
            const float dec = pdec;
            __syncthreads();
            if (n + 1 < 64) GLA_LOAD(n + 1);
            const int mt = w & 3, nt = w >> 2;
            const size_t tok0 = (size_t)b * SEQ + (size_t)n * 64;
            f32x4 oacc = {0.f, 0.f, 0.f, 0.f};
#pragma unroll
            for (int ks = 0; ks < 4; ++ks) { const bf16x8 a = ldsfrag(lds + QD_OFF + (16 * mt + fr) * ST272 + (32 * ks + 8 * fq) * 2), bb = ldsfrag(lds + ST_OFF + (16 * nt + fr) * ST272 + (32 * ks + 8 * fq) * 2);
                oacc = MFMA16(bb, a, oacc); }
#pragma unroll
            for (int q = 0; q < 2; ++q) { const int stile = 2 * nt + q; f32x4 sacc = {0.f, 0.f, 0.f, 0.f};
                if (stile <= mt) {
#pragma unroll
                    for (int ks = 0; ks < 4; ++ks) { const bf16x8 a = ldsfrag(lds + QD_OFF + (16 * mt + fr) * ST272 + (32 * ks + 8 * fq) * 2), bb = ldsfrag(lds + KD_OFF + (16 * stile + fr) * ST272 + (32 * ks + 8 * fq) * 2);
                        sacc = MFMA16(bb, a, sacc); } }
                const int t = 16 * mt + fr, s0 = 16 * stile + 4 * fq;
                const float a0 = (s0 + 0 <= t) ? sacc[0] : 0.f, a1 = (s0 + 1 <= t) ? sacc[1] : 0.f, a2 = (s0 + 2 <= t) ? sacc[2] : 0.f, a3 = (s0 + 3 <= t) ? sacc[3] : 0.f;
                v2u o; o.x = pk2(a0, a1); o.y = pk2(a2, a3); *(LAS v2u*)(lds + ATT_OFF + t * ST144 + s0 * 2) = o; }
#pragma unroll
            for (int vt = 0; vt < 2; ++vt) { st[vt] = st[vt] * dec;
#pragma unroll
                for (int ks = 0; ks < 2; ++ks) { const bf16x8 a = ldsfrag(lds + VT_OFF + (16 * vt + fr) * ST144 + (32 * ks + 8 * fq) * 2), bb = ldsfrag(lds + KET_OFF + (16 * w + fr) * ST144 + (32 * ks + 8 * fq) * 2);
                    st[vt] = MFMA16(a, bb, st[vt]); } }
            const bool cw = hC; const P0Dst dW = dC;
            if (cw) { P0_WRITE(SC, rC, gC, dC); P0_NEXT(cst, rC, gC, dC, hC); }
            __syncthreads();
            if (cw) { P0_STORE(SC, dW); }
#pragma unroll
            for (int vt = 0; vt < 2; ++vt)
#pragma unroll
                for (int j = 0; j < 4; ++j) *(LAS unsigned short*)(lds + ST_OFF + (16 * vt + 4 * fq + j) * ST272 + (16 * w + fr) * 2) = (unsigned short)f2bf(st[vt][j]);
#pragma unroll
            for (int ks = 0; ks < 2; ++ks) { const bf16x8 a = ldsfrag(lds + ATT_OFF + (16 * mt + fr) * ST144 + (32 * ks + 8 * fq) * 2), bb = ldsfrag(lds + VT_OFF + (16 * nt + fr) * ST144 + (32 * ks + 8 * fq) * 2);
                oacc = MFMA16(bb, a, oacc); }
            { const size_t tok = tok0 + 16 * mt + fr; const int col = h * 256 + vb * 32 + 16 * nt + 4 * fq;
              v2u o; o.x = pk2(oacc[0], oacc[1]); o.y = pk2(oacc[2], oacc[3]); *(v2u*)(GO + tok * 1024 + col) = o;
              float sq = (oacc[0] * oacc[0] + oacc[1] * oacc[1]) + (oacc[2] * oacc[2] + oacc[3] * oacc[3]); sq += __shfl_xor(sq, 16); sq += __shfl_xor(sq, 32);
              if (fq == 0) ossq[(tok * 4 + h) * 16 + vb * 2 + nt] = sq; }
            __syncthreads();
        }
#undef GLA_LOAD
    }
    while (hC) { const P0Dst dW = dC; P0_WRITE(SC, rC, gC, dC); P0_NEXT(cst, rC, gC, dC, hC); __syncthreads(); P0_STORE(SC, dW); __syncthreads(); }
}
DI void gla_gate_phase(Frame& F, const float* og) {
    const bf16* GO = wsp<bf16>(F, WS_GO); const bf16* QKVR = wsp<bf16>(F, WS_QKVR); const float* ossq = wsp<float>(F, WS_OSSQ); bf16* GG = wsp<bf16>(F, WS_GG);
    const int gw = F.vcu * NWAVES + F.wave, NGW = F.G * NWAVES, lane = F.lane;
    const int c0 = 16 * lane, hh = lane >> 4;
    f32x4 g4[4];
#pragma unroll
    for (int q = 0; q < 4; ++q) g4[q] = *(const f32x4*)(og + (c0 & 255) + 4 * q);
    constexpr int RB = 4;
#define GATE_MAP(r) ((((r) & 2047) >> 8) * 4096 + ((r) & 255) + 256 * ((r) >> 11))
    for (int m0 = gw; m0 < M; m0 += RB * NGW) {
        f32x4 sv[RB][4]; v4u ov[RB][2], rv[RB][2];
#pragma unroll
        for (int i = 0; i < RB; ++i) { const int r_ = m0 + i * NGW, m = GATE_MAP(r_); if (r_ < M) { const f32x4* sp = (const f32x4*)(ossq + ((size_t)m * 4 + hh) * 16);
#pragma unroll
                for (int q = 0; q < 4; ++q) sv[i][q] = sp[q];
                const v4u* op = (const v4u*)(GO + (size_t)m * 1024 + c0); const v4u* rp = (const v4u*)(QKVR + (size_t)m * 3072 + 2048 + c0);
                ov[i][0] = op[0]; ov[i][1] = op[1]; rv[i][0] = rp[0]; rv[i][1] = rp[1]; } }
#pragma unroll
        for (int i = 0; i < RB; ++i) { const int r_ = m0 + i * NGW, m = GATE_MAP(r_); if (r_ < M) { float s = 0.f;
#pragma unroll
                for (int q = 0; q < 4; ++q) { const f32x4 a = sv[i][q]; s += (a[0] + a[1]) + (a[2] + a[3]); }
                const float rs = 1.0f / sqrtf(s * (1.0f / 256.0f) + EPS);
                v4u* dp = (v4u*)(GG + (size_t)m * 1024 + c0);
                if constexpr (BOUT_F8 != 0) { const float r8 = 8.0f * rs; unsigned w8[4];
#pragma unroll
                    for (int q = 0; q < 2; ++q) { const v4u o = ov[i][q], r = rv[i][q]; const f32x4 ga = g4[2 * q], gb = g4[2 * q + 1];
                        int a_ = __builtin_amdgcn_cvt_pk_fp8_f32(pg8::c8(bflo(o.x) * r8 * ga[0] * pg8::silu_f(bflo(r.x))), pg8::c8(bfhi(o.x) * r8 * ga[1] * pg8::silu_f(bfhi(r.x))), 0, false);
                        a_ = __builtin_amdgcn_cvt_pk_fp8_f32(pg8::c8(bflo(o.y) * r8 * ga[2] * pg8::silu_f(bflo(r.y))), pg8::c8(bfhi(o.y) * r8 * ga[3] * pg8::silu_f(bfhi(r.y))), a_, true);
                        int b_ = __builtin_amdgcn_cvt_pk_fp8_f32(pg8::c8(bflo(o.z) * r8 * gb[0] * pg8::silu_f(bflo(r.z))), pg8::c8(bfhi(o.z) * r8 * gb[1] * pg8::silu_f(bfhi(r.z))), 0, false);
                        b_ = __builtin_amdgcn_cvt_pk_fp8_f32(pg8::c8(bflo(o.w) * r8 * gb[2] * pg8::silu_f(bflo(r.w))), pg8::c8(bfhi(o.w) * r8 * gb[3] * pg8::silu_f(bfhi(r.w))), b_, true);
                        w8[2 * q] = (unsigned)a_; w8[2 * q + 1] = (unsigned)b_; }
                    *(v4u*)((unsigned char*)GG + (size_t)m * 1024 + c0) = (v4u){w8[0], w8[1], w8[2], w8[3]}; }
                else
#pragma unroll
                for (int q = 0; q < 2; ++q) { const v4u o = ov[i][q], r = rv[i][q]; v4u d; const f32x4 ga = g4[2 * q], gb = g4[2 * q + 1];
                    d.x = pk2(bflo(o.x) * rs * ga[0] * pg8::silu_f(bflo(r.x)), bfhi(o.x) * rs * ga[1] * pg8::silu_f(bfhi(r.x)));
                    d.y = pk2(bflo(o.y) * rs * ga[2] * pg8::silu_f(bflo(r.y)), bfhi(o.y) * rs * ga[3] * pg8::silu_f(bfhi(r.y)));
                    d.z = pk2(bflo(o.z) * rs * gb[0] * pg8::silu_f(bflo(r.z)), bfhi(o.z) * rs * gb[1] * pg8::silu_f(bfhi(r.z)));
                    d.w = pk2(bflo(o.w) * rs * gb[2] * pg8::silu_f(bflo(r.w)), bfhi(o.w) * rs * gb[3] * pg8::silu_f(bfhi(r.w)));
                    dp[q] = d; } } }
    }
}
#undef GATE_MAP

DI void fox_attn_phase(Frame& F, const unsigned* knb) {
    constexpr int KST = 272, VST = 288, STAGE = 64 * KST + 64 * VST, V_OFF = 64 * KST, C_OFF = 2 * STAGE, WS_OFF = C_OFF + 16384;
    const bf16* QKV = wsp<bf16>(F, WS_QKVR); const float* logf = wsp<float>(F, WS_LOGF); bf16* AO = wsp<bf16>(F, WS_AO);
    LAS unsigned char* lds = F.lds; LAS float* cl = (LAS float*)(lds + C_OFF); LAS float* wsum = (LAS float*)(lds + WS_OFF); LAS unsigned* dflag = (LAS unsigned*)(lds + WS_OFF + 64);
    const int tid = F.tid, lane = F.lane, w = F.wave, fr = lane & 15, fq = lane >> 4;
    constexpr float SC2 = 0.08838834764831845f * 1.4426950408889634f, L2E = 1.4426950408889634f, THR = 8.0f;
    const int kfo = fr * KST + fq * 16;
    const int vfo = (4 * fq + (fr >> 2)) * VST + (fr & 3) * 8;
    int cur_bh = -1;
    for (int U = F.vcu; U < 1024; U += F.G) {
        const int r_ = U >> 8, v_ = U & 255, bh = v_ >> 2, i_ = v_ & 3; const int b = bh >> 3, h = bh & 7;
        const int qt = (r_ == 0) ? i_ : (r_ == 1) ? 7 - i_ : (r_ == 2) ? 8 + i_ : 15 - i_;
        if (bh != cur_bh) { cur_bh = bh;
          __syncthreads();
          float v8[8]; float tot = 0.f; const int p0 = tid * 8;
          { const float* lp = logf + ((size_t)b * SEQ + p0) * 8 + h;
#pragma unroll
              for (int e = 0; e < 8; ++e) v8[e] = lp[8 * e]; }
#pragma unroll
          for (int e = 0; e < 8; ++e) { tot += v8[e]; v8[e] = tot; }
          float inc = tot;
#pragma unroll
          for (int o = 1; o < 64; o <<= 1) { const float t = __shfl_up(inc, o); if (lane >= o) inc += t; }
          if (lane == 63) wsum[w] = inc;
          __syncthreads();
          float woff = 0.f;
#pragma unroll
          for (int q = 0; q < 8; ++q) woff += (q < w) ? wsum[q] : 0.f;
          const float excl = woff + inc - tot;
#pragma unroll
          for (int e = 0; e < 8; ++e) cl[p0 + e] = -L2E * (excl + v8[e]);
        }
        const int q0 = qt * 256 + 32 * w;
        bf16x8 qf[2][4]; float mrow[2], lrow[2]; f32x4 oacc[2][8];
#pragma unroll
        for (int mt = 0; mt < 2; ++mt) { const size_t tok = (size_t)b * SEQ + q0 + 16 * mt + fr;
#pragma unroll
            for (int ks = 0; ks < 4; ++ks) qf[mt][ks] = *(const bf16x8*)(QKV + tok * 3072 + h * 128 + 32 * ks + 8 * fq);
            mrow[mt] = -1.0e30f; lrow[mt] = 0.f;
#pragma unroll
            for (int dt = 0; dt < 8; ++dt) oacc[mt][dt] = (f32x4){0.f, 0.f, 0.f, 0.f}; }
        const int ntiles = 4 * (qt + 1);
        float qk_bound;
        { float q2 = 0.f;
#pragma unroll
          for (int mt = 0; mt < 2; ++mt) { float s = 0.f;
#pragma unroll
              for (int ks = 0; ks < 4; ++ks) { const v4u qq = __builtin_bit_cast(v4u, qf[mt][ks]);
                  s += (bflo(qq.x) * bflo(qq.x) + bfhi(qq.x) * bfhi(qq.x)) + (bflo(qq.y) * bflo(qq.y) + bfhi(qq.y) * bfhi(qq.y)) + (bflo(qq.z) * bflo(qq.z) + bfhi(qq.z) * bfhi(qq.z)) + (bflo(qq.w) * bflo(qq.w) + bfhi(qq.w) * bfhi(qq.w)); }
              s += __shfl_xor(s, 16); s += __shfl_xor(s, 32); q2 = fmaxf(q2, s); }
#pragma unroll
          for (int o = 1; o < 16; o <<= 1) q2 = fmaxf(q2, __shfl_xor(q2, o));
          const unsigned* kp = knb + (b * 8 + h) * 4; const float k2 = (__builtin_bit_cast(float, kp[0]) + __builtin_bit_cast(float, kp[1])) + (__builtin_bit_cast(float, kp[2]) + __builtin_bit_cast(float, kp[3]));
          qk_bound = sqrtf(q2 * k2) * (SC2 * 1.02f); }
        bool wdone = false;
        if (tid < 8) dflag[tid] = 0u;
        v4u pk_[2], pv_[2];
#define FOX_LOAD(jj) do { _Pragma("unroll") for (int i2 = 0; i2 < 2; ++i2) { const int c2 = tid + 512 * i2; const bf16* rp = QKV + ((size_t)b * SEQ + 64 * (jj) + (c2 >> 4)) * 3072 + h * 128 + (c2 & 15) * 8; \
            pk_[i2] = *(const v4u*)(rp + 1024); pv_[i2] = *(const v4u*)(rp + 2048); } } while (0)
#define FOX_STORE(st) do { _Pragma("unroll") for (int i2 = 0; i2 < 2; ++i2) { const int c2 = tid + 512 * i2; \
            *(LAS v4u*)(lds + (st) * STAGE + (c2 >> 4) * KST + (c2 & 15) * 16) = pk_[i2]; *(LAS v4u*)(lds + (st) * STAGE + V_OFF + (c2 >> 4) * VST + (c2 & 15) * 16) = pv_[i2]; } } while (0)
        FOX_LOAD(ntiles - 1);
        FOX_STORE(0);
        __syncthreads();
        for (int it = 0; it < ntiles; ++it) {
            const int j = ntiles - 1 - it, cur = it & 1; const int key0 = 64 * j;
            if (it + 1 < ntiles) FOX_LOAD(j - 1);
            if (!wdone && key0 <= q0 + 31) {
                LAS const unsigned char* kb = lds + cur * STAGE + kfo; LAS const unsigned char* vb = lds + cur * STAGE + V_OFF + vfo;
                f32x4 sacc[4][2];
#pragma unroll
                for (int nt = 0; nt < 4; ++nt) { sacc[nt][0] = (f32x4){0.f, 0.f, 0.f, 0.f}; sacc[nt][1] = (f32x4){0.f, 0.f, 0.f, 0.f}; }
                { bf16x8 ka[2][4];
#pragma unroll
                  for (int nt = 0; nt < 4; ++nt) ka[0][nt] = ldsfrag(kb + nt * 16 * KST);
#pragma unroll
                  for (int ks = 0; ks < 4; ++ks) {
                    if (ks + 1 < 4) {
#pragma unroll
                        for (int nt = 0; nt < 4; ++nt) ka[(ks + 1) & 1][nt] = ldsfrag(kb + nt * 16 * KST + (ks + 1) * 64); }
#pragma unroll
                    for (int nt = 0; nt < 4; ++nt) { sacc[nt][0] = MFMA16(ka[ks & 1][nt], qf[0][ks], sacc[nt][0]); sacc[nt][1] = MFMA16(ka[ks & 1][nt], qf[1][ks], sacc[nt][1]); } } }
                float mx0 = -__builtin_inff(), mx1 = -__builtin_inff();
#pragma unroll
                for (int nt = 0; nt < 4; ++nt) { const f32x4 ck = *(const LAS f32x4*)(cl + key0 + 16 * nt + 4 * fq);
                    sacc[nt][0] = sacc[nt][0] * SC2 + ck; sacc[nt][1] = sacc[nt][1] * SC2 + ck; }
                if (key0 + 63 > q0) {
#pragma unroll
                    for (int nt = 0; nt < 4; ++nt)
#pragma unroll
                        for (int e = 0; e < 4; ++e) { const int key = key0 + 16 * nt + 4 * fq + e;
                            if (key > q0 + fr) sacc[nt][0][e] = -__builtin_inff();
                            if (key > q0 + 16 + fr) sacc[nt][1][e] = -__builtin_inff(); } }
#pragma unroll
                for (int nt = 0; nt < 4; ++nt) { mx0 = fmaxf(mx0, fmaxf(fmaxf(sacc[nt][0][0], sacc[nt][0][1]), fmaxf(sacc[nt][0][2], sacc[nt][0][3])));
                    mx1 = fmaxf(mx1, fmaxf(fmaxf(sacc[nt][1][0], sacc[nt][1][1]), fmaxf(sacc[nt][1][2], sacc[nt][1][3]))); }
                mx0 = fmaxf(mx0, __shfl_xor(mx0, 16)); mx0 = fmaxf(mx0, __shfl_xor(mx0, 32)); mx1 = fmaxf(mx1, __shfl_xor(mx1, 16)); mx1 = fmaxf(mx1, __shfl_xor(mx1, 32));
                if (__any((mx0 > mrow[0] + THR) || (mx1 > mrow[1] + THR))) {
                    const float n0 = fmaxf(mrow[0], mx0), n1 = fmaxf(mrow[1], mx1);
                    const float a0 = __builtin_amdgcn_exp2f(mrow[0] - n0), a1 = __builtin_amdgcn_exp2f(mrow[1] - n1);
                    mrow[0] = n0; mrow[1] = n1; lrow[0] *= a0; lrow[1] *= a1;
#pragma unroll
                    for (int dt = 0; dt < 8; ++dt) { oacc[0][dt] = oacc[0][dt] * a0; oacc[1][dt] = oacc[1][dt] * a1; } }
                bf16x8 pf[2][2];
#pragma unroll
                for (int mt = 0; mt < 2; ++mt) { const float mm = mrow[mt]; float ls = 0.f; unsigned pw[8];
#pragma unroll
                    for (int nt = 0; nt < 4; ++nt) { const f32x4 t = sacc[nt][mt] - mm;
                        const float p0 = __builtin_amdgcn_exp2f(t[0]), p1 = __builtin_amdgcn_exp2f(t[1]), p2 = __builtin_amdgcn_exp2f(t[2]), p3 = __builtin_amdgcn_exp2f(t[3]);
                        ls += (p0 + p1) + (p2 + p3); pw[2 * nt] = pg8::cvt_pk_bf16(p0, p1); pw[2 * nt + 1] = pg8::cvt_pk_bf16(p2, p3); }
                    lrow[mt] += ls;
                    { v4u t0 = {pw[0], pw[1], pw[2], pw[3]}, t1 = {pw[4], pw[5], pw[6], pw[7]}; pf[mt][0] = __builtin_bit_cast(bf16x8, t0); pf[mt][1] = __builtin_bit_cast(bf16x8, t1); } }
                { bf16x8 va[2][4];
#pragma unroll
                  for (int i = 0; i < 4; ++i) va[0][i] = tr_frag(vb + i * 32, vb + 16 * VST + i * 32);
#pragma unroll
                  for (int g = 0; g < 4; ++g) { const int ks2 = g >> 1, d0 = (g & 1) * 4;
                    if (g + 1 < 4) { const int ks2n = (g + 1) >> 1, d0n = ((g + 1) & 1) * 4;
#pragma unroll
                        for (int i = 0; i < 4; ++i) va[(g + 1) & 1][i] = tr_frag(vb + (32 * ks2n) * VST + (d0n + i) * 32, vb + (32 * ks2n + 16) * VST + (d0n + i) * 32); }
#pragma unroll
                    for (int i = 0; i < 4; ++i) { oacc[0][d0 + i] = MFMA16(va[g & 1][i], pf[0][ks2], oacc[0][d0 + i]); oacc[1][d0 + i] = MFMA16(va[g & 1][i], pf[1][ks2], oacc[1][d0 + i]); } } }
            }
            if (!wdone && j > 0) {
                const float mmin = fminf(mrow[0], mrow[1]); float mm = mmin; mm = fminf(mm, __shfl_xor(mm, 1)); mm = fminf(mm, __shfl_xor(mm, 2)); mm = fminf(mm, __shfl_xor(mm, 4)); mm = fminf(mm, __shfl_xor(mm, 8));
                if (key0 - 1 <= q0 + 31 && __all(qk_bound + cl[key0 - 1] - mm < -40.0f)) { wdone = true; if (lane == 0) dflag[w] = 1u; } }
            if (it + 1 < ntiles) FOX_STORE(cur ^ 1);
            __syncthreads();
            { unsigned alld = 1u;
#pragma unroll
              for (int q = 0; q < 8; ++q) alld &= dflag[q];
              if (alld) break; }
        }
        __syncthreads();
#undef FOX_LOAD
#undef FOX_STORE
#pragma unroll
        for (int mt = 0; mt < 2; ++mt) { float l = lrow[mt]; l += __shfl_xor(l, 16); l += __shfl_xor(l, 32); const float inv = 1.0f / l;
            const size_t tok = (size_t)b * SEQ + q0 + 16 * mt + fr;
#pragma unroll
            for (int dt = 0; dt < 8; ++dt) {
                if constexpr (COUT_F8 != 0) { const f32x4 o = oacc[mt][dt] * (8.0f * inv);
                    int q_ = __builtin_amdgcn_cvt_pk_fp8_f32(pg8::c8(o[0]), pg8::c8(o[1]), 0, false); q_ = __builtin_amdgcn_cvt_pk_fp8_f32(pg8::c8(o[2]), pg8::c8(o[3]), q_, true);
                    *(unsigned*)((unsigned char*)AO + tok * 1024 + h * 128 + 16 * dt + 4 * fq) = (unsigned)q_; }
                else { const f32x4 o = oacc[mt][dt] * inv; v2u r; r.x = pg8::cvt_pk_bf16(o[0], o[1]); r.y = pg8::cvt_pk_bf16(o[2], o[3]); *(v2u*)(AO + tok * 1024 + h * 128 + 16 * dt + 4 * fq) = r; } } }
    }
}

constexpr int N_PHASES = 2 + 10 * MK_LAYERS;
__host__ __device__ constexpr bool phase_active(int id) {
    if (id == 0) return true;
    if (id == 1 + 10 * MK_LAYERS) return (MK_LAYERS % 2) == 1;
    const int l = (id - 1) / 10, s = (id - 1) % 10, mixer = l % 3; const bool moe = (l % 2) == 1;
    if (s == 0 || s == 1 || s == 4) return true;
    if (s == 2 || s == 3) return mixer == 1;
    if (s == 5 || s == 6) return true;
    return moe;
}
struct Args { const float* in[22]; float* out; unsigned char* ws; int ph_lo, ph_hi; };
#define IN(k) (lo <= (k) && (k) < hi)
#ifndef PROBE_MASK
#define PROBE_MASK 0
#endif
#define REPS(bit) _Pragma("unroll 1") for (int r_ = 0; r_ < ((PROBE_MASK & (bit)) ? 2 : 1); ++r_)
#define TWICE(bit, ...) do { if constexpr ((PROBE_MASK & (bit)) != 0) { __VA_ARGS__ xcd_barrier(bar); } __VA_ARGS__ } while (0)
#define SEAM(k) do { if ((k) + 1 < hi) xcd_barrier(bar); } while (0)
#define SEAML(k) do { if ((k) + 1 < hi) { if (F.MISC[10]) xcd_barrier_local(bar); else xcd_barrier(bar); } } while (0)
template <int L> DI void run_layer(Frame& F, const Args& args, const XcdBarrier& bar, const int lo, const int hi) {
    constexpr int l = L, mixer = L % 3, jm = L / 3, fi = L / 2, pb = 1 + 10 * L; constexpr bool moe = (L & 1) != 0;
    bf16* XB = wsp<bf16>(F, WS_XB); float* SSQ = wsp<float>(F, WS_SSQ);
    if (IN(pb + 0)) {
        if constexpr (mixer == 0) {
            if constexpr (l == 3 && AIN_F8 != 0) {
                pg8::Gemm g{(const bf16*)wsp<unsigned char>(F, WS_X8), wsp<bf16>(F, WS_WA_IN) + (size_t)jm * 4096 * 1024, M, 4096, D / 2}; pg8::StaticOrder S; S.init(M, 4096, F.G, (int)blockIdx.x);
                pg8::EpiAin E{SSQ, wsp<bf16>(F, WS_U), wsp<bf16>(F, WS_V), wsp<float>(F, WS_VSSQ), 1.0f / 64.0f};
                pg8::gemm_phase<pg8::EpiAin, pg8::StaticOrder, true, true, true>(F.lds + RING_OFF, g, S, E);
            } else {
                pg8::Gemm g{XB, wsp<bf16>(F, WS_WA_IN) + (size_t)jm * 4096 * 1024, M, 4096, D}; pg8::StaticOrder S; S.init(M, 4096, F.G, (int)blockIdx.x);
                pg8::EpiAin E{SSQ, wsp<bf16>(F, WS_U), wsp<bf16>(F, WS_V), wsp<float>(F, WS_VSSQ), 1.0f};
                pg8::gemm_phase<pg8::EpiAin, pg8::StaticOrder, true, true>(F.lds + RING_OFF, g, S, E);
            }
        } else {
            REPS(128) { if constexpr (mixer == 1) glow_phase(F, XB, args.in[1] + l * 1024, args.in[8]); else logf_phase(F, XB, args.in[1] + l * 1024, args.in[13], args.in[14]); }
            if constexpr (mixer == 2 && CIN_F8 != 0) {
                pg8::Gemm g{(const bf16*)wsp<unsigned char>(F, WS_X8), wsp<bf16>(F, WS_WC_IN), M, 3072, D / 2}; pg8::StaticOrder S; S.init(M, 3072, F.G, (int)blockIdx.x);
                pg8::EpiRow<true> E{SSQ, wsp<bf16>(F, WS_QKVR), 3072, (unsigned*)(F.ctl + CW_KNB), 1.0f / 64.0f};
                pg8::gemm_phase<pg8::EpiRow<true>, pg8::StaticOrder, true, true, true>(F.lds + RING_OFF, g, S, E);
            } else {
                pg8::Gemm g{XB, mixer == 1 ? wsp<bf16>(F, WS_WB_IN) : wsp<bf16>(F, WS_WC_IN), M, 3072, D}; pg8::StaticOrder S; S.init(M, 3072, F.G, (int)blockIdx.x);
                pg8::EpiRow<mixer == 2> E{SSQ, wsp<bf16>(F, WS_QKVR), 3072, (unsigned*)(F.ctl + CW_KNB), 1.0f};
                pg8::gemm_phase<pg8::EpiRow<mixer == 2>, pg8::StaticOrder, true, true>(F.lds + RING_OFF, g, S, E);
            }
        }
        SEAML(pb + 0);
    }
    if (IN(pb + 1)) { REPS(mixer == 0 ? 2 : mixer == 1 ? 4 : 32) {
        if constexpr (mixer == 0) mix_phase<(((AOUT_F8 >> jm) & 1) != 0)>(F, args.in[5] + (size_t)jm * 8 * 128 * 128, args.in[6] + (size_t)jm * 8 * 128, args.in[4] + (size_t)jm * AW);
        else if constexpr (mixer == 1) gla_prep_phase(F, args.in[9], args.in[10]);
        else fox_attn_phase(F, (const unsigned*)(F.ctl + CW_KNB));
        SEAML(pb + 1); } }
    if constexpr (mixer == 1) {
        if (IN(pb + 2)) { REPS(8) { gla_scan_phase(F, args); SEAML(pb + 2); } }
        if (IN(pb + 3)) { REPS(16) { gla_gate_phase(F, args.in[11]); SEAML(pb + 3); } }
    }
    if (IN(pb + 4)) {
        const bf16* A = mixer == 0 ? wsp<bf16>(F, WS_Y) : mixer == 1 ? wsp<bf16>(F, WS_GG) : wsp<bf16>(F, WS_AO);
        const bf16* Bt = mixer == 0 ? wsp<bf16>(F, WS_WA_OUT) + (size_t)jm * 1024 * 2048 : mixer == 1 ? wsp<bf16>(F, WS_WB_OUT) : wsp<bf16>(F, WS_WC_OUT);
        constexpr bool w8 = moe ? (MOE_F8 != 0) : ((DENSE_F8 >> fi) & 1) != 0;
        if constexpr ((mixer == 2 && COUT_F8 != 0) || (mixer == 1 && BOUT_F8 != 0)) {
            pg8::Gemm g{A, Bt, M, D, 512}; pg8::StaticOrder S; S.init(M, D, F.G, (int)blockIdx.x);
            pg8::EpiResid<false, w8> E{(const void*)XB, XB, SSQ, wsp<unsigned char>(F, WS_X8), 1.0f / 512.0f};
            pg8::gemm_phase<pg8::EpiResid<false, w8>, pg8::StaticOrder, true, true, true>(F.lds + RING_OFF, g, S, E);
        } else if constexpr (mixer == 0 && ((AOUT_F8 >> jm) & 1) != 0) {
            pg8::Gemm g{A, Bt, M, D, 1024}; pg8::StaticOrder S; S.init(M, D, F.G, (int)blockIdx.x);
            pg8::EpiResid<l == 0, w8> E{l == 0 ? (const void*)args.in[0] : (const void*)XB, XB, SSQ, wsp<unsigned char>(F, WS_X8), 1.0f / 256.0f};
            pg8::gemm_phase<pg8::EpiResid<l == 0, w8>, pg8::StaticOrder, true, true, true>(F.lds + RING_OFF, g, S, E);
        } else {
            pg8::Gemm g{A, Bt, M, D, mixer == 0 ? 2048 : 1024}; pg8::StaticOrder S; S.init(M, D, F.G, (int)blockIdx.x);
            pg8::EpiResid<l == 0, w8> E{l == 0 ? (const void*)args.in[0] : (const void*)XB, XB, SSQ, wsp<unsigned char>(F, WS_X8), 1.0f};
            pg8::gemm_phase<pg8::EpiResid<l == 0, w8>, pg8::StaticOrder, true, true>(F.lds + RING_OFF, g, S, E);
        }
        SEAML(pb + 4);
    }
    if constexpr (!moe) {
        constexpr bool f8 = ((DENSE_F8 >> fi) & 1) != 0;
        if (IN(pb + 5)) {
            if constexpr (f8) {
                pg8::Gemm g{(const bf16*)wsp<unsigned char>(F, WS_X8), (const bf16*)(wsp<unsigned char>(F, WS_WF_IN) + (size_t)fi * 2 * 7168 * 1024), M, 7168, D / 2}; pg8::StaticOrder S; S.init(M, 7168, F.G, (int)blockIdx.x);
                pg8::EpiSwiGLU8<0> E{SSQ, wsp<unsigned char>(F, WS_HF)};
                pg8::gemm_phase<pg8::EpiSwiGLU8<0>, pg8::StaticOrder, true, true, true>(F.lds + RING_OFF, g, S, E);
            } else {
                pg8::Gemm g{XB, wsp<bf16>(F, WS_WF_IN) + (size_t)fi * 7168 * 1024, M, 7168, D}; pg8::StaticOrder S; S.init(M, 7168, F.G, (int)blockIdx.x);
                pg8::EpiSwiGLU<0> E{SSQ, wsp<bf16>(F, WS_HF)};
                pg8::gemm_phase<pg8::EpiSwiGLU<0>, pg8::StaticOrder, true, true>(F.lds + RING_OFF, g, S, E);
            }
            SEAML(pb + 5);
        }
        if (IN(pb + 6)) {
            if constexpr (f8) {
                pg8::Gemm g{(const bf16*)wsp<unsigned char>(F, WS_HF), (const bf16*)(wsp<unsigned char>(F, WS_WF_OUT) + (size_t)fi * 2 * 1024 * 3584), M, D, FF / 2}; pg8::StaticOrder S; S.init(M, D, F.G, (int)blockIdx.x, 1);
                constexpr bool w8n = (l == 2 && AIN_F8 != 0);
                pg8::EpiResid<false, w8n> E{(const void*)XB, XB, SSQ, wsp<unsigned char>(F, WS_X8), 1.0f / 512.0f};
                pg8::gemm_phase<pg8::EpiResid<false, w8n>, pg8::StaticOrder, true, true, true>(F.lds + RING_OFF, g, S, E);
            } else {
                pg8::Gemm g{wsp<bf16>(F, WS_HF), wsp<bf16>(F, WS_WF_OUT) + (size_t)fi * 1024 * 3584, M, D, FF}; pg8::StaticOrder S; S.init(M, D, F.G, (int)blockIdx.x, 1);
                pg8::EpiResid<false> E{(const void*)XB, XB, SSQ, nullptr, 1.0f};
                pg8::gemm_phase<pg8::EpiResid<false>, pg8::StaticOrder, true, true>(F.lds + RING_OFF, g, S, E);
            }
            SEAML(pb + 6);
        }
    } else {
        unsigned* gcnt = (unsigned*)(F.ctl + CW_CNT + 64 * l);
        if (IN(pb + 5)) { router_phase(F, XB, args.in[2] + l * 1024, args.in[18] + (size_t)fi * 1024 * 8, gcnt); SEAM(pb + 5); }
        if (IN(pb + 6)) { REPS(64) { if constexpr (MOE_F8 != 0) rowtable_phase(F, gcnt); else gather_phase<false>(F, gcnt); SEAM(pb + 6); } }
        if (IN(pb + 7)) {
            if constexpr (MOE_F8 != 0) {
                pg8::Gemm g{(const bf16*)wsp<unsigned char>(F, WS_X8), (const bf16*)(wsp<unsigned char>(F, WS_WM_IN) + (size_t)fi * 8 * 7168 * 1024), MROWS, 7168, D / 2, wsp<int>(F, WS_ROWT)}; pg8::GroupedOrder S; S.init(gcnt, 28, F.G, (int)blockIdx.x);
                pg8::EpiSwiGLU8<1> E{wsp<float>(F, WS_ROWRS), wsp<unsigned char>(F, WS_HM)};
                TWICE(256, pg8::gemm_phase<pg8::EpiSwiGLU8<1>, pg8::GroupedOrder, true, true, true, true>(F.lds + RING_OFF, g, S, E););
            } else {
                pg8::Gemm g{wsp<bf16>(F, WS_XS), wsp<bf16>(F, WS_WM_IN) + (size_t)fi * 8 * 7168 * 1024, MROWS, 7168, D}; pg8::GroupedOrder S; S.init(gcnt, 28, F.G, (int)blockIdx.x);
                pg8::EpiSwiGLU<1> E{wsp<float>(F, WS_ROWRS), wsp<bf16>(F, WS_HM)};
                pg8::gemm_phase<pg8::EpiSwiGLU<1>, pg8::GroupedOrder, true, true>(F.lds + RING_OFF, g, S, E);
            }
            SEAM(pb + 7);
        }
        if (IN(pb + 8)) {
            if constexpr (MOE_F8 != 0) {
                pg8::Gemm g{(const bf16*)wsp<unsigned char>(F, WS_HM), (const bf16*)(wsp<unsigned char>(F, WS_WM_OUT) + (size_t)fi * 8 * 1024 * 3584), MROWS, D, FF / 2}; pg8::GroupedOrder S; S.init(gcnt, 4, F.G, (int)blockIdx.x, 1);
                pg8::EpiMoeOut E{wsp<int>(F, WS_ROWT), wsp<float>(F, WS_ROWG), wsp<bf16>(F, WS_OS), M, 1.0f / 512.0f};
                pg8::gemm_phase<pg8::EpiMoeOut, pg8::GroupedOrder, true, true, true>(F.lds + RING_OFF, g, S, E);
            } else {
                pg8::Gemm g{wsp<bf16>(F, WS_HM), wsp<bf16>(F, WS_WM_OUT) + (size_t)fi * 8 * 1024 * 3584, MROWS, D, FF}; pg8::GroupedOrder S; S.init(gcnt, 4, F.G, (int)blockIdx.x, 1);
                pg8::EpiMoeOut E{wsp<int>(F, WS_ROWT), wsp<float>(F, WS_ROWG), wsp<bf16>(F, WS_OS), M, 1.0f};
                pg8::gemm_phase<pg8::EpiMoeOut, pg8::GroupedOrder, true, true>(F.lds + RING_OFF, g, S, E);
            }
            SEAM(pb + 8);
        }
        if (IN(pb + 9)) { combine_phase(F, l == MK_LAYERS - 1, args.in[21], (l == 1 && CIN_F8 != 0) ? wsp<unsigned char>(F, WS_X8) : nullptr); if constexpr (l != MK_LAYERS - 1) SEAML(pb + 9); }
    }
}
__global__ void __launch_bounds__(NWAVES * 64, 2) trunk_fwd(Args args) {
    extern __shared__ __attribute__((aligned(16))) unsigned char lds[];
    Frame F;
    F.lds = (LAS unsigned char*)lds;
    F.MISC = (volatile LAS unsigned*)(F.lds + MISC_OFF);
    F.tid = threadIdx.x; F.lane = F.tid & 63; F.wave = __builtin_amdgcn_readfirstlane(F.tid >> 6);
    F.G = gridDim.x; { const int bx = blockIdx.x; F.vcu = (F.G % 8 == 0) ? (bx % 8) * (F.G / 8) + bx / 8 : bx; }
    F.out = args.out; F.ws = args.ws;
    F.ctl = (gu32*)(args.ws + WS_CTL);
    for (int u = F.tid; u < (LDS_BYTES - LDSCTL_OFF) / 4; u += NWAVES * 64) ((LAS unsigned*)(F.lds + LDSCTL_OFF))[u] = 0u;
    __syncthreads();
    XcdBarrier bar = xcd_barrier_post((unsigned*)(F.ctl + CW_BAR), F.MISC + 8);
    if (F.tid == 0 && (bar.x != (blockIdx.x & 7u) || gridDim.x != 256u)) __hip_atomic_fetch_or(F.ctl + CW_XMIS, 1u, __ATOMIC_RELAXED, __HIP_MEMORY_SCOPE_AGENT);
    const int lo = args.ph_lo, hi = args.ph_hi;
    if (IN(0)) { REPS(1) { p0_prologue(F, args); SEAM(0); } }
    if (F.tid == 0) F.MISC[10] = (MK_ONE_LAUNCH != 0 && lo == 0 && __hip_atomic_load(F.ctl + CW_XMIS, __ATOMIC_RELAXED, __HIP_MEMORY_SCOPE_AGENT) == 0u) ? 1u : 0u;
    __syncthreads();
    run_layer<0>(F, args, bar, lo, hi);
    if constexpr (MK_LAYERS > 1) run_layer<1>(F, args, bar, lo, hi);
    if constexpr (MK_LAYERS > 2) run_layer<2>(F, args, bar, lo, hi);
    if constexpr (MK_LAYERS > 3) run_layer<3>(F, args, bar, lo, hi);
    if ((MK_LAYERS % 2) == 1 && IN(1 + 10 * MK_LAYERS)) final_norm_phase(F, wsp<bf16>(F, WS_XB), args.in[21]);
}
#undef IN
#undef SEAM

extern "C" void kernel_launch(void* const* d_in, const int* in_sizes, int n_in, void* d_out, int out_size, void* d_ws, size_t ws_size, hipStream_t stream) {
    static int grid = 0;
    if (grid == 0) {
        if (n_in != 22 || in_sizes[0] != M * D || out_size != M * D || ws_size < WS_END) { fprintf(stderr, "kernel_launch: unexpected shapes / workspace (n_in %d, in0 %d, out %d, ws %zu, need %zu)\n", n_in, n_in > 0 ? in_sizes[0] : -1, out_size, ws_size, (size_t)WS_END); grid = -1; return; }
        int dev = 0, cus = 0, per_cu = 0;
        if (hipGetDevice(&dev) != hipSuccess || hipDeviceGetAttribute(&cus, hipDeviceAttributeMultiprocessorCount, dev) != hipSuccess) { grid = -1; return; }
        if (hipFuncSetAttribute((const void*)trunk_fwd, hipFuncAttributeMaxDynamicSharedMemorySize, LDS_BYTES) != hipSuccess) { fprintf(stderr, "kernel_launch: hipFuncSetAttribute failed\n"); grid = -1; return; }
        if (hipOccupancyMaxActiveBlocksPerMultiprocessor(&per_cu, (const void*)trunk_fwd, NWAVES * 64, LDS_BYTES) != hipSuccess || per_cu < 1) { fprintf(stderr, "kernel_launch: occupancy query reports %d workgroups per CU\n", per_cu); }
        (void)hipGetLastError();
        grid = cus;
    }
    if (grid < 0) return;
    if (hipMemsetAsync((char*)d_ws + WS_CTL, 0, CTL_ZERO_BYTES, stream) != hipSuccess) return;
    Args a{};
    for (int i = 0; i < 22; ++i) a.in[i] = (const float*)d_in[i];
    a.out = (float*)d_out; a.ws = (unsigned char*)d_ws;
#if MK_ONE_LAUNCH
    a.ph_lo = 0; a.ph_hi = N_PHASES;
    hipLaunchKernelGGL(trunk_fwd, dim3(grid), dim3(NWAVES * 64), LDS_BYTES, stream, a);
#else
    for (int p = 0; p < N_PHASES; ++p) { if (!phase_active(p)) continue; a.ph_lo = p; a.ph_hi = p + 1; hipLaunchKernelGGL(trunk_fwd, dim3(grid), dim3(NWAVES * 64), LDS_BYTES, stream, a); }
#endif
}
```

```cpp
#include <hip/hip_runtime.h>
#include <cstdio>
#include <cstdint>
namespace pg8 {
#define PG8_LAS __attribute__((address_space(3)))
typedef unsigned short bf16_t;
typedef short bf16x8 __attribute__((ext_vector_type(8)));
typedef float f32x4 __attribute__((ext_vector_type(4)));
typedef unsigned u32x4 __attribute__((ext_vector_type(4)));
typedef int i32x8 __attribute__((ext_vector_type(8)));
constexpr int BM = 256, BK = 64, HALF = 128, HTB = HALF * BK * 2  , STAGE_BYTES = 8 * HTB, NXCD = 8, WGM = 8;

__host__ __device__ __forceinline__ int lds_byte(int r, int c) { const int st = (r >> 4) * 2 + (c >> 5), rr = r & 15, cc = c & 31, ob = rr * 64 + cc * 2; return st * 1024 + (ob ^ (((ob >> 9) & 1) << 5)); }
__host__ __device__ __forceinline__ void stage_rc(int b, int& R, int& C) { const int st = b / 1024, sb = b % 1024, swz = sb ^ (((sb >> 9) & 1) << 5); R = (st >> 1) * 16 + swz / 64; C = (st & 1) * 32 + (swz % 64) / 2; }
__host__ __device__ __forceinline__ int perm32(int rho) { const int n = rho >> 4, i = rho & 15; return 8 * (i >> 2) + 4 * n + (i & 3); }

struct Unit { int pm, pn; };
struct Gemm { const bf16_t* A; const bf16_t* Bt; int M, N, K; const int* rowmap = nullptr; };

struct StaticOrder {
    int nM, nN, nwg, G, c, rev;
    __host__ __device__ void init(int M, int N, int G_, int c_, int rev_ = 0) { nM = M / BM; nN = N / BM; nwg = nM * nN; G = G_; c = c_; rev = rev_; }
    __host__ __device__ bool next(int i, Unit& u) const {
        const long L = (long)i * G + c; if (L >= nwg) return false;
        int wgid = (int)L; { const int q = nwg / NXCD, r = nwg % NXCD, xcd = wgid % NXCD, off = wgid / NXCD; const int cnt = q + (xcd < r ? 1 : 0); wgid = (xcd < r ? xcd * (q + 1) : r * (q + 1) + (xcd - r) * q) + (rev ? cnt - 1 - off : off); }
        const int nig = WGM * nN, gid = wgid / nig, fm = gid * WGM, gsz = (nM - fm) < WGM ? (nM - fm) : WGM;
        u.pm = fm + ((wgid % nig) % gsz); u.pn = (wgid % nig) / gsz; return true;
    }
    __device__ __forceinline__ void a_ready(const Unit&) const {}
    __device__ __forceinline__ void done(const Unit&) const {}
};

struct GroupedOrder {
    int nN, nM, nwg, G, c, rev; int s1, s2, s3, s4, s5, s6, s7;
    __device__ __forceinline__ void init(const unsigned* cnt, int nN_, int G_, int c_, int rev_ = 0) {
        nN = nN_; G = G_; c = c_; rev = rev_; int t = 0;
        t += (int)((cnt[0] + 255u) >> 8); s1 = t; t += (int)((cnt[1] + 255u) >> 8); s2 = t; t += (int)((cnt[2] + 255u) >> 8); s3 = t; t += (int)((cnt[3] + 255u) >> 8); s4 = t;
        t += (int)((cnt[4] + 255u) >> 8); s5 = t; t += (int)((cnt[5] + 255u) >> 8); s6 = t; t += (int)((cnt[6] + 255u) >> 8); s7 = t; t += (int)((cnt[7] + 255u) >> 8);
        nM = t; nwg = nM * nN;
    }
    __device__ __forceinline__ bool next(int i, Unit& u) const {
        const long L = (long)i * G + c; if (L >= nwg) return false;
        int wgid = (int)L; { const int q = nwg / NXCD, r = nwg % NXCD, xcd = wgid % NXCD, off = wgid / NXCD; const int cnt = q + (xcd < r ? 1 : 0); wgid = (xcd < r ? xcd * (q + 1) : r * (q + 1) + (xcd - r) * q) + (rev ? cnt - 1 - off : off); }
        const int nig = WGM * nN, gid = wgid / nig, fm = gid * WGM, gsz = (nM - fm) < WGM ? (nM - fm) : WGM;
        const int pm = fm + ((wgid % nig) % gsz), pnl = (wgid % nig) / gsz;
        const int e = (pm >= s1) + (pm >= s2) + (pm >= s3) + (pm >= s4) + (pm >= s5) + (pm >= s6) + (pm >= s7);
        u.pm = pm; u.pn = e * nN + pnl; return true;
    }
    __device__ __forceinline__ void a_ready(const Unit&) const {}
    __device__ __forceinline__ void done(const Unit&) const {}
};

__device__ __forceinline__ unsigned cvt_pk_bf16(float lo, float hi) { unsigned r; asm volatile("v_cvt_pk_bf16_f32 %0, %1, %2" : "=v"(r) : "v"(lo), "v"(hi)); return r; }
typedef unsigned u32x2 __attribute__((ext_vector_type(2)));
__device__ __forceinline__ float c8(float v) { return __builtin_amdgcn_fmed3f(v, -448.0f, 448.0f); }
constexpr float RMS_EPS = 1e-6f;
__device__ __forceinline__ float rs16(const float* ssq, int row, int fq) {
    const f32x4 a = *(const f32x4*)(ssq + (size_t)row * 16 + 4 * fq);
    float s = (a[0] + a[1]) + (a[2] + a[3]); s += __shfl_xor(s, 16); s += __shfl_xor(s, 32);
    return __builtin_amdgcn_rsqf(s * (1.0f / 1024.0f) + RMS_EPS);
}
__device__ __forceinline__ float gelu_t(float x) {
    const float t = x * (1.0f + 0.044715f * x * x);
    return x * __builtin_amdgcn_rcpf(1.0f + __builtin_amdgcn_exp2f(-2.302208198f * t));
}
__device__ __forceinline__ float silu_f(float x) { return x * __builtin_amdgcn_rcpf(1.0f + __builtin_amdgcn_exp2f(-1.4426950409f * x)); }
__device__ __forceinline__ f32x4 sig4(f32x4 a) {
    f32x4 e; e[0] = __builtin_amdgcn_exp2f(a[0]); e[1] = __builtin_amdgcn_exp2f(a[1]); e[2] = __builtin_amdgcn_exp2f(a[2]); e[3] = __builtin_amdgcn_exp2f(a[3]);
    e = e + 1.0f; f32x4 r; r[0] = __builtin_amdgcn_rcpf(e[0]); r[1] = __builtin_amdgcn_rcpf(e[1]); r[2] = __builtin_amdgcn_rcpf(e[2]); r[3] = __builtin_amdgcn_rcpf(e[3]); return r;
}
__device__ __forceinline__ f32x4 swiglu4(f32x4 g, f32x4 u, float ca, float ch) { return ((g * u) * ch) * sig4(g * ca); }
__device__ __forceinline__ f32x4 gelu4(f32x4 x) { const f32x4 p = (x * x) * (-2.302208198f * 0.044715f) + (-2.302208198f); return x * sig4(x * p); }

struct EpiAin {
    static constexpr bool PERM = true, AFTER_DRAIN = false, RS_LDS = false;
    const float* ssq; bf16_t* U; bf16_t* V; float* vssq; float sc;
    __device__ __forceinline__ void operator()(const f32x4 (&acc)[2][2][4][2], const Unit& u, int wr, int wc, int fr, int fq) const {
        const bool isv = u.pn >= 8; bf16_t* base = isv ? V : U;
        const int row0 = u.pm * BM + wr * 64 + fr, col0 = (u.pn & 7) * BM + wc * 32 + 8 * fq;
#pragma unroll
        for (int ai = 0; ai < 2; ++ai)
#pragma unroll
            for (int m = 0; m < 4; ++m) { const int row = row0 + ai * HALF + m * 16; const float rs = rs16(ssq, row, fq) * sc; float sq = 0.f; bf16_t* rowp = base + (size_t)row * 2048 + col0;
#pragma unroll
                for (int bj = 0; bj < 2; ++bj) { const f32x4 v0 = gelu4(acc[ai][bj][m][0] * rs), v1 = gelu4(acc[ai][bj][m][1] * rs);
                    { const f32x4 q = v0 * v0 + v1 * v1; sq += (q[0] + q[1]) + (q[2] + q[3]); }
                    u32x4 w; w.x = cvt_pk_bf16(v0[0], v0[1]); w.y = cvt_pk_bf16(v0[2], v0[3]); w.z = cvt_pk_bf16(v1[0], v1[1]); w.w = cvt_pk_bf16(v1[2], v1[3]);
                    *(u32x4*)(rowp + bj * HALF) = w; }
                if (isv) { sq += __shfl_xor(sq, 16); sq += __shfl_xor(sq, 32); if (fq == 0) vssq[(size_t)row * 32 + (u.pn - 8) * 4 + wc] = sq; } }
    }
};
template <bool KN> struct EpiRow {
    static constexpr bool PERM = true, AFTER_DRAIN = false, RS_LDS = false;
    const float* ssq; bf16_t* O; int ldc; unsigned* knb; float sc;
    __device__ __forceinline__ void operator()(const f32x4 (&acc)[2][2][4][2], const Unit& u, int wr, int wc, int fr, int fq) const {
        const int row0 = u.pm * BM + wr * 64 + fr, col0 = u.pn * BM + wc * 32 + 8 * fq;
        float kmx0 = 0.f, kmx1 = 0.f;
#pragma unroll
        for (int ai = 0; ai < 2; ++ai)
#pragma unroll
            for (int m = 0; m < 4; ++m) { const int row = row0 + ai * HALF + m * 16; const float rs = rs16(ssq, row, fq) * sc; bf16_t* rowp = O + (size_t)row * ldc + col0;
#pragma unroll
                for (int bj = 0; bj < 2; ++bj) { const f32x4 v0 = acc[ai][bj][m][0] * rs, v1 = acc[ai][bj][m][1] * rs;
                    u32x4 w; w.x = cvt_pk_bf16(v0[0], v0[1]); w.y = cvt_pk_bf16(v0[2], v0[3]); w.z = cvt_pk_bf16(v1[0], v1[1]); w.w = cvt_pk_bf16(v1[2], v1[3]);
                    *(u32x4*)(rowp + bj * HALF) = w;
                    if constexpr (KN) { float sq = ((v0[0] * v0[0] + v0[1] * v0[1]) + (v0[2] * v0[2] + v0[3] * v0[3])) + ((v1[0] * v1[0] + v1[1] * v1[1]) + (v1[2] * v1[2] + v1[3] * v1[3]));
                        sq += __shfl_xor(sq, 16); sq += __shfl_xor(sq, 32); if (bj == 0) kmx0 = fmaxf(kmx0, sq); else kmx1 = fmaxf(kmx1, sq); } } }
        if constexpr (KN) { if (u.pn >= 4 && u.pn < 8) {
#pragma unroll
                for (int o = 1; o < 16; o <<= 1) { kmx0 = fmaxf(kmx0, __shfl_xor(kmx0, o)); kmx1 = fmaxf(kmx1, __shfl_xor(kmx1, o)); }
                if ((threadIdx.x & 63) == 0) { const int bb = (u.pm * BM) >> 12, hd = 2 * (u.pn - 4);
                    __hip_atomic_fetch_max(knb + ((bb * 8 + hd) * 4 + wc), __builtin_bit_cast(unsigned, kmx0), __ATOMIC_RELAXED, __HIP_MEMORY_SCOPE_AGENT);
                    __hip_atomic_fetch_max(knb + ((bb * 8 + hd + 1) * 4 + wc), __builtin_bit_cast(unsigned, kmx1), __ATOMIC_RELAXED, __HIP_MEMORY_SCOPE_AGENT); } } }
    }
};
template <bool F32IN, bool W8 = false> struct EpiResid {
    static constexpr bool PERM = true, AFTER_DRAIN = false, RS_LDS = false;
    const void* xin; bf16_t* xb; float* ssq; unsigned char* x8; float oscale;
    __device__ __forceinline__ void operator()(const f32x4 (&acc)[2][2][4][2], const Unit& u, int wr, int wc, int fr, int fq) const {
        const int row0 = u.pm * BM + wr * 64 + fr, col0 = u.pn * BM + wc * 32 + 8 * fq;
        constexpr int MB = F32IN ? 2 : 4;
#pragma unroll
        for (int ai = 0; ai < 2; ++ai)
#pragma unroll
            for (int mb = 0; mb < 4; mb += MB) { u32x4 xr[MB][2][F32IN ? 2 : 1];
#pragma unroll
                for (int mi = 0; mi < MB; ++mi)
#pragma unroll
                    for (int bj = 0; bj < 2; ++bj) { const size_t o = (size_t)(row0 + ai * HALF + (mb + mi) * 16) * 1024 + col0 + bj * HALF;
                        if constexpr (F32IN) { xr[mi][bj][0] = *(const u32x4*)((const float*)xin + o); xr[mi][bj][1] = *(const u32x4*)((const float*)xin + o + 4); }
                        else xr[mi][bj][0] = *(const u32x4*)((const bf16_t*)xin + o); }
#pragma unroll
                for (int mi = 0; mi < MB; ++mi) { const int m = mb + mi; const int row = row0 + ai * HALF + m * 16; const size_t off = (size_t)row * 1024 + col0; float sq = 0.f;
#pragma unroll
                    for (int bj = 0; bj < 2; ++bj) { const size_t o = off + bj * HALF; f32x4 v0, v1;
                        if constexpr (F32IN) { v0 = __builtin_bit_cast(f32x4, xr[mi][bj][0]); v1 = __builtin_bit_cast(f32x4, xr[mi][bj][F32IN ? 1 : 0]); }
                        else { const u32x4 xw = xr[mi][bj][0];
                            v0 = (f32x4){__builtin_bit_cast(float, xw.x << 16), __builtin_bit_cast(float, xw.x & 0xffff0000u), __builtin_bit_cast(float, xw.y << 16), __builtin_bit_cast(float, xw.y & 0xffff0000u)};
                            v1 = (f32x4){__builtin_bit_cast(float, xw.z << 16), __builtin_bit_cast(float, xw.z & 0xffff0000u), __builtin_bit_cast(float, xw.w << 16), __builtin_bit_cast(float, xw.w & 0xffff0000u)}; }
                        v0 += acc[ai][bj][m][0] * oscale; v1 += acc[ai][bj][m][1] * oscale;
                        u32x4 w; w.x = cvt_pk_bf16(v0[0], v0[1]); w.y = cvt_pk_bf16(v0[2], v0[3]); w.z = cvt_pk_bf16(v1[0], v1[1]); w.w = cvt_pk_bf16(v1[2], v1[3]);
                        *(u32x4*)(xb + o) = w;
                        if constexpr (W8) { int p0 = __builtin_amdgcn_cvt_pk_fp8_f32(c8(v0[0]), c8(v0[1]), 0, false); p0 = __builtin_amdgcn_cvt_pk_fp8_f32(c8(v0[2]), c8(v0[3]), p0, true); int p1 = __builtin_amdgcn_cvt_pk_fp8_f32(c8(v1[0]), c8(v1[1]), 0, false); p1 = __builtin_amdgcn_cvt_pk_fp8_f32(c8(v1[2]), c8(v1[3]), p1, true);
                            u32x2 w8; w8.x = (unsigned)p0; w8.y = (unsigned)p1; *(u32x2*)(x8 + o) = w8; }
                        sq += ((v0[0] * v0[0] + v0[1] * v0[1]) + (v0[2] * v0[2] + v0[3] * v0[3])) + ((v1[0] * v1[0] + v1[1] * v1[1]) + (v1[2] * v1[2] + v1[3] * v1[3])); }
                    sq += __shfl_xor(sq, 16); sq += __shfl_xor(sq, 32); if (fq == 0) ssq[(size_t)row * 16 + u.pn * 4 + wc] = sq; }
                asm volatile("" ::: "memory"); }
    }
};
template <int MODE> struct EpiSwiGLU {
    static constexpr bool PERM = true, AFTER_DRAIN = false, RS_LDS = false;
    const float* ssq; bf16_t* H;
    __device__ __forceinline__ void operator()(const f32x4 (&acc)[2][2][4][2], const Unit& u, int wr, int wc, int fr, int fq) const {
        const int row0 = u.pm * BM + wr * 64 + fr, col0 = (u.pn % 28) * HALF + wc * 32 + 8 * fq;
#pragma unroll
        for (int ai = 0; ai < 2; ++ai)
#pragma unroll
            for (int m = 0; m < 4; ++m) { const int row = row0 + ai * HALF + m * 16; const float rs = MODE == 0 ? rs16(ssq, row, fq) : ssq[row];
                const float ca = rs * -1.4426950409f, ch = rs * rs;
                const f32x4 h0 = swiglu4(acc[ai][0][m][0], acc[ai][1][m][0], ca, ch), h1 = swiglu4(acc[ai][0][m][1], acc[ai][1][m][1], ca, ch);
                u32x4 w; w.x = cvt_pk_bf16(h0[0], h0[1]); w.y = cvt_pk_bf16(h0[2], h0[3]); w.z = cvt_pk_bf16(h1[0], h1[1]); w.w = cvt_pk_bf16(h1[2], h1[3]);
                *(u32x4*)(H + (size_t)row * 3584 + col0) = w; }
    }
};
template <int MODE> struct EpiSwiGLU8 {
    static constexpr bool PERM = true, AFTER_DRAIN = false, RS_LDS = (MODE == 1);
    const float* rrs; unsigned char* H8;
    __device__ __forceinline__ void operator()(const f32x4 (&acc)[2][2][4][2], const Unit& u, int wr, int wc, int fr, int fq, const PG8_LAS float* rsl = nullptr) const {
        const int row0 = u.pm * BM + wr * 64 + fr, col0 = (u.pn % 28) * HALF + wc * 32 + 8 * fq;
#pragma unroll
        for (int ai = 0; ai < 2; ++ai)
#pragma unroll
            for (int m = 0; m < 4; ++m) { const int row = row0 + ai * HALF + m * 16; const float rs = (MODE == 0 ? rs16(rrs, row, fq) : rsl[ai * 64 + m * 16 + fr]) * (1.0f / 64.0f);
                const float ca = rs * -1.4426950409f, ch = rs * rs * 8.0f;
                const f32x4 h0 = swiglu4(acc[ai][0][m][0], acc[ai][1][m][0], ca, ch), h1 = swiglu4(acc[ai][0][m][1], acc[ai][1][m][1], ca, ch);
                int w0 = __builtin_amdgcn_cvt_pk_fp8_f32(c8(h0[0]), c8(h0[1]), 0, false); w0 = __builtin_amdgcn_cvt_pk_fp8_f32(c8(h0[2]), c8(h0[3]), w0, true);
                int w1 = __builtin_amdgcn_cvt_pk_fp8_f32(c8(h1[0]), c8(h1[1]), 0, false); w1 = __builtin_amdgcn_cvt_pk_fp8_f32(c8(h1[2]), c8(h1[3]), w1, true);
                u32x2 w; w.x = (unsigned)w0; w.y = (unsigned)w1; *(u32x2*)(H8 + (size_t)row * 3584 + col0) = w; }
    }
};
struct EpiMoeOut {
    static constexpr bool PERM = true, AFTER_DRAIN = false, RS_LDS = false;
    const int* rtok; const float* rgate; bf16_t* OS; int M; float oscale;
    __device__ __forceinline__ void operator()(const f32x4 (&acc)[2][2][4][2], const Unit& u, int wr, int wc, int fr, int fq) const {
        const int row0 = u.pm * BM + wr * 64 + fr, col0 = (u.pn & 3) * BM + wc * 32 + 8 * fq;
#pragma unroll
        for (int ai = 0; ai < 2; ++ai)
#pragma unroll
            for (int m = 0; m < 4; ++m) { const int row = row0 + ai * HALF + m * 16; const int tk = rtok[row]; const float gt = rgate[row] * oscale;
                if (tk >= 0) { bf16_t* rowp = OS + ((size_t)(tk & 1) * M + (tk >> 1)) * 1024 + col0;
#pragma unroll
                    for (int bj = 0; bj < 2; ++bj) { const f32x4 v0 = acc[ai][bj][m][0] * gt, v1 = acc[ai][bj][m][1] * gt;
                        u32x4 w; w.x = cvt_pk_bf16(v0[0], v0[1]); w.y = cvt_pk_bf16(v0[2], v0[3]); w.z = cvt_pk_bf16(v1[0], v1[1]); w.w = cvt_pk_bf16(v1[2], v1[3]);
                        *(u32x4*)(rowp + bj * HALF) = w; } } }
    }
};

template <class Epi, class Sched, bool ALIGN_EPI = false, bool SP2 = false, bool F8 = false, bool GA = false>
__device__ __forceinline__ void gemm_phase(PG8_LAS unsigned char* lds, const Gemm g, const Sched& S, const Epi& E) {
    static_assert(!GA || SP2, "gathered A rows: SP2 path only");
    const int tid = threadIdx.x, wid = __builtin_amdgcn_readfirstlane(tid >> 6), lane = tid & 63, wr = wid >> 2, wc = wid & 3, fr = lane & 15, fq = lane >> 4;
    const int K = g.K, nt = K / BK;
    unsigned voffA[2], voffB[2];
#pragma unroll
    for (int i = 0; i < 2; ++i) { int R, C; stage_rc(tid * 16 + i * 8192, R, C); const int Rb = Epi::PERM ? ((R & ~31) + perm32(R & 31)) : R;
        voffA[i] = (unsigned)(R * K + C) * 2u; voffB[i] = (unsigned)(Rb * K + C) * 2u; }
    PG8_LAS unsigned char* const rowbuf = lds + STAGE_BYTES + 1024 + wid * 256;
    const unsigned cbA = voffA[0] - (unsigned)(((wid >> 1) * 16 + (lane >> 2)) * K) * 2u;
#define PG8_ROWDMA(u, par) do { const int* rp_ = g.rowmap + (size_t)(u).pm * BM + (lane >> 5) * 128 + ((lane >> 4) & 1) * 64 + (wid >> 1) * 16 + (lane & 15); \
        const unsigned la_ = __builtin_amdgcn_readfirstlane((unsigned)(unsigned long)(rowbuf + (par) * 2048)); unsigned keep_; \
        asm volatile("s_mov_b32 %0, m0\n\ts_mov_b32 m0, %2\n\ts_nop 0\n\tglobal_load_lds_dword %1, off\n\ts_mov_b32 m0, %0" : "=&s"(keep_) : "v"(rp_), "s"(la_) : "memory"); } while (0)
#define PG8_ROWGET(dst, par) do { _Pragma("unroll") for (int h_ = 0; h_ < 2; ++h_) _Pragma("unroll") for (int i_ = 0; i_ < 2; ++i_) { \
        const int t_ = *(const PG8_LAS int*)(rowbuf + (par) * 2048 + ((2 * h_ + i_) * 16 + (lane >> 2)) * 4); dst[h_][i_] = (unsigned)((t_ < 0 ? 0 : t_) >> 1) * (unsigned)(K * 2) + cbA; } } while (0)
    PG8_LAS unsigned char* const rsbuf = lds + STAGE_BYTES + 1024 + 4096 + wid * 512;
#define PG8_RSDMA(u) do { _Pragma("unroll") for (int ai_ = 0; ai_ < 2; ++ai_) { const float* rp_ = E.rrs + (size_t)(u).pm * BM + ai_ * HALF + wr * 64 + lane; \
        const unsigned la_ = __builtin_amdgcn_readfirstlane((unsigned)(unsigned long)(rsbuf + ai_ * 256)); unsigned keep_; \
        asm volatile("s_mov_b32 %0, m0\n\ts_mov_b32 m0, %2\n\ts_nop 0\n\tglobal_load_lds_dword %1, off\n\ts_mov_b32 m0, %0" : "=&s"(keep_) : "v"(rp_), "s"(la_) : "memory"); } } while (0)
    unsigned vGc[2][2], vS[2][2];
    const auto rsA = __builtin_amdgcn_make_buffer_rsrc((void*)g.A, 0, 0x40000000u, 0x00020000);
    const size_t kstep = (size_t)(BK * 2);
    const size_t hstep = (size_t)HALF * K * 2;
    const size_t tstep = 2 * hstep;
    const unsigned ldsw = (unsigned)wid * 1024u;
    const int aoff = lds_byte(wr * 64 + fr, fq * 8), boff = lds_byte(wc * 32 + fr, fq * 8);
#define PG8_SA(b, h) (((b) * 2 + (h)) * HTB)
#define PG8_SB(b, h) ((4 + (b) * 2 + (h)) * HTB)
#define PG8_STAGE(bufoff, gbase, voff) do { _Pragma("unroll") for (int _i = 0; _i < 2; ++_i) \
        __builtin_amdgcn_global_load_lds((const unsigned*)((const char*)(gbase) + (voff)[_i]), (PG8_LAS unsigned*)(lds + (bufoff) + ldsw + _i * 8192), 16, 0, 0); } while (0)
#define PG8_STAGE_A(bufoff, ptr, h, vsel) do { if constexpr (GA) { _Pragma("unroll") for (int _i = 0; _i < 2; ++_i)     \
            __builtin_amdgcn_raw_ptr_buffer_load_lds(rsA, (PG8_LAS void*)(lds + (bufoff) + ldsw + _i * 8192), 16, (int)vsel[h][_i], (int)((ptr) - (const char*)g.A), 0, 0); } \
        else PG8_STAGE(bufoff, (ptr) + ((h) ? hstep : 0), voffA); } while (0)
#define PG8_CAT8(p0_) __builtin_bit_cast(i32x8, __builtin_shufflevector(*(const PG8_LAS bf16x8*)(p0_), *(const PG8_LAS bf16x8*)((p0_) + 1024), 0, 1, 2, 3, 4, 5, 6, 7, 8, 9, 10, 11, 12, 13, 14, 15))
#define PG8_LDA(dst, b, h) do { if constexpr (F8) { _Pragma("unroll") for (int m = 0; m < 4; ++m) dst##8[m] = PG8_CAT8(lds + PG8_SA(b, h) + aoff + m * 2048); } \
        else { _Pragma("unroll") for (int m = 0; m < 4; ++m) _Pragma("unroll") for (int k = 0; k < 2; ++k) dst[m][k] = *(const PG8_LAS bf16x8*)(lds + PG8_SA(b, h) + aoff + m * 2048 + k * 1024); } } while (0)
#define PG8_LDB(dst, b, h) do { if constexpr (F8) { _Pragma("unroll") for (int n = 0; n < 2; ++n) dst##8[n] = PG8_CAT8(lds + PG8_SB(b, h) + boff + n * 2048); } \
        else { _Pragma("unroll") for (int n = 0; n < 2; ++n) _Pragma("unroll") for (int k = 0; k < 2; ++k) dst[n][k] = *(const PG8_LAS bf16x8*)(lds + PG8_SB(b, h) + boff + n * 2048 + k * 1024); } } while (0)
#define PG8_MMA(ai, bj, At, Bt) do { __builtin_amdgcn_s_setprio(1); \
        if constexpr (F8) { _Pragma("unroll") for (int m = 0; m < 4; ++m) _Pragma("unroll") for (int n = 0; n < 2; ++n) \
            asm volatile("v_mfma_scale_f32_16x16x128_f8f6f4 %0, %1, %2, %0, %3, %3 op_sel_hi:[0,0,0]" : "+v"(acc[ai][bj][m][n]) : "v"(Bt##8[n]), "v"(At##8[m]), "v"(f8one)); } \
        else { _Pragma("unroll") for (int m = 0; m < 4; ++m) _Pragma("unroll") for (int n = 0; n < 2; ++n) _Pragma("unroll") for (int k = 0; k < 2; ++k) \
            acc[ai][bj][m][n] = __builtin_amdgcn_mfma_f32_16x16x32_bf16(Bt[n][k], At[m][k], acc[ai][bj][m][n], 0, 0, 0); } \
        __builtin_amdgcn_s_setprio(0); } while (0)
#define PG8_WAIT_V(n) asm volatile("s_waitcnt vmcnt(" #n ")" ::: "memory")
#define PG8_WAIT_L(n) asm volatile("s_waitcnt lgkmcnt(" #n ")" ::: "memory")
#define PG8_BAR __builtin_amdgcn_s_barrier()
#define PG8_SCHED __builtin_amdgcn_sched_barrier(0)
    Unit cur, nxt; int ui = 0;
    if (!S.next(0, cur)) return;
#if defined(PG8_STAGGER_TICKS)
    if ((blockIdx.x >> 3) & 1) { const unsigned long long t0_ = __builtin_amdgcn_s_memrealtime(); while (__builtin_amdgcn_s_memrealtime() - t0_ < PG8_STAGGER_TICKS) __builtin_amdgcn_s_sleep(8); }
#endif
    f32x4 acc[2][2][4][2];
#pragma unroll
    for (int a = 0; a < 2; ++a)
#pragma unroll
        for (int b = 0; b < 2; ++b)
#pragma unroll
            for (int m = 0; m < 4; ++m)
#pragma unroll
                for (int n = 0; n < 2; ++n) acc[a][b][m][n] = (f32x4){0.f, 0.f, 0.f, 0.f};
    const int f8one = 0x7f7f7f7f;
    bf16x8 At[4][2], B0[2][2], B1[2][2]; i32x8 At8[4], B08[2], B18[2];
    const char* cA = GA ? (const char*)g.A : (const char*)g.A + (size_t)cur.pm * tstep; const char* cB = (const char*)g.Bt + (size_t)cur.pn * tstep;
    S.a_ready(cur);
    if constexpr (Epi::RS_LDS) PG8_RSDMA(cur);
    if constexpr (GA) { PG8_ROWDMA(cur, 0); asm volatile("s_waitcnt vmcnt(0)" ::: "memory"); PG8_ROWGET(vGc, 0); }
    if constexpr (SP2) {
        PG8_STAGE(PG8_SB(0, 0), cB, voffB); PG8_STAGE(PG8_SB(0, 1), cB + hstep, voffB); PG8_STAGE_A(PG8_SA(0, 0), cA, 0, vGc); PG8_STAGE_A(PG8_SA(0, 1), cA, 1, vGc);
        if (wr == 1) PG8_BAR;
        PG8_WAIT_V(2); PG8_BAR;
        PG8_STAGE(PG8_SB(1, 0), cB + kstep, voffB); PG8_STAGE_A(PG8_SA(1, 0), cA + kstep, 0, vGc); PG8_STAGE(PG8_SB(1, 1), cB + hstep + kstep, voffB);
        PG8_WAIT_V(6); PG8_BAR;
    } else {
        PG8_STAGE(PG8_SB(0, 0), cB, voffB); PG8_STAGE(PG8_SA(0, 0), cA, voffA); PG8_STAGE(PG8_SB(0, 1), cB + hstep, voffB); PG8_STAGE(PG8_SA(0, 1), cA + hstep, voffA);
        if (wr == 1) PG8_BAR;
        PG8_WAIT_V(4); PG8_BAR;
        PG8_STAGE(PG8_SB(1, 0), cB + kstep, voffB); PG8_STAGE(PG8_SA(1, 0), cA + kstep, voffA); PG8_STAGE(PG8_SB(1, 1), cB + hstep + kstep, voffB);
        PG8_WAIT_V(6); PG8_BAR;
    }
    for (;;) {
        const bool has_next = S.next(ui + 1, nxt);
        const char* nA = GA ? cA : has_next ? (const char*)g.A + (size_t)nxt.pm * tstep : cA; const char* nB = has_next ? (const char*)g.Bt + (size_t)nxt.pn * tstep : cB;
        if constexpr (GA) { if (has_next) PG8_ROWDMA(nxt, (ui + 1) & 1); }
        for (int t = 0; t < nt; t += 2) {
            const bool last = (t == nt - 2);
            const char* a1 = cA + (size_t)(t + 1) * kstep;
            const char* a2 = last ? nA : cA + (size_t)(t + 2) * kstep; const char* b2 = last ? nB : cB + (size_t)(t + 2) * kstep;
            const char* a3 = a2 + kstep; const char* b3 = b2 + kstep;
            if (last && has_next) S.a_ready(nxt);
            if constexpr (GA) { if (last && has_next) PG8_ROWGET(vS, (ui + 1) & 1);
                else { vS[0][0] = vGc[0][0]; vS[0][1] = vGc[0][1]; vS[1][0] = vGc[1][0]; vS[1][1] = vGc[1][1]; } }
            if constexpr (SP2) {
            PG8_LDB(B0, 0, 0); PG8_LDB(B1, 0, 1); PG8_SCHED; PG8_LDA(At, 0, 0); PG8_STAGE_A(PG8_SA(1, 1), a1, 1, vGc);
            PG8_WAIT_V(8); PG8_WAIT_L(0); PG8_BAR; PG8_MMA(0, 0, At, B0); PG8_MMA(0, 1, At, B1); PG8_BAR; PG8_SCHED;
            PG8_LDA(At, 0, 1); PG8_STAGE(PG8_SB(0, 0), b2, voffB); PG8_STAGE(PG8_SB(0, 1), b2 + hstep, voffB); PG8_STAGE_A(PG8_SA(0, 0), a2, 0, vS);
            PG8_WAIT_V(8); PG8_WAIT_L(0); PG8_BAR; PG8_MMA(1, 0, At, B0); PG8_MMA(1, 1, At, B1); PG8_BAR; PG8_SCHED;
            PG8_LDB(B0, 1, 0); PG8_LDB(B1, 1, 1); PG8_SCHED; PG8_LDA(At, 1, 0); PG8_STAGE_A(PG8_SA(0, 1), a2, 1, vS);
            PG8_WAIT_V(8); PG8_WAIT_L(0); PG8_BAR; PG8_MMA(0, 0, At, B0); PG8_MMA(0, 1, At, B1); PG8_BAR; PG8_SCHED;
            PG8_LDA(At, 1, 1); PG8_STAGE(PG8_SB(1, 0), b3, voffB); PG8_STAGE(PG8_SB(1, 1), b3 + hstep, voffB); PG8_STAGE_A(PG8_SA(1, 0), a3, 0, vS);
            PG8_WAIT_V(8); PG8_WAIT_L(0); PG8_BAR; PG8_MMA(1, 0, At, B0); PG8_MMA(1, 1, At, B1); PG8_BAR; PG8_SCHED;
            } else {
            PG8_LDB(B0, 0, 0); PG8_SCHED; PG8_LDA(At, 0, 0); PG8_STAGE(PG8_SA(1, 1), a1 + hstep, voffA);
            PG8_WAIT_L(8); PG8_BAR; PG8_WAIT_L(0); PG8_MMA(0, 0, At, B0); PG8_BAR; PG8_SCHED;
            PG8_LDB(B1, 0, 1); PG8_STAGE(PG8_SB(0, 0), b2, voffB);
            PG8_BAR; PG8_WAIT_L(0); PG8_MMA(0, 1, At, B1); PG8_BAR;
            PG8_LDA(At, 0, 1); PG8_STAGE(PG8_SA(0, 0), a2, voffA);
            PG8_BAR; PG8_WAIT_L(0); PG8_MMA(1, 0, At, B0); PG8_BAR; PG8_SCHED;
            PG8_STAGE(PG8_SB(0, 1), b2 + hstep, voffB);
            PG8_WAIT_V(6); PG8_BAR; PG8_MMA(1, 1, At, B1); PG8_BAR;
            PG8_LDB(B0, 1, 0); PG8_SCHED; PG8_LDA(At, 1, 0); PG8_STAGE(PG8_SA(0, 1), a2 + hstep, voffA);
            PG8_WAIT_L(8); PG8_BAR; PG8_WAIT_L(0); PG8_MMA(0, 0, At, B0); PG8_BAR; PG8_SCHED;
            PG8_LDB(B1, 1, 1); PG8_STAGE(PG8_SB(1, 0), b3, voffB);
            PG8_BAR; PG8_WAIT_L(0); PG8_MMA(0, 1, At, B1); PG8_BAR;
            PG8_LDA(At, 1, 1); PG8_STAGE(PG8_SA(1, 0), a3, voffA);
            PG8_BAR; PG8_WAIT_L(0); PG8_MMA(1, 0, At, B0); PG8_BAR; PG8_SCHED;
            PG8_STAGE(PG8_SB(1, 1), b3 + hstep, voffB);
            PG8_WAIT_V(6); PG8_BAR; PG8_MMA(1, 1, At, B1); PG8_BAR;
            }
        }
        if constexpr (F8) { asm volatile("s_nop 15\n\ts_nop 15" ::: "memory"); }
        if constexpr (ALIGN_EPI) { if (wr == 0) PG8_BAR; }
        if constexpr (!Epi::AFTER_DRAIN) { if constexpr (Epi::RS_LDS) E(acc, cur, wr, wc, fr, fq, (const PG8_LAS float*)rsbuf); else E(acc, cur, wr, wc, fr, fq); S.done(cur); }
        if (!has_next) break;
#pragma unroll
        for (int a = 0; a < 2; ++a)
#pragma unroll
            for (int b = 0; b < 2; ++b)
#pragma unroll
                for (int m = 0; m < 4; ++m)
#pragma unroll
                    for (int n = 0; n < 2; ++n) acc[a][b][m][n] = (f32x4){0.f, 0.f, 0.f, 0.f};
        cur = nxt; cA = nA; cB = nB; ++ui;
        if constexpr (Epi::RS_LDS) PG8_RSDMA(cur);
        if constexpr (GA) { vGc[0][0] = vS[0][0]; vGc[0][1] = vS[0][1]; vGc[1][0] = vS[1][0]; vGc[1][1] = vS[1][1]; }
        if constexpr (ALIGN_EPI) { if (wr == 1) PG8_BAR; }
    }
    PG8_WAIT_V(0);
    if constexpr (!ALIGN_EPI) { if (wr == 0) PG8_BAR; }
    PG8_BAR;
    if constexpr (Epi::AFTER_DRAIN) { E.fused(acc, cur, wr, wc, fr, fq, lds, wid, lane); S.done(cur); }
#undef PG8_SA
#undef PG8_SB
#undef PG8_STAGE
#undef PG8_STAGE_A
#undef PG8_ROWDMA
#undef PG8_RSDMA
#undef PG8_ROWGET
#undef PG8_LDA
#undef PG8_CAT8
#undef PG8_LDB
#undef PG8_MMA
#undef PG8_WAIT_V
#undef PG8_WAIT_L
#undef PG8_BAR
#undef PG8_SCHED
}
}

constexpr int NWAVES = 8;
constexpr int BATCH = 8, SEQ = 4096, D = 1024, M = BATCH * SEQ;
constexpr int AW = 2048, FF = 3584, NE = 8;
constexpr int MROWS = 2 * M + NE * 256;
constexpr float EPS = 1e-6f;
#ifndef MK_ONE_LAUNCH
#define MK_ONE_LAUNCH 1
#endif
#ifndef MK_LAYERS
#define MK_LAYERS 4
#endif
#ifndef MK_AIN_F8
#define MK_AIN_F8 1
#endif
constexpr int AIN_F8 = MK_AIN_F8;
#ifndef MK_AOUT_F8
#define MK_AOUT_F8 2
#endif
constexpr int AOUT_F8 = MK_AOUT_F8;
#ifndef MK_BOUT_F8
#define MK_BOUT_F8 0
#endif
constexpr int BOUT_F8 = MK_BOUT_F8;
#ifndef MK_COUT_F8
#define MK_COUT_F8 1
#endif
constexpr int COUT_F8 = MK_COUT_F8;
#ifndef MK_CIN_F8
#define MK_CIN_F8 1
#endif
constexpr int CIN_F8 = MK_CIN_F8;
#ifndef MK_MOE_F8
#define MK_MOE_F8 1
#endif
#ifndef MK_DENSE_F8
#define MK_DENSE_F8 2
#endif
constexpr int DENSE_F8 = MK_DENSE_F8;
constexpr int MOE_F8 = MK_MOE_F8;

constexpr size_t MiB = 1u << 20;
constexpr size_t WS_CTL = 0, CTL_ZERO_BYTES = 1 * MiB;
constexpr size_t WS_WA_IN = 2 * MiB, WS_WA_OUT = 18 * MiB, WS_WB_IN = 26 * MiB, WS_WB_OUT = 32 * MiB, WS_WC_IN = 34 * MiB, WS_WC_OUT = 40 * MiB;
constexpr size_t WS_WF_IN = 42 * MiB, WS_WF_OUT = 70 * MiB, WS_WM_IN = 84 * MiB, WS_WM_OUT = 308 * MiB;
constexpr size_t WS_X = 420 * MiB, WS_XB = 548 * MiB, WS_SSQ = 612 * MiB, WS_VSSQ = 614 * MiB, WS_GLOW = 618 * MiB, WS_LOGF = 620 * MiB, WS_OSSQ = 621 * MiB, WS_DEC = 629 * MiB;
constexpr size_t WS_TOKE = 630 * MiB, WS_TOKP = WS_TOKE + 256 * 1024, WS_TOKG = WS_TOKP + 256 * 1024, WS_TOKRS = WS_TOKG + 256 * 1024, WS_BLKB = WS_TOKRS + 128 * 1024;
constexpr size_t WS_ROWT = 632 * MiB, WS_ROWG = WS_ROWT + 512 * 1024, WS_ROWRS = WS_ROWG + 512 * 1024;
constexpr size_t WS_ACT = 640 * MiB;
constexpr size_t WS_U = WS_ACT, WS_V = WS_ACT + 128 * MiB, WS_Y = WS_ACT + 256 * MiB;
constexpr size_t WS_X8 = WS_X;
constexpr size_t WS_HF = WS_ACT;
constexpr size_t WS_QKVR = WS_ACT, WS_QD = WS_ACT + 192 * MiB, WS_KD = WS_ACT + 224 * MiB, WS_KET = WS_ACT + 256 * MiB, WS_VT = WS_ACT + 288 * MiB, WS_GO = WS_ACT + 352 * MiB, WS_GG = WS_ACT + 416 * MiB;
constexpr size_t WS_AO = WS_ACT + 192 * MiB;
constexpr size_t WS_XS = WS_ACT, WS_HM = WS_ACT + 132 * MiB, WS_OS = WS_ACT + 594 * MiB;
constexpr size_t WS_END = WS_ACT + 722 * MiB;
static_assert((size_t)MROWS * 1024 * 2 <= 132 * MiB && (size_t)MROWS * FF * 2 <= 462 * MiB, "MoE buffers");
constexpr int CW_TMO = 0, CW_CODE = 1, CW_XMIS = 2, CW_BAR = 4096, CW_CNT = 8192, CW_KNB = 12288;

constexpr int RING_OFF = 0, RING_BYTES = 131072;
constexpr int LDSCTL_OFF = RING_BYTES, MISC_OFF = LDSCTL_OFF + 320;
constexpr int LDS_BYTES = 147456;
static_assert(MISC_OFF + 128 <= LDS_BYTES, "LDS map");

#define GAS __attribute__((address_space(1)))
#define LAS __attribute__((address_space(3)))
#define DI __device__ __forceinline__
typedef unsigned short bf16;
typedef unsigned v4u __attribute__((ext_vector_type(4)));
typedef unsigned v2u __attribute__((ext_vector_type(2)));
typedef float f32x4 __attribute__((ext_vector_type(4)));
typedef short bf16x8 __attribute__((ext_vector_type(8)));
typedef short bf16x4 __attribute__((ext_vector_type(4)));
typedef GAS unsigned gu32;
#define RLX_AGENT __ATOMIC_RELAXED, __HIP_MEMORY_SCOPE_AGENT
#define LDS_WAIT() asm volatile("s_waitcnt lgkmcnt(0)" ::: "memory")
#define VM_WAIT() asm volatile("s_waitcnt vmcnt(0)" ::: "memory")
DI unsigned f2bf(float f) { unsigned u = __builtin_bit_cast(unsigned, f); return (u + 0x7fffu + ((u >> 16) & 1u)) >> 16; }
DI unsigned pk2(float lo, float hi) { return f2bf(lo) | (f2bf(hi) << 16); }
DI float bflo(unsigned w) { return __builtin_bit_cast(float, w << 16); }
DI float bfhi(unsigned w) { return __builtin_bit_cast(float, w & 0xffff0000u); }
DI float bf2f(bf16 h) { return __builtin_bit_cast(float, ((unsigned)h) << 16); }
DI float wave_sum(float v) {
#pragma unroll
    for (int o = 1; o < 64; o <<= 1) v += __shfl_xor(v, o);
    return v;
}
DI float logsig(float z) { return fminf(z, 0.f) - log1pf(__expf(-fabsf(z))); }
#define MFMA16(a, b, c) __builtin_amdgcn_mfma_f32_16x16x32_bf16((a), (b), (c), 0, 0, 0)
DI bf16x8 ldsfrag(LAS const unsigned char* p) { return *(LAS const bf16x8*)p; }
typedef short s16x4 __attribute__((ext_vector_type(4)));
DI bf16x8 tr_frag(LAS const unsigned char* p0, LAS const unsigned char* p1) {
    const s16x4 a = __builtin_amdgcn_ds_read_tr16_b64_v4i16((LAS s16x4*)p0), b = __builtin_amdgcn_ds_read_tr16_b64_v4i16((LAS s16x4*)p1);
    return __builtin_shufflevector(a, b, 0, 1, 2, 3, 4, 5, 6, 7);
}
#define XB_TMO      128
#define XB_XCNT(j)  (256  + 64 * (j))
#define XB_XSUB(j)  (1280 + 64 * (j))
#define XB_XGEN(j)  (2304 + 64 * (j))
#define XB_TOP      3328
#define XB_TOPGEN   3392
#define XCD_BAR_WORDS 3456
#define XB_SPIN_CAP (1u << 18)

__device__ __forceinline__ unsigned xb_ld(unsigned* p)              { return __hip_atomic_load(p, __ATOMIC_RELAXED, __HIP_MEMORY_SCOPE_AGENT); }
__device__ __forceinline__ unsigned xb_add(unsigned* p, unsigned v) { return __hip_atomic_fetch_add(p, v, __ATOMIC_RELAXED, __HIP_MEMORY_SCOPE_AGENT); }
__device__ __forceinline__ unsigned xb_xcc_id() { return (unsigned)__builtin_amdgcn_s_getreg((3 << 11) | 20) & 0xFu; }
#define XB_SPIN(cond, bar) do { unsigned _sp = 0; while (cond) { __builtin_amdgcn_s_sleep(1); \
    if ((++_sp & 255u) == 0u) { if (xb_ld(&(bar)[XB_TMO])) break; if (_sp > XB_SPIN_CAP) { atomicAdd(&(bar)[XB_TMO], 1u); break; } } } } while (0)

struct XcdBarrier {
    unsigned* bar; unsigned x;
    volatile LAS unsigned* st;
};

__device__ __forceinline__ XcdBarrier xcd_barrier_post(unsigned* bar, volatile LAS unsigned* st) {
    XcdBarrier b; b.bar = bar; b.x = xb_xcc_id(); b.st = st;
    if (threadIdx.x == 0) (void)xb_add(&bar[XB_XCNT(b.x)], 1u);
    return b;
}
__device__ __forceinline__ void xcd_barrier_complete(unsigned* bar, unsigned x, unsigned& nloc, unsigned& nx) {
    const unsigned G = gridDim.x * gridDim.y * gridDim.z;
    unsigned sum, cnt, mine, sp = 0u;
    for (;;) {
        sum = 0u; cnt = 0u; mine = 0u;
#pragma unroll
        for (unsigned j = 0; j < 16; ++j) { const unsigned c = xb_ld(&bar[XB_XCNT(j)]); sum += c; cnt += (c > 0u) ? 1u : 0u; mine = (j == x) ? c : mine; }
        if (sum == G) break;
        __builtin_amdgcn_s_sleep(1);
        if ((++sp & 255u) == 0u) { if (xb_ld(&bar[XB_TMO])) break; if (sp > XB_SPIN_CAP) { atomicAdd(&bar[XB_TMO], 1u); break; } }
    }
    nloc = mine > 0u ? mine : 1u; nx = cnt > 0u ? cnt : 1u;
}

__device__ __forceinline__ void xcd_barrier(const XcdBarrier& b) {
    asm volatile("s_waitcnt vmcnt(0)" ::: "memory");
    __syncthreads();
    if (threadIdx.x == 0) {
        unsigned* bar = b.bar;
        __builtin_amdgcn_s_waitcnt(0);
        unsigned nloc = b.st[0], nx = b.st[1];
        if (nloc == 0u) { xcd_barrier_complete(bar, b.x, nloc, nx); b.st[0] = nloc; b.st[1] = nx; }
        const unsigned old = xb_add(&bar[XB_XSUB(b.x)], 1u);
        const unsigned gen = old / nloc;
        if (old + 1u == (gen + 1u) * nloc) {
            __builtin_amdgcn_fence(__ATOMIC_RELEASE, "agent");
            asm volatile("s_waitcnt vmcnt(0)" ::: "memory");
            const unsigned og = xb_add(&bar[XB_TOP], 1u);
            const unsigned tg = og / nx;
            if (og + 1u == (tg + 1u) * nx) xb_add(&bar[XB_TOPGEN], 1u);
            else XB_SPIN(xb_ld(&bar[XB_TOPGEN]) == tg, bar);
            __builtin_amdgcn_fence(__ATOMIC_ACQUIRE, "agent");
            xb_add(&bar[XB_XGEN(b.x)], 1u);
            asm volatile("s_waitcnt vmcnt(0)" ::: "memory");
        } else {
            XB_SPIN(xb_ld(&bar[XB_XGEN(b.x)]) == gen, bar);
            __builtin_amdgcn_fence(__ATOMIC_ACQUIRE, "agent");
            asm volatile("s_waitcnt vmcnt(0)" ::: "memory");
        }
    }
    __syncthreads();
}

__device__ __forceinline__ void xcd_barrier_local(const XcdBarrier& b) {
    asm volatile("s_waitcnt vmcnt(0)" ::: "memory");
    __syncthreads();
    if (threadIdx.x == 0) {
        unsigned* bar = b.bar;
        __builtin_amdgcn_s_waitcnt(0);
        const unsigned nloc = b.st[0];
        const unsigned old = xb_add(&bar[XB_XSUB(b.x)], 1u);
        const unsigned gen = old / nloc;
        if (old + 1u == (gen + 1u) * nloc) xb_add(&bar[XB_XGEN(b.x)], 1u);
        else XB_SPIN(xb_ld(&bar[XB_XGEN(b.x)]) == gen, bar);
        __builtin_amdgcn_fence(__ATOMIC_ACQUIRE, "agent");
        asm volatile("s_waitcnt vmcnt(0)" ::: "memory");
    }
    __syncthreads();
}

struct Frame {
    LAS unsigned char* lds;
    volatile LAS unsigned* MISC;
    gu32* ctl;
    int tid, lane, wave;
    int vcu, G;
    float* out; unsigned char* ws;
};
template <class T> DI T* wsp(const Frame& F, size_t off) { return (T*)(F.ws + off); }

struct MatDesc { const float* W; int ldw, K, N; bf16* WT; int mode; const float* gain; int f8; };
template <class A> DI MatDesc get_mat(const Frame& F, const A& P, int idx) {
    MatDesc d; d.f8 = 0;
    if (idx < 2)        { const int j = idx;      d.W = P.in[3] + (size_t)j * 1024 * 4096; d.ldw = 4096; d.K = 1024; d.N = 4096; d.f8 = (j == 1 && AIN_F8) ? 1 : 0; d.WT = wsp<bf16>(F, WS_WA_IN) + (size_t)j * 4096 * 1024; d.mode = 0; d.gain = P.in[1] + (j ? 3 : 0) * 1024; }
    else if (idx < 4)   { const int j = idx - 2;  d.W = P.in[7] + (size_t)j * 2048 * 1024; d.ldw = 1024; d.K = 2048; d.N = 1024; d.f8 = (AOUT_F8 >> j) & 1; d.WT = wsp<bf16>(F, WS_WA_OUT) + (size_t)j * 1024 * 2048; d.mode = 0; d.gain = nullptr; }
    else if (idx == 4)  { d.W = P.in[8];  d.ldw = 3088; d.K = 1024; d.N = 3072; d.WT = wsp<bf16>(F, WS_WB_IN);  d.mode = 0; d.gain = P.in[1] + 1 * 1024; }
    else if (idx == 5)  { d.W = P.in[12]; d.ldw = 1024; d.K = 1024; d.N = 1024; d.WT = wsp<bf16>(F, WS_WB_OUT); d.mode = 0; d.gain = nullptr; d.f8 = BOUT_F8; }
    else if (idx == 6)  { d.W = P.in[13]; d.ldw = 3080; d.K = 1024; d.N = 3072; d.WT = wsp<bf16>(F, WS_WC_IN);  d.mode = 0; d.gain = P.in[1] + 2 * 1024; d.f8 = CIN_F8; }
    else if (idx == 7)  { d.W = P.in[15]; d.ldw = 1024; d.K = 1024; d.N = 1024; d.WT = wsp<bf16>(F, WS_WC_OUT); d.mode = 0; d.gain = nullptr; d.f8 = COUT_F8; }
    else if (idx < 10)  { const int i = idx - 8;  d.W = P.in[16] + (size_t)i * 1024 * 7168; d.ldw = 7168; d.K = 1024; d.N = 7168; d.f8 = (DENSE_F8 >> i) & 1; d.WT = d.f8 ? (bf16*)(wsp<unsigned char>(F, WS_WF_IN) + (size_t)i * 2 * 7168 * 1024) : wsp<bf16>(F, WS_WF_IN) + (size_t)i * 7168 * 1024; d.mode = 1; d.gain = P.in[2] + (2 * i) * 1024; }
    else if (idx < 12)  { const int i = idx - 10; d.W = P.in[17] + (size_t)i * 3584 * 1024; d.ldw = 1024; d.K = 3584; d.N = 1024; d.f8 = (DENSE_F8 >> i) & 1; d.WT = d.f8 ? (bf16*)(wsp<unsigned char>(F, WS_WF_OUT) + (size_t)i * 2 * 1024 * 3584) : wsp<bf16>(F, WS_WF_OUT) + (size_t)i * 1024 * 3584; d.mode = 0; d.gain = nullptr; }
    else if (idx < 28)  { const int q = idx - 12; d.W = P.in[19] + (size_t)q * 1024 * 7168; d.ldw = 7168; d.K = 1024; d.N = 7168; d.WT = MOE_F8 ? (bf16*)(wsp<unsigned char>(F, WS_WM_IN) + (size_t)q * 7168 * 1024) : wsp<bf16>(F, WS_WM_IN) + (size_t)q * 7168 * 1024; d.mode = 1; d.gain = P.in[2] + (2 * (q >> 3) + 1) * 1024; d.f8 = MOE_F8; }
    else                { const int q = idx - 28; d.W = P.in[20] + (size_t)q * 3584 * 1024; d.ldw = 1024; d.K = 3584; d.N = 1024; d.WT = MOE_F8 ? (bf16*)(wsp<unsigned char>(F, WS_WM_OUT) + (size_t)q * 1024 * 3584) : wsp<bf16>(F, WS_WM_OUT) + (size_t)q * 1024 * 3584; d.mode = 0; d.gain = nullptr; d.f8 = MOE_F8; }
    return d;
}
constexpr int NMATS = 44;
constexpr int P0_ST = 129;
struct P0Dst { bf16* base; int K; int f8; };
DI int p0_ntiles(const MatDesc& d) { return (d.K / 128) * (d.N / 128); }
DI P0Dst p0_load(const MatDesc& d, int tile, int tid, f32x4 (&r)[8], float (&g)[8]) {
    const int ntn = d.N / 128, kb = tile / ntn, nb = tile % ntn, k0 = 128 * kb, n0 = 128 * nb;
#pragma unroll
    for (int p = 0; p < 8; ++p) { const int k = k0 + p * 16 + (tid >> 5); r[p] = *(const f32x4*)(d.W + (size_t)k * d.ldw + n0 + 4 * (tid & 31)); g[p] = d.gain ? d.gain[k] : 1.0f; }
    int drow0 = n0;
    if (d.mode == 1) drow0 = (n0 < FF) ? (n0 >> 7) * 256 : ((n0 - FF) >> 7) * 256 + 128;
    P0Dst o; o.K = d.K; o.f8 = d.f8;
    if (d.f8) { o.base = (bf16*)((unsigned char*)d.WT + (size_t)drow0 * d.K + k0);
#pragma unroll
        for (int p = 0; p < 8; ++p) g[p] *= 64.0f; }
    else o.base = d.WT + (size_t)drow0 * d.K + k0;
    return o;
}
constexpr int N_EARLY = 6;
DI int morder(int i) { return i == 0 ? 0 : i == 1 ? 2 : i == 2 ? 4 : i == 3 ? 5 : i == 4 ? 8 : i == 5 ? 10 : i == 6 ? 1 : i == 7 ? 3 : i == 8 ? 6 : i == 9 ? 7 : i == 10 ? 9 : i == 11 ? 11 : i; }
struct P0State { int mi, i_hi, base, nt, T, stride; MatDesc d; };
template <class A> DI void p0_init(P0State& s, Frame& F, const A& P, int i_lo, int i_hi, int worker, int nworkers) { s.mi = i_lo; s.i_hi = i_hi; s.base = 0; s.T = worker; s.stride = nworkers; s.d = get_mat(F, P, morder(i_lo)); s.nt = p0_ntiles(s.d); }
#define P0_NEXT(st, r, g, dst, have) do { have = false; while (st.mi < st.i_hi && st.T >= st.base + st.nt) { st.base += st.nt; ++st.mi; if (st.mi < st.i_hi) { st.d = get_mat(F, P, morder(st.mi)); st.nt = p0_ntiles(st.d); } } \
        if (st.mi < st.i_hi) { dst = p0_load(st.d, st.T - st.base, tid, r, g); have = true; } st.T += st.stride; } while (0)
constexpr int P0_TST = 272;
#define P0_WRITE(S, r, g, dst) do { \
        _Pragma("unroll") for (int p = 0; p < 8; ++p) { f32x4 v_ = r[p] * g[p]; \
            if (dst.f8) { v_[0] = pg8::c8(v_[0]); v_[1] = pg8::c8(v_[1]); v_[2] = pg8::c8(v_[2]); v_[3] = pg8::c8(v_[3]); } \
            v2u w_; w_.x = pg8::cvt_pk_bf16(v_[0], v_[1]); w_.y = pg8::cvt_pk_bf16(v_[2], v_[3]); \
            *(LAS v2u*)((S) + (p * 16 + (tid >> 5)) * P0_TST + 8 * (tid & 31)) = w_; } \
        } while (0)
#define P0_STORE(S, dst) do { const int w_ = tid >> 6, fr_ = tid & 15, fq_ = (tid >> 4) & 3; \
        LAS const unsigned char* tp_ = (S) + (fr_ >> 2) * P0_TST + (16 * w_ + 4 * (fr_ & 3)) * 2; \
        if (dst.f8) { _Pragma("unroll") for (int kk = 0; kk < 2; ++kk) { const int kb_ = 64 * kk + 16 * fq_; \
            const bf16x8 a0_ = tr_frag(tp_ + kb_ * P0_TST, tp_ + (kb_ + 4) * P0_TST), a1_ = tr_frag(tp_ + (kb_ + 8) * P0_TST, tp_ + (kb_ + 12) * P0_TST); \
            const v4u x0_ = __builtin_bit_cast(v4u, a0_), x1_ = __builtin_bit_cast(v4u, a1_); v4u o; \
            { int q_ = __builtin_amdgcn_cvt_pk_fp8_f32(bflo(x0_.x), bfhi(x0_.x), 0, false); q_ = __builtin_amdgcn_cvt_pk_fp8_f32(bflo(x0_.y), bfhi(x0_.y), q_, true); o.x = (unsigned)q_; } \
            { int q_ = __builtin_amdgcn_cvt_pk_fp8_f32(bflo(x0_.z), bfhi(x0_.z), 0, false); q_ = __builtin_amdgcn_cvt_pk_fp8_f32(bflo(x0_.w), bfhi(x0_.w), q_, true); o.y = (unsigned)q_; } \
            { int q_ = __builtin_amdgcn_cvt_pk_fp8_f32(bflo(x1_.x), bfhi(x1_.x), 0, false); q_ = __builtin_amdgcn_cvt_pk_fp8_f32(bflo(x1_.y), bfhi(x1_.y), q_, true); o.z = (unsigned)q_; } \
            { int q_ = __builtin_amdgcn_cvt_pk_fp8_f32(bflo(x1_.z), bfhi(x1_.z), 0, false); q_ = __builtin_amdgcn_cvt_pk_fp8_f32(bflo(x1_.w), bfhi(x1_.w), q_, true); o.w = (unsigned)q_; } \
            *(v4u*)((unsigned char*)dst.base + (size_t)(16 * w_ + fr_) * dst.K + kb_) = o; } } \
        else { _Pragma("unroll") for (int kk = 0; kk < 4; ++kk) { const int kb_ = 32 * kk + 8 * fq_; \
            const bf16x8 a_ = tr_frag(tp_ + kb_ * P0_TST, tp_ + (kb_ + 4) * P0_TST); \
            *(v4u*)(dst.base + (size_t)(16 * w_ + fr_) * dst.K + kb_) = __builtin_bit_cast(v4u, a_); } } \
        } while (0)
template <class A> DI void p0_convert(Frame& F, const A& P, int i_lo, int i_hi, int worker, int nworkers) {
    LAS unsigned char* S = F.lds;
    const int tid = F.tid;
    P0State st; p0_init(st, F, P, i_lo, i_hi, worker, nworkers);
    f32x4 rA[8], rB[8]; float gA[8], gB[8]; P0Dst dA, dB; dA.base = nullptr; dA.K = 0; dA.f8 = 0; dB = dA; bool hA = false, hB = false;
    P0_NEXT(st, rA, gA, dA, hA);
    while (hA) {
        P0_NEXT(st, rB, gB, dB, hB);
        P0_WRITE(S, rA, gA, dA); __syncthreads(); P0_STORE(S, dA); __syncthreads();
        if (!hB) break;
        P0_NEXT(st, rA, gA, dA, hA);
        P0_WRITE(S, rB, gB, dB); __syncthreads(); P0_STORE(S, dB); __syncthreads();
    }
}
template <class A> DI void p0_prologue(Frame& F, const A& P) {
    const int gw = F.vcu * NWAVES + F.wave, NGW = F.G * NWAVES;
    { const float* x = P.in[0]; bf16* xb = wsp<bf16>(F, WS_XB); float* ssq = wsp<float>(F, WS_SSQ);
      for (int m = gw; m < M; m += NGW) {
        const f32x4* xr = (const f32x4*)(x + (size_t)m * D) + F.lane; f32x4 v[4]; float s = 0.f;
#pragma unroll
        for (int j = 0; j < 4; ++j) { v[j] = xr[64 * j]; s += (v[j][0] * v[j][0] + v[j][1] * v[j][1]) + (v[j][2] * v[j][2] + v[j][3] * v[j][3]); }
        s = wave_sum(s);
        v2u* o8 = (v2u*)(xb + (size_t)m * D) + F.lane;
#pragma unroll
        for (int j = 0; j < 4; ++j) { v2u w; w.x = pk2(v[j][0], v[j][1]); w.y = pk2(v[j][2], v[j][3]); o8[64 * j] = w; }
        if (F.lane < 4) { f32x4 z = {0.f, 0.f, 0.f, 0.f}; if (F.lane == 0) z[0] = s; *((f32x4*)(ssq + (size_t)m * 16) + F.lane) = z; }
      } }
    p0_convert(F, P, 0, N_EARLY, F.vcu, F.G);
}

constexpr int TH_ST = 2064, TH_WL = 16 * TH_ST;
template <int NOUT> DI void thin_stage(Frame& F, const float* gain, const float* W, int ldw, int c0) {
    LAS unsigned char* lds = F.lds;
    for (int i = F.tid; i < 1024 * 16; i += NWAVES * 64) { const int n = i & 15, k = i >> 4; const float v = (n < NOUT) ? gain[k] * W[(size_t)k * ldw + c0 + n] : 0.f;
        const unsigned hi = f2bf(v); const float r = v - __builtin_bit_cast(float, hi << 16);
        *(LAS unsigned short*)(lds + n * TH_ST + k * 2) = (unsigned short)hi; *(LAS unsigned short*)(lds + TH_WL + n * TH_ST + k * 2) = (unsigned short)f2bf(r); }
    __syncthreads();
}
DI void thin_tile(const bf16* x, int row0, LAS const unsigned char* lds, int lane, float& ss, f32x4& out) {
    const int fr = lane & 15, fq = lane >> 4; const bf16* xr = x + (size_t)(row0 + fr) * D + 8 * fq; LAS const unsigned char* wp = lds + fr * TH_ST + 16 * fq;
    f32x4 acc = {0.f, 0.f, 0.f, 0.f}; float s = 0.f;
#pragma unroll 1
    for (int kb = 0; kb < 4; ++kb) { v4u a[8];
#pragma unroll
        for (int i = 0; i < 8; ++i) a[i] = *(const v4u*)(xr + 32 * (8 * kb + i));
#pragma unroll
        for (int i = 0; i < 8; ++i) { const v4u q = a[i];
            s += (bflo(q.x) * bflo(q.x) + bfhi(q.x) * bfhi(q.x)) + (bflo(q.y) * bflo(q.y) + bfhi(q.y) * bfhi(q.y)) + (bflo(q.z) * bflo(q.z) + bfhi(q.z) * bfhi(q.z)) + (bflo(q.w) * bflo(q.w) + bfhi(q.w) * bfhi(q.w));
            const bf16x8 xa = __builtin_bit_cast(bf16x8, q); const bf16x8 wh = ldsfrag(wp + 64 * (8 * kb + i)), wl = ldsfrag(wp + TH_WL + 64 * (8 * kb + i));
            acc = MFMA16(wh, xa, acc); acc = MFMA16(wl, xa, acc); } }
    s += __shfl_xor(s, 16); s += __shfl_xor(s, 32);
    ss = s; out = acc;
}
DI void glow_phase(Frame& F, const bf16* x, const float* gain, const float* Wb) {
    thin_stage<16>(F, gain, Wb, 3088, 3072);
    float* glow = wsp<float>(F, WS_GLOW);
    const int gw = F.vcu * NWAVES + F.wave, NGW = F.G * NWAVES, fr = F.lane & 15, fq = F.lane >> 4;
    for (int t = gw; t < M / 16; t += NGW) { float ss; f32x4 o; thin_tile(x, 16 * t, F.lds, F.lane, ss, o);
        const float rs = 1.0f / sqrtf(ss * (1.0f / D) + EPS);
        *(f32x4*)(glow + (size_t)(16 * t + fr) * 16 + 4 * fq) = o * rs; }
    __syncthreads();
}
DI void logf_phase(Frame& F, const bf16* x, const float* gain, const float* Wc, const float* fb) {
    thin_stage<8>(F, gain, Wc, 3080, 3072);
    float* logf = wsp<float>(F, WS_LOGF);
    const int gw = F.vcu * NWAVES + F.wave, NGW = F.G * NWAVES, fr = F.lane & 15, fq = F.lane >> 4;
    const f32x4 fb4 = *(const f32x4*)(fb + 4 * (fq & 1));
    for (int t = gw; t < M / 16; t += NGW) { float ss; f32x4 o; thin_tile(x, 16 * t, F.lds, F.lane, ss, o);
        const float rs = 1.0f / sqrtf(ss * (1.0f / D) + EPS);
        if (fq < 2) { f32x4 r;
#pragma unroll
            for (int e = 0; e < 4; ++e) r[e] = logsig(o[e] * rs + fb4[e]);
            *(f32x4*)(logf + (size_t)(16 * t + fr) * 8 + 4 * fq) = r; } }
    __syncthreads();
}
DI void router_phase(Frame& F, const bf16* x, const float* gain, const float* Wr, unsigned* gcnt) {
    thin_stage<8>(F, gain, Wr, 8, 0);
    LAS unsigned* lcnt = (LAS unsigned*)(F.lds + 2 * TH_WL);
    if (F.tid < 8) lcnt[F.tid] = 0u;
    __syncthreads();
    int* tok_e = wsp<int>(F, WS_TOKE); int* tok_p = wsp<int>(F, WS_TOKP); float* tok_g = wsp<float>(F, WS_TOKG); float* tok_rs = wsp<float>(F, WS_TOKRS); int* blkb = wsp<int>(F, WS_BLKB);
    const int gw = F.vcu * NWAVES + F.wave, NGW = F.G * NWAVES, fr = F.lane & 15, fq = F.lane >> 4;
    for (int t = gw; t < M / 16; t += NGW) { float ss; f32x4 o; thin_tile(x, 16 * t, F.lds, F.lane, ss, o);
        const float rs = 1.0f / sqrtf(ss * (1.0f / D) + EPS);
        f32x4 o2; o2[0] = __shfl_xor(o[0], 16); o2[1] = __shfl_xor(o[1], 16); o2[2] = __shfl_xor(o[2], 16); o2[3] = __shfl_xor(o[3], 16);
        if (fq == 0) { const int row = 16 * t + fr;
            const float lg[8] = {o[0] * rs, o[1] * rs, o[2] * rs, o[3] * rs, o2[0] * rs, o2[1] * rs, o2[2] * rs, o2[3] * rs};
            float v1 = lg[0]; int i1 = 0;
#pragma unroll
            for (int e = 1; e < 8; ++e) { if (lg[e] > v1) { v1 = lg[e]; i1 = e; } }
            float v2 = -3.0e38f; int i2 = 0;
#pragma unroll
            for (int e = 0; e < 8; ++e) { if (e != i1 && lg[e] > v2) { v2 = lg[e]; i2 = e; } }
            const float g1 = 1.0f / (1.0f + __expf(v2 - v1)), g2 = 1.0f - g1;
            const unsigned p1 = __hip_atomic_fetch_add(lcnt + i1, 1u, __ATOMIC_RELAXED, __HIP_MEMORY_SCOPE_WORKGROUP);
            const unsigned p2 = __hip_atomic_fetch_add(lcnt + i2, 1u, __ATOMIC_RELAXED, __HIP_MEMORY_SCOPE_WORKGROUP);
            tok_e[2 * row] = i1; tok_e[2 * row + 1] = i2; tok_p[2 * row] = (int)p1; tok_p[2 * row + 1] = (int)p2; tok_g[2 * row] = g1; tok_g[2 * row + 1] = g2; tok_rs[row] = rs; } }
    __syncthreads();
    if (F.tid < 8) { const unsigned b = __hip_atomic_fetch_add(gcnt + F.tid, lcnt[F.tid], __ATOMIC_RELAXED, __HIP_MEMORY_SCOPE_AGENT); blkb[F.vcu * 8 + F.tid] = (int)b; }
    __syncthreads();
}
template <bool F8> DI void gather_phase(Frame& F, const unsigned* gcnt) {
    LAS int* seg = (LAS int*)(F.lds); LAS int* cntl = seg + 16;
    if (F.tid == 0) { int t = 0; for (int e = 0; e < 8; ++e) { const int c = (int)gcnt[e]; seg[e] = t; cntl[e] = c; t += (c + 255) & ~255; } seg[8] = t; }
    __syncthreads();
    const int* tok_e = wsp<int>(F, WS_TOKE); const int* tok_p = wsp<int>(F, WS_TOKP); const float* tok_g = wsp<float>(F, WS_TOKG); const float* tok_rs = wsp<float>(F, WS_TOKRS); const int* blkb = wsp<int>(F, WS_BLKB);
    int* rtok = wsp<int>(F, WS_ROWT); float* rgate = wsp<float>(F, WS_ROWG); float* rrs = wsp<float>(F, WS_ROWRS);
    const bf16* xb = wsp<bf16>(F, WS_XB); bf16* XS = wsp<bf16>(F, WS_XS);
    const int gw = F.vcu * NWAVES + F.wave, NGW = F.G * NWAVES;
    for (int row = gw; row < M; row += NGW) { const int owner = ((row >> 4) % NGW) / NWAVES;
        const v4u* src = (const v4u*)(xb + (size_t)row * D); v4u a, b;
        if constexpr (F8) { a = src[2 * F.lane]; b = src[2 * F.lane + 1];
            int w0 = __builtin_amdgcn_cvt_pk_fp8_f32(pg8::c8(bflo(a.x)), pg8::c8(bfhi(a.x)), 0, false); w0 = __builtin_amdgcn_cvt_pk_fp8_f32(pg8::c8(bflo(a.y)), pg8::c8(bfhi(a.y)), w0, true); int w1 = __builtin_amdgcn_cvt_pk_fp8_f32(pg8::c8(bflo(a.z)), pg8::c8(bfhi(a.z)), 0, false); w1 = __builtin_amdgcn_cvt_pk_fp8_f32(pg8::c8(bflo(a.w)), pg8::c8(bfhi(a.w)), w1, true);
            int w2 = __builtin_amdgcn_cvt_pk_fp8_f32(pg8::c8(bflo(b.x)), pg8::c8(bfhi(b.x)), 0, false); w2 = __builtin_amdgcn_cvt_pk_fp8_f32(pg8::c8(bflo(b.y)), pg8::c8(bfhi(b.y)), w2, true); int w3 = __builtin_amdgcn_cvt_pk_fp8_f32(pg8::c8(bflo(b.z)), pg8::c8(bfhi(b.z)), 0, false); w3 = __builtin_amdgcn_cvt_pk_fp8_f32(pg8::c8(bflo(b.w)), pg8::c8(bfhi(b.w)), w3, true);
            a = (v4u){(unsigned)w0, (unsigned)w1, (unsigned)w2, (unsigned)w3}; b = a; }
        else { a = src[F.lane]; b = src[64 + F.lane]; }
#pragma unroll
        for (int slot = 0; slot < 2; ++slot) { const int e = tok_e[2 * row + slot]; const int r = seg[e] + blkb[owner * 8 + e] + tok_p[2 * row + slot];
            if constexpr (F8) { *((v4u*)((unsigned char*)XS + (size_t)r * D) + F.lane) = a; }
            else { v4u* dst = (v4u*)(XS + (size_t)r * D); dst[F.lane] = a; dst[64 + F.lane] = b; }
            if (F.lane == 0) { rtok[r] = 2 * row + slot; rgate[r] = tok_g[2 * row + slot]; rrs[r] = tok_rs[row]; } } }
    if (F.vcu == 0) { for (int e = 0; e < 8; ++e) for (int r = seg[e] + cntl[e] + F.tid; r < seg[e + 1]; r += NWAVES * 64) rtok[r] = -1; }
    __syncthreads();
}
DI void rowtable_phase(Frame& F, const unsigned* gcnt) {
    LAS int* seg = (LAS int*)(F.lds); LAS int* cntl = seg + 16;
    if (F.tid == 0) { int t = 0; for (int e = 0; e < 8; ++e) { const int c = (int)gcnt[e]; seg[e] = t; cntl[e] = c; t += (c + 255) & ~255; } seg[8] = t; }
    __syncthreads();
    const int* tok_e = wsp<int>(F, WS_TOKE); const int* tok_p = wsp<int>(F, WS_TOKP); const float* tok_g = wsp<float>(F, WS_TOKG); const float* tok_rs = wsp<float>(F, WS_TOKRS); const int* blkb = wsp<int>(F, WS_BLKB);
    int* rtok = wsp<int>(F, WS_ROWT); float* rgate = wsp<float>(F, WS_ROWG); float* rrs = wsp<float>(F, WS_ROWRS);
    const int NGW = F.G * NWAVES;
    for (int j = F.vcu * (NWAVES * 64) + F.tid; j < 2 * M; j += F.G * NWAVES * 64) { const int row = j >> 1, owner = ((row >> 4) % NGW) / NWAVES;
        const int e = tok_e[j]; const int r = seg[e] + blkb[owner * 8 + e] + tok_p[j];
        rtok[r] = j; rgate[r] = tok_g[j]; rrs[r] = tok_rs[row]; }
    if (F.vcu == 0) { for (int e = 0; e < 8; ++e) for (int r = seg[e] + cntl[e] + F.tid; r < seg[e + 1]; r += NWAVES * 64) rtok[r] = -1; }
    __syncthreads();
}
DI void combine_phase(Frame& F, bool fin, const float* fg, unsigned char* x8) {
    bf16* xb = wsp<bf16>(F, WS_XB); float* ssq = wsp<float>(F, WS_SSQ); const bf16* OS = wsp<bf16>(F, WS_OS);
    const int gw = F.vcu * NWAVES + F.wave, NGW = F.G * NWAVES;
    constexpr int RB = 2;
    for (int m0 = gw; m0 < M; m0 += RB * NGW) {
        v2u cx[RB][4], ca[RB][4], cb[RB][4];
#pragma unroll
        for (int i = 0; i < RB; ++i) { const int r_ = m0 + i * NGW, m = ((r_ & 2047) >> 8) * 4096 + (r_ & 255) + 256 * (r_ >> 11); if (r_ < M) {
                const v2u* xr = (const v2u*)(xb + (size_t)m * D) + F.lane; const v2u* o0 = (const v2u*)(OS + (size_t)m * D) + F.lane; const v2u* o1 = (const v2u*)(OS + ((size_t)M + m) * D) + F.lane;
#pragma unroll
                for (int j = 0; j < 4; ++j) { cx[i][j] = xr[64 * j]; ca[i][j] = o0[64 * j]; cb[i][j] = o1[64 * j]; } } }
#pragma unroll
        for (int i = 0; i < RB; ++i) { const int r_ = m0 + i * NGW, m = ((r_ & 2047) >> 8) * 4096 + (r_ & 255) + 256 * (r_ >> 11); if (r_ < M) {
        f32x4 v[4]; float s = 0.f;
#pragma unroll
        for (int j = 0; j < 4; ++j) { const v2u c = cx[i][j], a = ca[i][j], b = cb[i][j];
            v[j][0] = bflo(c.x) + (bflo(a.x) + bflo(b.x)); v[j][1] = bfhi(c.x) + (bfhi(a.x) + bfhi(b.x)); v[j][2] = bflo(c.y) + (bflo(a.y) + bflo(b.y)); v[j][3] = bfhi(c.y) + (bfhi(a.y) + bfhi(b.y));
            s += (v[j][0] * v[j][0] + v[j][1] * v[j][1]) + (v[j][2] * v[j][2] + v[j][3] * v[j][3]); }
        s = wave_sum(s);
        if (!fin) {
            v2u* o8 = (v2u*)(xb + (size_t)m * D) + F.lane;
#pragma unroll
            for (int j = 0; j < 4; ++j) { v2u w; w.x = pk2(v[j][0], v[j][1]); w.y = pk2(v[j][2], v[j][3]); o8[64 * j] = w; }
            if (x8) {
#pragma unroll
                for (int j = 0; j < 4; ++j) { int p = __builtin_amdgcn_cvt_pk_fp8_f32(pg8::c8(v[j][0]), pg8::c8(v[j][1]), 0, false); p = __builtin_amdgcn_cvt_pk_fp8_f32(pg8::c8(v[j][2]), pg8::c8(v[j][3]), p, true); *((unsigned*)(x8 + (size_t)m * D) + F.lane + 64 * j) = (unsigned)p; } }
            if (F.lane < 4) { f32x4 z = {0.f, 0.f, 0.f, 0.f}; if (F.lane == 0) z[0] = s; *((f32x4*)(ssq + (size_t)m * 16) + F.lane) = z; }
        } else {
            const float rs = 1.0f / sqrtf(s * (1.0f / D) + EPS); f32x4* ow = (f32x4*)(F.out + (size_t)m * D) + F.lane; const f32x4* g4 = (const f32x4*)fg + F.lane;
#pragma unroll
            for (int j = 0; j < 4; ++j) { const f32x4 g = g4[64 * j]; ow[64 * j] = v[j] * rs * g; }
        } } }
    }
}
DI void final_norm_phase(Frame& F, const bf16* x, const float* fg) {
    const int gw = F.vcu * NWAVES + F.wave, NGW = F.G * NWAVES;
    for (int m = gw; m < M; m += NGW) {
        const v2u* xr = (const v2u*)(x + (size_t)m * D) + F.lane; f32x4 v[4]; float s = 0.f;
#pragma unroll
        for (int j = 0; j < 4; ++j) { const v2u c = xr[64 * j]; v[j] = (f32x4){bflo(c.x), bfhi(c.x), bflo(c.y), bfhi(c.y)}; s += (v[j][0] * v[j][0] + v[j][1] * v[j][1]) + (v[j][2] * v[j][2] + v[j][3] * v[j][3]); }
        s = wave_sum(s);
        const float rs = 1.0f / sqrtf(s * (1.0f / D) + EPS); f32x4* ow = (f32x4*)(F.out + (size_t)m * D) + F.lane; const f32x4* g4 = (const f32x4*)fg + F.lane;
#pragma unroll
        for (int j = 0; j < 4; ++j) { const f32x4 g = g4[64 * j]; ow[64 * j] = v[j] * rs * g; }
    }
}


typedef __amdgpu_buffer_rsrc_t brsrc;
DI brsrc mk_rsrc(const void* p, unsigned bytes) { return __builtin_amdgcn_make_buffer_rsrc((void*)p, 0, bytes, 0x00020000); }
DI v4u bld128(brsrc r, unsigned voff, unsigned soff) { return __builtin_bit_cast(v4u, __builtin_amdgcn_raw_buffer_load_b128(r, voff, soff, 0)); }
DI v2u bld64(brsrc r, unsigned voff, unsigned soff) { return __builtin_bit_cast(v2u, __builtin_amdgcn_raw_buffer_load_b64(r, voff, soff, 0)); }
DI void bst64(brsrc r, unsigned voff, unsigned soff, v2u v) { __builtin_amdgcn_raw_buffer_store_b64(v, r, voff, soff, 0); }

template <bool Y8> DI void mix_phase(Frame& F, const float* ws_, const float* bs, const float* vg) {
    constexpr int WT_OFF = 0, WT_ST = 272, V_OFF = 34816, V_ST = 544, RS_OFF = 104448, BS_OFF = 105472, VG_OFF = 109568;
    const bf16* U = wsp<bf16>(F, WS_U); const bf16* V = wsp<bf16>(F, WS_V); bf16* Y = wsp<bf16>(F, WS_Y); const float* vssq = wsp<float>(F, WS_VSSQ);
    LAS unsigned char* lds = F.lds; LAS float* rsv = (LAS float*)(lds + RS_OFF); LAS float* bsl = (LAS float*)(lds + BS_OFF); LAS float* vgl = (LAS float*)(lds + VG_OFF);
    { const f32x4 b4 = (F.tid < 256) ? *(const f32x4*)(bs + 4 * F.tid) : (f32x4){0.f, 0.f, 0.f, 0.f}; const f32x4 g4 = *(const f32x4*)(vg + 4 * F.tid);
      if (F.tid < 256) *(LAS f32x4*)(bsl + 4 * F.tid) = b4; *(LAS f32x4*)(vgl + 4 * F.tid) = g4; }
    const int tid = F.tid, lane = F.lane, w = F.wave, fr = lane & 15, fq = lane >> 4;
    const int wfo = WT_OFF + fr * WT_ST + fq * 8;
    const int vfo = V_OFF + (4 * fq + (fr >> 2)) * V_ST + (32 * w + 4 * (fr & 3)) * 2;
    const brsrc rW = mk_rsrc(ws_, 8u * 128 * 128 * 4), rV = mk_rsrc(V, (unsigned)M * AW * 2), rU = mk_rsrc(U, (unsigned)M * AW * 2), rY = mk_rsrc(Y, (unsigned)M * AW * 2);
    const unsigned ulo8 = (unsigned)(fr * AW + 32 * w + 4 * fq);
    for (int c = F.vcu; c < 256; c += F.G) {
        const int tok0 = c * 128;
        if (tid < 128) { const f32x4* p = (const f32x4*)(vssq + (size_t)(tok0 + tid) * 32); float s = 0.f;
#pragma unroll
            for (int q = 0; q < 8; ++q) { const f32x4 a = p[q]; s += (a[0] + a[1]) + (a[2] + a[3]); }
            rsv[tid] = 1.0f / sqrtf(s * (1.0f / AW) + EPS); }
        f32x4 wreg[8]; v4u vreg[8];
        const unsigned wlo = (unsigned)((tid >> 5) * 512 + (tid & 31) * 16), vlo = (unsigned)((tid >> 5) * (AW * 2) + (tid & 31) * 16);
#define MIX_LOAD(gg) do { const unsigned ws_o = (unsigned)(gg) * 65536u, vs_o = (unsigned)tok0 * (AW * 2) + (unsigned)(gg) * 512u; \
            _Pragma("unroll") for (int it = 0; it < 8; ++it) { wreg[it] = __builtin_bit_cast(f32x4, bld128(rW, wlo, ws_o + (unsigned)(it * 16 * 512))); vreg[it] = bld128(rV, vlo, vs_o + (unsigned)(it * 16 * AW * 2)); } } while (0)
        MIX_LOAD(0);
        __syncthreads();
#pragma unroll 1
        for (int g = 0; g < 8; ++g) {
            const unsigned us_o = (unsigned)tok0 * (AW * 2) + (unsigned)g * 512u;
            const unsigned ulo = (unsigned)(fr * (AW * 2) + (32 * w + 4 * fq) * 2);
            v2u ureg[2][4][2];
#pragma unroll
            for (int hf = 0; hf < 2; ++hf)
#pragma unroll
                for (int m4 = 0; m4 < 4; ++m4)
#pragma unroll
                    for (int n2 = 0; n2 < 2; ++n2) ureg[hf][m4][n2] = bld64(rU, ulo, us_o + (unsigned)((16 * (4 * hf + m4)) * AW * 2 + 32 * n2));
#pragma unroll
            for (int it = 0; it < 8; ++it) { const int idx = it * 512 + tid, t = idx >> 5, s4 = (idx & 31) * 4; const f32x4 wv = wreg[it];
                const float a0 = (s4 + 0 <= t) ? wv[0] * rsv[s4 + 0] : 0.f, a1 = (s4 + 1 <= t) ? wv[1] * rsv[s4 + 1] : 0.f, a2 = (s4 + 2 <= t) ? wv[2] * rsv[s4 + 2] : 0.f, a3 = (s4 + 3 <= t) ? wv[3] * rsv[s4 + 3] : 0.f;
                v2u o; o.x = pk2(a0, a1); o.y = pk2(a2, a3); *(LAS v2u*)(lds + WT_OFF + t * WT_ST + s4 * 2) = o;
                *(LAS v4u*)(lds + V_OFF + (idx >> 5) * V_ST + (idx & 31) * 16) = vreg[it]; }
            __syncthreads();
            if (g + 1 < 8) MIX_LOAD(g + 1);
#pragma unroll
            for (int hf = 0; hf < 2; ++hf) {
                f32x4 acc[4][2];
#pragma unroll
                for (int m4 = 0; m4 < 4; ++m4) { acc[m4][0] = (f32x4){0.f, 0.f, 0.f, 0.f}; acc[m4][1] = (f32x4){0.f, 0.f, 0.f, 0.f}; }
#pragma unroll
                for (int ks = 0; ks < 4; ++ks) { if (32 * ks > 16 * (4 * hf + 3) + 15) continue;
                    const bf16x8 b0 = tr_frag(lds + vfo + (32 * ks) * V_ST, lds + vfo + (32 * ks + 16) * V_ST), b1 = tr_frag(lds + vfo + (32 * ks) * V_ST + 32, lds + vfo + (32 * ks + 16) * V_ST + 32);
#pragma unroll
                    for (int m4 = 0; m4 < 4; ++m4) { const int mt = 4 * hf + m4; if (32 * ks > 16 * mt + 15) continue;
                        const v2u lo = *(const LAS v2u*)(lds + wfo + mt * 16 * WT_ST + ks * 64), hi = *(const LAS v2u*)(lds + wfo + mt * 16 * WT_ST + ks * 64 + 32);
                        const v4u av = {lo.x, lo.y, hi.x, hi.y}; const bf16x8 a = __builtin_bit_cast(bf16x8, av);
                        acc[m4][0] = MFMA16(b0, a, acc[m4][0]); acc[m4][1] = MFMA16(b1, a, acc[m4][1]); }
                    __builtin_amdgcn_sched_barrier(0); }
#pragma unroll
                for (int m4 = 0; m4 < 4; ++m4) { const int t = 16 * (4 * hf + m4) + fr; const float bt = bsl[g * 128 + t];
#pragma unroll
                    for (int n2 = 0; n2 < 2; ++n2) { const int col = g * 256 + 32 * w + 16 * n2 + 4 * fq;
                        const v2u uu = ureg[hf][m4][n2]; const f32x4 gg = *(const LAS f32x4*)(vgl + col); const f32x4 a = acc[m4][n2];
                        v2u r; r.x = pk2(bflo(uu.x) * (a[0] * gg[0] + bt), bfhi(uu.x) * (a[1] * gg[1] + bt)); r.y = pk2(bflo(uu.y) * (a[2] * gg[2] + bt), bfhi(uu.y) * (a[3] * gg[3] + bt));
                        if constexpr (Y8) { int p8 = __builtin_amdgcn_cvt_pk_fp8_f32(pg8::c8(4.0f * bflo(uu.x) * (a[0] * gg[0] + bt)), pg8::c8(4.0f * bfhi(uu.x) * (a[1] * gg[1] + bt)), 0, false);
                            p8 = __builtin_amdgcn_cvt_pk_fp8_f32(pg8::c8(4.0f * bflo(uu.y) * (a[2] * gg[2] + bt)), pg8::c8(4.0f * bfhi(uu.y) * (a[3] * gg[3] + bt)), p8, true);
                            __builtin_amdgcn_raw_buffer_store_b32((unsigned)p8, rY, ulo8, (unsigned)tok0 * AW + (unsigned)g * 256u + (unsigned)((16 * (4 * hf + m4)) * AW + 16 * n2), 0); }
                        else bst64(rY, ulo, us_o + (unsigned)((16 * (4 * hf + m4)) * AW * 2 + 32 * n2), r); }
                    __builtin_amdgcn_sched_barrier(0); }
            }
            __syncthreads();
        }
#undef MIX_LOAD
    }
}

DI void gla_prep_phase(Frame& F, const float* wg2, const float* gb) {
    constexpr int GL_OFF = 0, SEG_OFF = 4096, OFFS_OFF = 6144, EBL_OFF = 8192, BC_OFF = 8704, KETL_OFF = 41472, VTL_OFF = 59904, TST = 144;
    const bf16* QKVR = wsp<bf16>(F, WS_QKVR); const float* glow = wsp<float>(F, WS_GLOW);
    bf16* QD = wsp<bf16>(F, WS_QD); bf16* KD = wsp<bf16>(F, WS_KD); bf16* KET = wsp<bf16>(F, WS_KET); bf16* VT = wsp<bf16>(F, WS_VT); float* DEC = wsp<float>(F, WS_DEC);
    LAS unsigned char* lds = F.lds;
    LAS float* gl = (LAS float*)(lds + GL_OFF); LAS float* segs = (LAS float*)(lds + SEG_OFF); LAS float* offs = (LAS float*)(lds + OFFS_OFF); LAS float* ebl = (LAS float*)(lds + EBL_OFF); LAS float* bcl = (LAS float*)(lds + BC_OFF);
    const int tid = F.tid;
    const int t2 = tid >> 3, kb = (tid & 7) * 16, dvb = (tid & 7) * 32, k = tid & 127, tq = tid >> 7;
    float wv[16]; float bias = 0.f; int hcur = -1;
    v4u q0, q1, k0, k1, vv[4]; f32x4 gv = {0.f, 0.f, 0.f, 0.f};
#define PREP_LOAD(uu) do { const int h_ = (uu) & 3, n_ = ((uu) >> 2) & 63, b_ = (uu) >> 8; const int t0_ = b_ * SEQ + n_ * 64; const bf16* rowp = QKVR + (size_t)(t0_ + t2) * 3072; \
        q0 = *(const v4u*)(rowp + h_ * 128 + kb); q1 = *(const v4u*)(rowp + h_ * 128 + kb + 8); k0 = *(const v4u*)(rowp + 512 + h_ * 128 + kb); k1 = *(const v4u*)(rowp + 512 + h_ * 128 + kb + 8); \
        _Pragma("unroll") for (int i = 0; i < 4; ++i) vv[i] = *(const v4u*)(rowp + 1024 + h_ * 256 + dvb + 8 * i); \
        if (tid < 256) gv = *((const f32x4*)(glow + (size_t)t0_ * 16) + tid); } while (0)
#define PREP_MAP(s) ((((s) & 255) >> 5) * 256 + ((s) & 31) + 32 * ((s) >> 8))
    if (F.vcu < 2048) PREP_LOAD(PREP_MAP(F.vcu));
    for (int sidx = F.vcu; sidx < 2048; sidx += F.G) { const int uidx = PREP_MAP(sidx);
        const int h = uidx & 3, n = (uidx >> 2) & 63, b = uidx >> 8; const int t0 = b * SEQ + n * 64; const int bhn = (b * 4 + h) * 64 + n;
        if (h != hcur) { hcur = h;
#pragma unroll
            for (int r = 0; r < 16; ++r) wv[r] = wg2[r * 512 + h * 128 + k];
            bias = gb[h * 128 + k]; }
        if (tid < 256) *((LAS f32x4*)gl + tid) = gv;
        __syncthreads();
        { float cum = 0.f;
#pragma unroll
          for (int i = 0; i < 16; ++i) { const LAS f32x4* gp = (const LAS f32x4*)(gl + (tq * 16 + i) * 16); float z = bias;
#pragma unroll
              for (int q = 0; q < 4; ++q) { const f32x4 g4 = gp[q]; z += g4[0] * wv[4 * q] + g4[1] * wv[4 * q + 1] + g4[2] * wv[4 * q + 2] + g4[3] * wv[4 * q + 3]; }
              cum += (fminf(z, 0.f) - __logf(1.0f + __expf(-fabsf(z)))) * (1.0f / 16.0f); bcl[(tq * 16 + i) * 128 + k] = cum; }
          segs[tq * 128 + k] = cum; }
        __syncthreads();
        if (tid < 128) { const float s0 = segs[tid], s1 = segs[128 + tid], s2 = segs[256 + tid], s3 = segs[384 + tid];
            offs[tid] = 0.f; offs[128 + tid] = s0; offs[256 + tid] = s0 + s1; offs[384 + tid] = (s0 + s1) + s2;
            const float eb = __expf(((s0 + s1) + s2) + s3); ebl[tid] = eb; DEC[(size_t)bhn * 128 + tid] = eb; }
        __syncthreads();
        { const int tq2 = t2 >> 4; unsigned qo[8], ko[8]; const unsigned qw[8] = {q0.x, q0.y, q0.z, q0.w, q1.x, q1.y, q1.z, q1.w}, kw[8] = {k0.x, k0.y, k0.z, k0.w, k1.x, k1.y, k1.z, k1.w};
          LAS unsigned short* kt = (LAS unsigned short*)(lds + KETL_OFF); const int rot = ((t2 * 2 + 16 * (tid & 7)) & 127) >> 1;
#pragma unroll
          for (int e = 0; e < 16; e += 2) { float qd2[2], kd2[2];
#pragma unroll
              for (int u = 0; u < 2; ++u) { const int kk = kb + e + u; const float bcum = bcl[t2 * 128 + kk] + offs[tq2 * 128 + kk];
                  const float e1 = __expf(bcum), e2 = __builtin_amdgcn_rcpf(e1);
                  const float qv = u ? bfhi(qw[e >> 1]) : bflo(qw[e >> 1]), kv = u ? bfhi(kw[e >> 1]) : bflo(kw[e >> 1]);
                  qd2[u] = qv * 0.08838834764831845f * e1; kd2[u] = kv * e2;
                  kt[kk * (TST / 2) + rot] = (unsigned short)f2bf(kv * e2 * ebl[kk]); }
              qo[e >> 1] = pk2(qd2[0], qd2[1]); ko[e >> 1] = pk2(kd2[0], kd2[1]); }
          bf16* qdp = QD + (size_t)(t0 + t2) * 512 + h * 128 + kb; bf16* kdp = KD + (size_t)(t0 + t2) * 512 + h * 128 + kb;
          { v4u a = {qo[0], qo[1], qo[2], qo[3]}, c = {qo[4], qo[5], qo[6], qo[7]}; *(v4u*)qdp = a; *(v4u*)(qdp + 8) = c; }
          { v4u a = {ko[0], ko[1], ko[2], ko[3]}, c = {ko[4], ko[5], ko[6], ko[7]}; *(v4u*)kdp = a; *(v4u*)(kdp + 8) = c; }
          LAS unsigned short* vt = (LAS unsigned short*)(lds + VTL_OFF);
#pragma unroll
          for (int i = 0; i < 4; ++i) { const unsigned w4[4] = {vv[i].x, vv[i].y, vv[i].z, vv[i].w};
#pragma unroll
              for (int e = 0; e < 4; ++e) { const int dv = dvb + 8 * i + 2 * e; vt[dv * (TST / 2) + rot] = (unsigned short)(w4[e] & 0xffffu); vt[(dv + 1) * (TST / 2) + rot] = (unsigned short)(w4[e] >> 16); } } }
        if (sidx + F.G < 2048) PREP_LOAD(PREP_MAP(sidx + F.G));
        __syncthreads();
#pragma unroll
        for (int i = 0; i < 2; ++i) { const int c = tid + 512 * i, r = c >> 3, ch = c & 7;
            *(v4u*)(KET + ((size_t)bhn * 128 + r) * 64 + ch * 8) = *(const LAS v4u*)(lds + KETL_OFF + r * TST + (((ch + (r >> 4)) & 7) * 16)); }
#pragma unroll
        for (int i = 0; i < 4; ++i) { const int c = tid + 512 * i, r = c >> 3, ch = c & 7;
            *(v4u*)(VT + ((size_t)bhn * 256 + r) * 64 + ch * 8) = *(const LAS v4u*)(lds + VTL_OFF + r * TST + (((ch + (r >> 5)) & 7) * 16)); }
        __syncthreads();
    }
#undef PREP_LOAD
#undef PREP_MAP
}

template <class A> DI void gla_scan_phase(Frame& F, const A& P) {
    constexpr int QD_OFF = 0, KD_OFF = 17408, KET_OFF = 34816, VT_OFF = 53248, ATT_OFF = 57856, ST_OFF = 67072, ST272 = 272, ST144 = 144;
    const bf16* QD = wsp<bf16>(F, WS_QD); const bf16* KD = wsp<bf16>(F, WS_KD); const bf16* KET = wsp<bf16>(F, WS_KET); const bf16* VT = wsp<bf16>(F, WS_VT); const float* DEC = wsp<float>(F, WS_DEC);
    bf16* GO = wsp<bf16>(F, WS_GO); float* ossq = wsp<float>(F, WS_OSSQ);
    LAS unsigned char* lds = F.lds;
    const int tid = F.tid, lane = F.lane, w = F.wave, fr = lane & 15, fq = lane >> 4;
    LAS unsigned char* SC = lds + 76800;
    P0State cst; p0_init(cst, F, P, N_EARLY, NMATS, F.vcu, F.G);
    f32x4 rC[8]; float gC[8]; P0Dst dC; dC.base = nullptr; dC.K = 0; dC.f8 = 0; bool hC = false;
    P0_NEXT(cst, rC, gC, dC, hC);
    for (int uidx = F.vcu; uidx < 256; uidx += F.G) {
        const int vb = uidx & 7, h = (uidx >> 3) & 3, b = uidx >> 5;
        for (int i = tid; i < (32 * ST272) / 4; i += NWAVES * 64) ((LAS unsigned*)(lds + ST_OFF))[i] = 0u;
        f32x4 st[2] = {(f32x4){0.f, 0.f, 0.f, 0.f}, (f32x4){0.f, 0.f, 0.f, 0.f}};
        v4u pq[2], pk[2], pe[2], pv; float pdec;
#define GLA_LOAD(nn) do { const int bhn_ = (b * 4 + h) * 64 + (nn); const size_t t0_ = (size_t)b * SEQ + (size_t)(nn) * 64; \
            _Pragma("unroll") for (int i_ = 0; i_ < 2; ++i_) { const int c_ = tid + 512 * i_; const int r_ = c_ >> 4, ch_ = c_ & 15; \
                pq[i_] = *(const v4u*)(QD + (t0_ + r_) * 512 + h * 128 + ch_ * 8); pk[i_] = *(const v4u*)(KD + (t0_ + r_) * 512 + h * 128 + ch_ * 8); \
                pe[i_] = *(const v4u*)(KET + (size_t)bhn_ * 8192 + (size_t)c_ * 8); } \
            if (tid < 256) pv = *(const v4u*)(VT + ((size_t)bhn_ * 256 + vb * 32) * 64 + (size_t)tid * 8); \
            pdec = DEC[(size_t)bhn_ * 128 + 16 * w + fr]; } while (0)
        GLA_LOAD(0);
        for (int n = 0; n < 64; ++n) {
#pragma unroll
            for (int i = 0; i < 2; ++i) { const int c = tid + 512 * i; const int r = c >> 4, ch = c & 15;
                *(LAS v4u*)(lds + QD_OFF + r * ST272 + ch * 16) = pq[i]; *(LAS v4u*)(lds + KD_OFF + r * ST272 + ch * 16) = pk[i];
                const int rk = c >> 3, ck = c & 7; *(LAS v4u*)(lds + KET_OFF + rk * ST144 + ck * 16) = pe[i]; }
            if (tid < 256) { const int rv = tid >> 3, cv = tid & 7; *(LAS v4u*)(lds + VT_OFF + rv * ST144 + cv * 16) = pv; }
            const float dec = pdec;
            __syncthreads();
            if (n + 1 < 64) GLA_LOAD(n + 1);
            const int mt = w & 3, nt = w >> 2;
            const size_t tok0 = (size_t)b * SEQ + (size_t)n * 64;
            f32x4 oacc = {0.f, 0.f, 0.f, 0.f};
#pragma unroll
            for (int ks = 0; ks < 4; ++ks) { const bf16x8 a = ldsfrag(lds + QD_OFF + (16 * mt + fr) * ST272 + (32 * ks + 8 * fq) * 2), bb = ldsfrag(lds + ST_OFF + (16 * nt + fr) * ST272 + (32 * ks + 8 * fq) * 2);
                oacc = MFMA16(bb, a, oacc); }
#pragma unroll
            for (int q = 0; q < 2; ++q) { const int stile = 2 * nt + q; f32x4 sacc = {0.f, 0.f, 0.f, 0.f};
                if (stile <= mt) {
#pragma unroll
                    for (int ks = 0; ks < 4; ++ks) { const bf16x8 a = ldsfrag(lds + QD_OFF + (16 * mt + fr) * ST272 + (32 * ks + 8 * fq) * 2), bb = ldsfrag(lds + KD_OFF + (16 * stile + fr) * ST272 + (32 * ks + 8 * fq) * 2);
                        sacc = MFMA16(bb, a, sacc); } }
                const int t = 16 * mt + fr, s0 = 16 * stile + 4 * fq;
                const float a0 = (s0 + 0 <= t) ? sacc[0] : 0.f, a1 = (s0 + 1 <= t) ? sacc[1] : 0.f, a2 = (s0 + 2 <= t) ? sacc[2] : 0.f, a3 = (s0 + 3 <= t) ? sacc[3] : 0.f;
                v2u o; o.x = pk2(a0, a1); o.y = pk2(a2, a3); *(LAS v2u*)(lds + ATT_OFF + t * ST144 + s0 * 2) = o; }
#pragma unroll
            for (int vt = 0; vt < 2; ++vt) { st[vt] = st[vt] * dec;
#pragma unroll
                for (int ks = 0; ks < 2; ++ks) { const bf16x8 a = ldsfrag(lds + VT_OFF + (16 * vt + fr) * ST144 + (32 * ks + 8 * fq) * 2), bb = ldsfrag(lds + KET_OFF + (16 * w + fr) * ST144 + (32 * ks + 8 * fq) * 2);
                    st[vt] = MFMA16(a, bb, st[vt]); } }
            const bool cw = hC; const P0Dst dW = dC;
            if (cw) { P0_WRITE(SC, rC, gC, dC); P0_NEXT(cst, rC, gC, dC, hC); }
            __syncthreads();
            if (cw) { P0_STORE(SC, dW); }
#pragma unroll
            for (int vt = 0; vt < 2; ++vt)
#pragma unroll
                for (int j = 0; j < 4; ++j) *(LAS unsigned short*)(lds + ST_OFF + (16 * vt + 4 * fq + j) * ST272 + (16 * w + fr) * 2) = (unsigned short)f2bf(st[vt][j]);
#pragma unroll
            for (int ks = 0; ks < 2; ++ks) { const bf16x8 a = ldsfrag(lds + ATT_OFF + (16 * mt + fr) * ST144 + (32 * ks + 8 * fq) * 2), bb = ldsfrag(lds + VT_OFF + (16 * nt + fr) * ST144 + (32 * ks + 8 * fq) * 2);
                oacc = MFMA16(bb, a, oacc); }
            { const size_t tok = tok0 + 16 * mt + fr; const int col = h * 256 + vb * 32 + 16 * nt + 4 * fq;
              v2u o; o.x = pk2(oacc[0], oacc[1]); o.y = pk2(oacc[2], oacc[3]); *(v2u*)(GO + tok * 1024 + col) = o;
              float sq = (oacc[0] * oacc[0] + oacc[1] * oacc[1]) + (oacc[2] * oacc[2] + oacc[3] * oacc[3]); sq += __shfl_xor(sq, 16); sq += __shfl_xor(sq, 32);
              if (fq == 0) ossq[(tok * 4 + h) * 16 + vb * 2 + nt] = sq; }
            __syncthreads();
        }
#undef GLA_LOAD
    }
    while (hC) { const P0Dst dW = dC; P0_WRITE(SC, rC, gC, dC); P0_NEXT(cst, rC, gC, dC, hC); __syncthreads(); P0_STORE(SC, dW); __syncthreads(); }
}
DI void gla_gate_phase(Frame& F, const float* og) {
    const bf16* GO = wsp<bf16>(F, WS_GO); const bf16* QKVR = wsp<bf16>(F, WS_QKVR); const float* ossq = wsp<float>(F, WS_OSSQ); bf16* GG = wsp<bf16>(F, WS_GG);
    const int gw = F.vcu * NWAVES + F.wave, NGW = F.G * NWAVES, lane = F.lane;
    const int c0 = 16 * lane, hh = lane >> 4;
    f32x4 g4[4];
#pragma unroll
    for (int q = 0; q < 4; ++q) g4[q] = *(const f32x4*)(og + (c0 & 255) + 4 * q);
    constexpr int RB = 4;
#define GATE_MAP(r) ((((r) & 2047) >> 8) * 4096 + ((r) & 255) + 256 * ((r) >> 11))
    for (int m0 = gw; m0 < M; m0 += RB * NGW) {
        f32x4 sv[RB][4]; v4u ov[RB][2], rv[RB][2];
#pragma unroll
        for (int i = 0; i < RB; ++i) { const int r_ = m0 + i * NGW, m = GATE_MAP(r_); if (r_ < M) { const f32x4* sp = (const f32x4*)(ossq + ((size_t)m * 4 + hh) * 16);
#pragma unroll
                for (int q = 0; q < 4; ++q) sv[i][q] = sp[q];
                const v4u* op = (const v4u*)(GO + (size_t)m * 1024 + c0); const v4u* rp = (const v4u*)(QKVR + (size_t)m * 3072 + 2048 + c0);
                ov[i][0] = op[0]; ov[i][1] = op[1]; rv[i][0] = rp[0]; rv[i][1] = rp[1]; } }
#pragma unroll
        for (int i = 0; i < RB; ++i) { const int r_ = m0 + i * NGW, m = GATE_MAP(r_); if (r_ < M) { float s = 0.f;
#pragma unroll
                for (int q = 0; q < 4; ++q) { const f32x4 a = sv[i][q]; s += (a[0] + a[1]) + (a[2] + a[3]); }
                const float rs = 1.0f / sqrtf(s * (1.0f / 256.0f) + EPS);
                v4u* dp = (v4u*)(GG + (size_t)m * 1024 + c0);
                if constexpr (BOUT_F8 != 0) { const float r8 = 8.0f * rs; unsigned w8[4];
#pragma unroll
                    for (int q = 0; q < 2; ++q) { const v4u o = ov[i][q], r = rv[i][q]; const f32x4 ga = g4[2 * q], gb = g4[2 * q + 1];
                        int a_ = __builtin_amdgcn_cvt_pk_fp8_f32(pg8::c8(bflo(o.x) * r8 * ga[0] * pg8::silu_f(bflo(r.x))), pg8::c8(bfhi(o.x) * r8 * ga[1] * pg8::silu_f(bfhi(r.x))), 0, false);
                        a_ = __builtin_amdgcn_cvt_pk_fp8_f32(pg8::c8(bflo(o.y) * r8 * ga[2] * pg8::silu_f(bflo(r.y))), pg8::c8(bfhi(o.y) * r8 * ga[3] * pg8::silu_f(bfhi(r.y))), a_, true);
                        int b_ = __builtin_amdgcn_cvt_pk_fp8_f32(pg8::c8(bflo(o.z) * r8 * gb[0] * pg8::silu_f(bflo(r.z))), pg8::c8(bfhi(o.z) * r8 * gb[1] * pg8::silu_f(bfhi(r.z))), 0, false);
                        b_ = __builtin_amdgcn_cvt_pk_fp8_f32(pg8::c8(bflo(o.w) * r8 * gb[2] * pg8::silu_f(bflo(r.w))), pg8::c8(bfhi(o.w) * r8 * gb[3] * pg8::silu_f(bfhi(r.w))), b_, true);
                        w8[2 * q] = (unsigned)a_; w8[2 * q + 1] = (unsigned)b_; }
                    *(v4u*)((unsigned char*)GG + (size_t)m * 1024 + c0) = (v4u){w8[0], w8[1], w8[2], w8[3]}; }
                else
#pragma unroll
                for (int q = 0; q < 2; ++q) { const v4u o = ov[i][q], r = rv[i][q]; v4u d; const f32x4 ga = g4[2 * q], gb = g4[2 * q + 1];
                    d.x = pk2(bflo(o.x) * rs * ga[0] * pg8::silu_f(bflo(r.x)), bfhi(o.x) * rs * ga[1] * pg8::silu_f(bfhi(r.x)));
                    d.y = pk2(bflo(o.y) * rs * ga[2] * pg8::silu_f(bflo(r.y)), bfhi(o.y) * rs * ga[3] * pg8::silu_f(bfhi(r.y)));
                    d.z = pk2(bflo(o.z) * rs * gb[0] * pg8::silu_f(bflo(r.z)), bfhi(o.z) * rs * gb[1] * pg8::silu_f(bfhi(r.z)));
                    d.w = pk2(bflo(o.w) * rs * gb[2] * pg8::silu_f(bflo(r.w)), bfhi(o.w) * rs * gb[3] * pg8::silu_f(bfhi(r.w)));
                    dp[q] = d; } } }
    }
}
#undef GATE_MAP

DI void fox_attn_phase(Frame& F, const unsigned* knb) {
    constexpr int KST = 272, VST = 288, STAGE = 64 * KST + 64 * VST, V_OFF = 64 * KST, C_OFF = 2 * STAGE, WS_OFF = C_OFF + 16384;
    const bf16* QKV = wsp<bf16>(F, WS_QKVR); const float* logf = wsp<float>(F, WS_LOGF); bf16* AO = wsp<bf16>(F, WS_AO);
    LAS unsigned char* lds = F.lds; LAS float* cl = (LAS float*)(lds + C_OFF); LAS float* wsum = (LAS float*)(lds + WS_OFF); LAS unsigned* dflag = (LAS unsigned*)(lds + WS_OFF + 64);
    const int tid = F.tid, lane = F.lane, w = F.wave, fr = lane & 15, fq = lane >> 4;
    constexpr float SC2 = 0.08838834764831845f * 1.4426950408889634f, L2E = 1.4426950408889634f, THR = 8.0f;
    const int kfo = fr * KST + fq * 16;
    const int vfo = (4 * fq + (fr >> 2)) * VST + (fr & 3) * 8;
    int cur_bh = -1;
    for (int U = F.vcu; U < 1024; U += F.G) {
        const int r_ = U >> 8, v_ = U & 255, bh = v_ >> 2, i_ = v_ & 3; const int b = bh >> 3, h = bh & 7;
        const int qt = (r_ == 0) ? i_ : (r_ == 1) ? 7 - i_ : (r_ == 2) ? 8 + i_ : 15 - i_;
        if (bh != cur_bh) { cur_bh = bh;
          __syncthreads();
          float v8[8]; float tot = 0.f; const int p0 = tid * 8;
          { const float* lp = logf + ((size_t)b * SEQ + p0) * 8 + h;
#pragma unroll
              for (int e = 0; e < 8; ++e) v8[e] = lp[8 * e]; }
#pragma unroll
          for (int e = 0; e < 8; ++e) { tot += v8[e]; v8[e] = tot; }
          float inc = tot;
#pragma unroll
          for (int o = 1; o < 64; o <<= 1) { const float t = __shfl_up(inc, o); if (lane >= o) inc += t; }
          if (lane == 63) wsum[w] = inc;
          __syncthreads();
          float woff = 0.f;
#pragma unroll
          for (int q = 0; q < 8; ++q) woff += (q < w) ? wsum[q] : 0.f;
          const float excl = woff + inc - tot;
#pragma unroll
          for (int e = 0; e < 8; ++e) cl[p0 + e] = -L2E * (excl + v8[e]);
        }
        const int q0 = qt * 256 + 32 * w;
        bf16x8 qf[2][4]; float mrow[2], lrow[2]; f32x4 oacc[2][8];
#pragma unroll
        for (int mt = 0; mt < 2; ++mt) { const size_t tok = (size_t)b * SEQ + q0 + 16 * mt + fr;
#pragma unroll
            for (int ks = 0; ks < 4; ++ks) qf[mt][ks] = *(const bf16x8*)(QKV + tok * 3072 + h * 128 + 32 * ks + 8 * fq);
            mrow[mt] = -1.0e30f; lrow[mt] = 0.f;
#pragma unroll
            for (int dt = 0; dt < 8; ++dt) oacc[mt][dt] = (f32x4){0.f, 0.f, 0.f, 0.f}; }
        const int ntiles = 4 * (qt + 1);
        float qk_bound;
        { float q2 = 0.f;
#pragma unroll
          for (int mt = 0; mt < 2; ++mt) { float s = 0.f;
#pragma unroll
              for (int ks = 0; ks < 4; ++ks) { const v4u qq = __builtin_bit_cast(v4u, qf[mt][ks]);
                  s += (bflo(qq.x) * bflo(qq.x) + bfhi(qq.x) * bfhi(qq.x)) + (bflo(qq.y) * bflo(qq.y) + bfhi(qq.y) * bfhi(qq.y)) + (bflo(qq.z) * bflo(qq.z) + bfhi(qq.z) * bfhi(qq.z)) + (bflo(qq.w) * bflo(qq.w) + bfhi(qq.w) * bfhi(qq.w)); }
              s += __shfl_xor(s, 16); s += __shfl_xor(s, 32); q2 = fmaxf(q2, s); }
#pragma unroll
          for (int o = 1; o < 16; o <<= 1) q2 = fmaxf(q2, __shfl_xor(q2, o));
          const unsigned* kp = knb + (b * 8 + h) * 4; const float k2 = (__builtin_bit_cast(float, kp[0]) + __builtin_bit_cast(float, kp[1])) + (__builtin_bit_cast(float, kp[2]) + __builtin_bit_cast(float, kp[3]));
          qk_bound = sqrtf(q2 * k2) * (SC2 * 1.02f); }
        bool wdone = false;
        if (tid < 8) dflag[tid] = 0u;
        v4u pk_[2], pv_[2];
#define FOX_LOAD(jj) do { _Pragma("unroll") for (int i2 = 0; i2 < 2; ++i2) { const int c2 = tid + 512 * i2; const bf16* rp = QKV + ((size_t)b * SEQ + 64 * (jj) + (c2 >> 4)) * 3072 + h * 128 + (c2 & 15) * 8; \
            pk_[i2] = *(const v4u*)(rp + 1024); pv_[i2] = *(const v4u*)(rp + 2048); } } while (0)
#define FOX_STORE(st) do { _Pragma("unroll") for (int i2 = 0; i2 < 2; ++i2) { const int c2 = tid + 512 * i2; \
            *(LAS v4u*)(lds + (st) * STAGE + (c2 >> 4) * KST + (c2 & 15) * 16) = pk_[i2]; *(LAS v4u*)(lds + (st) * STAGE + V_OFF + (c2 >> 4) * VST + (c2 & 15) * 16) = pv_[i2]; } } while (0)
        FOX_LOAD(ntiles - 1);
        FOX_STORE(0);
        __syncthreads();
        for (int it = 0; it < ntiles; ++it) {
            const int j = ntiles - 1 - it, cur = it & 1; const int key0 = 64 * j;
            if (it + 1 < ntiles) FOX_LOAD(j - 1);
            if (!wdone && key0 <= q0 + 31) {
                LAS const unsigned char* kb = lds + cur * STAGE + kfo; LAS const unsigned char* vb = lds + cur * STAGE + V_OFF + vfo;
                f32x4 sacc[4][2];
#pragma unroll
                for (int nt = 0; nt < 4; ++nt) { sacc[nt][0] = (f32x4){0.f, 0.f, 0.f, 0.f}; sacc[nt][1] = (f32x4){0.f, 0.f, 0.f, 0.f}; }
                { bf16x8 ka[2][4];
#pragma unroll
                  for (int nt = 0; nt < 4; ++nt) ka[0][nt] = ldsfrag(kb + nt * 16 * KST);
#pragma unroll
                  for (int ks = 0; ks < 4; ++ks) {
                    if (ks + 1 < 4) {
#pragma unroll
                        for (int nt = 0; nt < 4; ++nt) ka[(ks + 1) & 1][nt] = ldsfrag(kb + nt * 16 * KST + (ks + 1) * 64); }
#pragma unroll
                    for (int nt = 0; nt < 4; ++nt) { sacc[nt][0] = MFMA16(ka[ks & 1][nt], qf[0][ks], sacc[nt][0]); sacc[nt][1] = MFMA16(ka[ks & 1][nt], qf[1][ks], sacc[nt][1]); } } }
                float mx0 = -__builtin_inff(), mx1 = -__builtin_inff();
#pragma unroll
                for (int nt = 0; nt < 4; ++nt) { const f32x4 ck = *(const LAS f32x4*)(cl + key0 + 16 * nt + 4 * fq);
                    sacc[nt][0] = sacc[nt][0] * SC2 + ck; sacc[nt][1] = sacc[nt][1] * SC2 + ck; }
                if (key0 + 63 > q0) {
#pragma unroll
                    for (int nt = 0; nt < 4; ++nt)
#pragma unroll
                        for (int e = 0; e < 4; ++e) { const int key = key0 + 16 * nt + 4 * fq + e;
                            if (key > q0 + fr) sacc[nt][0][e] = -__builtin_inff();
                            if (key > q0 + 16 + fr) sacc[nt][1][e] = -__builtin_inff(); } }
#pragma unroll
                for (int nt = 0; nt < 4; ++nt) { mx0 = fmaxf(mx0, fmaxf(fmaxf(sacc[nt][0][0], sacc[nt][0][1]), fmaxf(sacc[nt][0][2], sacc[nt][0][3])));
                    mx1 = fmaxf(mx1, fmaxf(fmaxf(sacc[nt][1][0], sacc[nt][1][1]), fmaxf(sacc[nt][1][2], sacc[nt][1][3]))); }
                mx0 = fmaxf(mx0, __shfl_xor(mx0, 16)); mx0 = fmaxf(mx0, __shfl_xor(mx0, 32)); mx1 = fmaxf(mx1, __shfl_xor(mx1, 16)); mx1 = fmaxf(mx1, __shfl_xor(mx1, 32));
                if (__any((mx0 > mrow[0] + THR) || (mx1 > mrow[1] + THR))) {
                    const float n0 = fmaxf(mrow[0], mx0), n1 = fmaxf(mrow[1], mx1);
                    const float a0 = __builtin_amdgcn_exp2f(mrow[0] - n0), a1 = __builtin_amdgcn_exp2f(mrow[1] - n1);
                    mrow[0] = n0; mrow[1] = n1; lrow[0] *= a0; lrow[1] *= a1;
#pragma unroll
                    for (int dt = 0; dt < 8; ++dt) { oacc[0][dt] = oacc[0][dt] * a0; oacc[1][dt] = oacc[1][dt] * a1; } }
                bf16x8 pf[2][2];
#pragma unroll
                for (int mt = 0; mt < 2; ++mt) { const float mm = mrow[mt]; float ls = 0.f; unsigned pw[8];
#pragma unroll
                    for (int nt = 0; nt < 4; ++nt) { const f32x4 t = sacc[nt][mt] - mm;
                        const float p0 = __builtin_amdgcn_exp2f(t[0]), p1 = __builtin_amdgcn_exp2f(t[1]), p2 = __builtin_amdgcn_exp2f(t[2]), p3 = __builtin_amdgcn_exp2f(t[3]);
                        ls += (p0 + p1) + (p2 + p3); pw[2 * nt] = pg8::cvt_pk_bf16(p0, p1); pw[2 * nt + 1] = pg8::cvt_pk_bf16(p2, p3); }
                    lrow[mt] += ls;
                    { v4u t0 = {pw[0], pw[1], pw[2], pw[3]}, t1 = {pw[4], pw[5], pw[6], pw[7]}; pf[mt][0] = __builtin_bit_cast(bf16x8, t0); pf[mt][1] = __builtin_bit_cast(bf16x8, t1); } }
                { bf16x8 va[2][4];
#pragma unroll
                  for (int i = 0; i < 4; ++i) va[0][i] = tr_frag(vb + i * 32, vb + 16 * VST + i * 32);
#pragma unroll
                  for (int g = 0; g < 4; ++g) { const int ks2 = g >> 1, d0 = (g & 1) * 4;
                    if (g + 1 < 4) { const int ks2n = (g + 1) >> 1, d0n = ((g + 1) & 1) * 4;
#pragma unroll
                        for (int i = 0; i < 4; ++i) va[(g + 1) & 1][i] = tr_frag(vb + (32 * ks2n) * VST + (d0n + i) * 32, vb + (32 * ks2n + 16) * VST + (d0n + i) * 32); }
#pragma unroll
                    for (int i = 0; i < 4; ++i) { oacc[0][d0 + i] = MFMA16(va[g & 1][i], pf[0][ks2], oacc[0][d0 + i]); oacc[1][d0 + i] = MFMA16(va[g & 1][i], pf[1][ks2], oacc[1][d0 + i]); } } }
            }
            if (!wdone && j > 0) {
                const float mmin = fminf(mrow[0], mrow[1]); float mm = mmin; mm = fminf(mm, __shfl_xor(mm, 1)); mm = fminf(mm, __shfl_xor(mm, 2)); mm = fminf(mm, __shfl_xor(mm, 4)); mm = fminf(mm, __shfl_xor(mm, 8));
                if (key0 - 1 <= q0 + 31 && __all(qk_bound + cl[key0 - 1] - mm < -40.0f)) { wdone = true; if (lane == 0) dflag[w] = 1u; } }
            if (it + 1 < ntiles) FOX_STORE(cur ^ 1);
            __syncthreads();
            { unsigned alld = 1u;
#pragma unroll
              for (int q = 0; q < 8; ++q) alld &= dflag[q];
              if (alld) break; }
        }
        __syncthreads();
#undef FOX_LOAD
#undef FOX_STORE
#pragma unroll
        for (int mt = 0; mt < 2; ++mt) { float l = lrow[mt]; l += __shfl_xor(l, 16); l += __shfl_xor(l, 32); const float inv = 1.0f / l;
            const size_t tok = (size_t)b * SEQ + q0 + 16 * mt + fr;
#pragma unroll
            for (int dt = 0; dt < 8; ++dt) {
                if constexpr (COUT_F8 != 0) { const f32x4 o = oacc[mt][dt] * (8.0f * inv);
                    int q_ = __builtin_amdgcn_cvt_pk_fp8_f32(pg8::c8(o[0]), pg8::c8(o[1]), 0, false); q_ = __builtin_amdgcn_cvt_pk_fp8_f32(pg8::c8(o[2]), pg8::c8(o[3]), q_, true);
                    *(unsigned*)((unsigned char*)AO + tok * 1024 + h * 128 + 16 * dt + 4 * fq) = (unsigned)q_; }
                else { const f32x4 o = oacc[mt][dt] * inv; v2u r; r.x = pg8::cvt_pk_bf16(o[0], o[1]); r.y = pg8::cvt_pk_bf16(o[2], o[3]); *(v2u*)(AO + tok * 1024 + h * 128 + 16 * dt + 4 * fq) = r; } } }
    }
}

constexpr int N_PHASES = 2 + 10 * MK_LAYERS;
__host__ __device__ constexpr bool phase_active(int id) {
    if (id == 0) return true;
    if (id == 1 + 10 * MK_LAYERS) return (MK_LAYERS % 2) == 1;
    const int l = (id - 1) / 10, s = (id - 1) % 10, mixer = l % 3; const bool moe = (l % 2) == 1;
    if (s == 0 || s == 1 || s == 4) return true;
    if (s == 2 || s == 3) return mixer == 1;
    if (s == 5 || s == 6) return true;
    return moe;
}
struct Args { const float* in[22]; float* out; unsigned char* ws; int ph_lo, ph_hi; };
#define IN(k) (lo <= (k) && (k) < hi)
#ifndef PROBE_MASK
#define PROBE_MASK 0
#endif
#define REPS(bit) _Pragma("unroll 1") for (int r_ = 0; r_ < ((PROBE_MASK & (bit)) ? 2 : 1); ++r_)
#define TWICE(bit, ...) do { if constexpr ((PROBE_MASK & (bit)) != 0) { __VA_ARGS__ xcd_barrier(bar); } __VA_ARGS__ } while (0)
#define SEAM(k) do { if ((k) + 1 < hi) xcd_barrier(bar); } while (0)
#define SEAML(k) do { if ((k) + 1 < hi) { if (F.MISC[10]) xcd_barrier_local(bar); else xcd_barrier(bar); } } while (0)
template <int L> DI void run_layer(Frame& F, const Args& args, const XcdBarrier& bar, const int lo, const int hi) {
    constexpr int l = L, mixer = L % 3, jm = L / 3, fi = L / 2, pb = 1 + 10 * L; constexpr bool moe = (L & 1) != 0;
    bf16* XB = wsp<bf16>(F, WS_XB); float* SSQ = wsp<float>(F, WS_SSQ);
    if (IN(pb + 0)) {
        if constexpr (mixer == 0) {
            if constexpr (l == 3 && AIN_F8 != 0) {
                pg8::Gemm g{(const bf16*)wsp<unsigned char>(F, WS_X8), wsp<bf16>(F, WS_WA_IN) + (size_t)jm * 4096 * 1024, M, 4096, D / 2}; pg8::StaticOrder S; S.init(M, 4096, F.G, (int)blockIdx.x);
                pg8::EpiAin E{SSQ, wsp<bf16>(F, WS_U), wsp<bf16>(F, WS_V), wsp<float>(F, WS_VSSQ), 1.0f / 64.0f};
                pg8::gemm_phase<pg8::EpiAin, pg8::StaticOrder, true, true, true>(F.lds + RING_OFF, g, S, E);
            } else {
                pg8::Gemm g{XB, wsp<bf16>(F, WS_WA_IN) + (size_t)jm * 4096 * 1024, M, 4096, D}; pg8::StaticOrder S; S.init(M, 4096, F.G, (int)blockIdx.x);
                pg8::EpiAin E{SSQ, wsp<bf16>(F, WS_U), wsp<bf16>(F, WS_V), wsp<float>(F, WS_VSSQ), 1.0f};
                pg8::gemm_phase<pg8::EpiAin, pg8::StaticOrder, true, true>(F.lds + RING_OFF, g, S, E);
            }
        } else {
            REPS(128) { if constexpr (mixer == 1) glow_phase(F, XB, args.in[1] + l * 1024, args.in[8]); else logf_phase(F, XB, args.in[1] + l * 1024, args.in[13], args.in[14]); }
            if constexpr (mixer == 2 && CIN_F8 != 0) {
                pg8::Gemm g{(const bf16*)wsp<unsigned char>(F, WS_X8), wsp<bf16>(F, WS_WC_IN), M, 3072, D / 2}; pg8::StaticOrder S; S.init(M, 3072, F.G, (int)blockIdx.x);
                pg8::EpiRow<true> E{SSQ, wsp<bf16>(F, WS_QKVR), 3072, (unsigned*)(F.ctl + CW_KNB), 1.0f / 64.0f};
                pg8::gemm_phase<pg8::EpiRow<true>, pg8::StaticOrder, true, true, true>(F.lds + RING_OFF, g, S, E);
            } else {
                pg8::Gemm g{XB, mixer == 1 ? wsp<bf16>(F, WS_WB_IN) : wsp<bf16>(F, WS_WC_IN), M, 3072, D}; pg8::StaticOrder S; S.init(M, 3072, F.G, (int)blockIdx.x);
                pg8::EpiRow<mixer == 2> E{SSQ, wsp<bf16>(F, WS_QKVR), 3072, (unsigned*)(F.ctl + CW_KNB), 1.0f};
                pg8::gemm_phase<pg8::EpiRow<mixer == 2>, pg8::StaticOrder, true, true>(F.lds + RING_OFF, g, S, E);
            }
        }
        SEAML(pb + 0);
    }
    if (IN(pb + 1)) { REPS(mixer == 0 ? 2 : mixer == 1 ? 4 : 32) {
        if constexpr (mixer == 0) mix_phase<(((AOUT_F8 >> jm) & 1) != 0)>(F, args.in[5] + (size_t)jm * 8 * 128 * 128, args.in[6] + (size_t)jm * 8 * 128, args.in[4] + (size_t)jm * AW);
        else if constexpr (mixer == 1) gla_prep_phase(F, args.in[9], args.in[10]);
        else fox_attn_phase(F, (const unsigned*)(F.ctl + CW_KNB));
        SEAML(pb + 1); } }
    if constexpr (mixer == 1) {
        if (IN(pb + 2)) { REPS(8) { gla_scan_phase(F, args); SEAML(pb + 2); } }
        if (IN(pb + 3)) { REPS(16) { gla_gate_phase(F, args.in[11]); SEAML(pb + 3); } }
    }
    if (IN(pb + 4)) {
        const bf16* A = mixer == 0 ? wsp<bf16>(F, WS_Y) : mixer == 1 ? wsp<bf16>(F, WS_GG) : wsp<bf16>(F, WS_AO);
        const bf16* Bt = mixer == 0 ? wsp<bf16>(F, WS_WA_OUT) + (size_t)jm * 1024 * 2048 : mixer == 1 ? wsp<bf16>(F, WS_WB_OUT) : wsp<bf16>(F, WS_WC_OUT);
        constexpr bool w8 = moe ? (MOE_F8 != 0) : ((DENSE_F8 >> fi) & 1) != 0;
        if constexpr ((mixer == 2 && COUT_F8 != 0) || (mixer == 1 && BOUT_F8 != 0)) {
            pg8::Gemm g{A, Bt, M, D, 512}; pg8::StaticOrder S; S.init(M, D, F.G, (int)blockIdx.x);
            pg8::EpiResid<false, w8> E{(const void*)XB, XB, SSQ, wsp<unsigned char>(F, WS_X8), 1.0f / 512.0f};
            pg8::gemm_phase<pg8::EpiResid<false, w8>, pg8::StaticOrder, true, true, true>(F.lds + RING_OFF, g, S, E);
        } else if constexpr (mixer == 0 && ((AOUT_F8 >> jm) & 1) != 0) {
            pg8::Gemm g{A, Bt, M, D, 1024}; pg8::StaticOrder S; S.init(M, D, F.G, (int)blockIdx.x);
            pg8::EpiResid<l == 0, w8> E{l == 0 ? (const void*)args.in[0] : (const void*)XB, XB, SSQ, wsp<unsigned char>(F, WS_X8), 1.0f / 256.0f};
            pg8::gemm_phase<pg8::EpiResid<l == 0, w8>, pg8::StaticOrder, true, true, true>(F.lds + RING_OFF, g, S, E);
        } else {
            pg8::Gemm g{A, Bt, M, D, mixer == 0 ? 2048 : 1024}; pg8::StaticOrder S; S.init(M, D, F.G, (int)blockIdx.x);
            pg8::EpiResid<l == 0, w8> E{l == 0 ? (const void*)args.in[0] : (const void*)XB, XB, SSQ, wsp<unsigned char>(F, WS_X8), 1.0f};
            pg8::gemm_phase<pg8::EpiResid<l == 0, w8>, pg8::StaticOrder, true, true>(F.lds + RING_OFF, g, S, E);
        }
        SEAML(pb + 4);
    }
    if constexpr (!moe) {
        constexpr bool f8 = ((DENSE_F8 >> fi) & 1) != 0;
        if (IN(pb + 5)) {
            if constexpr (f8) {
                pg8::Gemm g{(const bf16*)wsp<unsigned char>(F, WS_X8), (const bf16*)(wsp<unsigned char>(F, WS_WF_IN) + (size_t)fi * 2 * 7168 * 1024), M, 7168, D / 2}; pg8::StaticOrder S; S.init(M, 7168, F.G, (int)blockIdx.x);
                pg8::EpiSwiGLU8<0> E{SSQ, wsp<unsigned char>(F, WS_HF)};
                pg8::gemm_phase<pg8::EpiSwiGLU8<0>, pg8::StaticOrder, true, true, true>(F.lds + RING_OFF, g, S, E);
            } else {
                pg8::Gemm g{XB, wsp<bf16>(F, WS_WF_IN) + (size_t)fi * 7168 * 1024, M, 7168, D}; pg8::StaticOrder S; S.init(M, 7168, F.G, (int)blockIdx.x);
                pg8::EpiSwiGLU<0> E{SSQ, wsp<bf16>(F, WS_HF)};
                pg8::gemm_phase<pg8::EpiSwiGLU<0>, pg8::StaticOrder, true, true>(F.lds + RING_OFF, g, S, E);
            }
            SEAML(pb + 5);
        }
        if (IN(pb + 6)) {
            if constexpr (f8) {
                pg8::Gemm g{(const bf16*)wsp<unsigned char>(F, WS_HF), (const bf16*)(wsp<unsigned char>(F, WS_WF_OUT) + (size_t)fi * 2 * 1024 * 3584), M, D, FF / 2}; pg8::StaticOrder S; S.init(M, D, F.G, (int)blockIdx.x, 1);
                constexpr bool w8n = (l == 2 && AIN_F8 != 0);
                pg8::EpiResid<false, w8n> E{(const void*)XB, XB, SSQ, wsp<unsigned char>(F, WS_X8), 1.0f / 512.0f};
                pg8::gemm_phase<pg8::EpiResid<false, w8n>, pg8::StaticOrder, true, true, true>(F.lds + RING_OFF, g, S, E);
            } else {
                pg8::Gemm g{wsp<bf16>(F, WS_HF), wsp<bf16>(F, WS_WF_OUT) + (size_t)fi * 1024 * 3584, M, D, FF}; pg8::StaticOrder S; S.init(M, D, F.G, (int)blockIdx.x, 1);
                pg8::EpiResid<false> E{(const void*)XB, XB, SSQ, nullptr, 1.0f};
                pg8::gemm_phase<pg8::EpiResid<false>, pg8::StaticOrder, true, true>(F.lds + RING_OFF, g, S, E);
            }
            SEAML(pb + 6);
        }
    } else {
        unsigned* gcnt = (unsigned*)(F.ctl + CW_CNT + 64 * l);
        if (IN(pb + 5)) { router_phase(F, XB, args.in[2] + l * 1024, args.in[18] + (size_t)fi * 1024 * 8, gcnt); SEAM(pb + 5); }
        if (IN(pb + 6)) { REPS(64) { if constexpr (MOE_F8 != 0) rowtable_phase(F, gcnt); else gather_phase<false>(F, gcnt); SEAM(pb + 6); } }
        if (IN(pb + 7)) {
            if constexpr (MOE_F8 != 0) {
                pg8::Gemm g{(const bf16*)wsp<unsigned char>(F, WS_X8), (const bf16*)(wsp<unsigned char>(F, WS_WM_IN) + (size_t)fi * 8 * 7168 * 1024), MROWS, 7168, D / 2, wsp<int>(F, WS_ROWT)}; pg8::GroupedOrder S; S.init(gcnt, 28, F.G, (int)blockIdx.x);
                pg8::EpiSwiGLU8<1> E{wsp<float>(F, WS_ROWRS), wsp<unsigned char>(F, WS_HM)};
                TWICE(256, pg8::gemm_phase<pg8::EpiSwiGLU8<1>, pg8::GroupedOrder, true, true, true, true>(F.lds + RING_OFF, g, S, E););
            } else {
                pg8::Gemm g{wsp<bf16>(F, WS_XS), wsp<bf16>(F, WS_WM_IN) + (size_t)fi * 8 * 7168 * 1024, MROWS, 7168, D}; pg8::GroupedOrder S; S.init(gcnt, 28, F.G, (int)blockIdx.x);
                pg8::EpiSwiGLU<1> E{wsp<float>(F, WS_ROWRS), wsp<bf16>(F, WS_HM)};
                pg8::gemm_phase<pg8::EpiSwiGLU<1>, pg8::GroupedOrder, true, true>(F.lds + RING_OFF, g, S, E);
            }
            SEAM(pb + 7);
        }
        if (IN(pb + 8)) {
            if constexpr (MOE_F8 != 0) {
                pg8::Gemm g{(const bf16*)wsp<unsigned char>(F, WS_HM), (const bf16*)(wsp<unsigned char>(F, WS_WM_OUT) + (size_t)fi * 8 * 1024 * 3584), MROWS, D, FF / 2}; pg8::GroupedOrder S; S.init(gcnt, 4, F.G, (int)blockIdx.x, 1);
                pg8::EpiMoeOut E{wsp<int>(F, WS_ROWT), wsp<float>(F, WS_ROWG), wsp<bf16>(F, WS_OS), M, 1.0f / 512.0f};
                pg8::gemm_phase<pg8::EpiMoeOut, pg8::GroupedOrder, true, true, true>(F.lds + RING_OFF, g, S, E);
            } else {
                pg8::Gemm g{wsp<bf16>(F, WS_HM), wsp<bf16>(F, WS_WM_OUT) + (size_t)fi * 8 * 1024 * 3584, MROWS, D, FF}; pg8::GroupedOrder S; S.init(gcnt, 4, F.G, (int)blockIdx.x, 1);
                pg8::EpiMoeOut E{wsp<int>(F, WS_ROWT), wsp<float>(F, WS_ROWG), wsp<bf16>(F, WS_OS), M, 1.0f};
                pg8::gemm_phase<pg8::EpiMoeOut, pg8::GroupedOrder, true, true>(F.lds + RING_OFF, g, S, E);
            }
            SEAM(pb + 8);
        }
        if (IN(pb + 9)) { combine_phase(F, l == MK_LAYERS - 1, args.in[21], (l == 1 && CIN_F8 != 0) ? wsp<unsigned char>(F, WS_X8) : nullptr); if constexpr (l != MK_LAYERS - 1) SEAML(pb + 9); }
    }
}
__global__ void __launch_bounds__(NWAVES * 64, 2) trunk_fwd(Args args) {
    extern __shared__ __attribute__((aligned(16))) unsigned char lds[];
    Frame F;
    F.lds = (LAS unsigned char*)lds;
    F.MISC = (volatile LAS unsigned*)(F.lds + MISC_OFF);
    F.tid = threadIdx.x; F.lane = F.tid & 63; F.wave = __builtin_amdgcn_readfirstlane(F.tid >> 6);
    F.G = gridDim.x; { const int bx = blockIdx.x; F.vcu = (F.G % 8 == 0) ? (bx % 8) * (F.G / 8) + bx / 8 : bx; }
    F.out = args.out; F.ws = args.ws;
    F.ctl = (gu32*)(args.ws + WS_CTL);
    for (int u = F.tid; u < (LDS_BYTES - LDSCTL_OFF) / 4; u += NWAVES * 64) ((LAS unsigned*)(F.lds + LDSCTL_OFF))[u] = 0u;
    __syncthreads();
    XcdBarrier bar = xcd_barrier_post((unsigned*)(F.ctl + CW_BAR), F.MISC + 8);
    if (F.tid == 0 && (bar.x != (blockIdx.x & 7u) || gridDim.x != 256u)) __hip_atomic_fetch_or(F.ctl + CW_XMIS, 1u, __ATOMIC_RELAXED, __HIP_MEMORY_SCOPE_AGENT);
    const int lo = args.ph_lo, hi = args.ph_hi;
    if (IN(0)) { REPS(1) { p0_prologue(F, args); SEAM(0); } }
    if (F.tid == 0) F.MISC[10] = (MK_ONE_LAUNCH != 0 && lo == 0 && __hip_atomic_load(F.ctl + CW_XMIS, __ATOMIC_RELAXED, __HIP_MEMORY_SCOPE_AGENT) == 0u) ? 1u : 0u;
    __syncthreads();
    run_layer<0>(F, args, bar, lo, hi);
    if constexpr (MK_LAYERS > 1) run_layer<1>(F, args, bar, lo, hi);
    if constexpr (MK_LAYERS > 2) run_layer<2>(F, args, bar, lo, hi);
    if constexpr (MK_LAYERS > 3) run_layer<3>(F, args, bar, lo, hi);
    if ((MK_LAYERS % 2) == 1 && IN(1 + 10 * MK_LAYERS)) final_norm_phase(F, wsp<bf16>(F, WS_XB), args.in[21]);
}
#undef IN
#undef SEAM

extern "C" void kernel_launch(void* const* d_in, const int* in_sizes, int n_in, void* d_out, int out_size, void* d_ws, size_t ws_size, hipStream_t stream) {
    static int grid = 0;
    if (grid == 0) {
        if (n_in != 22 || in_sizes[0] != M * D || out_size != M * D || ws_size < WS_END) { fprintf(stderr, "kernel_launch: unexpected shapes / workspace (n_in %d, in0 %d, out %d, ws %zu, need %zu)\n", n_in, n_in > 0 ? in_sizes[0] : -1, out_size, ws_size, (size_t)WS_END); grid = -1; return; }
        int dev = 0, cus = 0, per_cu = 0;
        if (hipGetDevice(&dev) != hipSuccess || hipDeviceGetAttribute(&cus, hipDeviceAttributeMultiprocessorCount, dev) != hipSuccess) { grid = -1; return; }
        if (hipFuncSetAttribute((const void*)trunk_fwd, hipFuncAttributeMaxDynamicSharedMemorySize, LDS_BYTES) != hipSuccess) { fprintf(stderr, "kernel_launch: hipFuncSetAttribute failed\n"); grid = -1; return; }
        if (hipOccupancyMaxActiveBlocksPerMultiprocessor(&per_cu, (const void*)trunk_fwd, NWAVES * 64, LDS_BYTES) != hipSuccess || per_cu < 1) { fprintf(stderr, "kernel_launch: occupancy query reports %d workgroups per CU\n", per_cu); }
        (void)hipGetLastError();
        grid = cus;
    }
    if (grid < 0) return;
    if (hipMemsetAsync((char*)d_ws + WS_CTL, 0, CTL_ZERO_BYTES, stream) != hipSuccess) return;
    Args a{};
    for (int i = 0; i < 22; ++i) a.in[i] = (const float*)d_in[i];
    a.out = (float*)d_out; a.ws = (unsigned char*)d_ws;
#if MK_ONE_LAUNCH
    a.ph_lo = 0; a.ph_hi = N_PHASES;
    hipLaunchKernelGGL(trunk_fwd, dim3(grid), dim3(NWAVES * 64), LDS_BYTES, stream, a);
#else
    for (int p = 0; p < N_PHASES; ++p) { if (!phase_active(p)) continue; a.ph_lo = p; a.ph_hi = p + 1; hipLaunchKernelGGL(trunk_fwd, dim3(grid), dim3(NWAVES * 64), LDS_BYTES, stream, a); }
#endif
}
```

```cpp
#include <hip/hip_runtime.h>
#include <cstdio>
#include <cstdint>
namespace pg8 {
#define PG8_LAS __attribute__((address_space(3)))
typedef unsigned short bf16_t;
typedef short bf16x8 __attribute__((ext_vector_type(8)));
typedef float f32x4 __attribute__((ext_vector_type(4)));
typedef unsigned u32x4 __attribute__((ext_vector_type(4)));
typedef int i32x8 __attribute__((ext_vector_type(8)));
constexpr int BM = 256, BK = 64, HALF = 128, HTB = HALF * BK * 2  , STAGE_BYTES = 8 * HTB, NXCD = 8, WGM = 8;

__host__ __device__ __forceinline__ int lds_byte(int r, int c) { const int st = (r >> 4) * 2 + (c >> 5), rr = r & 15, cc = c & 31, ob = rr * 64 + cc * 2; return st * 1024 + (ob ^ (((ob >> 9) & 1) << 5)); }
__host__ __device__ __forceinline__ void stage_rc(int b, int& R, int& C) { const int st = b / 1024, sb = b % 1024, swz = sb ^ (((sb >> 9) & 1) << 5); R = (st >> 1) * 16 + swz / 64; C = (st & 1) * 32 + (swz % 64) / 2; }
__host__ __device__ __forceinline__ int perm32(int rho) { const int n = rho >> 4, i = rho & 15; return 8 * (i >> 2) + 4 * n + (i & 3); }

struct Unit { int pm, pn; };
struct Gemm { const bf16_t* A; const bf16_t* Bt; int M, N, K; const int* rowmap = nullptr; };

struct StaticOrder {
    int nM, nN, nwg, G, c, rev;
    __host__ __device__ void init(int M, int N, int G_, int c_, int rev_ = 0) { nM = M / BM; nN = N / BM; nwg = nM * nN; G = G_; c = c_; rev = rev_; }
    __host__ __device__ bool next(int i, Unit& u) const {
        const long L = (long)i * G + c; if (L >= nwg) return false;
        int wgid = (int)L; { const int q = nwg / NXCD, r = nwg % NXCD, xcd = wgid % NXCD, off = wgid / NXCD; const int cnt = q + (xcd < r ? 1 : 0); wgid = (xcd < r ? xcd * (q + 1) : r * (q + 1) + (xcd - r) * q) + (rev ? cnt - 1 - off : off); }
        const int nig = WGM * nN, gid = wgid / nig, fm = gid * WGM, gsz = (nM - fm) < WGM ? (nM - fm) : WGM;
        u.pm = fm + ((wgid % nig) % gsz); u.pn = (wgid % nig) / gsz; return true;
    }
    __device__ __forceinline__ void a_ready(const Unit&) const {}
    __device__ __forceinline__ void done(const Unit&) const {}
};

struct GroupedOrder {
    int nN, nM, nwg, G, c, rev; int s1, s2, s3, s4, s5, s6, s7;
    __device__ __forceinline__ void init(const unsigned* cnt, int nN_, int G_, int c_, int rev_ = 0) {
        nN = nN_; G = G_; c = c_; rev = rev_; int t = 0;
        t += (int)((cnt[0] + 255u) >> 8); s1 = t; t += (int)((cnt[1] + 255u) >> 8); s2 = t; t += (int)((cnt[2] + 255u) >> 8); s3 = t; t += (int)((cnt[3] + 255u) >> 8); s4 = t;
        t += (int)((cnt[4] + 255u) >> 8); s5 = t; t += (int)((cnt[5] + 255u) >> 8); s6 = t; t += (int)((cnt[6] + 255u) >> 8); s7 = t; t += (int)((cnt[7] + 255u) >> 8);
        nM = t; nwg = nM * nN;
    }
    __device__ __forceinline__ bool next(int i, Unit& u) const {
        const long L = (long)i * G + c; if (L >= nwg) return false;
        int wgid = (int)L; { const int q = nwg / NXCD, r = nwg % NXCD, xcd = wgid % NXCD, off = wgid / NXCD; const int cnt = q + (xcd < r ? 1 : 0); wgid = (xcd < r ? xcd * (q + 1) : r * (q + 1) + (xcd - r) * q) + (rev ? cnt - 1 - off : off); }
        const int nig = WGM * nN, gid = wgid / nig, fm = gid * WGM, gsz = (nM - fm) < WGM ? (nM - fm) : WGM;
        const int pm = fm + ((wgid % nig) % gsz), pnl = (wgid % nig) / gsz;
        const int e = (pm >= s1) + (pm >= s2) + (pm >= s3) + (pm >= s4) + (pm >= s5) + (pm >= s6) + (pm >= s7);
        u.pm = pm; u.pn = e * nN + pnl; return true;
    }
    __device__ __forceinline__ void a_ready(const Unit&) const {}
    __device__ __forceinline__ void done(const Unit&) const {}
};

__device__ __forceinline__ unsigned cvt_pk_bf16(float lo, float hi) { unsigned r; asm volatile("v_cvt_pk_bf16_f32 %0, %1, %2" : "=v"(r) : "v"(lo), "v"(hi)); return r; }
typedef unsigned u32x2 __attribute__((ext_vector_type(2)));
__device__ __forceinline__ float c8(float v) { return __builtin_amdgcn_fmed3f(v, -448.0f, 448.0f); }
constexpr float RMS_EPS = 1e-6f;
__device__ __forceinline__ float rs16(const float* ssq, int row, int fq) {
    const f32x4 a = *(const f32x4*)(ssq + (size_t)row * 16 + 4 * fq);
    float s = (a[0] + a[1]) + (a[2] + a[3]); s += __shfl_xor(s, 16); s += __shfl_xor(s, 32);
    return __builtin_amdgcn_rsqf(s * (1.0f / 1024.0f) + RMS_EPS);
}
__device__ __forceinline__ float gelu_t(float x) {
    const float t = x * (1.0f + 0.044715f * x * x);
    return x * __builtin_amdgcn_rcpf(1.0f + __builtin_amdgcn_exp2f(-2.302208198f * t));
}
__device__ __forceinline__ float silu_f(float x) { return x * __builtin_amdgcn_rcpf(1.0f + __builtin_amdgcn_exp2f(-1.4426950409f * x)); }
__device__ __forceinline__ f32x4 sig4(f32x4 a) {
    f32x4 e; e[0] = __builtin_amdgcn_exp2f(a[0]); e[1] = __builtin_amdgcn_exp2f(a[1]); e[2] = __builtin_amdgcn_exp2f(a[2]); e[3] = __builtin_amdgcn_exp2f(a[3]);
    e = e + 1.0f; f32x4 r; r[0] = __builtin_amdgcn_rcpf(e[0]); r[1] = __builtin_amdgcn_rcpf(e[1]); r[2] = __builtin_amdgcn_rcpf(e[2]); r[3] = __builtin_amdgcn_rcpf(e[3]); return r;
}
__device__ __forceinline__ f32x4 swiglu4(f32x4 g, f32x4 u, float ca, float ch) { return ((g * u) * ch) * sig4(g * ca); }
__device__ __forceinline__ f32x4 gelu4(f32x4 x) { const f32x4 p = (x * x) * (-2.302208198f * 0.044715f) + (-2.302208198f); return x * sig4(x * p); }

struct EpiAin {
    static constexpr bool PERM = true, AFTER_DRAIN = false, RS_LDS = false;
    const float* ssq; bf16_t* U; bf16_t* V; float* vssq; float sc;
    __device__ __forceinline__ void operator()(const f32x4 (&acc)[2][2][4][2], const Unit& u, int wr, int wc, int fr, int fq) const {
        const bool isv = u.pn >= 8; bf16_t* base = isv ? V : U;
        const int row0 = u.pm * BM + wr * 64 + fr, col0 = (u.pn & 7) * BM + wc * 32 + 8 * fq;
#pragma unroll
        for (int ai = 0; ai < 2; ++ai)
#pragma unroll
            for (int m = 0; m < 4; ++m) { const int row = row0 + ai * HALF + m * 16; const float rs = rs16(ssq, row, fq) * sc; float sq = 0.f; bf16_t* rowp = base + (size_t)row * 2048 + col0;
#pragma unroll
                for (int bj = 0; bj < 2; ++bj) { const f32x4 v0 = gelu4(acc[ai][bj][m][0] * rs), v1 = gelu4(acc[ai][bj][m][1] * rs);
                    { const f32x4 q = v0 * v0 + v1 * v1; sq += (q[0] + q[1]) + (q[2] + q[3]); }
                    u32x4 w; w.x = cvt_pk_bf16(v0[0], v0[1]); w.y = cvt_pk_bf16(v0[2], v0[3]); w.z = cvt_pk_bf16(v1[0], v1[1]); w.w = cvt_pk_bf16(v1[2], v1[3]);
                    *(u32x4*)(rowp + bj * HALF) = w; }
                if (isv) { sq += __shfl_xor(sq, 16); sq += __shfl_xor(sq, 32); if (fq == 0) vssq[(size_t)row * 32 + (u.pn - 8) * 4 + wc] = sq; } }
    }
};
template <bool KN> struct EpiRow {
    static constexpr bool PERM = true, AFTER_DRAIN = false, RS_LDS = false;
    const float* ssq; bf16_t* O; int ldc; unsigned* knb; float sc;
    __device__ __forceinline__ void operator()(const f32x4 (&acc)[2][2][4][2], const Unit& u, int wr, int wc, int fr, int fq) const {
        const int row0 = u.pm * BM + wr * 64 + fr, col0 = u.pn * BM + wc * 32 + 8 * fq;
        float kmx0 = 0.f, kmx1 = 0.f;
#pragma unroll
        for (int ai = 0; ai < 2; ++ai)
#pragma unroll
            for (int m = 0; m < 4; ++m) { const int row = row0 + ai * HALF + m * 16; const float rs = rs16(ssq, row, fq) * sc; bf16_t* rowp = O + (size_t)row * ldc + col0;
#pragma unroll
                for (int bj = 0; bj < 2; ++bj) { const f32x4 v0 = acc[ai][bj][m][0] * rs, v1 = acc[ai][bj][m][1] * rs;
                    u32x4 w; w.x = cvt_pk_bf16(v0[0], v0[1]); w.y = cvt_pk_bf16(v0[2], v0[3]); w.z = cvt_pk_bf16(v1[0], v1[1]); w.w = cvt_pk_bf16(v1[2], v1[3]);
                    *(u32x4*)(rowp + bj * HALF) = w;
                    if constexpr (KN) { float sq = ((v0[0] * v0[0] + v0[1] * v0[1]) + (v0[2] * v0[2] + v0[3] * v0[3])) + ((v1[0] * v1[0] + v1[1] * v1[1]) + (v1[2] * v1[2] + v1[3] * v1[3]));
                        sq += __shfl_xor(sq, 16); sq += __shfl_xor(sq, 32); if (bj == 0) kmx0 = fmaxf(kmx0, sq); else kmx1 = fmaxf(kmx1, sq); } } }
        if constexpr (KN) { if (u.pn >= 4 && u.pn < 8) {
#pragma unroll
                for (int o = 1; o < 16; o <<= 1) { kmx0 = fmaxf(kmx0, __shfl_xor(kmx0, o)); kmx1 = fmaxf(kmx1, __shfl_xor(kmx1, o)); }
                if ((threadIdx.x & 63) == 0) { const int bb = (u.pm * BM) >> 12, hd = 2 * (u.pn - 4);
                    __hip_atomic_fetch_max(knb + ((bb * 8 + hd) * 4 + wc), __builtin_bit_cast(unsigned, kmx0), __ATOMIC_RELAXED, __HIP_MEMORY_SCOPE_AGENT);
                    __hip_atomic_fetch_max(knb + ((bb * 8 + hd + 1) * 4 + wc), __builtin_bit_cast(unsigned, kmx1), __ATOMIC_RELAXED, __HIP_MEMORY_SCOPE_AGENT); } } }
    }
};
template <bool F32IN, bool W8 = false> struct EpiResid {
    static constexpr bool PERM = true, AFTER_DRAIN = false, RS_LDS = false;
    const void* xin; bf16_t* xb; float* ssq; unsigned char* x8; float oscale;
    __device__ __forceinline__ void operator()(const f32x4 (&acc)[2][2][4][2], const Unit& u, int wr, int wc, int fr, int fq) const {
        const int row0 = u.pm * BM + wr * 64 + fr, col0 = u.pn * BM + wc * 32 + 8 * fq;
        constexpr int MB = F32IN ? 2 : 4;
#pragma unroll
        for (int ai = 0; ai < 2; ++ai)
#pragma unroll
            for (int mb = 0; mb < 4; mb += MB) { u32x4 xr[MB][2][F32IN ? 2 : 1];
#pragma unroll
                for (int mi = 0; mi < MB; ++mi)
#pragma unroll
                    for (int bj = 0; bj < 2; ++bj) { const size_t o = (size_t)(row0 + ai * HALF + (mb + mi) * 16) * 1024 + col0 + bj * HALF;
                        if constexpr (F32IN) { xr[mi][bj][0] = *(const u32x4*)((const float*)xin + o); xr[mi][bj][1] = *(const u32x4*)((const float*)xin + o + 4); }
                        else xr[mi][bj][0] = *(const u32x4*)((const bf16_t*)xin + o); }
#pragma unroll
                for (int mi = 0; mi < MB; ++mi) { const int m = mb + mi; const int row = row0 + ai * HALF + m * 16; const size_t off = (size_t)row * 1024 + col0; float sq = 0.f;
#pragma unroll
                    for (int bj = 0; bj < 2; ++bj) { const size_t o = off + bj * HALF; f32x4 v0, v1;
                        if constexpr (F32IN) { v0 = __builtin_bit_cast(f32x4, xr[mi][bj][0]); v1 = __builtin_bit_cast(f32x4, xr[mi][bj][F32IN ? 1 : 0]); }
                        else { const u32x4 xw = xr[mi][bj][0];
                            v0 = (f32x4){__builtin_bit_cast(float, xw.x << 16), __builtin_bit_cast(float, xw.x & 0xffff0000u), __builtin_bit_cast(float, xw.y << 16), __builtin_bit_cast(float, xw.y & 0xffff0000u)};
                            v1 = (f32x4){__builtin_bit_cast(float, xw.z << 16), __builtin_bit_cast(float, xw.z & 0xffff0000u), __builtin_bit_cast(float, xw.w << 16), __builtin_bit_cast(float, xw.w & 0xffff0000u)}; }
                        v0 += acc[ai][bj][m][0] * oscale; v1 += acc[ai][bj][m][1] * oscale;
                        u32x4 w; w.x = cvt_pk_bf16(v0[0], v0[1]); w.y = cvt_pk_bf16(v0[2], v0[3]); w.z = cvt_pk_bf16(v1[0], v1[1]); w.w = cvt_pk_bf16(v1[2], v1[3]);
                        *(u32x4*)(xb + o) = w;
                        if constexpr (W8) { int p0 = __builtin_amdgcn_cvt_pk_fp8_f32(c8(v0[0]), c8(v0[1]), 0, false); p0 = __builtin_amdgcn_cvt_pk_fp8_f32(c8(v0[2]), c8(v0[3]), p0, true); int p1 = __builtin_amdgcn_cvt_pk_fp8_f32(c8(v1[0]), c8(v1[1]), 0, false); p1 = __builtin_amdgcn_cvt_pk_fp8_f32(c8(v1[2]), c8(v1[3]), p1, true);
                            u32x2 w8; w8.x = (unsigned)p0; w8.y = (unsigned)p1; *(u32x2*)(x8 + o) = w8; }
                        sq += ((v0[0] * v0[0] + v0[1] * v0[1]) + (v0[2] * v0[2] + v0[3] * v0[3])) + ((v1[0] * v1[0] + v1[1] * v1[1]) + (v1[2] * v1[2] + v1[3] * v1[3])); }
                    sq += __shfl_xor(sq, 16); sq += __shfl_xor(sq, 32); if (fq == 0) ssq[(size_t)row * 16 + u.pn * 4 + wc] = sq; }
                asm volatile("" ::: "memory"); }
    }
};
template <int MODE> struct EpiSwiGLU {
    static constexpr bool PERM = true, AFTER_DRAIN = false, RS_LDS = false;
    const float* ssq; bf16_t* H;
    __device__ __forceinline__ void operator()(const f32x4 (&acc)[2][2][4][2], const Unit& u, int wr, int wc, int fr, int fq) const {
        const int row0 = u.pm * BM + wr * 64 + fr, col0 = (u.pn % 28) * HALF + wc * 32 + 8 * fq;
#pragma unroll
        for (int ai = 0; ai < 2; ++ai)
#pragma unroll
            for (int m = 0; m < 4; ++m) { const int row = row0 + ai * HALF + m * 16; const float rs = MODE == 0 ? rs16(ssq, row, fq) : ssq[row];
                const float ca = rs * -1.4426950409f, ch = rs * rs;
                const f32x4 h0 = swiglu4(acc[ai][0][m][0], acc[ai][1][m][0], ca, ch), h1 = swiglu4(acc[ai][0][m][1], acc[ai][1][m][1], ca, ch);
                u32x4 w; w.x = cvt_pk_bf16(h0[0], h0[1]); w.y = cvt_pk_bf16(h0[2], h0[3]); w.z = cvt_pk_bf16(h1[0], h1[1]); w.w = cvt_pk_bf16(h1[2], h1[3]);
                *(u32x4*)(H + (size_t)row * 3584 + col0) = w; }
    }
};
template <int MODE> struct EpiSwiGLU8 {
    static constexpr bool PERM = true, AFTER_DRAIN = false, RS_LDS = (MODE == 1);
    const float* rrs; unsigned char* H8;
    __device__ __forceinline__ void operator()(const f32x4 (&acc)[2][2][4][2], const Unit& u, int wr, int wc, int fr, int fq, const PG8_LAS float* rsl = nullptr) const {
        const int row0 = u.pm * BM + wr * 64 + fr, col0 = (u.pn % 28) * HALF + wc * 32 + 8 * fq;
#pragma unroll
        for (int ai = 0; ai < 2; ++ai)
#pragma unroll
            for (int m = 0; m < 4; ++m) { const int row = row0 + ai * HALF + m * 16; const float rs = (MODE == 0 ? rs16(rrs, row, fq) : rsl[ai * 64 + m * 16 + fr]) * (1.0f / 64.0f);
                const float ca = rs * -1.4426950409f, ch = rs * rs * 8.0f;
                const f32x4 h0 = swiglu4(acc[ai][0][m][0], acc[ai][1][m][0], ca, ch), h1 = swiglu4(acc[ai][0][m][1], acc[ai][1][m][1], ca, ch);
                int w0 = __builtin_amdgcn_cvt_pk_fp8_f32(c8(h0[0]), c8(h0[1]), 0, false); w0 = __builtin_amdgcn_cvt_pk_fp8_f32(c8(h0[2]), c8(h0[3]), w0, true);
                int w1 = __builtin_amdgcn_cvt_pk_fp8_f32(c8(h1[0]), c8(h1[1]), 0, false); w1 = __builtin_amdgcn_cvt_pk_fp8_f32(c8(h1[2]), c8(h1[3]), w1, true);
                u32x2 w; w.x = (unsigned)w0; w.y = (unsigned)w1; *(u32x2*)(H8 + (size_t)row * 3584 + col0) = w; }
    }
};
struct EpiMoeOut {
    static constexpr bool PERM = true, AFTER_DRAIN = false, RS_LDS = false;
    const int* rtok; const float* rgate; bf16_t* OS; int M; float oscale;
    __device__ __forceinline__ void operator()(const f32x4 (&acc)[2][2][4][2], const Unit& u, int wr, int wc, int fr, int fq) const {
        const int row0 = u.pm * BM + wr * 64 + fr, col0 = (u.pn & 3) * BM + wc * 32 + 8 * fq;
        int tkv[2][4]; float gtv[2][4];
#pragma unroll
        for (int ai = 0; ai < 2; ++ai)
#pragma unroll
            for (int m = 0; m < 4; ++m) { const int row = row0 + ai * HALF + m * 16; tkv[ai][m] = rtok[row]; gtv[ai][m] = rgate[row]; }
#pragma unroll
        for (int ai = 0; ai < 2; ++ai)
#pragma unroll
            for (int m = 0; m < 4; ++m) { const int tk = tkv[ai][m]; const float gt = gtv[ai][m] * oscale;
                if (tk >= 0) { bf16_t* rowp = OS + ((size_t)(tk & 1) * M + (tk >> 1)) * 1024 + col0;
#pragma unroll
                    for (int bj = 0; bj < 2; ++bj) { const f32x4 v0 = acc[ai][bj][m][0] * gt, v1 = acc[ai][bj][m][1] * gt;
                        u32x4 w; w.x = cvt_pk_bf16(v0[0], v0[1]); w.y = cvt_pk_bf16(v0[2], v0[3]); w.z = cvt_pk_bf16(v1[0], v1[1]); w.w = cvt_pk_bf16(v1[2], v1[3]);
                        *(u32x4*)(rowp + bj * HALF) = w; } } }
    }
};

template <class Epi, class Sched, bool ALIGN_EPI = false, bool SP2 = false, bool F8 = false, bool GA = false>
__device__ __forceinline__ void gemm_phase(PG8_LAS unsigned char* lds, const Gemm g, const Sched& S, const Epi& E) {
    static_assert(!GA || SP2, "gathered A rows: SP2 path only");
    const int tid = threadIdx.x, wid = __builtin_amdgcn_readfirstlane(tid >> 6), lane = tid & 63, wr = wid >> 2, wc = wid & 3, fr = lane & 15, fq = lane >> 4;
    const int K = g.K, nt = K / BK;
    unsigned voffA[2], voffB[2];
#pragma unroll
    for (int i = 0; i < 2; ++i) { int R, C; stage_rc(tid * 16 + i * 8192, R, C); const int Rb = Epi::PERM ? ((R & ~31) + perm32(R & 31)) : R;
        voffA[i] = (unsigned)(R * K + C) * 2u; voffB[i] = (unsigned)(Rb * K + C) * 2u; }
    PG8_LAS unsigned char* const rowbuf = lds + STAGE_BYTES + 1024 + wid * 256;
    const unsigned cbA = voffA[0] - (unsigned)(((wid >> 1) * 16 + (lane >> 2)) * K) * 2u;
#define PG8_ROWDMA(u, par) do { const int* rp_ = g.rowmap + (size_t)(u).pm * BM + (lane >> 5) * 128 + ((lane >> 4) & 1) * 64 + (wid >> 1) * 16 + (lane & 15); \
        const unsigned la_ = __builtin_amdgcn_readfirstlane((unsigned)(unsigned long)(rowbuf + (par) * 2048)); unsigned keep_; \
        asm volatile("s_mov_b32 %0, m0\n\ts_mov_b32 m0, %2\n\ts_nop 0\n\tglobal_load_lds_dword %1, off\n\ts_mov_b32 m0, %0" : "=&s"(keep_) : "v"(rp_), "s"(la_) : "memory"); } while (0)
#define PG8_ROWGET(dst, par) do { _Pragma("unroll") for (int h_ = 0; h_ < 2; ++h_) _Pragma("unroll") for (int i_ = 0; i_ < 2; ++i_) { \
        const int t_ = *(const PG8_LAS int*)(rowbuf + (par) * 2048 + ((2 * h_ + i_) * 16 + (lane >> 2)) * 4); dst[h_][i_] = (unsigned)((t_ < 0 ? 0 : t_) >> 1) * (unsigned)(K * 2) + cbA; } } while (0)
    PG8_LAS unsigned char* const rsbuf = lds + STAGE_BYTES + 1024 + 4096 + wid * 512;
#define PG8_RSDMA(u) do { _Pragma("unroll") for (int ai_ = 0; ai_ < 2; ++ai_) { const float* rp_ = E.rrs + (size_t)(u).pm * BM + ai_ * HALF + wr * 64 + lane; \
        const unsigned la_ = __builtin_amdgcn_readfirstlane((unsigned)(unsigned long)(rsbuf + ai_ * 256)); unsigned keep_; \
        asm volatile("s_mov_b32 %0, m0\n\ts_mov_b32 m0, %2\n\ts_nop 0\n\tglobal_load_lds_dword %1, off\n\ts_mov_b32 m0, %0" : "=&s"(keep_) : "v"(rp_), "s"(la_) : "memory"); } } while (0)
    unsigned vGc[2][2], vS[2][2];
    const auto rsA = __builtin_amdgcn_make_buffer_rsrc((void*)g.A, 0, 0x40000000u, 0x00020000);
    const size_t kstep = (size_t)(BK * 2);
    const size_t hstep = (size_t)HALF * K * 2;
    const size_t tstep = 2 * hstep;
    const unsigned ldsw = (unsigned)wid * 1024u;
    const int aoff = lds_byte(wr * 64 + fr, fq * 8), boff = lds_byte(wc * 32 + fr, fq * 8);
#define PG8_SA(b, h) (((b) * 2 + (h)) * HTB)
#define PG8_SB(b, h) ((4 + (b) * 2 + (h)) * HTB)
#define PG8_STAGE(bufoff, gbase, voff) do { _Pragma("unroll") for (int _i = 0; _i < 2; ++_i) \
        __builtin_amdgcn_global_load_lds((const unsigned*)((const char*)(gbase) + (voff)[_i]), (PG8_LAS unsigned*)(lds + (bufoff) + ldsw + _i * 8192), 16, 0, 0); } while (0)
#define PG8_STAGE_A(bufoff, ptr, h, vsel) do { if constexpr (GA) { _Pragma("unroll") for (int _i = 0; _i < 2; ++_i)     \
            __builtin_amdgcn_raw_ptr_buffer_load_lds(rsA, (PG8_LAS void*)(lds + (bufoff) + ldsw + _i * 8192), 16, (int)vsel[h][_i], (int)((ptr) - (const char*)g.A), 0, 0); } \
        else PG8_STAGE(bufoff, (ptr) + ((h) ? hstep : 0), voffA); } while (0)
#define PG8_CAT8(p0_) __builtin_bit_cast(i32x8, __builtin_shufflevector(*(const PG8_LAS bf16x8*)(p0_), *(const PG8_LAS bf16x8*)((p0_) + 1024), 0, 1, 2, 3, 4, 5, 6, 7, 8, 9, 10, 11, 12, 13, 14, 15))
#define PG8_LDA(dst, b, h) do { if constexpr (F8) { _Pragma("unroll") for (int m = 0; m < 4; ++m) dst##8[m] = PG8_CAT8(lds + PG8_SA(b, h) + aoff + m * 2048); } \
        else { _Pragma("unroll") for (int m = 0; m < 4; ++m) _Pragma("unroll") for (int k = 0; k < 2; ++k) dst[m][k] = *(const PG8_LAS bf16x8*)(lds + PG8_SA(b, h) + aoff + m * 2048 + k * 1024); } } while (0)
#define PG8_LDB(dst, b, h) do { if constexpr (F8) { _Pragma("unroll") for (int n = 0; n < 2; ++n) dst##8[n] = PG8_CAT8(lds + PG8_SB(b, h) + boff + n * 2048); } \
        else { _Pragma("unroll") for (int n = 0; n < 2; ++n) _Pragma("unroll") for (int k = 0; k < 2; ++k) dst[n][k] = *(const PG8_LAS bf16x8*)(lds + PG8_SB(b, h) + boff + n * 2048 + k * 1024); } } while (0)
#define PG8_MMA(ai, bj, At, Bt) do { __builtin_amdgcn_s_setprio(1); \
        if constexpr (F8) { _Pragma("unroll") for (int m = 0; m < 4; ++m) _Pragma("unroll") for (int n = 0; n < 2; ++n) \
            asm volatile("v_mfma_scale_f32_16x16x128_f8f6f4 %0, %1, %2, %0, %3, %3 op_sel_hi:[0,0,0]" : "+v"(acc[ai][bj][m][n]) : "v"(Bt##8[n]), "v"(At##8[m]), "v"(f8one)); } \
        else { _Pragma("unroll") for (int m = 0; m < 4; ++m) _Pragma("unroll") for (int n = 0; n < 2; ++n) _Pragma("unroll") for (int k = 0; k < 2; ++k) \
            acc[ai][bj][m][n] = __builtin_amdgcn_mfma_f32_16x16x32_bf16(Bt[n][k], At[m][k], acc[ai][bj][m][n], 0, 0, 0); } \
        __builtin_amdgcn_s_setprio(0); } while (0)
#define PG8_WAIT_V(n) asm volatile("s_waitcnt vmcnt(" #n ")" ::: "memory")
#define PG8_WAIT_L(n) asm volatile("s_waitcnt lgkmcnt(" #n ")" ::: "memory")
#define PG8_BAR __builtin_amdgcn_s_barrier()
#define PG8_SCHED __builtin_amdgcn_sched_barrier(0)
    Unit cur, nxt; int ui = 0;
    if (!S.next(0, cur)) return;
#if defined(PG8_STAGGER_TICKS)
    if ((blockIdx.x >> 3) & 1) { const unsigned long long t0_ = __builtin_amdgcn_s_memrealtime(); while (__builtin_amdgcn_s_memrealtime() - t0_ < PG8_STAGGER_TICKS) __builtin_amdgcn_s_sleep(8); }
#endif
    f32x4 acc[2][2][4][2];
#pragma unroll
    for (int a = 0; a < 2; ++a)
#pragma unroll
        for (int b = 0; b < 2; ++b)
#pragma unroll
            for (int m = 0; m < 4; ++m)
#pragma unroll
                for (int n = 0; n < 2; ++n) acc[a][b][m][n] = (f32x4){0.f, 0.f, 0.f, 0.f};
    const int f8one = 0x7f7f7f7f;
    bf16x8 At[4][2], B0[2][2], B1[2][2]; i32x8 At8[4], B08[2], B18[2];
    const char* cA = GA ? (const char*)g.A : (const char*)g.A + (size_t)cur.pm * tstep; const char* cB = (const char*)g.Bt + (size_t)cur.pn * tstep;
    S.a_ready(cur);
    if constexpr (Epi::RS_LDS) PG8_RSDMA(cur);
    if constexpr (GA) { PG8_ROWDMA(cur, 0); asm volatile("s_waitcnt vmcnt(0)" ::: "memory"); PG8_ROWGET(vGc, 0); }
    if constexpr (SP2) {
        PG8_STAGE(PG8_SB(0, 0), cB, voffB); PG8_STAGE(PG8_SB(0, 1), cB + hstep, voffB); PG8_STAGE_A(PG8_SA(0, 0), cA, 0, vGc); PG8_STAGE_A(PG8_SA(0, 1), cA, 1, vGc);
        if (wr == 1) PG8_BAR;
        PG8_WAIT_V(2); PG8_BAR;
        PG8_STAGE(PG8_SB(1, 0), cB + kstep, voffB); PG8_STAGE_A(PG8_SA(1, 0), cA + kstep, 0, vGc); PG8_STAGE(PG8_SB(1, 1), cB + hstep + kstep, voffB);
        PG8_WAIT_V(6); PG8_BAR;
    } else {
        PG8_STAGE(PG8_SB(0, 0), cB, voffB); PG8_STAGE(PG8_SA(0, 0), cA, voffA); PG8_STAGE(PG8_SB(0, 1), cB + hstep, voffB); PG8_STAGE(PG8_SA(0, 1), cA + hstep, voffA);
        if (wr == 1) PG8_BAR;
        PG8_WAIT_V(4); PG8_BAR;
        PG8_STAGE(PG8_SB(1, 0), cB + kstep, voffB); PG8_STAGE(PG8_SA(1, 0), cA + kstep, voffA); PG8_STAGE(PG8_SB(1, 1), cB + hstep + kstep, voffB);
        PG8_WAIT_V(6); PG8_BAR;
    }
    for (;;) {
        const bool has_next = S.next(ui + 1, nxt);
        const char* nA = GA ? cA : has_next ? (const char*)g.A + (size_t)nxt.pm * tstep : cA; const char* nB = has_next ? (const char*)g.Bt + (size_t)nxt.pn * tstep : cB;
        if constexpr (GA) { if (has_next) PG8_ROWDMA(nxt, (ui + 1) & 1); }
        for (int t = 0; t < nt; t += 2) {
            const bool last = (t == nt - 2);
            const char* a1 = cA + (size_t)(t + 1) * kstep;
            const char* a2 = last ? nA : cA + (size_t)(t + 2) * kstep; const char* b2 = last ? nB : cB + (size_t)(t + 2) * kstep;
            const char* a3 = a2 + kstep; const char* b3 = b2 + kstep;
            if (last && has_next) S.a_ready(nxt);
            if constexpr (GA) { if (last && has_next) PG8_ROWGET(vS, (ui + 1) & 1);
                else { vS[0][0] = vGc[0][0]; vS[0][1] = vGc[0][1]; vS[1][0] = vGc[1][0]; vS[1][1] = vGc[1][1]; } }
            if constexpr (SP2) {
            PG8_LDB(B0, 0, 0); PG8_LDB(B1, 0, 1); PG8_SCHED; PG8_LDA(At, 0, 0); PG8_STAGE_A(PG8_SA(1, 1), a1, 1, vGc);
            PG8_WAIT_V(8); PG8_WAIT_L(0); PG8_BAR; PG8_MMA(0, 0, At, B0); PG8_MMA(0, 1, At, B1); PG8_BAR; PG8_SCHED;
            PG8_LDA(At, 0, 1); PG8_STAGE(PG8_SB(0, 0), b2, voffB); PG8_STAGE(PG8_SB(0, 1), b2 + hstep, voffB); PG8_STAGE_A(PG8_SA(0, 0), a2, 0, vS);
            PG8_WAIT_V(8); PG8_WAIT_L(0); PG8_BAR; PG8_MMA(1, 0, At, B0); PG8_MMA(1, 1, At, B1); PG8_BAR; PG8_SCHED;
            PG8_LDB(B0, 1, 0); PG8_LDB(B1, 1, 1); PG8_SCHED; PG8_LDA(At, 1, 0); PG8_STAGE_A(PG8_SA(0, 1), a2, 1, vS);
            PG8_WAIT_V(8); PG8_WAIT_L(0); PG8_BAR; PG8_MMA(0, 0, At, B0); PG8_MMA(0, 1, At, B1); PG8_BAR; PG8_SCHED;
            PG8_LDA(At, 1, 1); PG8_STAGE(PG8_SB(1, 0), b3, voffB); PG8_STAGE(PG8_SB(1, 1), b3 + hstep, voffB); PG8_STAGE_A(PG8_SA(1, 0), a3, 0, vS);
            PG8_WAIT_V(8); PG8_WAIT_L(0); PG8_BAR; PG8_MMA(1, 0, At, B0); PG8_MMA(1, 1, At, B1); PG8_BAR; PG8_SCHED;
            } else {
            PG8_LDB(B0, 0, 0); PG8_SCHED; PG8_LDA(At, 0, 0); PG8_STAGE(PG8_SA(1, 1), a1 + hstep, voffA);
            PG8_WAIT_L(8); PG8_BAR; PG8_WAIT_L(0); PG8_MMA(0, 0, At, B0); PG8_BAR; PG8_SCHED;
            PG8_LDB(B1, 0, 1); PG8_STAGE(PG8_SB(0, 0), b2, voffB);
            PG8_BAR; PG8_WAIT_L(0); PG8_MMA(0, 1, At, B1); PG8_BAR;
            PG8_LDA(At, 0, 1); PG8_STAGE(PG8_SA(0, 0), a2, voffA);
            PG8_BAR; PG8_WAIT_L(0); PG8_MMA(1, 0, At, B0); PG8_BAR; PG8_SCHED;
            PG8_STAGE(PG8_SB(0, 1), b2 + hstep, voffB);
            PG8_WAIT_V(6); PG8_BAR; PG8_MMA(1, 1, At, B1); PG8_BAR;
            PG8_LDB(B0, 1, 0); PG8_SCHED; PG8_LDA(At, 1, 0); PG8_STAGE(PG8_SA(0, 1), a2 + hstep, voffA);
            PG8_WAIT_L(8); PG8_BAR; PG8_WAIT_L(0); PG8_MMA(0, 0, At, B0); PG8_BAR; PG8_SCHED;
            PG8_LDB(B1, 1, 1); PG8_STAGE(PG8_SB(1, 0), b3, voffB);
            PG8_BAR; PG8_WAIT_L(0); PG8_MMA(0, 1, At, B1); PG8_BAR;
            PG8_LDA(At, 1, 1); PG8_STAGE(PG8_SA(1, 0), a3, voffA);
            PG8_BAR; PG8_WAIT_L(0); PG8_MMA(1, 0, At, B0); PG8_BAR; PG8_SCHED;
            PG8_STAGE(PG8_SB(1, 1), b3 + hstep, voffB);
            PG8_WAIT_V(6); PG8_BAR; PG8_MMA(1, 1, At, B1); PG8_BAR;
            }
        }
        if constexpr (F8) { asm volatile("s_nop 15\n\ts_nop 15" ::: "memory"); }
        if constexpr (ALIGN_EPI) { if (wr == 0) PG8_BAR; }
        if constexpr (!Epi::AFTER_DRAIN) { if constexpr (Epi::RS_LDS) E(acc, cur, wr, wc, fr, fq, (const PG8_LAS float*)rsbuf); else E(acc, cur, wr, wc, fr, fq); S.done(cur); }
        if (!has_next) break;
#pragma unroll
        for (int a = 0; a < 2; ++a)
#pragma unroll
            for (int b = 0; b < 2; ++b)
#pragma unroll
                for (int m = 0; m < 4; ++m)
#pragma unroll
                    for (int n = 0; n < 2; ++n) acc[a][b][m][n] = (f32x4){0.f, 0.f, 0.f, 0.f};
        cur = nxt; cA = nA; cB = nB; ++ui;
        if constexpr (Epi::RS_LDS) PG8_RSDMA(cur);
        if constexpr (GA) { vGc[0][0] = vS[0][0]; vGc[0][1] = vS[0][1]; vGc[1][0] = vS[1][0]; vGc[1][1] = vS[1][1]; }
        if constexpr (ALIGN_EPI) { if (wr == 1) PG8_BAR; }
    }
    PG8_WAIT_V(0);
    if constexpr (!ALIGN_EPI) { if (wr == 0) PG8_BAR; }
    PG8_BAR;
    if constexpr (Epi::AFTER_DRAIN) { E.fused(acc, cur, wr, wc, fr, fq, lds, wid, lane); S.done(cur); }
#undef PG8_SA
#undef PG8_SB
#undef PG8_STAGE
#undef PG8_STAGE_A
#undef PG8_ROWDMA
#undef PG8_RSDMA
#undef PG8_ROWGET
#undef PG8_LDA
#undef PG8_CAT8
#undef PG8_LDB
#undef PG8_MMA
#undef PG8_WAIT_V
#undef PG8_WAIT_L
#undef PG8_BAR
#undef PG8_SCHED
}
}

constexpr int NWAVES = 8;
constexpr int BATCH = 8, SEQ = 4096, D = 1024, M = BATCH * SEQ;
constexpr int AW = 2048, FF = 3584, NE = 8;
constexpr int MROWS = 2 * M + NE * 256;
constexpr float EPS = 1e-6f;
#ifndef MK_ONE_LAUNCH
#define MK_ONE_LAUNCH 1
#endif
#ifndef MK_LAYERS
#define MK_LAYERS 4
#endif
#ifndef MK_AIN_F8
#define MK_AIN_F8 1
#endif
constexpr int AIN_F8 = MK_AIN_F8;
#ifndef MK_AOUT_F8
#define MK_AOUT_F8 2
#endif
constexpr int AOUT_F8 = MK_AOUT_F8;
#ifndef MK_BOUT_F8
#define MK_BOUT_F8 0
#endif
constexpr int BOUT_F8 = MK_BOUT_F8;
#ifndef MK_COUT_F8
#define MK_COUT_F8 1
#endif
constexpr int COUT_F8 = MK_COUT_F8;
#ifndef MK_CIN_F8
#define MK_CIN_F8 1
#endif
constexpr int CIN_F8 = MK_CIN_F8;
#ifndef MK_MOE_F8
#define MK_MOE_F8 1
#endif
#ifndef MK_DENSE_F8
#define MK_DENSE_F8 2
#endif
constexpr int DENSE_F8 = MK_DENSE_F8;
constexpr int MOE_F8 = MK_MOE_F8;

constexpr size_t MiB = 1u << 20;
constexpr size_t WS_CTL = 0, CTL_ZERO_BYTES = 1 * MiB;
constexpr size_t WS_WA_IN = 2 * MiB, WS_WA_OUT = 18 * MiB, WS_WB_IN = 26 * MiB, WS_WB_OUT = 32 * MiB, WS_WC_IN = 34 * MiB, WS_WC_OUT = 40 * MiB;
constexpr size_t WS_WF_IN = 42 * MiB, WS_WF_OUT = 70 * MiB, WS_WM_IN = 84 * MiB, WS_WM_OUT = 308 * MiB;
constexpr size_t WS_X = 420 * MiB, WS_XB = 548 * MiB, WS_SSQ = 612 * MiB, WS_VSSQ = 614 * MiB, WS_GLOW = 618 * MiB, WS_LOGF = 620 * MiB, WS_OSSQ = 621 * MiB, WS_DEC = 629 * MiB;
constexpr size_t WS_TOKE = 630 * MiB, WS_TOKP = WS_TOKE + 256 * 1024, WS_TOKG = WS_TOKP + 256 * 1024, WS_TOKRS = WS_TOKG + 256 * 1024, WS_BLKB = WS_TOKRS + 128 * 1024;
constexpr size_t WS_ROWT = 632 * MiB, WS_ROWG = WS_ROWT + 512 * 1024, WS_ROWRS = WS_ROWG + 512 * 1024;
constexpr size_t WS_ACT = 640 * MiB;
constexpr size_t WS_U = WS_ACT, WS_V = WS_ACT + 128 * MiB, WS_Y = WS_ACT + 256 * MiB;
constexpr size_t WS_X8 = WS_X;
constexpr size_t WS_HF = WS_ACT;
constexpr size_t WS_QKVR = WS_ACT, WS_QD = WS_ACT + 192 * MiB, WS_KD = WS_ACT + 224 * MiB, WS_KET = WS_ACT + 256 * MiB, WS_VT = WS_ACT + 288 * MiB, WS_GO = WS_ACT + 352 * MiB, WS_GG = WS_ACT + 416 * MiB;
constexpr size_t WS_AO = WS_ACT + 192 * MiB;
constexpr size_t WS_XS = WS_ACT, WS_HM = WS_ACT + 132 * MiB, WS_OS = WS_ACT + 594 * MiB;
constexpr size_t WS_END = WS_ACT + 722 * MiB;
static_assert((size_t)MROWS * 1024 * 2 <= 132 * MiB && (size_t)MROWS * FF * 2 <= 462 * MiB, "MoE buffers");
constexpr int CW_TMO = 0, CW_CODE = 1, CW_XMIS = 2, CW_BAR = 4096, CW_CNT = 8192, CW_KNB = 12288;

constexpr int RING_OFF = 0, RING_BYTES = 131072;
constexpr int LDSCTL_OFF = RING_BYTES, MISC_OFF = LDSCTL_OFF + 320;
constexpr int LDS_BYTES = 147456;
static_assert(MISC_OFF + 128 <= LDS_BYTES, "LDS map");

#define GAS __attribute__((address_space(1)))
#define LAS __attribute__((address_space(3)))
#define DI __device__ __forceinline__
typedef unsigned short bf16;
typedef unsigned v4u __attribute__((ext_vector_type(4)));
typedef unsigned v2u __attribute__((ext_vector_type(2)));
typedef float f32x4 __attribute__((ext_vector_type(4)));
typedef short bf16x8 __attribute__((ext_vector_type(8)));
typedef short bf16x4 __attribute__((ext_vector_type(4)));
typedef GAS unsigned gu32;
#define RLX_AGENT __ATOMIC_RELAXED, __HIP_MEMORY_SCOPE_AGENT
#define LDS_WAIT() asm volatile("s_waitcnt lgkmcnt(0)" ::: "memory")
#define VM_WAIT() asm volatile("s_waitcnt vmcnt(0)" ::: "memory")
DI unsigned f2bf(float f) { unsigned u = __builtin_bit_cast(unsigned, f); return (u + 0x7fffu + ((u >> 16) & 1u)) >> 16; }
DI unsigned pk2(float lo, float hi) { return f2bf(lo) | (f2bf(hi) << 16); }
DI float bflo(unsigned w) { return __builtin_bit_cast(float, w << 16); }
DI float bfhi(unsigned w) { return __builtin_bit_cast(float, w & 0xffff0000u); }
DI float bf2f(bf16 h) { return __builtin_bit_cast(float, ((unsigned)h) << 16); }
DI float wave_sum(float v) {
#pragma unroll
    for (int o = 1; o < 64; o <<= 1) v += __shfl_xor(v, o);
    return v;
}
DI float logsig(float z) { return fminf(z, 0.f) - log1pf(__expf(-fabsf(z))); }
#define MFMA16(a, b, c) __builtin_amdgcn_mfma_f32_16x16x32_bf16((a), (b), (c), 0, 0, 0)
DI bf16x8 ldsfrag(LAS const unsigned char* p) { return *(LAS const bf16x8*)p; }
typedef short s16x4 __attribute__((ext_vector_type(4)));
DI bf16x8 tr_frag(LAS const unsigned char* p0, LAS const unsigned char* p1) {
    const s16x4 a = __builtin_amdgcn_ds_read_tr16_b64_v4i16((LAS s16x4*)p0), b = __builtin_amdgcn_ds_read_tr16_b64_v4i16((LAS s16x4*)p1);
    return __builtin_shufflevector(a, b, 0, 1, 2, 3, 4, 5, 6, 7);
}
#define XB_TMO      128
#define XB_XCNT(j)  (256  + 64 * (j))
#define XB_XSUB(j)  (1280 + 64 * (j))
#define XB_XGEN(j)  (2304 + 64 * (j))
#define XB_TOP      3328
#define XB_TOPGEN   3392
#define XCD_BAR_WORDS 3456
#define XB_SPIN_CAP (1u << 18)

__device__ __forceinline__ unsigned xb_ld(unsigned* p)              { return __hip_atomic_load(p, __ATOMIC_RELAXED, __HIP_MEMORY_SCOPE_AGENT); }
__device__ __forceinline__ unsigned xb_add(unsigned* p, unsigned v) { return __hip_atomic_fetch_add(p, v, __ATOMIC_RELAXED, __HIP_MEMORY_SCOPE_AGENT); }
__device__ __forceinline__ unsigned xb_xcc_id() { return (unsigned)__builtin_amdgcn_s_getreg((3 << 11) | 20) & 0xFu; }
#define XB_SPIN(cond, bar) do { unsigned _sp = 0; while (cond) { __builtin_amdgcn_s_sleep(1); \
    if ((++_sp & 255u) == 0u) { if (xb_ld(&(bar)[XB_TMO])) break; if (_sp > XB_SPIN_CAP) { atomicAdd(&(bar)[XB_TMO], 1u); break; } } } } while (0)

struct XcdBarrier {
    unsigned* bar; unsigned x;
    volatile LAS unsigned* st;
};

__device__ __forceinline__ XcdBarrier xcd_barrier_post(unsigned* bar, volatile LAS unsigned* st) {
    XcdBarrier b; b.bar = bar; b.x = xb_xcc_id(); b.st = st;
    if (threadIdx.x == 0) (void)xb_add(&bar[XB_XCNT(b.x)], 1u);
    return b;
}
__device__ __forceinline__ void xcd_barrier_complete(unsigned* bar, unsigned x, unsigned& nloc, unsigned& nx) {
    const unsigned G = gridDim.x * gridDim.y * gridDim.z;
    unsigned sum, cnt, mine, sp = 0u;
    for (;;) {
        sum = 0u; cnt = 0u; mine = 0u;
#pragma unroll
        for (unsigned j = 0; j < 16; ++j) { const unsigned c = xb_ld(&bar[XB_XCNT(j)]); sum += c; cnt += (c > 0u) ? 1u : 0u; mine = (j == x) ? c : mine; }
        if (sum == G) break;
        __builtin_amdgcn_s_sleep(1);
        if ((++sp & 255u) == 0u) { if (xb_ld(&bar[XB_TMO])) break; if (sp > XB_SPIN_CAP) { atomicAdd(&bar[XB_TMO], 1u); break; } }
    }
    nloc = mine > 0u ? mine : 1u; nx = cnt > 0u ? cnt : 1u;
}

__device__ __forceinline__ void xcd_barrier(const XcdBarrier& b) {
    asm volatile("s_waitcnt vmcnt(0)" ::: "memory");
    __syncthreads();
    if (threadIdx.x == 0) {
        unsigned* bar = b.bar;
        __builtin_amdgcn_s_waitcnt(0);
        unsigned nloc = b.st[0], nx = b.st[1];
        if (nloc == 0u) { xcd_barrier_complete(bar, b.x, nloc, nx); b.st[0] = nloc; b.st[1] = nx; }
        const unsigned old = xb_add(&bar[XB_XSUB(b.x)], 1u);
        const unsigned gen = old / nloc;
        if (old + 1u == (gen + 1u) * nloc) {
            __builtin_amdgcn_fence(__ATOMIC_RELEASE, "agent");
            asm volatile("s_waitcnt vmcnt(0)" ::: "memory");
            const unsigned og = xb_add(&bar[XB_TOP], 1u);
            const unsigned tg = og / nx;
            if (og + 1u == (tg + 1u) * nx) xb_add(&bar[XB_TOPGEN], 1u);
            else XB_SPIN(xb_ld(&bar[XB_TOPGEN]) == tg, bar);
            __builtin_amdgcn_fence(__ATOMIC_ACQUIRE, "agent");
            xb_add(&bar[XB_XGEN(b.x)], 1u);
            asm volatile("s_waitcnt vmcnt(0)" ::: "memory");
        } else {
            XB_SPIN(xb_ld(&bar[XB_XGEN(b.x)]) == gen, bar);
            __builtin_amdgcn_fence(__ATOMIC_ACQUIRE, "agent");
            asm volatile("s_waitcnt vmcnt(0)" ::: "memory");
        }
    }
    __syncthreads();
}

__device__ __forceinline__ void xcd_barrier_local(const XcdBarrier& b) {
    asm volatile("s_waitcnt vmcnt(0)" ::: "memory");
    __syncthreads();
    if (threadIdx.x == 0) {
        unsigned* bar = b.bar;
        __builtin_amdgcn_s_waitcnt(0);
        const unsigned nloc = b.st[0];
        const unsigned old = xb_add(&bar[XB_XSUB(b.x)], 1u);
        const unsigned gen = old / nloc;
        if (old + 1u == (gen + 1u) * nloc) xb_add(&bar[XB_XGEN(b.x)], 1u);
        else XB_SPIN(xb_ld(&bar[XB_XGEN(b.x)]) == gen, bar);
        __builtin_amdgcn_fence(__ATOMIC_ACQUIRE, "agent");
        asm volatile("s_waitcnt vmcnt(0)" ::: "memory");
    }
    __syncthreads();
}

struct Frame {
    LAS unsigned char* lds;
    volatile LAS unsigned* MISC;
    gu32* ctl;
    int tid, lane, wave;
    int vcu, G;
    float* out; unsigned char* ws;
};
template <class T> DI T* wsp(const Frame& F, size_t off) { return (T*)(F.ws + off); }

struct MatDesc { const float* W; int ldw, K, N; bf16* WT; int mode; const float* gain; int f8; };
template <class A> DI MatDesc get_mat(const Frame& F, const A& P, int idx) {
    MatDesc d; d.f8 = 0;
    if (idx < 2)        { const int j = idx;      d.W = P.in[3] + (size_t)j * 1024 * 4096; d.ldw = 4096; d.K = 1024; d.N = 4096; d.f8 = (j == 1 && AIN_F8) ? 1 : 0; d.WT = wsp<bf16>(F, WS_WA_IN) + (size_t)j * 4096 * 1024; d.mode = 0; d.gain = P.in[1] + (j ? 3 : 0) * 1024; }
    else if (idx < 4)   { const int j = idx - 2;  d.W = P.in[7] + (size_t)j * 2048 * 1024; d.ldw = 1024; d.K = 2048; d.N = 1024; d.f8 = (AOUT_F8 >> j) & 1; d.WT = wsp<bf16>(F, WS_WA_OUT) + (size_t)j * 1024 * 2048; d.mode = 0; d.gain = nullptr; }
    else if (idx == 4)  { d.W = P.in[8];  d.ldw = 3088; d.K = 1024; d.N = 3072; d.WT = wsp<bf16>(F, WS_WB_IN);  d.mode = 0; d.gain = P.in[1] + 1 * 1024; }
    else if (idx == 5)  { d.W = P.in[12]; d.ldw = 1024; d.K = 1024; d.N = 1024; d.WT = wsp<bf16>(F, WS_WB_OUT); d.mode = 0; d.gain = nullptr; d.f8 = BOUT_F8; }
    else if (idx == 6)  { d.W = P.in[13]; d.ldw = 3080; d.K = 1024; d.N = 3072; d.WT = wsp<bf16>(F, WS_WC_IN);  d.mode = 0; d.gain = P.in[1] + 2 * 1024; d.f8 = CIN_F8; }
    else if (idx == 7)  { d.W = P.in[15]; d.ldw = 1024; d.K = 1024; d.N = 1024; d.WT = wsp<bf16>(F, WS_WC_OUT); d.mode = 0; d.gain = nullptr; d.f8 = COUT_F8; }
    else if (idx < 10)  { const int i = idx - 8;  d.W = P.in[16] + (size_t)i * 1024 * 7168; d.ldw = 7168; d.K = 1024; d.N = 7168; d.f8 = (DENSE_F8 >> i) & 1; d.WT = d.f8 ? (bf16*)(wsp<unsigned char>(F, WS_WF_IN) + (size_t)i * 2 * 7168 * 1024) : wsp<bf16>(F, WS_WF_IN) + (size_t)i * 7168 * 1024; d.mode = 1; d.gain = P.in[2] + (2 * i) * 1024; }
    else if (idx < 12)  { const int i = idx - 10; d.W = P.in[17] + (size_t)i * 3584 * 1024; d.ldw = 1024; d.K = 3584; d.N = 1024; d.f8 = (DENSE_F8 >> i) & 1; d.WT = d.f8 ? (bf16*)(wsp<unsigned char>(F, WS_WF_OUT) + (size_t)i * 2 * 1024 * 3584) : wsp<bf16>(F, WS_WF_OUT) + (size_t)i * 1024 * 3584; d.mode = 0; d.gain = nullptr; }
    else if (idx < 28)  { const int q = idx - 12; d.W = P.in[19] + (size_t)q * 1024 * 7168; d.ldw = 7168; d.K = 1024; d.N = 7168; d.WT = MOE_F8 ? (bf16*)(wsp<unsigned char>(F, WS_WM_IN) + (size_t)q * 7168 * 1024) : wsp<bf16>(F, WS_WM_IN) + (size_t)q * 7168 * 1024; d.mode = 1; d.gain = P.in[2] + (2 * (q >> 3) + 1) * 1024; d.f8 = MOE_F8; }
    else                { const int q = idx - 28; d.W = P.in[20] + (size_t)q * 3584 * 1024; d.ldw = 1024; d.K = 3584; d.N = 1024; d.WT = MOE_F8 ? (bf16*)(wsp<unsigned char>(F, WS_WM_OUT) + (size_t)q * 1024 * 3584) : wsp<bf16>(F, WS_WM_OUT) + (size_t)q * 1024 * 3584; d.mode = 0; d.gain = nullptr; d.f8 = MOE_F8; }
    return d;
}
constexpr int NMATS = 44;
constexpr int P0_ST = 129;
struct P0Dst { bf16* base; int K; int f8; };
DI int p0_ntiles(const MatDesc& d) { return (d.K / 128) * (d.N / 128); }
DI P0Dst p0_load(const MatDesc& d, int tile, int tid, f32x4 (&r)[8], float (&g)[8]) {
    const int ntn = d.N / 128, kb = tile / ntn, nb = tile % ntn, k0 = 128 * kb, n0 = 128 * nb;
#pragma unroll
    for (int p = 0; p < 8; ++p) { const int k = k0 + p * 16 + (tid >> 5); r[p] = *(const f32x4*)(d.W + (size_t)k * d.ldw + n0 + 4 * (tid & 31)); g[p] = d.gain ? d.gain[k] : 1.0f; }
    int drow0 = n0;
    if (d.mode == 1) drow0 = (n0 < FF) ? (n0 >> 7) * 256 : ((n0 - FF) >> 7) * 256 + 128;
    P0Dst o; o.K = d.K; o.f8 = d.f8;
    if (d.f8) { o.base = (bf16*)((unsigned char*)d.WT + (size_t)drow0 * d.K + k0);
#pragma unroll
        for (int p = 0; p < 8; ++p) g[p] *= 64.0f; }
    else o.base = d.WT + (size_t)drow0 * d.K + k0;
    return o;
}
constexpr int N_EARLY = 6;
DI int morder(int i) { return i == 0 ? 0 : i == 1 ? 2 : i == 2 ? 4 : i == 3 ? 5 : i == 4 ? 8 : i == 5 ? 10 : i == 6 ? 1 : i == 7 ? 3 : i == 8 ? 6 : i == 9 ? 7 : i == 10 ? 9 : i == 11 ? 11 : i; }
struct P0State { int mi, i_hi, base, nt, T, stride; MatDesc d; };
template <class A> DI void p0_init(P0State& s, Frame& F, const A& P, int i_lo, int i_hi, int worker, int nworkers) { s.mi = i_lo; s.i_hi = i_hi; s.base = 0; s.T = worker; s.stride = nworkers; s.d = get_mat(F, P, morder(i_lo)); s.nt = p0_ntiles(s.d); }
#define P0_NEXT(st, r, g, dst, have) do { have = false; while (st.mi < st.i_hi && st.T >= st.base + st.nt) { st.base += st.nt; ++st.mi; if (st.mi < st.i_hi) { st.d = get_mat(F, P, morder(st.mi)); st.nt = p0_ntiles(st.d); } } \
        if (st.mi < st.i_hi) { dst = p0_load(st.d, st.T - st.base, tid, r, g); have = true; } st.T += st.stride; } while (0)
constexpr int P0_TST = 272;
#define P0_WRITE(S, r, g, dst) do { \
        _Pragma("unroll") for (int p = 0; p < 8; ++p) { f32x4 v_ = r[p] * g[p]; \
            if (dst.f8) { v_[0] = pg8::c8(v_[0]); v_[1] = pg8::c8(v_[1]); v_[2] = pg8::c8(v_[2]); v_[3] = pg8::c8(v_[3]); } \
            v2u w_; w_.x = pg8::cvt_pk_bf16(v_[0], v_[1]); w_.y = pg8::cvt_pk_bf16(v_[2], v_[3]); \
            *(LAS v2u*)((S) + (p * 16 + (tid >> 5)) * P0_TST + 8 * (tid & 31)) = w_; } \
        } while (0)
#define P0_STORE(S, dst) do { const int w_ = tid >> 6, fr_ = tid & 15, fq_ = (tid >> 4) & 3; \
        LAS const unsigned char* tp_ = (S) + (fr_ >> 2) * P0_TST + (16 * w_ + 4 * (fr_ & 3)) * 2; \
        if (dst.f8) { _Pragma("unroll") for (int kk = 0; kk < 2; ++kk) { const int kb_ = 64 * kk + 16 * fq_; \
            const bf16x8 a0_ = tr_frag(tp_ + kb_ * P0_TST, tp_ + (kb_ + 4) * P0_TST), a1_ = tr_frag(tp_ + (kb_ + 8) * P0_TST, tp_ + (kb_ + 12) * P0_TST); \
            const v4u x0_ = __builtin_bit_cast(v4u, a0_), x1_ = __builtin_bit_cast(v4u, a1_); v4u o; \
            { int q_ = __builtin_amdgcn_cvt_pk_fp8_f32(bflo(x0_.x), bfhi(x0_.x), 0, false); q_ = __builtin_amdgcn_cvt_pk_fp8_f32(bflo(x0_.y), bfhi(x0_.y), q_, true); o.x = (unsigned)q_; } \
            { int q_ = __builtin_amdgcn_cvt_pk_fp8_f32(bflo(x0_.z), bfhi(x0_.z), 0, false); q_ = __builtin_amdgcn_cvt_pk_fp8_f32(bflo(x0_.w), bfhi(x0_.w), q_, true); o.y = (unsigned)q_; } \
            { int q_ = __builtin_amdgcn_cvt_pk_fp8_f32(bflo(x1_.x), bfhi(x1_.x), 0, false); q_ = __builtin_amdgcn_cvt_pk_fp8_f32(bflo(x1_.y), bfhi(x1_.y), q_, true); o.z = (unsigned)q_; } \
            { int q_ = __builtin_amdgcn_cvt_pk_fp8_f32(bflo(x1_.z), bfhi(x1_.z), 0, false); q_ = __builtin_amdgcn_cvt_pk_fp8_f32(bflo(x1_.w), bfhi(x1_.w), q_, true); o.w = (unsigned)q_; } \
            *(v4u*)((unsigned char*)dst.base + (size_t)(16 * w_ + fr_) * dst.K + kb_) = o; } } \
        else { _Pragma("unroll") for (int kk = 0; kk < 4; ++kk) { const int kb_ = 32 * kk + 8 * fq_; \
            const bf16x8 a_ = tr_frag(tp_ + kb_ * P0_TST, tp_ + (kb_ + 4) * P0_TST); \
            *(v4u*)(dst.base + (size_t)(16 * w_ + fr_) * dst.K + kb_) = __builtin_bit_cast(v4u, a_); } } \
        } while (0)
template <class A> DI void p0_convert(Frame& F, const A& P, int i_lo, int i_hi, int worker, int nworkers) {
    LAS unsigned char* S = F.lds;
    const int tid = F.tid;
    P0State st; p0_init(st, F, P, i_lo, i_hi, worker, nworkers);
    f32x4 rA[8], rB[8]; float gA[8], gB[8]; P0Dst dA, dB; dA.base = nullptr; dA.K = 0; dA.f8 = 0; dB = dA; bool hA = false, hB = false;
    P0_NEXT(st, rA, gA, dA, hA);
    while (hA) {
        P0_NEXT(st, rB, gB, dB, hB);
        P0_WRITE(S, rA, gA, dA); __syncthreads(); P0_STORE(S, dA); __syncthreads();
        if (!hB) break;
        P0_NEXT(st, rA, gA, dA, hA);
        P0_WRITE(S, rB, gB, dB); __syncthreads(); P0_STORE(S, dB); __syncthreads();
    }
}
template <class A> DI void p0_prologue(Frame& F, const A& P) {
    const int gw = F.vcu * NWAVES + F.wave, NGW = F.G * NWAVES;
    { const float* x = P.in[0]; bf16* xb = wsp<bf16>(F, WS_XB); float* ssq = wsp<float>(F, WS_SSQ);
      for (int m = gw; m < M; m += NGW) {
        const f32x4* xr = (const f32x4*)(x + (size_t)m * D) + F.lane; f32x4 v[4]; float s = 0.f;
#pragma unroll
        for (int j = 0; j < 4; ++j) { v[j] = xr[64 * j]; s += (v[j][0] * v[j][0] + v[j][1] * v[j][1]) + (v[j][2] * v[j][2] + v[j][3] * v[j][3]); }
        s = wave_sum(s);
        v2u* o8 = (v2u*)(xb + (size_t)m * D) + F.lane;
#pragma unroll
        for (int j = 0; j < 4; ++j) { v2u w; w.x = pk2(v[j][0], v[j][1]); w.y = pk2(v[j][2], v[j][3]); o8[64 * j] = w; }
        if (F.lane < 4) { f32x4 z = {0.f, 0.f, 0.f, 0.f}; if (F.lane == 0) z[0] = s; *((f32x4*)(ssq + (size_t)m * 16) + F.lane) = z; }
      } }
    p0_convert(F, P, 0, N_EARLY, F.vcu, F.G);
}

constexpr int TH_ST = 2064, TH_WL = 16 * TH_ST;
template <int NOUT> DI void thin_stage(Frame& F, const float* gain, const float* W, int ldw, int c0) {
    LAS unsigned char* lds = F.lds;
    for (int i = F.tid; i < 1024 * 16; i += NWAVES * 64) { const int n = i & 15, k = i >> 4; const float v = (n < NOUT) ? gain[k] * W[(size_t)k * ldw + c0 + n] : 0.f;
        const unsigned hi = f2bf(v); const float r = v - __builtin_bit_cast(float, hi << 16);
        *(LAS unsigned short*)(lds + n * TH_ST + k * 2) = (unsigned short)hi; *(LAS unsigned short*)(lds + TH_WL + n * TH_ST + k * 2) = (unsigned short)f2bf(r); }
    __syncthreads();
}
DI void thin_tile(const bf16* x, int row0, LAS const unsigned char* lds, int lane, float& ss, f32x4& out) {
    const int fr = lane & 15, fq = lane >> 4; const bf16* xr = x + (size_t)(row0 + fr) * D + 8 * fq; LAS const unsigned char* wp = lds + fr * TH_ST + 16 * fq;
    f32x4 acc = {0.f, 0.f, 0.f, 0.f}; float s = 0.f;
#pragma unroll 1
    for (int kb = 0; kb < 4; ++kb) { v4u a[8];
#pragma unroll
        for (int i = 0; i < 8; ++i) a[i] = *(const v4u*)(xr + 32 * (8 * kb + i));
#pragma unroll
        for (int i = 0; i < 8; ++i) { const v4u q = a[i];
            s += (bflo(q.x) * bflo(q.x) + bfhi(q.x) * bfhi(q.x)) + (bflo(q.y) * bflo(q.y) + bfhi(q.y) * bfhi(q.y)) + (bflo(q.z) * bflo(q.z) + bfhi(q.z) * bfhi(q.z)) + (bflo(q.w) * bflo(q.w) + bfhi(q.w) * bfhi(q.w));
            const bf16x8 xa = __builtin_bit_cast(bf16x8, q); const bf16x8 wh = ldsfrag(wp + 64 * (8 * kb + i)), wl = ldsfrag(wp + TH_WL + 64 * (8 * kb + i));
            acc = MFMA16(wh, xa, acc); acc = MFMA16(wl, xa, acc); } }
    s += __shfl_xor(s, 16); s += __shfl_xor(s, 32);
    ss = s; out = acc;
}
DI void glow_phase(Frame& F, const bf16* x, const float* gain, const float* Wb) {
    thin_stage<16>(F, gain, Wb, 3088, 3072);
    float* glow = wsp<float>(F, WS_GLOW);
    const int gw = F.vcu * NWAVES + F.wave, NGW = F.G * NWAVES, fr = F.lane & 15, fq = F.lane >> 4;
    for (int t = gw; t < M / 16; t += NGW) { float ss; f32x4 o; thin_tile(x, 16 * t, F.lds, F.lane, ss, o);
        const float rs = 1.0f / sqrtf(ss * (1.0f / D) + EPS);
        *(f32x4*)(glow + (size_t)(16 * t + fr) * 16 + 4 * fq) = o * rs; }
    __syncthreads();
}
DI void logf_phase(Frame& F, const bf16* x, const float* gain, const float* Wc, const float* fb) {
    thin_stage<8>(F, gain, Wc, 3080, 3072);
    float* logf = wsp<float>(F, WS_LOGF);
    const int gw = F.vcu * NWAVES + F.wave, NGW = F.G * NWAVES, fr = F.lane & 15, fq = F.lane >> 4;
    const f32x4 fb4 = *(const f32x4*)(fb + 4 * (fq & 1));
    for (int t = gw; t < M / 16; t += NGW) { float ss; f32x4 o; thin_tile(x, 16 * t, F.lds, F.lane, ss, o);
        const float rs = 1.0f / sqrtf(ss * (1.0f / D) + EPS);
        if (fq < 2) { f32x4 r;
#pragma unroll
            for (int e = 0; e < 4; ++e) r[e] = logsig(o[e] * rs + fb4[e]);
            *(f32x4*)(logf + (size_t)(16 * t + fr) * 8 + 4 * fq) = r; } }
    __syncthreads();
}
DI void router_phase(Frame& F, const bf16* x, const float* gain, const float* Wr, unsigned* gcnt) {
    thin_stage<8>(F, gain, Wr, 8, 0);
    LAS unsigned* lcnt = (LAS unsigned*)(F.lds + 2 * TH_WL);
    if (F.tid < 8) lcnt[F.tid] = 0u;
    __syncthreads();
    int* tok_e = wsp<int>(F, WS_TOKE); int* tok_p = wsp<int>(F, WS_TOKP); float* tok_g = wsp<float>(F, WS_TOKG); float* tok_rs = wsp<float>(F, WS_TOKRS); int* blkb = wsp<int>(F, WS_BLKB);
    const int gw = F.vcu * NWAVES + F.wave, NGW = F.G * NWAVES, fr = F.lane & 15, fq = F.lane >> 4;
    for (int t = gw; t < M / 16; t += NGW) { float ss; f32x4 o; thin_tile(x, 16 * t, F.lds, F.lane, ss, o);
        const float rs = 1.0f / sqrtf(ss * (1.0f / D) + EPS);
        f32x4 o2; o2[0] = __shfl_xor(o[0], 16); o2[1] = __shfl_xor(o[1], 16); o2[2] = __shfl_xor(o[2], 16); o2[3] = __shfl_xor(o[3], 16);
        if (fq == 0) { const int row = 16 * t + fr;
            const float lg[8] = {o[0] * rs, o[1] * rs, o[2] * rs, o[3] * rs, o2[0] * rs, o2[1] * rs, o2[2] * rs, o2[3] * rs};
            float v1 = lg[0]; int i1 = 0;
#pragma unroll
            for (int e = 1; e < 8; ++e) { if (lg[e] > v1) { v1 = lg[e]; i1 = e; } }
            float v2 = -3.0e38f; int i2 = 0;
#pragma unroll
            for (int e = 0; e < 8; ++e) { if (e != i1 && lg[e] > v2) { v2 = lg[e]; i2 = e; } }
            const float g1 = 1.0f / (1.0f + __expf(v2 - v1)), g2 = 1.0f - g1;
            const unsigned p1 = __hip_atomic_fetch_add(lcnt + i1, 1u, __ATOMIC_RELAXED, __HIP_MEMORY_SCOPE_WORKGROUP);
            const unsigned p2 = __hip_atomic_fetch_add(lcnt + i2, 1u, __ATOMIC_RELAXED, __HIP_MEMORY_SCOPE_WORKGROUP);
            tok_e[2 * row] = i1; tok_e[2 * row + 1] = i2; tok_p[2 * row] = (int)p1; tok_p[2 * row + 1] = (int)p2; tok_g[2 * row] = g1; tok_g[2 * row + 1] = g2; tok_rs[row] = rs; } }
    __syncthreads();
    if (F.tid < 8) { const unsigned b = __hip_atomic_fetch_add(gcnt + F.tid, lcnt[F.tid], __ATOMIC_RELAXED, __HIP_MEMORY_SCOPE_AGENT); blkb[F.vcu * 8 + F.tid] = (int)b; }
    __syncthreads();
}
template <bool F8> DI void gather_phase(Frame& F, const unsigned* gcnt) {
    LAS int* seg = (LAS int*)(F.lds); LAS int* cntl = seg + 16;
    if (F.tid == 0) { int t = 0; for (int e = 0; e < 8; ++e) { const int c = (int)gcnt[e]; seg[e] = t; cntl[e] = c; t += (c + 255) & ~255; } seg[8] = t; }
    __syncthreads();
    const int* tok_e = wsp<int>(F, WS_TOKE); const int* tok_p = wsp<int>(F, WS_TOKP); const float* tok_g = wsp<float>(F, WS_TOKG); const float* tok_rs = wsp<float>(F, WS_TOKRS); const int* blkb = wsp<int>(F, WS_BLKB);
    int* rtok = wsp<int>(F, WS_ROWT); float* rgate = wsp<float>(F, WS_ROWG); float* rrs = wsp<float>(F, WS_ROWRS);
    const bf16* xb = wsp<bf16>(F, WS_XB); bf16* XS = wsp<bf16>(F, WS_XS);
    const int gw = F.vcu * NWAVES + F.wave, NGW = F.G * NWAVES;
    for (int row = gw; row < M; row += NGW) { const int owner = ((row >> 4) % NGW) / NWAVES;
        const v4u* src = (const v4u*)(xb + (size_t)row * D); v4u a, b;
        if constexpr (F8) { a = src[2 * F.lane]; b = src[2 * F.lane + 1];
            int w0 = __builtin_amdgcn_cvt_pk_fp8_f32(pg8::c8(bflo(a.x)), pg8::c8(bfhi(a.x)), 0, false); w0 = __builtin_amdgcn_cvt_pk_fp8_f32(pg8::c8(bflo(a.y)), pg8::c8(bfhi(a.y)), w0, true); int w1 = __builtin_amdgcn_cvt_pk_fp8_f32(pg8::c8(bflo(a.z)), pg8::c8(bfhi(a.z)), 0, false); w1 = __builtin_amdgcn_cvt_pk_fp8_f32(pg8::c8(bflo(a.w)), pg8::c8(bfhi(a.w)), w1, true);
            int w2 = __builtin_amdgcn_cvt_pk_fp8_f32(pg8::c8(bflo(b.x)), pg8::c8(bfhi(b.x)), 0, false); w2 = __builtin_amdgcn_cvt_pk_fp8_f32(pg8::c8(bflo(b.y)), pg8::c8(bfhi(b.y)), w2, true); int w3 = __builtin_amdgcn_cvt_pk_fp8_f32(pg8::c8(bflo(b.z)), pg8::c8(bfhi(b.z)), 0, false); w3 = __builtin_amdgcn_cvt_pk_fp8_f32(pg8::c8(bflo(b.w)), pg8::c8(bfhi(b.w)), w3, true);
            a = (v4u){(unsigned)w0, (unsigned)w1, (unsigned)w2, (unsigned)w3}; b = a; }
        else { a = src[F.lane]; b = src[64 + F.lane]; }
#pragma unroll
        for (int slot = 0; slot < 2; ++slot) { const int e = tok_e[2 * row + slot]; const int r = seg[e] + blkb[owner * 8 + e] + tok_p[2 * row + slot];
            if constexpr (F8) { *((v4u*)((unsigned char*)XS + (size_t)r * D) + F.lane) = a; }
            else { v4u* dst = (v4u*)(XS + (size_t)r * D); dst[F.lane] = a; dst[64 + F.lane] = b; }
            if (F.lane == 0) { rtok[r] = 2 * row + slot; rgate[r] = tok_g[2 * row + slot]; rrs[r] = tok_rs[row]; } } }
    if (F.vcu == 0) { for (int e = 0; e < 8; ++e) for (int r = seg[e] + cntl[e] + F.tid; r < seg[e + 1]; r += NWAVES * 64) rtok[r] = -1; }
    __syncthreads();
}
DI void rowtable_phase(Frame& F, const unsigned* gcnt) {
    LAS int* seg = (LAS int*)(F.lds); LAS int* cntl = seg + 16;
    if (F.tid == 0) { int t = 0; for (int e = 0; e < 8; ++e) { const int c = (int)gcnt[e]; seg[e] = t; cntl[e] = c; t += (c + 255) & ~255; } seg[8] = t; }
    __syncthreads();
    const int* tok_e = wsp<int>(F, WS_TOKE); const int* tok_p = wsp<int>(F, WS_TOKP); const float* tok_g = wsp<float>(F, WS_TOKG); const float* tok_rs = wsp<float>(F, WS_TOKRS); const int* blkb = wsp<int>(F, WS_BLKB);
    int* rtok = wsp<int>(F, WS_ROWT); float* rgate = wsp<float>(F, WS_ROWG); float* rrs = wsp<float>(F, WS_ROWRS);
    const int NGW = F.G * NWAVES;
    for (int j = F.vcu * (NWAVES * 64) + F.tid; j < 2 * M; j += F.G * NWAVES * 64) { const int row = j >> 1, owner = ((row >> 4) % NGW) / NWAVES;
        const int e = tok_e[j]; const int r = seg[e] + blkb[owner * 8 + e] + tok_p[j];
        rtok[r] = j; rgate[r] = tok_g[j]; rrs[r] = tok_rs[row]; }
    if (F.vcu == 0) { for (int e = 0; e < 8; ++e) for (int r = seg[e] + cntl[e] + F.tid; r < seg[e + 1]; r += NWAVES * 64) rtok[r] = -1; }
    __syncthreads();
}
DI void combine_phase(Frame& F, bool fin, const float* fg, unsigned char* x8) {
    bf16* xb = wsp<bf16>(F, WS_XB); float* ssq = wsp<float>(F, WS_SSQ); const bf16* OS = wsp<bf16>(F, WS_OS);
    const int gw = F.vcu * NWAVES + F.wave, NGW = F.G * NWAVES;
    constexpr int RB = 2;
    for (int m0 = gw; m0 < M; m0 += RB * NGW) {
        v2u cx[RB][4], ca[RB][4], cb[RB][4];
#pragma unroll
        for (int i = 0; i < RB; ++i) { const int r_ = m0 + i * NGW, m = ((r_ & 2047) >> 8) * 4096 + (r_ & 255) + 256 * (r_ >> 11); if (r_ < M) {
                const v2u* xr = (const v2u*)(xb + (size_t)m * D) + F.lane; const v2u* o0 = (const v2u*)(OS + (size_t)m * D) + F.lane; const v2u* o1 = (const v2u*)(OS + ((size_t)M + m) * D) + F.lane;
#pragma unroll
                for (int j = 0; j < 4; ++j) { cx[i][j] = xr[64 * j]; ca[i][j] = o0[64 * j]; cb[i][j] = o1[64 * j]; } } }
#pragma unroll
        for (int i = 0; i < RB; ++i) { const int r_ = m0 + i * NGW, m = ((r_ & 2047) >> 8) * 4096 + (r_ & 255) + 256 * (r_ >> 11); if (r_ < M) {
        f32x4 v[4]; float s = 0.f;
#pragma unroll
        for (int j = 0; j < 4; ++j) { const v2u c = cx[i][j], a = ca[i][j], b = cb[i][j];
            v[j][0] = bflo(c.x) + (bflo(a.x) + bflo(b.x)); v[j][1] = bfhi(c.x) + (bfhi(a.x) + bfhi(b.x)); v[j][2] = bflo(c.y) + (bflo(a.y) + bflo(b.y)); v[j][3] = bfhi(c.y) + (bfhi(a.y) + bfhi(b.y));
            s += (v[j][0] * v[j][0] + v[j][1] * v[j][1]) + (v[j][2] * v[j][2] + v[j][3] * v[j][3]); }
        s = wave_sum(s);
        if (!fin) {
            v2u* o8 = (v2u*)(xb + (size_t)m * D) + F.lane;
#pragma unroll
            for (int j = 0; j < 4; ++j) { v2u w; w.x = pk2(v[j][0], v[j][1]); w.y = pk2(v[j][2], v[j][3]); o8[64 * j] = w; }
            if (x8) {
#pragma unroll
                for (int j = 0; j < 4; ++j) { int p = __builtin_amdgcn_cvt_pk_fp8_f32(pg8::c8(v[j][0]), pg8::c8(v[j][1]), 0, false); p = __builtin_amdgcn_cvt_pk_fp8_f32(pg8::c8(v[j][2]), pg8::c8(v[j][3]), p, true); *((unsigned*)(x8 + (size_t)m * D) + F.lane + 64 * j) = (unsigned)p; } }
            if (F.lane < 4) { f32x4 z = {0.f, 0.f, 0.f, 0.f}; if (F.lane == 0) z[0] = s; *((f32x4*)(ssq + (size_t)m * 16) + F.lane) = z; }
        } else {
            const float rs = 1.0f / sqrtf(s * (1.0f / D) + EPS); f32x4* ow = (f32x4*)(F.out + (size_t)m * D) + F.lane; const f32x4* g4 = (const f32x4*)fg + F.lane;
#pragma unroll
            for (int j = 0; j < 4; ++j) { const f32x4 g = g4[64 * j]; ow[64 * j] = v[j] * rs * g; }
        } } }
    }
}
DI void final_norm_phase(Frame& F, const bf16* x, const float* fg) {
    const int gw = F.vcu * NWAVES + F.wave, NGW = F.G * NWAVES;
    for (int m = gw; m < M; m += NGW) {
        const v2u* xr = (const v2u*)(x + (size_t)m * D) + F.lane; f32x4 v[4]; float s = 0.f;
#pragma unroll
        for (int j = 0; j < 4; ++j) { const v2u c = xr[64 * j]; v[j] = (f32x4){bflo(c.x), bfhi(c.x), bflo(c.y), bfhi(c.y)}; s += (v[j][0] * v[j][0] + v[j][1] * v[j][1]) + (v[j][2] * v[j][2] + v[j][3] * v[j][3]); }
        s = wave_sum(s);
        const float rs = 1.0f / sqrtf(s * (1.0f / D) + EPS); f32x4* ow = (f32x4*)(F.out + (size_t)m * D) + F.lane; const f32x4* g4 = (const f32x4*)fg + F.lane;
#pragma unroll
        for (int j = 0; j < 4; ++j) { const f32x4 g = g4[64 * j]; ow[64 * j] = v[j] * rs * g; }
    }
}


typedef __amdgpu_buffer_rsrc_t brsrc;
DI brsrc mk_rsrc(const void* p, unsigned bytes) { return __builtin_amdgcn_make_buffer_rsrc((void*)p, 0, bytes, 0x00020000); }
DI v4u bld128(brsrc r, unsigned voff, unsigned soff) { return __builtin_bit_cast(v4u, __builtin_amdgcn_raw_buffer_load_b128(r, voff, soff, 0)); }
DI v2u bld64(brsrc r, unsigned voff, unsigned soff) { return __builtin_bit_cast(v2u, __builtin_amdgcn_raw_buffer_load_b64(r, voff, soff, 0)); }
DI void bst64(brsrc r, unsigned voff, unsigned soff, v2u v) { __builtin_amdgcn_raw_buffer_store_b64(v, r, voff, soff, 0); }

template <bool Y8> DI void mix_phase(Frame& F, const float* ws_, const float* bs, const float* vg) {
    constexpr int WT_OFF = 0, WT_ST = 272, V_OFF = 34816, V_ST = 544, RS_OFF = 104448, BS_OFF = 105472, VG_OFF = 109568;
    const bf16* U = wsp<bf16>(F, WS_U); const bf16* V = wsp<bf16>(F, WS_V); bf16* Y = wsp<bf16>(F, WS_Y); const float* vssq = wsp<float>(F, WS_VSSQ);
    LAS unsigned char* lds = F.lds; LAS float* rsv = (LAS float*)(lds + RS_OFF); LAS float* bsl = (LAS float*)(lds + BS_OFF); LAS float* vgl = (LAS float*)(lds + VG_OFF);
    { const f32x4 b4 = (F.tid < 256) ? *(const f32x4*)(bs + 4 * F.tid) : (f32x4){0.f, 0.f, 0.f, 0.f}; const f32x4 g4 = *(const f32x4*)(vg + 4 * F.tid);
      if (F.tid < 256) *(LAS f32x4*)(bsl + 4 * F.tid) = b4; *(LAS f32x4*)(vgl + 4 * F.tid) = g4; }
    const int tid = F.tid, lane = F.lane, w = F.wave, fr = lane & 15, fq = lane >> 4;
    const int wfo = WT_OFF + fr * WT_ST + fq * 8;
    const int vfo = V_OFF + (4 * fq + (fr >> 2)) * V_ST + (32 * w + 4 * (fr & 3)) * 2;
    const brsrc rW = mk_rsrc(ws_, 8u * 128 * 128 * 4), rV = mk_rsrc(V, (unsigned)M * AW * 2), rU = mk_rsrc(U, (unsigned)M * AW * 2), rY = mk_rsrc(Y, (unsigned)M * AW * 2);
    const unsigned ulo8 = (unsigned)(fr * AW + 32 * w + 4 * fq);
    for (int c = F.vcu; c < 256; c += F.G) {
        const int tok0 = c * 128;
        if (tid < 128) { const f32x4* p = (const f32x4*)(vssq + (size_t)(tok0 + tid) * 32); float s = 0.f;
#pragma unroll
            for (int q = 0; q < 8; ++q) { const f32x4 a = p[q]; s += (a[0] + a[1]) + (a[2] + a[3]); }
            rsv[tid] = 1.0f / sqrtf(s * (1.0f / AW) + EPS); }
        f32x4 wreg[8]; v4u vreg[8];
        const unsigned wlo = (unsigned)((tid >> 5) * 512 + (tid & 31) * 16), vlo = (unsigned)((tid >> 5) * (AW * 2) + (tid & 31) * 16);
#define MIX_LOAD(gg) do { const unsigned ws_o = (unsigned)(gg) * 65536u, vs_o = (unsigned)tok0 * (AW * 2) + (unsigned)(gg) * 512u; \
            _Pragma("unroll") for (int it = 0; it < 8; ++it) { wreg[it] = __builtin_bit_cast(f32x4, bld128(rW, wlo, ws_o + (unsigned)(it * 16 * 512))); vreg[it] = bld128(rV, vlo, vs_o + (unsigned)(it * 16 * AW * 2)); } } while (0)
        MIX_LOAD(0);
        __syncthreads();
#pragma unroll 1
        for (int g = 0; g < 8; ++g) {
            const unsigned us_o = (unsigned)tok0 * (AW * 2) + (unsigned)g * 512u;
            const unsigned ulo = (unsigned)(fr * (AW * 2) + (32 * w + 4 * fq) * 2);
            v2u ureg[2][4][2];
#pragma unroll
            for (int hf = 0; hf < 2; ++hf)
#pragma unroll
                for (int m4 = 0; m4 < 4; ++m4)
#pragma unroll
                    for (int n2 = 0; n2 < 2; ++n2) ureg[hf][m4][n2] = bld64(rU, ulo, us_o + (unsigned)((16 * (4 * hf + m4)) * AW * 2 + 32 * n2));
#pragma unroll
            for (int it = 0; it < 8; ++it) { const int idx = it * 512 + tid, t = idx >> 5, s4 = (idx & 31) * 4; const f32x4 wv = wreg[it];
                const float a0 = (s4 + 0 <= t) ? wv[0] * rsv[s4 + 0] : 0.f, a1 = (s4 + 1 <= t) ? wv[1] * rsv[s4 + 1] : 0.f, a2 = (s4 + 2 <= t) ? wv[2] * rsv[s4 + 2] : 0.f, a3 = (s4 + 3 <= t) ? wv[3] * rsv[s4 + 3] : 0.f;
                v2u o; o.x = pk2(a0, a1); o.y = pk2(a2, a3); *(LAS v2u*)(lds + WT_OFF + t * WT_ST + s4 * 2) = o;
                *(LAS v4u*)(lds + V_OFF + (idx >> 5) * V_ST + (idx & 31) * 16) = vreg[it]; }
            __syncthreads();
            if (g + 1 < 8) MIX_LOAD(g + 1);
#pragma unroll
            for (int hf = 0; hf < 2; ++hf) {
                f32x4 acc[4][2];
#pragma unroll
                for (int m4 = 0; m4 < 4; ++m4) { acc[m4][0] = (f32x4){0.f, 0.f, 0.f, 0.f}; acc[m4][1] = (f32x4){0.f, 0.f, 0.f, 0.f}; }
#pragma unroll
                for (int ks = 0; ks < 4; ++ks) { if (32 * ks > 16 * (4 * hf + 3) + 15) continue;
                    const bf16x8 b0 = tr_frag(lds + vfo + (32 * ks) * V_ST, lds + vfo + (32 * ks + 16) * V_ST), b1 = tr_frag(lds + vfo + (32 * ks) * V_ST + 32, lds + vfo + (32 * ks + 16) * V_ST + 32);
#pragma unroll
                    for (int m4 = 0; m4 < 4; ++m4) { const int mt = 4 * hf + m4; if (32 * ks > 16 * mt + 15) continue;
                        const v2u lo = *(const LAS v2u*)(lds + wfo + mt * 16 * WT_ST + ks * 64), hi = *(const LAS v2u*)(lds + wfo + mt * 16 * WT_ST + ks * 64 + 32);
                        const v4u av = {lo.x, lo.y, hi.x, hi.y}; const bf16x8 a = __builtin_bit_cast(bf16x8, av);
                        acc[m4][0] = MFMA16(b0, a, acc[m4][0]); acc[m4][1] = MFMA16(b1, a, acc[m4][1]); }
                    __builtin_amdgcn_sched_barrier(0); }
#pragma unroll
                for (int m4 = 0; m4 < 4; ++m4) { const int t = 16 * (4 * hf + m4) + fr; const float bt = bsl[g * 128 + t];
#pragma unroll
                    for (int n2 = 0; n2 < 2; ++n2) { const int col = g * 256 + 32 * w + 16 * n2 + 4 * fq;
                        const v2u uu = ureg[hf][m4][n2]; const f32x4 gg = *(const LAS f32x4*)(vgl + col); const f32x4 a = acc[m4][n2];
                        v2u r; r.x = pk2(bflo(uu.x) * (a[0] * gg[0] + bt), bfhi(uu.x) * (a[1] * gg[1] + bt)); r.y = pk2(bflo(uu.y) * (a[2] * gg[2] + bt), bfhi(uu.y) * (a[3] * gg[3] + bt));
                        if constexpr (Y8) { int p8 = __builtin_amdgcn_cvt_pk_fp8_f32(pg8::c8(4.0f * bflo(uu.x) * (a[0] * gg[0] + bt)), pg8::c8(4.0f * bfhi(uu.x) * (a[1] * gg[1] + bt)), 0, false);
                            p8 = __builtin_amdgcn_cvt_pk_fp8_f32(pg8::c8(4.0f * bflo(uu.y) * (a[2] * gg[2] + bt)), pg8::c8(4.0f * bfhi(uu.y) * (a[3] * gg[3] + bt)), p8, true);
                            __builtin_amdgcn_raw_buffer_store_b32((unsigned)p8, rY, ulo8, (unsigned)tok0 * AW + (unsigned)g * 256u + (unsigned)((16 * (4 * hf + m4)) * AW + 16 * n2), 0); }
                        else bst64(rY, ulo, us_o + (unsigned)((16 * (4 * hf + m4)) * AW * 2 + 32 * n2), r); }
                    __builtin_amdgcn_sched_barrier(0); }
            }
            __syncthreads();
        }
#undef MIX_LOAD
    }
}

DI void gla_prep_phase(Frame& F, const float* wg2, const float* gb) {
    constexpr int GL_OFF = 0, SEG_OFF = 4096, OFFS_OFF = 6144, EBL_OFF = 8192, BC_OFF = 8704, KETL_OFF = 41472, VTL_OFF = 59904, TST = 144;
    const bf16* QKVR = wsp<bf16>(F, WS_QKVR); const float* glow = wsp<float>(F, WS_GLOW);
    bf16* QD = wsp<bf16>(F, WS_QD); bf16* KD = wsp<bf16>(F, WS_KD); bf16* KET = wsp<bf16>(F, WS_KET); bf16* VT = wsp<bf16>(F, WS_VT); float* DEC = wsp<float>(F, WS_DEC);
    LAS unsigned char* lds = F.lds;
    LAS float* gl = (LAS float*)(lds + GL_OFF); LAS float* segs = (LAS float*)(lds + SEG_OFF); LAS float* offs = (LAS float*)(lds + OFFS_OFF); LAS float* ebl = (LAS float*)(lds + EBL_OFF); LAS float* bcl = (LAS float*)(lds + BC_OFF);
    const int tid = F.tid;
    const int t2 = tid >> 3, kb = (tid & 7) * 16, dvb = (tid & 7) * 32, k = tid & 127, tq = tid >> 7;
    float wv[16]; float bias = 0.f; int hcur = -1;
    v4u q0, q1, k0, k1, vv[4]; f32x4 gv = {0.f, 0.f, 0.f, 0.f};
#define PREP_LOAD(uu) do { const int h_ = (uu) & 3, n_ = ((uu) >> 2) & 63, b_ = (uu) >> 8; const int t0_ = b_ * SEQ + n_ * 64; const bf16* rowp = QKVR + (size_t)(t0_ + t2) * 3072; \
        q0 = *(const v4u*)(rowp + h_ * 128 + kb); q1 = *(const v4u*)(rowp + h_ * 128 + kb + 8); k0 = *(const v4u*)(rowp + 512 + h_ * 128 + kb); k1 = *(const v4u*)(rowp + 512 + h_ * 128 + kb + 8); \
        _Pragma("unroll") for (int i = 0; i < 4; ++i) vv[i] = *(const v4u*)(rowp + 1024 + h_ * 256 + dvb + 8 * i); \
        if (tid < 256) gv = *((const f32x4*)(glow + (size_t)t0_ * 16) + tid); } while (0)
#define PREP_MAP(s) ((((s) & 255) >> 5) * 256 + ((s) & 31) + 32 * ((s) >> 8))
    if (F.vcu < 2048) PREP_LOAD(PREP_MAP(F.vcu));
    for (int sidx = F.vcu; sidx < 2048; sidx += F.G) { const int uidx = PREP_MAP(sidx);
        const int h = uidx & 3, n = (uidx >> 2) & 63, b = uidx >> 8; const int t0 = b * SEQ + n * 64; const int bhn = (b * 4 + h) * 64 + n;
        if (h != hcur) { hcur = h;
#pragma unroll
            for (int r = 0; r < 16; ++r) wv[r] = wg2[r * 512 + h * 128 + k];
            bias = gb[h * 128 + k]; }
        if (tid < 256) *((LAS f32x4*)gl + tid) = gv;
        __syncthreads();
        { float cum = 0.f;
#pragma unroll
          for (int i = 0; i < 16; ++i) { const LAS f32x4* gp = (const LAS f32x4*)(gl + (tq * 16 + i) * 16); float z = bias;
#pragma unroll
              for (int q = 0; q < 4; ++q) { const f32x4 g4 = gp[q]; z += g4[0] * wv[4 * q] + g4[1] * wv[4 * q + 1] + g4[2] * wv[4 * q + 2] + g4[3] * wv[4 * q + 3]; }
              cum += (fminf(z, 0.f) - __logf(1.0f + __expf(-fabsf(z)))) * (1.0f / 16.0f); bcl[(tq * 16 + i) * 128 + k] = cum; }
          segs[tq * 128 + k] = cum; }
        __syncthreads();
        if (tid < 128) { const float s0 = segs[tid], s1 = segs[128 + tid], s2 = segs[256 + tid], s3 = segs[384 + tid];
            offs[tid] = 0.f; offs[128 + tid] = s0; offs[256 + tid] = s0 + s1; offs[384 + tid] = (s0 + s1) + s2;
            const float eb = __expf(((s0 + s1) + s2) + s3); ebl[tid] = eb; DEC[(size_t)bhn * 128 + tid] = eb; }
        __syncthreads();
        { const int tq2 = t2 >> 4; unsigned qo[8], ko[8]; const unsigned qw[8] = {q0.x, q0.y, q0.z, q0.w, q1.x, q1.y, q1.z, q1.w}, kw[8] = {k0.x, k0.y, k0.z, k0.w, k1.x, k1.y, k1.z, k1.w};
          LAS unsigned short* kt = (LAS unsigned short*)(lds + KETL_OFF); const int rot = ((t2 * 2 + 16 * (tid & 7)) & 127) >> 1;
#pragma unroll
          for (int e = 0; e < 16; e += 2) { float qd2[2], kd2[2];
#pragma unroll
              for (int u = 0; u < 2; ++u) { const int kk = kb + e + u; const float bcum = bcl[t2 * 128 + kk] + offs[tq2 * 128 + kk];
                  const float e1 = __expf(bcum), e2 = __builtin_amdgcn_rcpf(e1);
                  const float qv = u ? bfhi(qw[e >> 1]) : bflo(qw[e >> 1]), kv = u ? bfhi(kw[e >> 1]) : bflo(kw[e >> 1]);
                  qd2[u] = qv * 0.08838834764831845f * e1; kd2[u] = kv * e2;
                  kt[kk * (TST / 2) + rot] = (unsigned short)f2bf(kv * e2 * ebl[kk]); }
              qo[e >> 1] = pk2(qd2[0], qd2[1]); ko[e >> 1] = pk2(kd2[0], kd2[1]); }
          bf16* qdp = QD + (size_t)(t0 + t2) * 512 + h * 128 + kb; bf16* kdp = KD + (size_t)(t0 + t2) * 512 + h * 128 + kb;
          { v4u a = {qo[0], qo[1], qo[2], qo[3]}, c = {qo[4], qo[5], qo[6], qo[7]}; *(v4u*)qdp = a; *(v4u*)(qdp + 8) = c; }
          { v4u a = {ko[0], ko[1], ko[2], ko[3]}, c = {ko[4], ko[5], ko[6], ko[7]}; *(v4u*)kdp = a; *(v4u*)(kdp + 8) = c; }
          LAS unsigned short* vt = (LAS unsigned short*)(lds + VTL_OFF);
#pragma unroll
          for (int i = 0; i < 4; ++i) { const unsigned w4[4] = {vv[i].x, vv[i].y, vv[i].z, vv[i].w};
#pragma unroll
              for (int e = 0; e < 4; ++e) { const int dv = dvb + 8 * i + 2 * e; vt[dv * (TST / 2) + rot] = (unsigned short)(w4[e] & 0xffffu); vt[(dv + 1) * (TST / 2) + rot] = (unsigned short)(w4[e] >> 16); } } }
        if (sidx + F.G < 2048) PREP_LOAD(PREP_MAP(sidx + F.G));
        __syncthreads();
#pragma unroll
        for (int i = 0; i < 2; ++i) { const int c = tid + 512 * i, r = c >> 3, ch = c & 7;
            *(v4u*)(KET + ((size_t)bhn * 128 + r) * 64 + ch * 8) = *(const LAS v4u*)(lds + KETL_OFF + r * TST + (((ch + (r >> 4)) & 7) * 16)); }
#pragma unroll
        for (int i = 0; i < 4; ++i) { const int c = tid + 512 * i, r = c >> 3, ch = c & 7;
            *(v4u*)(VT + ((size_t)bhn * 256 + r) * 64 + ch * 8) = *(const LAS v4u*)(lds + VTL_OFF + r * TST + (((ch + (r >> 5)) & 7) * 16)); }
        __syncthreads();
    }
#undef PREP_LOAD
#undef PREP_MAP
}

template <class A> DI void gla_scan_phase(Frame& F, const A& P) {
    constexpr int QD_OFF = 0, KD_OFF = 17408, KET_OFF = 34816, VT_OFF = 53248, ATT_OFF = 57856, ST_OFF = 67072, ST272 = 272, ST144 = 144;
    const bf16* QD = wsp<bf16>(F, WS_QD); const bf16* KD = wsp<bf16>(F, WS_KD); const bf16* KET = wsp<bf16>(F, WS_KET); const bf16* VT = wsp<bf16>(F, WS_VT); const float* DEC = wsp<float>(F, WS_DEC);
    bf16* GO = wsp<bf16>(F, WS_GO); float* ossq = wsp<float>(F, WS_OSSQ);
    LAS unsigned char* lds = F.lds;
    const int tid = F.tid, lane = F.lane, w = F.wave, fr = lane & 15, fq = lane >> 4;
    LAS unsigned char* SC = lds + 76800;
    P0State cst; p0_init(cst, F, P, N_EARLY, NMATS, F.vcu, F.G);
    f32x4 rC[8]; float gC[8]; P0Dst dC; dC.base = nullptr; dC.K = 0; dC.f8 = 0; bool hC = false;
    P0_NEXT(cst, rC, gC, dC, hC);
    for (int uidx = F.vcu; uidx < 256; uidx += F.G) {
        const int vb = uidx & 7, h = (uidx >> 3) & 3, b = uidx >> 5;
        for (int i = tid; i < (32 * ST272) / 4; i += NWAVES * 64) ((LAS unsigned*)(lds + ST_OFF))[i] = 0u;
        f32x4 st[2] = {(f32x4){0.f, 0.f, 0.f, 0.f}, (f32x4){0.f, 0.f, 0.f, 0.f}};
        v4u pq[2], pk[2], pe[2], pv; float pdec;
#define GLA_LOAD(nn) do { const int bhn_ = (b * 4 + h) * 64 + (nn); const size_t t0_ = (size_t)b * SEQ + (size_t)(nn) * 64; \
            _Pragma("unroll") for (int i_ = 0; i_ < 2; ++i_) { const int c_ = tid + 512 * i_; const int r_ = c_ >> 4, ch_ = c_ & 15; \
                pq[i_] = *(const v4u*)(QD + (t0_ + r_) * 512 + h * 128 + ch_ * 8); pk[i_] = *(const v4u*)(KD + (t0_ + r_) * 512 + h * 128 + ch_ * 8); \
                pe[i_] = *(const v4u*)(KET + (size_t)bhn_ * 8192 + (size_t)c_ * 8); } \
            if (tid < 256) pv = *(const v4u*)(VT + ((size_t)bhn_ * 256 + vb * 32) * 64 + (size_t)tid * 8); \
            pdec = DEC[(size_t)bhn_ * 128 + 16 * w + fr]; } while (0)
        GLA_LOAD(0);
        for (int n = 0; n < 64; ++n) {
#pragma unroll
            for (int i = 0; i < 2; ++i) { const int c = tid + 512 * i; const int r = c >> 4, ch = c & 15;
                *(LAS v4u*)(lds + QD_OFF + r * ST272 + ch * 16) = pq[i]; *(LAS v4u*)(lds + KD_OFF + r * ST272 + ch * 16) = pk[i];
                const int rk = c >> 3, ck = c & 7; *(LAS v4u*)(lds + KET_OFF + rk * ST144 + ck * 16) = pe[i]; }
            if (tid < 256) { const int rv = tid >> 3, cv = tid & 7; *(LAS v4u*)(lds + VT_OFF + rv * ST144 + cv * 16) = pv; }
            const float dec = pdec;
            __syncthreads();
            if (n + 1 < 64) GLA_LOAD(n + 1);
            const int mt = w & 3, nt = w >> 2;
            const size_t tok0 = (size_t)b * SEQ + (size_t)n * 64;
            f32x4 oacc = {0.f, 0.f, 0.f, 0.f};
#pragma unroll
            for (int ks = 0; ks < 4; ++ks) { const bf16x8 a = ldsfrag(lds + QD_OFF + (16 * mt + fr) * ST272 + (32 * ks + 8 * fq) * 2), bb = ldsfrag(lds + ST_OFF + (16 * nt + fr) * ST272 + (32 * ks + 8 * fq) * 2);
                oacc = MFMA16(bb, a, oacc); }
#pragma unroll
            for (int q = 0; q < 2; ++q) { const int stile = 2 * nt + q; f32x4 sacc = {0.f, 0.f, 0.f, 0.f};
                if (stile <= mt) {
#pragma unroll
                    for (int ks = 0; ks < 4; ++ks) { const bf16x8 a = ldsfrag(lds + QD_OFF + (16 * mt + fr) * ST272 + (32 * ks + 8 * fq) * 2), bb = ldsfrag(lds + KD_OFF + (16 * stile + fr) * ST272 + (32 * ks + 8 * fq) * 2);
                        sacc = MFMA16(bb, a, sacc); } }
                const int t = 16 * mt + fr, s0 = 16 * stile + 4 * fq;
                const float a0 = (s0 + 0 <= t) ? sacc[0] : 0.f, a1 = (s0 + 1 <= t) ? sacc[1] : 0.f, a2 = (s0 + 2 <= t) ? sacc[2] : 0.f, a3 = (s0 + 3 <= t) ? sacc[3] : 0.f;
                v2u o; o.x = pk2(a0, a1); o.y = pk2(a2, a3); *(LAS v2u*)(lds + ATT_OFF + t * ST144 + s0 * 2) = o; }
#pragma unroll
            for (int vt = 0; vt < 2; ++vt) { st[vt] = st[vt] * dec;
#pragma unroll
                for (int ks = 0; ks < 2; ++ks) { const bf16x8 a = ldsfrag(lds + VT_OFF + (16 * vt + fr) * ST144 + (32 * ks + 8 * fq) * 2), bb = ldsfrag(lds + KET_OFF + (16 * w + fr) * ST144 + (32 * ks + 8 * fq) * 2);
                    st[vt] = MFMA16(a, bb, st[vt]); } }
            const bool cw = hC; const P0Dst dW = dC;
            if (cw) { P0_WRITE(SC, rC, gC, dC); P0_NEXT(cst, rC, gC, dC, hC); }
            __syncthreads();
            if (cw) { P0_STORE(SC, dW); }
#pragma unroll
            for (int vt = 0; vt < 2; ++vt)
#pragma unroll
                for (int j = 0; j < 4; ++j) *(LAS unsigned short*)(lds + ST_OFF + (16 * vt + 4 * fq + j) * ST272 + (16 * w + fr) * 2) = (unsigned short)f2bf(st[vt][j]);
#pragma unroll
            for (int ks = 0; ks < 2; ++ks) { const bf16x8 a = ldsfrag(lds + ATT_OFF + (16 * mt + fr) * ST144 + (32 * ks + 8 * fq) * 2), bb = ldsfrag(lds + VT_OFF + (16 * nt + fr) * ST144 + (32 * ks + 8 * fq) * 2);
                oacc = MFMA16(bb, a, oacc); }
            { const size_t tok = tok0 + 16 * mt + fr; const int col = h * 256 + vb * 32 + 16 * nt + 4 * fq;
              v2u o; o.x = pk2(oacc[0], oacc[1]); o.y = pk2(oacc[2], oacc[3]); *(v2u*)(GO + tok * 1024 + col) = o;
              float sq = (oacc[0] * oacc[0] + oacc[1] * oacc[1]) + (oacc[2] * oacc[2] + oacc[3] * oacc[3]); sq += __shfl_xor(sq, 16); sq += __shfl_xor(sq, 32);
              if (fq == 0) ossq[(tok * 4 + h) * 16 + vb * 2 + nt] = sq; }
            __syncthreads();
        }
#undef GLA_LOAD
    }
    while (hC) { const P0Dst dW = dC; P0_WRITE(SC, rC, gC, dC); P0_NEXT(cst, rC, gC, dC, hC); __syncthreads(); P0_STORE(SC, dW); __syncthreads(); }
}
DI void gla_gate_phase(Frame& F, const float* og) {
    const bf16* GO = wsp<bf16>(F, WS_GO); const bf16* QKVR = wsp<bf16>(F, WS_QKVR); const float* ossq = wsp<float>(F, WS_OSSQ); bf16* GG = wsp<bf16>(F, WS_GG);
    const int gw = F.vcu * NWAVES + F.wave, NGW = F.G * NWAVES, lane = F.lane;
    const int c0 = 16 * lane, hh = lane >> 4;
    f32x4 g4[4];
#pragma unroll
    for (int q = 0; q < 4; ++q) g4[q] = *(const f32x4*)(og + (c0 & 255) + 4 * q);
    constexpr int RB = 4;
#define GATE_MAP(r) ((((r) & 2047) >> 8) * 4096 + ((r) & 255) + 256 * ((r) >> 11))
    for (int m0 = gw; m0 < M; m0 += RB * NGW) {
        f32x4 sv[RB][4]; v4u ov[RB][2], rv[RB][2];
#pragma unroll
        for (int i = 0; i < RB; ++i) { const int r_ = m0 + i * NGW, m = GATE_MAP(r_); if (r_ < M) { const f32x4* sp = (const f32x4*)(ossq + ((size_t)m * 4 + hh) * 16);
#pragma unroll
                for (int q = 0; q < 4; ++q) sv[i][q] = sp[q];
                const v4u* op = (const v4u*)(GO + (size_t)m * 1024 + c0); const v4u* rp = (const v4u*)(QKVR + (size_t)m * 3072 + 2048 + c0);
                ov[i][0] = op[0]; ov[i][1] = op[1]; rv[i][0] = rp[0]; rv[i][1] = rp[1]; } }
#pragma unroll
        for (int i = 0; i < RB; ++i) { const int r_ = m0 + i * NGW, m = GATE_MAP(r_); if (r_ < M) { float s = 0.f;
#pragma unroll
                for (int q = 0; q < 4; ++q) { const f32x4 a = sv[i][q]; s += (a[0] + a[1]) + (a[2] + a[3]); }
                const float rs = 1.0f / sqrtf(s * (1.0f / 256.0f) + EPS);
                v4u* dp = (v4u*)(GG + (size_t)m * 1024 + c0);
                if constexpr (BOUT_F8 != 0) { const float r8 = 8.0f * rs; unsigned w8[4];
#pragma unroll
                    for (int q = 0; q < 2; ++q) { const v4u o = ov[i][q], r = rv[i][q]; const f32x4 ga = g4[2 * q], gb = g4[2 * q + 1];
                        int a_ = __builtin_amdgcn_cvt_pk_fp8_f32(pg8::c8(bflo(o.x) * r8 * ga[0] * pg8::silu_f(bflo(r.x))), pg8::c8(bfhi(o.x) * r8 * ga[1] * pg8::silu_f(bfhi(r.x))), 0, false);
                        a_ = __builtin_amdgcn_cvt_pk_fp8_f32(pg8::c8(bflo(o.y) * r8 * ga[2] * pg8::silu_f(bflo(r.y))), pg8::c8(bfhi(o.y) * r8 * ga[3] * pg8::silu_f(bfhi(r.y))), a_, true);
                        int b_ = __builtin_amdgcn_cvt_pk_fp8_f32(pg8::c8(bflo(o.z) * r8 * gb[0] * pg8::silu_f(bflo(r.z))), pg8::c8(bfhi(o.z) * r8 * gb[1] * pg8::silu_f(bfhi(r.z))), 0, false);
                        b_ = __builtin_amdgcn_cvt_pk_fp8_f32(pg8::c8(bflo(o.w) * r8 * gb[2] * pg8::silu_f(bflo(r.w))), pg8::c8(bfhi(o.w) * r8 * gb[3] * pg8::silu_f(bfhi(r.w))), b_, true);
                        w8[2 * q] = (unsigned)a_; w8[2 * q + 1] = (unsigned)b_; }
                    *(v4u*)((unsigned char*)GG + (size_t)m * 1024 + c0) = (v4u){w8[0], w8[1], w8[2], w8[3]}; }
                else
#pragma unroll
                for (int q = 0; q < 2; ++q) { const v4u o = ov[i][q], r = rv[i][q]; v4u d; const f32x4 ga = g4[2 * q], gb = g4[2 * q + 1];
                    d.x = pk2(bflo(o.x) * rs * ga[0] * pg8::silu_f(bflo(r.x)), bfhi(o.x) * rs * ga[1] * pg8::silu_f(bfhi(r.x)));
                    d.y = pk2(bflo(o.y) * rs * ga[2] * pg8::silu_f(bflo(r.y)), bfhi(o.y) * rs * ga[3] * pg8::silu_f(bfhi(r.y)));
                    d.z = pk2(bflo(o.z) * rs * gb[0] * pg8::silu_f(bflo(r.z)), bfhi(o.z) * rs * gb[1] * pg8::silu_f(bfhi(r.z)));
                    d.w = pk2(bflo(o.w) * rs * gb[2] * pg8::silu_f(bflo(r.w)), bfhi(o.w) * rs * gb[3] * pg8::silu_f(bfhi(r.w)));
                    dp[q] = d; } } }
    }
}
#undef GATE_MAP

DI void fox_attn_phase(Frame& F, const unsigned* knb) {
    constexpr int KST = 272, VST = 288, STAGE = 64 * KST + 64 * VST, V_OFF = 64 * KST, C_OFF = 2 * STAGE, WS_OFF = C_OFF + 16384;
    const bf16* QKV = wsp<bf16>(F, WS_QKVR); const float* logf = wsp<float>(F, WS_LOGF); bf16* AO = wsp<bf16>(F, WS_AO);
    LAS unsigned char* lds = F.lds; LAS float* cl = (LAS float*)(lds + C_OFF); LAS float* wsum = (LAS float*)(lds + WS_OFF); LAS unsigned* dflag = (LAS unsigned*)(lds + WS_OFF + 64);
    const int tid = F.tid, lane = F.lane, w = F.wave, fr = lane & 15, fq = lane >> 4;
    constexpr float SC2 = 0.08838834764831845f * 1.4426950408889634f, L2E = 1.4426950408889634f, THR = 8.0f;
    const int kfo = fr * KST + fq * 16;
    const int vfo = (4 * fq + (fr >> 2)) * VST + (fr & 3) * 8;
    int cur_bh = -1;
    for (int U = F.vcu; U < 1024; U += F.G) {
        const int r_ = U >> 8, v_ = U & 255, bh = v_ >> 2, i_ = v_ & 3; const int b = bh >> 3, h = bh & 7;
        const int qt = (r_ == 0) ? i_ : (r_ == 1) ? 7 - i_ : (r_ == 2) ? 8 + i_ : 15 - i_;
        if (bh != cur_bh) { cur_bh = bh;
          __syncthreads();
          float v8[8]; float tot = 0.f; const int p0 = tid * 8;
          { const float* lp = logf + ((size_t)b * SEQ + p0) * 8 + h;
#pragma unroll
              for (int e = 0; e < 8; ++e) v8[e] = lp[8 * e]; }
#pragma unroll
          for (int e = 0; e < 8; ++e) { tot += v8[e]; v8[e] = tot; }
          float inc = tot;
#pragma unroll
          for (int o = 1; o < 64; o <<= 1) { const float t = __shfl_up(inc, o); if (lane >= o) inc += t; }
          if (lane == 63) wsum[w] = inc;
          __syncthreads();
          float woff = 0.f;
#pragma unroll
          for (int q = 0; q < 8; ++q) woff += (q < w) ? wsum[q] : 0.f;
          const float excl = woff + inc - tot;
#pragma unroll
          for (int e = 0; e < 8; ++e) cl[p0 + e] = -L2E * (excl + v8[e]);
        }
        const int q0 = qt * 256 + 32 * w;
        bf16x8 qf[2][4]; float mrow[2], lrow[2]; f32x4 oacc[2][8];
#pragma unroll
        for (int mt = 0; mt < 2; ++mt) { const size_t tok = (size_t)b * SEQ + q0 + 16 * mt + fr;
#pragma unroll
            for (int ks = 0; ks < 4; ++ks) qf[mt][ks] = *(const bf16x8*)(QKV + tok * 3072 + h * 128 + 32 * ks + 8 * fq);
            mrow[mt] = -1.0e30f; lrow[mt] = 0.f;
#pragma unroll
            for (int dt = 0; dt < 8; ++dt) oacc[mt][dt] = (f32x4){0.f, 0.f, 0.f, 0.f}; }
        const int ntiles = 4 * (qt + 1);
        float qk_bound;
        { float q2 = 0.f;
#pragma unroll
          for (int mt = 0; mt < 2; ++mt) { float s = 0.f;
#pragma unroll
              for (int ks = 0; ks < 4; ++ks) { const v4u qq = __builtin_bit_cast(v4u, qf[mt][ks]);
                  s += (bflo(qq.x) * bflo(qq.x) + bfhi(qq.x) * bfhi(qq.x)) + (bflo(qq.y) * bflo(qq.y) + bfhi(qq.y) * bfhi(qq.y)) + (bflo(qq.z) * bflo(qq.z) + bfhi(qq.z) * bfhi(qq.z)) + (bflo(qq.w) * bflo(qq.w) + bfhi(qq.w) * bfhi(qq.w)); }
              s += __shfl_xor(s, 16); s += __shfl_xor(s, 32); q2 = fmaxf(q2, s); }
#pragma unroll
          for (int o = 1; o < 16; o <<= 1) q2 = fmaxf(q2, __shfl_xor(q2, o));
          const unsigned* kp = knb + (b * 8 + h) * 4; const float k2 = (__builtin_bit_cast(float, kp[0]) + __builtin_bit_cast(float, kp[1])) + (__builtin_bit_cast(float, kp[2]) + __builtin_bit_cast(float, kp[3]));
          qk_bound = sqrtf(q2 * k2) * (SC2 * 1.02f); }
        bool wdone = false;
        if (tid < 8) dflag[tid] = 0u;
        v4u pk_[2], pv_[2];
#define FOX_LOAD(jj) do { _Pragma("unroll") for (int i2 = 0; i2 < 2; ++i2) { const int c2 = tid + 512 * i2; const bf16* rp = QKV + ((size_t)b * SEQ + 64 * (jj) + (c2 >> 4)) * 3072 + h * 128 + (c2 & 15) * 8; \
            pk_[i2] = *(const v4u*)(rp + 1024); pv_[i2] = *(const v4u*)(rp + 2048); } } while (0)
#define FOX_STORE(st) do { _Pragma("unroll") for (int i2 = 0; i2 < 2; ++i2) { const int c2 = tid + 512 * i2; \
            *(LAS v4u*)(lds + (st) * STAGE + (c2 >> 4) * KST + (c2 & 15) * 16) = pk_[i2]; *(LAS v4u*)(lds + (st) * STAGE + V_OFF + (c2 >> 4) * VST + (c2 & 15) * 16) = pv_[i2]; } } while (0)
        FOX_LOAD(ntiles - 1);
        FOX_STORE(0);
        __syncthreads();
        for (int it = 0; it < ntiles; ++it) {
            const int j = ntiles - 1 - it, cur = it & 1; const int key0 = 64 * j;
            if (it + 1 < ntiles) FOX_LOAD(j - 1);
            if (!wdone && key0 <= q0 + 31) {
                LAS const unsigned char* kb = lds + cur * STAGE + kfo; LAS const unsigned char* vb = lds + cur * STAGE + V_OFF + vfo;
                f32x4 sacc[4][2];
#pragma unroll
                for (int nt = 0; nt < 4; ++nt) { sacc[nt][0] = (f32x4){0.f, 0.f, 0.f, 0.f}; sacc[nt][1] = (f32x4){0.f, 0.f, 0.f, 0.f}; }
                { bf16x8 ka[2][4];
#pragma unroll
                  for (int nt = 0; nt < 4; ++nt) ka[0][nt] = ldsfrag(kb + nt * 16 * KST);
#pragma unroll
                  for (int ks = 0; ks < 4; ++ks) {
                    if (ks + 1 < 4) {
#pragma unroll
                        for (int nt = 0; nt < 4; ++nt) ka[(ks + 1) & 1][nt] = ldsfrag(kb + nt * 16 * KST + (ks + 1) * 64); }
#pragma unroll
                    for (int nt = 0; nt < 4; ++nt) { sacc[nt][0] = MFMA16(ka[ks & 1][nt], qf[0][ks], sacc[nt][0]); sacc[nt][1] = MFMA16(ka[ks & 1][nt], qf[1][ks], sacc[nt][1]); } } }
                float mx0 = -__builtin_inff(), mx1 = -__builtin_inff();
#pragma unroll
                for (int nt = 0; nt < 4; ++nt) { const f32x4 ck = *(const LAS f32x4*)(cl + key0 + 16 * nt + 4 * fq);
                    sacc[nt][0] = sacc[nt][0] * SC2 + ck; sacc[nt][1] = sacc[nt][1] * SC2 + ck; }
                if (key0 + 63 > q0) {
#pragma unroll
                    for (int nt = 0; nt < 4; ++nt)
#pragma unroll
                        for (int e = 0; e < 4; ++e) { const int key = key0 + 16 * nt + 4 * fq + e;
                            if (key > q0 + fr) sacc[nt][0][e] = -__builtin_inff();
                            if (key > q0 + 16 + fr) sacc[nt][1][e] = -__builtin_inff(); } }
#pragma unroll
                for (int nt = 0; nt < 4; ++nt) { mx0 = fmaxf(mx0, fmaxf(fmaxf(sacc[nt][0][0], sacc[nt][0][1]), fmaxf(sacc[nt][0][2], sacc[nt][0][3])));
                    mx1 = fmaxf(mx1, fmaxf(fmaxf(sacc[nt][1][0], sacc[nt][1][1]), fmaxf(sacc[nt][1][2], sacc[nt][1][3]))); }
                mx0 = fmaxf(mx0, __shfl_xor(mx0, 16)); mx0 = fmaxf(mx0, __shfl_xor(mx0, 32)); mx1 = fmaxf(mx1, __shfl_xor(mx1, 16)); mx1 = fmaxf(mx1, __shfl_xor(mx1, 32));
                if (__any((mx0 > mrow[0] + THR) || (mx1 > mrow[1] + THR))) {
                    const float n0 = fmaxf(mrow[0], mx0), n1 = fmaxf(mrow[1], mx1);
                    const float a0 = __builtin_amdgcn_exp2f(mrow[0] - n0), a1 = __builtin_amdgcn_exp2f(mrow[1] - n1);
                    mrow[0] = n0; mrow[1] = n1; lrow[0] *= a0; lrow[1] *= a1;
#pragma unroll
                    for (int dt = 0; dt < 8; ++dt) { oacc[0][dt] = oacc[0][dt] * a0; oacc[1][dt] = oacc[1][dt] * a1; } }
                bf16x8 pf[2][2];
#pragma unroll
                for (int mt = 0; mt < 2; ++mt) { const float mm = mrow[mt]; float ls = 0.f; unsigned pw[8];
#pragma unroll
                    for (int nt = 0; nt < 4; ++nt) { const f32x4 t = sacc[nt][mt] - mm;
                        const float p0 = __builtin_amdgcn_exp2f(t[0]), p1 = __builtin_amdgcn_exp2f(t[1]), p2 = __builtin_amdgcn_exp2f(t[2]), p3 = __builtin_amdgcn_exp2f(t[3]);
                        ls += (p0 + p1) + (p2 + p3); pw[2 * nt] = pg8::cvt_pk_bf16(p0, p1); pw[2 * nt + 1] = pg8::cvt_pk_bf16(p2, p3); }
                    lrow[mt] += ls;
                    { v4u t0 = {pw[0], pw[1], pw[2], pw[3]}, t1 = {pw[4], pw[5], pw[6], pw[7]}; pf[mt][0] = __builtin_bit_cast(bf16x8, t0); pf[mt][1] = __builtin_bit_cast(bf16x8, t1); } }
                { bf16x8 va[2][4];
#pragma unroll
                  for (int i = 0; i < 4; ++i) va[0][i] = tr_frag(vb + i * 32, vb + 16 * VST + i * 32);
#pragma unroll
                  for (int g = 0; g < 4; ++g) { const int ks2 = g >> 1, d0 = (g & 1) * 4;
                    if (g + 1 < 4) { const int ks2n = (g + 1) >> 1, d0n = ((g + 1) & 1) * 4;
#pragma unroll
                        for (int i = 0; i < 4; ++i) va[(g + 1) & 1][i] = tr_frag(vb + (32 * ks2n) * VST + (d0n + i) * 32, vb + (32 * ks2n + 16) * VST + (d0n + i) * 32); }
#pragma unroll
                    for (int i = 0; i < 4; ++i) { oacc[0][d0 + i] = MFMA16(va[g & 1][i], pf[0][ks2], oacc[0][d0 + i]); oacc[1][d0 + i] = MFMA16(va[g & 1][i], pf[1][ks2], oacc[1][d0 + i]); } } }
            }
            if (!wdone && j > 0) {
                const float mmin = fminf(mrow[0], mrow[1]); float mm = mmin; mm = fminf(mm, __shfl_xor(mm, 1)); mm = fminf(mm, __shfl_xor(mm, 2)); mm = fminf(mm, __shfl_xor(mm, 4)); mm = fminf(mm, __shfl_xor(mm, 8));
                if (key0 - 1 <= q0 + 31 && __all(qk_bound + cl[key0 - 1] - mm < -40.0f)) { wdone = true; if (lane == 0) dflag[w] = 1u; } }
            if (it + 1 < ntiles) FOX_STORE(cur ^ 1);
            __syncthreads();
            { unsigned alld = 1u;
#pragma unroll
              for (int q = 0; q < 8; ++q) alld &= dflag[q];
              if (alld) break; }
        }
        __syncthreads();
#undef FOX_LOAD
#undef FOX_STORE
#pragma unroll
        for (int mt = 0; mt < 2; ++mt) { float l = lrow[mt]; l += __shfl_xor(l, 16); l += __shfl_xor(l, 32); const float inv = 1.0f / l;
            const size_t tok = (size_t)b * SEQ + q0 + 16 * mt + fr;
#pragma unroll
            for (int dt = 0; dt < 8; ++dt) {
                if constexpr (COUT_F8 != 0) { const f32x4 o = oacc[mt][dt] * (8.0f * inv);
                    int q_ = __builtin_amdgcn_cvt_pk_fp8_f32(pg8::c8(o[0]), pg8::c8(o[1]), 0, false); q_ = __builtin_amdgcn_cvt_pk_fp8_f32(pg8::c8(o[2]), pg8::c8(o[3]), q_, true);
                    *(unsigned*)((unsigned char*)AO + tok * 1024 + h * 128 + 16 * dt + 4 * fq) = (unsigned)q_; }
                else { const f32x4 o = oacc[mt][dt] * inv; v2u r; r.x = pg8::cvt_pk_bf16(o[0], o[1]); r.y = pg8::cvt_pk_bf16(o[2], o[3]); *(v2u*)(AO + tok * 1024 + h * 128 + 16 * dt + 4 * fq) = r; } } }
    }
}

constexpr int N_PHASES = 2 + 10 * MK_LAYERS;
__host__ __device__ constexpr bool phase_active(int id) {
    if (id == 0) return true;
    if (id == 1 + 10 * MK_LAYERS) return (MK_LAYERS % 2) == 1;
    const int l = (id - 1) / 10, s = (id - 1) % 10, mixer = l % 3; const bool moe = (l % 2) == 1;
    if (s == 0 || s == 1 || s == 4) return true;
    if (s == 2 || s == 3) return mixer == 1;
    if (s == 5 || s == 6) return true;
    return moe;
}
struct Args { const float* in[22]; float* out; unsigned char* ws; int ph_lo, ph_hi; };
#define IN(k) (lo <= (k) && (k) < hi)
#ifndef PROBE_MASK
#define PROBE_MASK 0
#endif
#define REPS(bit) _Pragma("unroll 1") for (int r_ = 0; r_ < ((PROBE_MASK & (bit)) ? 2 : 1); ++r_)
#define TWICE(bit, ...) do { if constexpr ((PROBE_MASK & (bit)) != 0) { __VA_ARGS__ xcd_barrier(bar); } __VA_ARGS__ } while (0)
#define SEAM(k) do { if ((k) + 1 < hi) xcd_barrier(bar); } while (0)
#define SEAML(k) do { if ((k) + 1 < hi) { if (F.MISC[10]) xcd_barrier_local(bar); else xcd_barrier(bar); } } while (0)
template <int L> DI void run_layer(Frame& F, const Args& args, const XcdBarrier& bar, const int lo, const int hi) {
    constexpr int l = L, mixer = L % 3, jm = L / 3, fi = L / 2, pb = 1 + 10 * L; constexpr bool moe = (L & 1) != 0;
    bf16* XB = wsp<bf16>(F, WS_XB); float* SSQ = wsp<float>(F, WS_SSQ);
    if (IN(pb + 0)) {
        if constexpr (mixer == 0) {
            if constexpr (l == 3 && AIN_F8 != 0) {
                pg8::Gemm g{(const bf16*)wsp<unsigned char>(F, WS_X8), wsp<bf16>(F, WS_WA_IN) + (size_t)jm * 4096 * 1024, M, 4096, D / 2}; pg8::StaticOrder S; S.init(M, 4096, F.G, (int)blockIdx.x);
                pg8::EpiAin E{SSQ, wsp<bf16>(F, WS_U), wsp<bf16>(F, WS_V), wsp<float>(F, WS_VSSQ), 1.0f / 64.0f};
                pg8::gemm_phase<pg8::EpiAin, pg8::StaticOrder, true, true, true>(F.lds + RING_OFF, g, S, E);
            } else {
                pg8::Gemm g{XB, wsp<bf16>(F, WS_WA_IN) + (size_t)jm * 4096 * 1024, M, 4096, D}; pg8::StaticOrder S; S.init(M, 4096, F.G, (int)blockIdx.x);
                pg8::EpiAin E{SSQ, wsp<bf16>(F, WS_U), wsp<bf16>(F, WS_V), wsp<float>(F, WS_VSSQ), 1.0f};
                pg8::gemm_phase<pg8::EpiAin, pg8::StaticOrder, true, true>(F.lds + RING_OFF, g, S, E);
            }
        } else {
            REPS(128) { if constexpr (mixer == 1) glow_phase(F, XB, args.in[1] + l * 1024, args.in[8]); else logf_phase(F, XB, args.in[1] + l * 1024, args.in[13], args.in[14]); }
            if constexpr (mixer == 2 && CIN_F8 != 0) {
                pg8::Gemm g{(const bf16*)wsp<unsigned char>(F, WS_X8), wsp<bf16>(F, WS_WC_IN), M, 3072, D / 2}; pg8::StaticOrder S; S.init(M, 3072, F.G, (int)blockIdx.x);
                pg8::EpiRow<true> E{SSQ, wsp<bf16>(F, WS_QKVR), 3072, (unsigned*)(F.ctl + CW_KNB), 1.0f / 64.0f};
                pg8::gemm_phase<pg8::EpiRow<true>, pg8::StaticOrder, true, true, true>(F.lds + RING_OFF, g, S, E);
            } else {
                pg8::Gemm g{XB, mixer == 1 ? wsp<bf16>(F, WS_WB_IN) : wsp<bf16>(F, WS_WC_IN), M, 3072, D}; pg8::StaticOrder S; S.init(M, 3072, F.G, (int)blockIdx.x);
                pg8::EpiRow<mixer == 2> E{SSQ, wsp<bf16>(F, WS_QKVR), 3072, (unsigned*)(F.ctl + CW_KNB), 1.0f};
                pg8::gemm_phase<pg8::EpiRow<mixer == 2>, pg8::StaticOrder, true, true>(F.lds + RING_OFF, g, S, E);
            }
        }
        SEAML(pb + 0);
    }
    if (IN(pb + 1)) { REPS(mixer == 0 ? 2 : mixer == 1 ? 4 : 32) {
        if constexpr (mixer == 0) mix_phase<(((AOUT_F8 >> jm) & 1) != 0)>(F, args.in[5] + (size_t)jm * 8 * 128 * 128, args.in[6] + (size_t)jm * 8 * 128, args.in[4] + (size_t)jm * AW);
        else if constexpr (mixer == 1) gla_prep_phase(F, args.in[9], args.in[10]);
        else fox_attn_phase(F, (const unsigned*)(F.ctl + CW_KNB));
        SEAML(pb + 1); } }
    if constexpr (mixer == 1) {
        if (IN(pb + 2)) { REPS(8) { gla_scan_phase(F, args); SEAML(pb + 2); } }
        if (IN(pb + 3)) { REPS(16) { gla_gate_phase(F, args.in[11]); SEAML(pb + 3); } }
    }
    if (IN(pb + 4)) {
        const bf16* A = mixer == 0 ? wsp<bf16>(F, WS_Y) : mixer == 1 ? wsp<bf16>(F, WS_GG) : wsp<bf16>(F, WS_AO);
        const bf16* Bt = mixer == 0 ? wsp<bf16>(F, WS_WA_OUT) + (size_t)jm * 1024 * 2048 : mixer == 1 ? wsp<bf16>(F, WS_WB_OUT) : wsp<bf16>(F, WS_WC_OUT);
        constexpr bool w8 = moe ? (MOE_F8 != 0) : ((DENSE_F8 >> fi) & 1) != 0;
        if constexpr ((mixer == 2 && COUT_F8 != 0) || (mixer == 1 && BOUT_F8 != 0)) {
            pg8::Gemm g{A, Bt, M, D, 512}; pg8::StaticOrder S; S.init(M, D, F.G, (int)blockIdx.x);
            pg8::EpiResid<false, w8> E{(const void*)XB, XB, SSQ, wsp<unsigned char>(F, WS_X8), 1.0f / 512.0f};
            pg8::gemm_phase<pg8::EpiResid<false, w8>, pg8::StaticOrder, true, true, true>(F.lds + RING_OFF, g, S, E);
        } else if constexpr (mixer == 0 && ((AOUT_F8 >> jm) & 1) != 0) {
            pg8::Gemm g{A, Bt, M, D, 1024}; pg8::StaticOrder S; S.init(M, D, F.G, (int)blockIdx.x);
            pg8::EpiResid<l == 0, w8> E{l == 0 ? (const void*)args.in[0] : (const void*)XB, XB, SSQ, wsp<unsigned char>(F, WS_X8), 1.0f / 256.0f};
            pg8::gemm_phase<pg8::EpiResid<l == 0, w8>, pg8::StaticOrder, true, true, true>(F.lds + RING_OFF, g, S, E);
        } else {
            pg8::Gemm g{A, Bt, M, D, mixer == 0 ? 2048 : 1024}; pg8::StaticOrder S; S.init(M, D, F.G, (int)blockIdx.x);
            pg8::EpiResid<l == 0, w8> E{l == 0 ? (const void*)args.in[0] : (const void*)XB, XB, SSQ, wsp<unsigned char>(F, WS_X8), 1.0f};
            pg8::gemm_phase<pg8::EpiResid<l == 0, w8>, pg8::StaticOrder, true, true>(F.lds + RING_OFF, g, S, E);
        }
        SEAML(pb + 4);
    }
    if constexpr (!moe) {
        constexpr bool f8 = ((DENSE_F8 >> fi) & 1) != 0;
        if (IN(pb + 5)) {
            if constexpr (f8) {
                pg8::Gemm g{(const bf16*)wsp<unsigned char>(F, WS_X8), (const bf16*)(wsp<unsigned char>(F, WS_WF_IN) + (size_t)fi * 2 * 7168 * 1024), M, 7168, D / 2}; pg8::StaticOrder S; S.init(M, 7168, F.G, (int)blockIdx.x);
                pg8::EpiSwiGLU8<0> E{SSQ, wsp<unsigned char>(F, WS_HF)};
                pg8::gemm_phase<pg8::EpiSwiGLU8<0>, pg8::StaticOrder, true, true, true>(F.lds + RING_OFF, g, S, E);
            } else {
                pg8::Gemm g{XB, wsp<bf16>(F, WS_WF_IN) + (size_t)fi * 7168 * 1024, M, 7168, D}; pg8::StaticOrder S; S.init(M, 7168, F.G, (int)blockIdx.x);
                pg8::EpiSwiGLU<0> E{SSQ, wsp<bf16>(F, WS_HF)};
                pg8::gemm_phase<pg8::EpiSwiGLU<0>, pg8::StaticOrder, true, true>(F.lds + RING_OFF, g, S, E);
            }
            SEAML(pb + 5);
        }
        if (IN(pb + 6)) {
            if constexpr (f8) {
                pg8::Gemm g{(const bf16*)wsp<unsigned char>(F, WS_HF), (const bf16*)(wsp<unsigned char>(F, WS_WF_OUT) + (size_t)fi * 2 * 1024 * 3584), M, D, FF / 2}; pg8::StaticOrder S; S.init(M, D, F.G, (int)blockIdx.x, 1);
                constexpr bool w8n = (l == 2 && AIN_F8 != 0);
                pg8::EpiResid<false, w8n> E{(const void*)XB, XB, SSQ, wsp<unsigned char>(F, WS_X8), 1.0f / 512.0f};
                pg8::gemm_phase<pg8::EpiResid<false, w8n>, pg8::StaticOrder, true, true, true>(F.lds + RING_OFF, g, S, E);
            } else {
                pg8::Gemm g{wsp<bf16>(F, WS_HF), wsp<bf16>(F, WS_WF_OUT) + (size_t)fi * 1024 * 3584, M, D, FF}; pg8::StaticOrder S; S.init(M, D, F.G, (int)blockIdx.x, 1);
                pg8::EpiResid<false> E{(const void*)XB, XB, SSQ, nullptr, 1.0f};
                pg8::gemm_phase<pg8::EpiResid<false>, pg8::StaticOrder, true, true>(F.lds + RING_OFF, g, S, E);
            }
            SEAML(pb + 6);
        }
    } else {
        unsigned* gcnt = (unsigned*)(F.ctl + CW_CNT + 64 * l);
        if (IN(pb + 5)) { router_phase(F, XB, args.in[2] + l * 1024, args.in[18] + (size_t)fi * 1024 * 8, gcnt); SEAM(pb + 5); }
        if (IN(pb + 6)) { REPS(64) { if constexpr (MOE_F8 != 0) rowtable_phase(F, gcnt); else gather_phase<false>(F, gcnt); SEAM(pb + 6); } }
        if (IN(pb + 7)) {
            if constexpr (MOE_F8 != 0) {
                pg8::Gemm g{(const bf16*)wsp<unsigned char>(F, WS_X8), (const bf16*)(wsp<unsigned char>(F, WS_WM_IN) + (size_t)fi * 8 * 7168 * 1024), MROWS, 7168, D / 2, wsp<int>(F, WS_ROWT)}; pg8::GroupedOrder S; S.init(gcnt, 28, F.G, (int)blockIdx.x);
                pg8::EpiSwiGLU8<1> E{wsp<float>(F, WS_ROWRS), wsp<unsigned char>(F, WS_HM)};
                TWICE(256, pg8::gemm_phase<pg8::EpiSwiGLU8<1>, pg8::GroupedOrder, true, true, true, true>(F.lds + RING_OFF, g, S, E););
            } else {
                pg8::Gemm g{wsp<bf16>(F, WS_XS), wsp<bf16>(F, WS_WM_IN) + (size_t)fi * 8 * 7168 * 1024, MROWS, 7168, D}; pg8::GroupedOrder S; S.init(gcnt, 28, F.G, (int)blockIdx.x);
                pg8::EpiSwiGLU<1> E{wsp<float>(F, WS_ROWRS), wsp<bf16>(F, WS_HM)};
                pg8::gemm_phase<pg8::EpiSwiGLU<1>, pg8::GroupedOrder, true, true>(F.lds + RING_OFF, g, S, E);
            }
            SEAM(pb + 7);
        }
        if (IN(pb + 8)) {
            if constexpr (MOE_F8 != 0) {
                pg8::Gemm g{(const bf16*)wsp<unsigned char>(F, WS_HM), (const bf16*)(wsp<unsigned char>(F, WS_WM_OUT) + (size_t)fi * 8 * 1024 * 3584), MROWS, D, FF / 2}; pg8::GroupedOrder S; S.init(gcnt, 4, F.G, (int)blockIdx.x, 1);
                pg8::EpiMoeOut E{wsp<int>(F, WS_ROWT), wsp<float>(F, WS_ROWG), wsp<bf16>(F, WS_OS), M, 1.0f / 512.0f};
                pg8::gemm_phase<pg8::EpiMoeOut, pg8::GroupedOrder, true, true, true>(F.lds + RING_OFF, g, S, E);
            } else {
                pg8::Gemm g{wsp<bf16>(F, WS_HM), wsp<bf16>(F, WS_WM_OUT) + (size_t)fi * 8 * 1024 * 3584, MROWS, D, FF}; pg8::GroupedOrder S; S.init(gcnt, 4, F.G, (int)blockIdx.x, 1);
                pg8::EpiMoeOut E{wsp<int>(F, WS_ROWT), wsp<float>(F, WS_ROWG), wsp<bf16>(F, WS_OS), M, 1.0f};
                pg8::gemm_phase<pg8::EpiMoeOut, pg8::GroupedOrder, true, true>(F.lds + RING_OFF, g, S, E);
            }
            SEAM(pb + 8);
        }
        if (IN(pb + 9)) { combine_phase(F, l == MK_LAYERS - 1, args.in[21], (l == 1 && CIN_F8 != 0) ? wsp<unsigned char>(F, WS_X8) : nullptr); if constexpr (l != MK_LAYERS - 1) SEAML(pb + 9); }
    }
}
__global__ void __launch_bounds__(NWAVES * 64, 2) trunk_fwd(Args args) {
    extern __shared__ __attribute__((aligned(16))) unsigned char lds[];
    Frame F;
    F.lds = (LAS unsigned char*)lds;
    F.MISC = (volatile LAS unsigned*)(F.lds + MISC_OFF);
    F.tid = threadIdx.x; F.lane = F.tid & 63; F.wave = __builtin_amdgcn_readfirstlane(F.tid >> 6);
    F.G = gridDim.x; { const int bx = blockIdx.x; F.vcu = (F.G % 8 == 0) ? (bx % 8) * (F.G / 8) + bx / 8 : bx; }
    F.out = args.out; F.ws = args.ws;
    F.ctl = (gu32*)(args.ws + WS_CTL);
    for (int u = F.tid; u < (LDS_BYTES - LDSCTL_OFF) / 4; u += NWAVES * 64) ((LAS unsigned*)(F.lds + LDSCTL_OFF))[u] = 0u;
    __syncthreads();
    XcdBarrier bar = xcd_barrier_post((unsigned*)(F.ctl + CW_BAR), F.MISC + 8);
    if (F.tid == 0 && (bar.x != (blockIdx.x & 7u) || gridDim.x != 256u)) __hip_atomic_fetch_or(F.ctl + CW_XMIS, 1u, __ATOMIC_RELAXED, __HIP_MEMORY_SCOPE_AGENT);
    const int lo = args.ph_lo, hi = args.ph_hi;
    if (IN(0)) { REPS(1) { p0_prologue(F, args); SEAM(0); } }
    if (F.tid == 0) F.MISC[10] = (MK_ONE_LAUNCH != 0 && lo == 0 && __hip_atomic_load(F.ctl + CW_XMIS, __ATOMIC_RELAXED, __HIP_MEMORY_SCOPE_AGENT) == 0u) ? 1u : 0u;
    __syncthreads();
    run_layer<0>(F, args, bar, lo, hi);
    if constexpr (MK_LAYERS > 1) run_layer<1>(F, args, bar, lo, hi);
    if constexpr (MK_LAYERS > 2) run_layer<2>(F, args, bar, lo, hi);
    if constexpr (MK_LAYERS > 3) run_layer<3>(F, args, bar, lo, hi);
    if ((MK_LAYERS % 2) == 1 && IN(1 + 10 * MK_LAYERS)) final_norm_phase(F, wsp<bf16>(F, WS_XB), args.in[21]);
}
#undef IN
#undef SEAM

extern "C" void kernel_launch(void* const* d_in, const int* in_sizes, int n_in, void* d_out, int out_size, void* d_ws, size_t ws_size, hipStream_t stream) {
    static int grid = 0;
    if (grid == 0) {
        if (n_in != 22 || in_sizes[0] != M * D || out_size != M * D || ws_size < WS_END) { fprintf(stderr, "kernel_launch: unexpected shapes / workspace (n_in %d, in0 %d, out %d, ws %zu, need %zu)\n", n_in, n_in > 0 ? in_sizes[0] : -1, out_size, ws_size, (size_t)WS_END); grid = -1; return; }
        int dev = 0, cus = 0, per_cu = 0;
        if (hipGetDevice(&dev) != hipSuccess || hipDeviceGetAttribute(&cus, hipDeviceAttributeMultiprocessorCount, dev) != hipSuccess) { grid = -1; return; }
        if (hipFuncSetAttribute((const void*)trunk_fwd, hipFuncAttributeMaxDynamicSharedMemorySize, LDS_BYTES) != hipSuccess) { fprintf(stderr, "kernel_launch: hipFuncSetAttribute failed\n"); grid = -1; return; }
        if (hipOccupancyMaxActiveBlocksPerMultiprocessor(&per_cu, (const void*)trunk_fwd, NWAVES * 64, LDS_BYTES) != hipSuccess || per_cu < 1) { fprintf(stderr, "kernel_launch: occupancy query reports %d workgroups per CU\n", per_cu); }
        (void)hipGetLastError();
        grid = cus;
    }
    if (grid < 0) return;
    if (hipMemsetAsync((char*)d_ws + WS_CTL, 0, CTL_ZERO_BYTES, stream) != hipSuccess) return;
    Args a{};
    for (int i = 0; i < 22; ++i) a.in[i] = (const float*)d_in[i];
    a.out = (float*)d_out; a.ws = (unsigned char*)d_ws;
#if MK_ONE_LAUNCH
    a.ph_lo = 0; a.ph_hi = N_PHASES;
    hipLaunchKernelGGL(trunk_fwd, dim3(grid), dim3(NWAVES * 64), LDS_BYTES, stream, a);
#else
    for (int p = 0; p < N_PHASES; ++p) { if (!phase_active(p)) continue; a.ph_lo = p; a.ph_hi = p + 1; hipLaunchKernelGGL(trunk_fwd, dim3(grid), dim3(NWAVES * 64), LDS_BYTES, stream, a); }
#endif
}
```

```cpp
#include <hip/hip_runtime.h>
#include <cstdio>
#include <cstdint>
namespace pg8 {
#define PG8_LAS __attribute__((address_space(3)))
typedef unsigned short bf16_t;
typedef short bf16x8 __attribute__((ext_vector_type(8)));
typedef float f32x4 __attribute__((ext_vector_type(4)));
typedef unsigned u32x4 __attribute__((ext_vector_type(4)));
typedef int i32x8 __attribute__((ext_vector_type(8)));
constexpr int BM = 256, BK = 64, HALF = 128, HTB = HALF * BK * 2  , STAGE_BYTES = 8 * HTB, NXCD = 8, WGM = 8;

__host__ __device__ __forceinline__ int lds_byte(int r, int c) { const int st = (r >> 4) * 2 + (c >> 5), rr = r & 15, cc = c & 31, ob = rr * 64 + cc * 2; return st * 1024 + (ob ^ (((ob >> 9) & 1) << 5)); }
__host__ __device__ __forceinline__ void stage_rc(int b, int& R, int& C) { const int st = b / 1024, sb = b % 1024, swz = sb ^ (((sb >> 9) & 1) << 5); R = (st >> 1) * 16 + swz / 64; C = (st & 1) * 32 + (swz % 64) / 2; }
__host__ __device__ __forceinline__ int perm32(int rho) { const int n = rho >> 4, i = rho & 15; return 8 * (i >> 2) + 4 * n + (i & 3); }

struct Unit { int pm, pn; };
struct Gemm { const bf16_t* A; const bf16_t* Bt; int M, N, K; const int* rowmap = nullptr; };

struct StaticOrder {
    int nM, nN, nwg, G, c, rev;
    __host__ __device__ void init(int M, int N, int G_, int c_, int rev_ = 0) { nM = M / BM; nN = N / BM; nwg = nM * nN; G = G_; c = c_; rev = rev_; }
    __host__ __device__ bool next(int i, Unit& u) const {
        const long L = (long)i * G + c; if (L >= nwg) return false;
        int wgid = (int)L; { const int q = nwg / NXCD, r = nwg % NXCD, xcd = wgid % NXCD, off = wgid / NXCD; const int cnt = q + (xcd < r ? 1 : 0); wgid = (xcd < r ? xcd * (q + 1) : r * (q + 1) + (xcd - r) * q) + (rev ? cnt - 1 - off : off); }
        const int nig = WGM * nN, gid = wgid / nig, fm = gid * WGM, gsz = (nM - fm) < WGM ? (nM - fm) : WGM;
        u.pm = fm + ((wgid % nig) % gsz); u.pn = (wgid % nig) / gsz; return true;
    }
    __device__ __forceinline__ void a_ready(const Unit&) const {}
    __device__ __forceinline__ void done(const Unit&) const {}
};

struct GroupedOrder {
    int nN, nM, nwg, G, c, rev; int s1, s2, s3, s4, s5, s6, s7;
    __device__ __forceinline__ void init(const unsigned* cnt, int nN_, int G_, int c_, int rev_ = 0) {
        nN = nN_; G = G_; c = c_; rev = rev_; int t = 0;
        t += (int)((cnt[0] + 255u) >> 8); s1 = t; t += (int)((cnt[1] + 255u) >> 8); s2 = t; t += (int)((cnt[2] + 255u) >> 8); s3 = t; t += (int)((cnt[3] + 255u) >> 8); s4 = t;
        t += (int)((cnt[4] + 255u) >> 8); s5 = t; t += (int)((cnt[5] + 255u) >> 8); s6 = t; t += (int)((cnt[6] + 255u) >> 8); s7 = t; t += (int)((cnt[7] + 255u) >> 8);
        nM = t; nwg = nM * nN;
    }
    __device__ __forceinline__ bool next(int i, Unit& u) const {
        const long L = (long)i * G + c; if (L >= nwg) return false;
        int wgid = (int)L; { const int q = nwg / NXCD, r = nwg % NXCD, xcd = wgid % NXCD, off = wgid / NXCD; const int cnt = q + (xcd < r ? 1 : 0); wgid = (xcd < r ? xcd * (q + 1) : r * (q + 1) + (xcd - r) * q) + (rev ? cnt - 1 - off : off); }
        const int nig = WGM * nN, gid = wgid / nig, fm = gid * WGM, gsz = (nM - fm) < WGM ? (nM - fm) : WGM;
        const int pm = fm + ((wgid % nig) % gsz), pnl = (wgid % nig) / gsz;
        const int e = (pm >= s1) + (pm >= s2) + (pm >= s3) + (pm >= s4) + (pm >= s5) + (pm >= s6) + (pm >= s7);
        u.pm = pm; u.pn = e * nN + pnl; return true;
    }
    __device__ __forceinline__ void a_ready(const Unit&) const {}
    __device__ __forceinline__ void done(const Unit&) const {}
};

__device__ __forceinline__ unsigned cvt_pk_bf16(float lo, float hi) { unsigned r; asm volatile("v_cvt_pk_bf16_f32 %0, %1, %2" : "=v"(r) : "v"(lo), "v"(hi)); return r; }
typedef unsigned u32x2 __attribute__((ext_vector_type(2)));
__device__ __forceinline__ float c8(float v) { return __builtin_amdgcn_fmed3f(v, -448.0f, 448.0f); }
constexpr float RMS_EPS = 1e-6f;
__device__ __forceinline__ float rs16(const float* ssq, int row, int fq) {
    const f32x4 a = *(const f32x4*)(ssq + (size_t)row * 16 + 4 * fq);
    float s = (a[0] + a[1]) + (a[2] + a[3]); s += __shfl_xor(s, 16); s += __shfl_xor(s, 32);
    return __builtin_amdgcn_rsqf(s * (1.0f / 1024.0f) + RMS_EPS);
}
__device__ __forceinline__ float gelu_t(float x) {
    const float t = x * (1.0f + 0.044715f * x * x);
    return x * __builtin_amdgcn_rcpf(1.0f + __builtin_amdgcn_exp2f(-2.302208198f * t));
}
__device__ __forceinline__ float silu_f(float x) { return x * __builtin_amdgcn_rcpf(1.0f + __builtin_amdgcn_exp2f(-1.4426950409f * x)); }
__device__ __forceinline__ f32x4 sig4(f32x4 a) {
    f32x4 e; e[0] = __builtin_amdgcn_exp2f(a[0]); e[1] = __builtin_amdgcn_exp2f(a[1]); e[2] = __builtin_amdgcn_exp2f(a[2]); e[3] = __builtin_amdgcn_exp2f(a[3]);
    e = e + 1.0f; f32x4 r; r[0] = __builtin_amdgcn_rcpf(e[0]); r[1] = __builtin_amdgcn_rcpf(e[1]); r[2] = __builtin_amdgcn_rcpf(e[2]); r[3] = __builtin_amdgcn_rcpf(e[3]); return r;
}
__device__ __forceinline__ f32x4 swiglu4(f32x4 g, f32x4 u, float ca, float ch) { return ((g * u) * ch) * sig4(g * ca); }
__device__ __forceinline__ f32x4 gelu4(f32x4 x) { const f32x4 p = (x * x) * (-2.302208198f * 0.044715f) + (-2.302208198f); return x * sig4(x * p); }

struct EpiAin {
    static constexpr bool PERM = true, AFTER_DRAIN = false, RS_LDS = false;
    const float* ssq; bf16_t* U; bf16_t* V; float* vssq; float sc;
    __device__ __forceinline__ void operator()(const f32x4 (&acc)[2][2][4][2], const Unit& u, int wr, int wc, int fr, int fq) const {
        const bool isv = u.pn >= 8; bf16_t* base = isv ? V : U;
        const int row0 = u.pm * BM + wr * 64 + fr, col0 = (u.pn & 7) * BM + wc * 32 + 8 * fq;
        float rsv[2][4];
#pragma unroll
        for (int ai = 0; ai < 2; ++ai)
#pragma unroll
            for (int m = 0; m < 4; ++m) rsv[ai][m] = rs16(ssq, row0 + ai * HALF + m * 16, fq) * sc;
#pragma unroll
        for (int ai = 0; ai < 2; ++ai)
#pragma unroll
            for (int m = 0; m < 4; ++m) { const int row = row0 + ai * HALF + m * 16; const float rs = rsv[ai][m]; float sq = 0.f; bf16_t* rowp = base + (size_t)row * 2048 + col0;
#pragma unroll
                for (int bj = 0; bj < 2; ++bj) { const f32x4 v0 = gelu4(acc[ai][bj][m][0] * rs), v1 = gelu4(acc[ai][bj][m][1] * rs);
                    { const f32x4 q = v0 * v0 + v1 * v1; sq += (q[0] + q[1]) + (q[2] + q[3]); }
                    u32x4 w; w.x = cvt_pk_bf16(v0[0], v0[1]); w.y = cvt_pk_bf16(v0[2], v0[3]); w.z = cvt_pk_bf16(v1[0], v1[1]); w.w = cvt_pk_bf16(v1[2], v1[3]);
                    *(u32x4*)(rowp + bj * HALF) = w; }
                if (isv) { sq += __shfl_xor(sq, 16); sq += __shfl_xor(sq, 32); if (fq == 0) vssq[(size_t)row * 32 + (u.pn - 8) * 4 + wc] = sq; } }
    }
};
template <bool KN> struct EpiRow {
    static constexpr bool PERM = true, AFTER_DRAIN = false, RS_LDS = false;
    const float* ssq; bf16_t* O; int ldc; unsigned* knb; float sc;
    __device__ __forceinline__ void operator()(const f32x4 (&acc)[2][2][4][2], const Unit& u, int wr, int wc, int fr, int fq) const {
        const int row0 = u.pm * BM + wr * 64 + fr, col0 = u.pn * BM + wc * 32 + 8 * fq;
        float kmx0 = 0.f, kmx1 = 0.f;
#pragma unroll
        for (int ai = 0; ai < 2; ++ai)
#pragma unroll
            for (int m = 0; m < 4; ++m) { const int row = row0 + ai * HALF + m * 16; const float rs = rs16(ssq, row, fq) * sc; bf16_t* rowp = O + (size_t)row * ldc + col0;
#pragma unroll
                for (int bj = 0; bj < 2; ++bj) { const f32x4 v0 = acc[ai][bj][m][0] * rs, v1 = acc[ai][bj][m][1] * rs;
                    u32x4 w; w.x = cvt_pk_bf16(v0[0], v0[1]); w.y = cvt_pk_bf16(v0[2], v0[3]); w.z = cvt_pk_bf16(v1[0], v1[1]); w.w = cvt_pk_bf16(v1[2], v1[3]);
                    *(u32x4*)(rowp + bj * HALF) = w;
                    if constexpr (KN) { float sq = ((v0[0] * v0[0] + v0[1] * v0[1]) + (v0[2] * v0[2] + v0[3] * v0[3])) + ((v1[0] * v1[0] + v1[1] * v1[1]) + (v1[2] * v1[2] + v1[3] * v1[3]));
                        sq += __shfl_xor(sq, 16); sq += __shfl_xor(sq, 32); if (bj == 0) kmx0 = fmaxf(kmx0, sq); else kmx1 = fmaxf(kmx1, sq); } } }
        if constexpr (KN) { if (u.pn >= 4 && u.pn < 8) {
#pragma unroll
                for (int o = 1; o < 16; o <<= 1) { kmx0 = fmaxf(kmx0, __shfl_xor(kmx0, o)); kmx1 = fmaxf(kmx1, __shfl_xor(kmx1, o)); }
                if ((threadIdx.x & 63) == 0) { const int bb = (u.pm * BM) >> 12, hd = 2 * (u.pn - 4);
                    __hip_atomic_fetch_max(knb + ((bb * 8 + hd) * 4 + wc), __builtin_bit_cast(unsigned, kmx0), __ATOMIC_RELAXED, __HIP_MEMORY_SCOPE_AGENT);
                    __hip_atomic_fetch_max(knb + ((bb * 8 + hd + 1) * 4 + wc), __builtin_bit_cast(unsigned, kmx1), __ATOMIC_RELAXED, __HIP_MEMORY_SCOPE_AGENT); } } }
    }
};
template <bool F32IN, bool W8 = false> struct EpiResid {
    static constexpr bool PERM = true, AFTER_DRAIN = false, RS_LDS = false;
    const void* xin; bf16_t* xb; float* ssq; unsigned char* x8; float oscale;
    __device__ __forceinline__ void operator()(const f32x4 (&acc)[2][2][4][2], const Unit& u, int wr, int wc, int fr, int fq) const {
        const int row0 = u.pm * BM + wr * 64 + fr, col0 = u.pn * BM + wc * 32 + 8 * fq;
        constexpr int MB = F32IN ? 2 : 4;
#pragma unroll
        for (int ai = 0; ai < 2; ++ai)
#pragma unroll
            for (int mb = 0; mb < 4; mb += MB) { u32x4 xr[MB][2][F32IN ? 2 : 1];
#pragma unroll
                for (int mi = 0; mi < MB; ++mi)
#pragma unroll
                    for (int bj = 0; bj < 2; ++bj) { const size_t o = (size_t)(row0 + ai * HALF + (mb + mi) * 16) * 1024 + col0 + bj * HALF;
                        if constexpr (F32IN) { xr[mi][bj][0] = *(const u32x4*)((const float*)xin + o); xr[mi][bj][1] = *(const u32x4*)((const float*)xin + o + 4); }
                        else xr[mi][bj][0] = *(const u32x4*)((const bf16_t*)xin + o); }
#pragma unroll
                for (int mi = 0; mi < MB; ++mi) { const int m = mb + mi; const int row = row0 + ai * HALF + m * 16; const size_t off = (size_t)row * 1024 + col0; float sq = 0.f;
#pragma unroll
                    for (int bj = 0; bj < 2; ++bj) { const size_t o = off + bj * HALF; f32x4 v0, v1;
                        if constexpr (F32IN) { v0 = __builtin_bit_cast(f32x4, xr[mi][bj][0]); v1 = __builtin_bit_cast(f32x4, xr[mi][bj][F32IN ? 1 : 0]); }
                        else { const u32x4 xw = xr[mi][bj][0];
                            v0 = (f32x4){__builtin_bit_cast(float, xw.x << 16), __builtin_bit_cast(float, xw.x & 0xffff0000u), __builtin_bit_cast(float, xw.y << 16), __builtin_bit_cast(float, xw.y & 0xffff0000u)};
                            v1 = (f32x4){__builtin_bit_cast(float, xw.z << 16), __builtin_bit_cast(float, xw.z & 0xffff0000u), __builtin_bit_cast(float, xw.w << 16), __builtin_bit_cast(float, xw.w & 0xffff0000u)}; }
                        v0 += acc[ai][bj][m][0] * oscale; v1 += acc[ai][bj][m][1] * oscale;
                        u32x4 w; w.x = cvt_pk_bf16(v0[0], v0[1]); w.y = cvt_pk_bf16(v0[2], v0[3]); w.z = cvt_pk_bf16(v1[0], v1[1]); w.w = cvt_pk_bf16(v1[2], v1[3]);
                        *(u32x4*)(xb + o) = w;
                        if constexpr (W8) { int p0 = __builtin_amdgcn_cvt_pk_fp8_f32(c8(v0[0]), c8(v0[1]), 0, false); p0 = __builtin_amdgcn_cvt_pk_fp8_f32(c8(v0[2]), c8(v0[3]), p0, true); int p1 = __builtin_amdgcn_cvt_pk_fp8_f32(c8(v1[0]), c8(v1[1]), 0, false); p1 = __builtin_amdgcn_cvt_pk_fp8_f32(c8(v1[2]), c8(v1[3]), p1, true);
                            u32x2 w8; w8.x = (unsigned)p0; w8.y = (unsigned)p1; *(u32x2*)(x8 + o) = w8; }
                        sq += ((v0[0] * v0[0] + v0[1] * v0[1]) + (v0[2] * v0[2] + v0[3] * v0[3])) + ((v1[0] * v1[0] + v1[1] * v1[1]) + (v1[2] * v1[2] + v1[3] * v1[3])); }
                    sq += __shfl_xor(sq, 16); sq += __shfl_xor(sq, 32); if (fq == 0) ssq[(size_t)row * 16 + u.pn * 4 + wc] = sq; }
                asm volatile("" ::: "memory"); }
    }
};
template <int MODE> struct EpiSwiGLU {
    static constexpr bool PERM = true, AFTER_DRAIN = false, RS_LDS = false;
    const float* ssq; bf16_t* H;
    __device__ __forceinline__ void operator()(const f32x4 (&acc)[2][2][4][2], const Unit& u, int wr, int wc, int fr, int fq) const {
        const int row0 = u.pm * BM + wr * 64 + fr, col0 = (u.pn % 28) * HALF + wc * 32 + 8 * fq;
#pragma unroll
        for (int ai = 0; ai < 2; ++ai)
#pragma unroll
            for (int m = 0; m < 4; ++m) { const int row = row0 + ai * HALF + m * 16; const float rs = MODE == 0 ? rs16(ssq, row, fq) : ssq[row];
                const float ca = rs * -1.4426950409f, ch = rs * rs;
                const f32x4 h0 = swiglu4(acc[ai][0][m][0], acc[ai][1][m][0], ca, ch), h1 = swiglu4(acc[ai][0][m][1], acc[ai][1][m][1], ca, ch);
                u32x4 w; w.x = cvt_pk_bf16(h0[0], h0[1]); w.y = cvt_pk_bf16(h0[2], h0[3]); w.z = cvt_pk_bf16(h1[0], h1[1]); w.w = cvt_pk_bf16(h1[2], h1[3]);
                *(u32x4*)(H + (size_t)row * 3584 + col0) = w; }
    }
};
template <int MODE> struct EpiSwiGLU8 {
    static constexpr bool PERM = true, AFTER_DRAIN = false, RS_LDS = (MODE == 1);
    const float* rrs; unsigned char* H8;
    __device__ __forceinline__ void operator()(const f32x4 (&acc)[2][2][4][2], const Unit& u, int wr, int wc, int fr, int fq, const PG8_LAS float* rsl = nullptr) const {
        const int row0 = u.pm * BM + wr * 64 + fr, col0 = (u.pn % 28) * HALF + wc * 32 + 8 * fq;
#pragma unroll
        for (int ai = 0; ai < 2; ++ai)
#pragma unroll
            for (int m = 0; m < 4; ++m) { const int row = row0 + ai * HALF + m * 16; const float rs = (MODE == 0 ? rs16(rrs, row, fq) : rsl[ai * 64 + m * 16 + fr]) * (1.0f / 64.0f);
                const float ca = rs * -1.4426950409f, ch = rs * rs * 8.0f;
                const f32x4 h0 = swiglu4(acc[ai][0][m][0], acc[ai][1][m][0], ca, ch), h1 = swiglu4(acc[ai][0][m][1], acc[ai][1][m][1], ca, ch);
                int w0 = __builtin_amdgcn_cvt_pk_fp8_f32(c8(h0[0]), c8(h0[1]), 0, false); w0 = __builtin_amdgcn_cvt_pk_fp8_f32(c8(h0[2]), c8(h0[3]), w0, true);
                int w1 = __builtin_amdgcn_cvt_pk_fp8_f32(c8(h1[0]), c8(h1[1]), 0, false); w1 = __builtin_amdgcn_cvt_pk_fp8_f32(c8(h1[2]), c8(h1[3]), w1, true);
                u32x2 w; w.x = (unsigned)w0; w.y = (unsigned)w1; *(u32x2*)(H8 + (size_t)row * 3584 + col0) = w; }
    }
};
struct EpiMoeOut {
    static constexpr bool PERM = true, AFTER_DRAIN = false, RS_LDS = false;
    const int* rtok; const float* rgate; bf16_t* OS; int M; float oscale;
    __device__ __forceinline__ void operator()(const f32x4 (&acc)[2][2][4][2], const Unit& u, int wr, int wc, int fr, int fq) const {
        const int row0 = u.pm * BM + wr * 64 + fr, col0 = (u.pn & 3) * BM + wc * 32 + 8 * fq;
        int tkv[2][4]; float gtv[2][4];
#pragma unroll
        for (int ai = 0; ai < 2; ++ai)
#pragma unroll
            for (int m = 0; m < 4; ++m) { const int row = row0 + ai * HALF + m * 16; tkv[ai][m] = rtok[row]; gtv[ai][m] = rgate[row]; }
#pragma unroll
        for (int ai = 0; ai < 2; ++ai)
#pragma unroll
            for (int m = 0; m < 4; ++m) { const int tk = tkv[ai][m]; const float gt = gtv[ai][m] * oscale;
                if (tk >= 0) { bf16_t* rowp = OS + ((size_t)(tk & 1) * M + (tk >> 1)) * 1024 + col0;
#pragma unroll
                    for (int bj = 0; bj < 2; ++bj) { const f32x4 v0 = acc[ai][bj][m][0] * gt, v1 = acc[ai][bj][m][1] * gt;
                        u32x4 w; w.x = cvt_pk_bf16(v0[0], v0[1]); w.y = cvt_pk_bf16(v0[2], v0[3]); w.z = cvt_pk_bf16(v1[0], v1[1]); w.w = cvt_pk_bf16(v1[2], v1[3]);
                        *(u32x4*)(rowp + bj * HALF) = w; } } }
    }
};

template <class Epi, class Sched, bool ALIGN_EPI = false, bool SP2 = false, bool F8 = false, bool GA = false>
__device__ __forceinline__ void gemm_phase(PG8_LAS unsigned char* lds, const Gemm g, const Sched& S, const Epi& E) {
    static_assert(!GA || SP2, "gathered A rows: SP2 path only");
    const int tid = threadIdx.x, wid = __builtin_amdgcn_readfirstlane(tid >> 6), lane = tid & 63, wr = wid >> 2, wc = wid & 3, fr = lane & 15, fq = lane >> 4;
    const int K = g.K, nt = K / BK;
    unsigned voffA[2], voffB[2];
#pragma unroll
    for (int i = 0; i < 2; ++i) { int R, C; stage_rc(tid * 16 + i * 8192, R, C); const int Rb = Epi::PERM ? ((R & ~31) + perm32(R & 31)) : R;
        voffA[i] = (unsigned)(R * K + C) * 2u; voffB[i] = (unsigned)(Rb * K + C) * 2u; }
    PG8_LAS unsigned char* const rowbuf = lds + STAGE_BYTES + 1024 + wid * 256;
    const unsigned cbA = voffA[0] - (unsigned)(((wid >> 1) * 16 + (lane >> 2)) * K) * 2u;
#define PG8_ROWDMA(u, par) do { const int* rp_ = g.rowmap + (size_t)(u).pm * BM + (lane >> 5) * 128 + ((lane >> 4) & 1) * 64 + (wid >> 1) * 16 + (lane & 15); \
        const unsigned la_ = __builtin_amdgcn_readfirstlane((unsigned)(unsigned long)(rowbuf + (par) * 2048)); unsigned keep_; \
        asm volatile("s_mov_b32 %0, m0\n\ts_mov_b32 m0, %2\n\ts_nop 0\n\tglobal_load_lds_dword %1, off\n\ts_mov_b32 m0, %0" : "=&s"(keep_) : "v"(rp_), "s"(la_) : "memory"); } while (0)
#define PG8_ROWGET(dst, par) do { _Pragma("unroll") for (int h_ = 0; h_ < 2; ++h_) _Pragma("unroll") for (int i_ = 0; i_ < 2; ++i_) { \
        const int t_ = *(const PG8_LAS int*)(rowbuf + (par) * 2048 + ((2 * h_ + i_) * 16 + (lane >> 2)) * 4); dst[h_][i_] = (unsigned)((t_ < 0 ? 0 : t_) >> 1) * (unsigned)(K * 2) + cbA; } } while (0)
    PG8_LAS unsigned char* const rsbuf = lds + STAGE_BYTES + 1024 + 4096 + wid * 512;
#define PG8_RSDMA(u) do { _Pragma("unroll") for (int ai_ = 0; ai_ < 2; ++ai_) { const float* rp_ = E.rrs + (size_t)(u).pm * BM + ai_ * HALF + wr * 64 + lane; \
        const unsigned la_ = __builtin_amdgcn_readfirstlane((unsigned)(unsigned long)(rsbuf + ai_ * 256)); unsigned keep_; \
        asm volatile("s_mov_b32 %0, m0\n\ts_mov_b32 m0, %2\n\ts_nop 0\n\tglobal_load_lds_dword %1, off\n\ts_mov_b32 m0, %0" : "=&s"(keep_) : "v"(rp_), "s"(la_) : "memory"); } } while (0)
    unsigned vGc[2][2], vS[2][2];
    const auto rsA = __builtin_amdgcn_make_buffer_rsrc((void*)g.A, 0, 0x40000000u, 0x00020000);
    const size_t kstep = (size_t)(BK * 2);
    const size_t hstep = (size_t)HALF * K * 2;
    const size_t tstep = 2 * hstep;
    const unsigned ldsw = (unsigned)wid * 1024u;
    const int aoff = lds_byte(wr * 64 + fr, fq * 8), boff = lds_byte(wc * 32 + fr, fq * 8);
#define PG8_SA(b, h) (((b) * 2 + (h)) * HTB)
#define PG8_SB(b, h) ((4 + (b) * 2 + (h)) * HTB)
#define PG8_STAGE(bufoff, gbase, voff) do { _Pragma("unroll") for (int _i = 0; _i < 2; ++_i) \
        __builtin_amdgcn_global_load_lds((const unsigned*)((const char*)(gbase) + (voff)[_i]), (PG8_LAS unsigned*)(lds + (bufoff) + ldsw + _i * 8192), 16, 0, 0); } while (0)
#define PG8_STAGE_A(bufoff, ptr, h, vsel) do { if constexpr (GA) { _Pragma("unroll") for (int _i = 0; _i < 2; ++_i)     \
            __builtin_amdgcn_raw_ptr_buffer_load_lds(rsA, (PG8_LAS void*)(lds + (bufoff) + ldsw + _i * 8192), 16, (int)vsel[h][_i], (int)((ptr) - (const char*)g.A), 0, 0); } \
        else PG8_STAGE(bufoff, (ptr) + ((h) ? hstep : 0), voffA); } while (0)
#define PG8_CAT8(p0_) __builtin_bit_cast(i32x8, __builtin_shufflevector(*(const PG8_LAS bf16x8*)(p0_), *(const PG8_LAS bf16x8*)((p0_) + 1024), 0, 1, 2, 3, 4, 5, 6, 7, 8, 9, 10, 11, 12, 13, 14, 15))
#define PG8_LDA(dst, b, h) do { if constexpr (F8) { _Pragma("unroll") for (int m = 0; m < 4; ++m) dst##8[m] = PG8_CAT8(lds + PG8_SA(b, h) + aoff + m * 2048); } \
        else { _Pragma("unroll") for (int m = 0; m < 4; ++m) _Pragma("unroll") for (int k = 0; k < 2; ++k) dst[m][k] = *(const PG8_LAS bf16x8*)(lds + PG8_SA(b, h) + aoff + m * 2048 + k * 1024); } } while (0)
#define PG8_LDB(dst, b, h) do { if constexpr (F8) { _Pragma("unroll") for (int n = 0; n < 2; ++n) dst##8[n] = PG8_CAT8(lds + PG8_SB(b, h) + boff + n * 2048); } \
        else { _Pragma("unroll") for (int n = 0; n < 2; ++n) _Pragma("unroll") for (int k = 0; k < 2; ++k) dst[n][k] = *(const PG8_LAS bf16x8*)(lds + PG8_SB(b, h) + boff + n * 2048 + k * 1024); } } while (0)
#define PG8_MMA(ai, bj, At, Bt) do { __builtin_amdgcn_s_setprio(1); \
        if constexpr (F8) { _Pragma("unroll") for (int m = 0; m < 4; ++m) _Pragma("unroll") for (int n = 0; n < 2; ++n) \
            asm volatile("v_mfma_scale_f32_16x16x128_f8f6f4 %0, %1, %2, %0, %3, %3 op_sel_hi:[0,0,0]" : "+v"(acc[ai][bj][m][n]) : "v"(Bt##8[n]), "v"(At##8[m]), "v"(f8one)); } \
        else { _Pragma("unroll") for (int m = 0; m < 4; ++m) _Pragma("unroll") for (int n = 0; n < 2; ++n) _Pragma("unroll") for (int k = 0; k < 2; ++k) \
            acc[ai][bj][m][n] = __builtin_amdgcn_mfma_f32_16x16x32_bf16(Bt[n][k], At[m][k], acc[ai][bj][m][n], 0, 0, 0); } \
        __builtin_amdgcn_s_setprio(0); } while (0)
#define PG8_WAIT_V(n) asm volatile("s_waitcnt vmcnt(" #n ")" ::: "memory")
#define PG8_WAIT_L(n) asm volatile("s_waitcnt lgkmcnt(" #n ")" ::: "memory")
#define PG8_BAR __builtin_amdgcn_s_barrier()
#define PG8_SCHED __builtin_amdgcn_sched_barrier(0)
    Unit cur, nxt; int ui = 0;
    if (!S.next(0, cur)) return;
#if defined(PG8_STAGGER_TICKS)
    if ((blockIdx.x >> 3) & 1) { const unsigned long long t0_ = __builtin_amdgcn_s_memrealtime(); while (__builtin_amdgcn_s_memrealtime() - t0_ < PG8_STAGGER_TICKS) __builtin_amdgcn_s_sleep(8); }
#endif
    f32x4 acc[2][2][4][2];
#pragma unroll
    for (int a = 0; a < 2; ++a)
#pragma unroll
        for (int b = 0; b < 2; ++b)
#pragma unroll
            for (int m = 0; m < 4; ++m)
#pragma unroll
                for (int n = 0; n < 2; ++n) acc[a][b][m][n] = (f32x4){0.f, 0.f, 0.f, 0.f};
    const int f8one = 0x7f7f7f7f;
    bf16x8 At[4][2], B0[2][2], B1[2][2]; i32x8 At8[4], B08[2], B18[2];
    const char* cA = GA ? (const char*)g.A : (const char*)g.A + (size_t)cur.pm * tstep; const char* cB = (const char*)g.Bt + (size_t)cur.pn * tstep;
    S.a_ready(cur);
    if constexpr (Epi::RS_LDS) PG8_RSDMA(cur);
    if constexpr (GA) { PG8_ROWDMA(cur, 0); asm volatile("s_waitcnt vmcnt(0)" ::: "memory"); PG8_ROWGET(vGc, 0); }
    if constexpr (SP2) {
        PG8_STAGE(PG8_SB(0, 0), cB, voffB); PG8_STAGE(PG8_SB(0, 1), cB + hstep, voffB); PG8_STAGE_A(PG8_SA(0, 0), cA, 0, vGc); PG8_STAGE_A(PG8_SA(0, 1), cA, 1, vGc);
        if (wr == 1) PG8_BAR;
        PG8_WAIT_V(2); PG8_BAR;
        PG8_STAGE(PG8_SB(1, 0), cB + kstep, voffB); PG8_STAGE_A(PG8_SA(1, 0), cA + kstep, 0, vGc); PG8_STAGE(PG8_SB(1, 1), cB + hstep + kstep, voffB);
        PG8_WAIT_V(6); PG8_BAR;
    } else {
        PG8_STAGE(PG8_SB(0, 0), cB, voffB); PG8_STAGE(PG8_SA(0, 0), cA, voffA); PG8_STAGE(PG8_SB(0, 1), cB + hstep, voffB); PG8_STAGE(PG8_SA(0, 1), cA + hstep, voffA);
        if (wr == 1) PG8_BAR;
        PG8_WAIT_V(4); PG8_BAR;
        PG8_STAGE(PG8_SB(1, 0), cB + kstep, voffB); PG8_STAGE(PG8_SA(1, 0), cA + kstep, voffA); PG8_STAGE(PG8_SB(1, 1), cB + hstep + kstep, voffB);
        PG8_WAIT_V(6); PG8_BAR;
    }
    for (;;) {
        const bool has_next = S.next(ui + 1, nxt);
        const char* nA = GA ? cA : has_next ? (const char*)g.A + (size_t)nxt.pm * tstep : cA; const char* nB = has_next ? (const char*)g.Bt + (size_t)nxt.pn * tstep : cB;
        if constexpr (GA) { if (has_next) PG8_ROWDMA(nxt, (ui + 1) & 1); }
        for (int t = 0; t < nt; t += 2) {
            const bool last = (t == nt - 2);
            const char* a1 = cA + (size_t)(t + 1) * kstep;
            const char* a2 = last ? nA : cA + (size_t)(t + 2) * kstep; const char* b2 = last ? nB : cB + (size_t)(t + 2) * kstep;
            const char* a3 = a2 + kstep; const char* b3 = b2 + kstep;
            if (last && has_next) S.a_ready(nxt);
            if constexpr (GA) { if (last && has_next) PG8_ROWGET(vS, (ui + 1) & 1);
                else { vS[0][0] = vGc[0][0]; vS[0][1] = vGc[0][1]; vS[1][0] = vGc[1][0]; vS[1][1] = vGc[1][1]; } }
            if constexpr (SP2) {
            PG8_LDB(B0, 0, 0); PG8_LDB(B1, 0, 1); PG8_SCHED; PG8_LDA(At, 0, 0); PG8_STAGE_A(PG8_SA(1, 1), a1, 1, vGc);
            PG8_WAIT_V(8); PG8_WAIT_L(0); PG8_BAR; PG8_MMA(0, 0, At, B0); PG8_MMA(0, 1, At, B1); PG8_BAR; PG8_SCHED;
            PG8_LDA(At, 0, 1); PG8_STAGE(PG8_SB(0, 0), b2, voffB); PG8_STAGE(PG8_SB(0, 1), b2 + hstep, voffB); PG8_STAGE_A(PG8_SA(0, 0), a2, 0, vS);
            PG8_WAIT_V(8); PG8_WAIT_L(0); PG8_BAR; PG8_MMA(1, 0, At, B0); PG8_MMA(1, 1, At, B1); PG8_BAR; PG8_SCHED;
            PG8_LDB(B0, 1, 0); PG8_LDB(B1, 1, 1); PG8_SCHED; PG8_LDA(At, 1, 0); PG8_STAGE_A(PG8_SA(0, 1), a2, 1, vS);
            PG8_WAIT_V(8); PG8_WAIT_L(0); PG8_BAR; PG8_MMA(0, 0, At, B0); PG8_MMA(0, 1, At, B1); PG8_BAR; PG8_SCHED;
            PG8_LDA(At, 1, 1); PG8_STAGE(PG8_SB(1, 0), b3, voffB); PG8_STAGE(PG8_SB(1, 1), b3 + hstep, voffB); PG8_STAGE_A(PG8_SA(1, 0), a3, 0, vS);
            PG8_WAIT_V(8); PG8_WAIT_L(0); PG8_BAR; PG8_MMA(1, 0, At, B0); PG8_MMA(1, 1, At, B1); PG8_BAR; PG8_SCHED;
            } else {
            PG8_LDB(B0, 0, 0); PG8_SCHED; PG8_LDA(At, 0, 0); PG8_STAGE(PG8_SA(1, 1), a1 + hstep, voffA);
            PG8_WAIT_L(8); PG8_BAR; PG8_WAIT_L(0); PG8_MMA(0, 0, At, B0); PG8_BAR; PG8_SCHED;
            PG8_LDB(B1, 0, 1); PG8_STAGE(PG8_SB(0, 0), b2, voffB);
            PG8_BAR; PG8_WAIT_L(0); PG8_MMA(0, 1, At, B1); PG8_BAR;
            PG8_LDA(At, 0, 1); PG8_STAGE(PG8_SA(0, 0), a2, voffA);
            PG8_BAR; PG8_WAIT_L(0); PG8_MMA(1, 0, At, B0); PG8_BAR; PG8_SCHED;
            PG8_STAGE(PG8_SB(0, 1), b2 + hstep, voffB);
            PG8_WAIT_V(6); PG8_BAR; PG8_MMA(1, 1, At, B1); PG8_BAR;
            PG8_LDB(B0, 1, 0); PG8_SCHED; PG8_LDA(At, 1, 0); PG8_STAGE(PG8_SA(0, 1), a2 + hstep, voffA);
            PG8_WAIT_L(8); PG8_BAR; PG8_WAIT_L(0); PG8_MMA(0, 0, At, B0); PG8_BAR; PG8_SCHED;
            PG8_LDB(B1, 1, 1); PG8_STAGE(PG8_SB(1, 0), b3, voffB);
            PG8_BAR; PG8_WAIT_L(0); PG8_MMA(0, 1, At, B1); PG8_BAR;
            PG8_LDA(At, 1, 1); PG8_STAGE(PG8_SA(1, 0), a3, voffA);
            PG8_BAR; PG8_WAIT_L(0); PG8_MMA(1, 0, At, B0); PG8_BAR; PG8_SCHED;
            PG8_STAGE(PG8_SB(1, 1), b3 + hstep, voffB);
            PG8_WAIT_V(6); PG8_BAR; PG8_MMA(1, 1, At, B1); PG8_BAR;
            }
        }
        if constexpr (F8) { asm volatile("s_nop 15\n\ts_nop 15" ::: "memory"); }
        if constexpr (ALIGN_EPI) { if (wr == 0) PG8_BAR; }
        if constexpr (!Epi::AFTER_DRAIN) { if constexpr (Epi::RS_LDS) E(acc, cur, wr, wc, fr, fq, (const PG8_LAS float*)rsbuf); else E(acc, cur, wr, wc, fr, fq); S.done(cur); }
        if (!has_next) break;
#pragma unroll
        for (int a = 0; a < 2; ++a)
#pragma unroll
            for (int b = 0; b < 2; ++b)
#pragma unroll
                for (int m = 0; m < 4; ++m)
#pragma unroll
                    for (int n = 0; n < 2; ++n) acc[a][b][m][n] = (f32x4){0.f, 0.f, 0.f, 0.f};
        cur = nxt; cA = nA; cB = nB; ++ui;
        if constexpr (Epi::RS_LDS) PG8_RSDMA(cur);
        if constexpr (GA) { vGc[0][0] = vS[0][0]; vGc[0][1] = vS[0][1]; vGc[1][0] = vS[1][0]; vGc[1][1] = vS[1][1]; }
        if constexpr (ALIGN_EPI) { if (wr == 1) PG8_BAR; }
    }
    PG8_WAIT_V(0);
    if constexpr (!ALIGN_EPI) { if (wr == 0) PG8_BAR; }
    PG8_BAR;
    if constexpr (Epi::AFTER_DRAIN) { E.fused(acc, cur, wr, wc, fr, fq, lds, wid, lane); S.done(cur); }
#undef PG8_SA
#undef PG8_SB
#undef PG8_STAGE
#undef PG8_STAGE_A
#undef PG8_ROWDMA
#undef PG8_RSDMA
#undef PG8_ROWGET
#undef PG8_LDA
#undef PG8_CAT8
#undef PG8_LDB
#undef PG8_MMA
#undef PG8_WAIT_V
#undef PG8_WAIT_L
#undef PG8_BAR
#undef PG8_SCHED
}
}

constexpr int NWAVES = 8;
constexpr int BATCH = 8, SEQ = 4096, D = 1024, M = BATCH * SEQ;
constexpr int AW = 2048, FF = 3584, NE = 8;
constexpr int MROWS = 2 * M + NE * 256;
constexpr float EPS = 1e-6f;
#ifndef MK_ONE_LAUNCH
#define MK_ONE_LAUNCH 1
#endif
#ifndef MK_LAYERS
#define MK_LAYERS 4
#endif
#ifndef MK_AIN_F8
#define MK_AIN_F8 1
#endif
constexpr int AIN_F8 = MK_AIN_F8;
#ifndef MK_AOUT_F8
#define MK_AOUT_F8 2
#endif
constexpr int AOUT_F8 = MK_AOUT_F8;
#ifndef MK_BOUT_F8
#define MK_BOUT_F8 0
#endif
constexpr int BOUT_F8 = MK_BOUT_F8;
#ifndef MK_COUT_F8
#define MK_COUT_F8 1
#endif
constexpr int COUT_F8 = MK_COUT_F8;
#ifndef MK_CIN_F8
#define MK_CIN_F8 1
#endif
constexpr int CIN_F8 = MK_CIN_F8;
#ifndef MK_MOE_F8
#define MK_MOE_F8 1
#endif
#ifndef MK_DENSE_F8
#define MK_DENSE_F8 2
#endif
constexpr int DENSE_F8 = MK_DENSE_F8;
constexpr int MOE_F8 = MK_MOE_F8;

constexpr size_t MiB = 1u << 20;
constexpr size_t WS_CTL = 0, CTL_ZERO_BYTES = 1 * MiB;
constexpr size_t WS_WA_IN = 2 * MiB, WS_WA_OUT = 18 * MiB, WS_WB_IN = 26 * MiB, WS_WB_OUT = 32 * MiB, WS_WC_IN = 34 * MiB, WS_WC_OUT = 40 * MiB;
constexpr size_t WS_WF_IN = 42 * MiB, WS_WF_OUT = 70 * MiB, WS_WM_IN = 84 * MiB, WS_WM_OUT = 308 * MiB;
constexpr size_t WS_X = 420 * MiB, WS_XB = 548 * MiB, WS_SSQ = 612 * MiB, WS_VSSQ = 614 * MiB, WS_GLOW = 618 * MiB, WS_LOGF = 620 * MiB, WS_OSSQ = 621 * MiB, WS_DEC = 629 * MiB;
constexpr size_t WS_TOKE = 630 * MiB, WS_TOKP = WS_TOKE + 256 * 1024, WS_TOKG = WS_TOKP + 256 * 1024, WS_TOKRS = WS_TOKG + 256 * 1024, WS_BLKB = WS_TOKRS + 128 * 1024;
constexpr size_t WS_ROWT = 632 * MiB, WS_ROWG = WS_ROWT + 512 * 1024, WS_ROWRS = WS_ROWG + 512 * 1024;
constexpr size_t WS_ACT = 640 * MiB;
constexpr size_t WS_U = WS_ACT, WS_V = WS_ACT + 128 * MiB, WS_Y = WS_ACT + 256 * MiB;
constexpr size_t WS_X8 = WS_X;
constexpr size_t WS_HF = WS_ACT;
constexpr size_t WS_QKVR = WS_ACT, WS_QD = WS_ACT + 192 * MiB, WS_KD = WS_ACT + 224 * MiB, WS_KET = WS_ACT + 256 * MiB, WS_VT = WS_ACT + 288 * MiB, WS_GO = WS_ACT + 352 * MiB, WS_GG = WS_ACT + 416 * MiB;
constexpr size_t WS_AO = WS_ACT + 192 * MiB;
constexpr size_t WS_XS = WS_ACT, WS_HM = WS_ACT + 132 * MiB, WS_OS = WS_ACT + 594 * MiB;
constexpr size_t WS_END = WS_ACT + 722 * MiB;
static_assert((size_t)MROWS * 1024 * 2 <= 132 * MiB && (size_t)MROWS * FF * 2 <= 462 * MiB, "MoE buffers");
constexpr int CW_TMO = 0, CW_CODE = 1, CW_XMIS = 2, CW_BAR = 4096, CW_CNT = 8192, CW_KNB = 12288;

constexpr int RING_OFF = 0, RING_BYTES = 131072;
constexpr int LDSCTL_OFF = RING_BYTES, MISC_OFF = LDSCTL_OFF + 320;
constexpr int LDS_BYTES = 147456;
static_assert(MISC_OFF + 128 <= LDS_BYTES, "LDS map");

#define GAS __attribute__((address_space(1)))
#define LAS __attribute__((address_space(3)))
#define DI __device__ __forceinline__
typedef unsigned short bf16;
typedef unsigned v4u __attribute__((ext_vector_type(4)));
typedef unsigned v2u __attribute__((ext_vector_type(2)));
typedef float f32x4 __attribute__((ext_vector_type(4)));
typedef short bf16x8 __attribute__((ext_vector_type(8)));
typedef short bf16x4 __attribute__((ext_vector_type(4)));
typedef GAS unsigned gu32;
#define RLX_AGENT __ATOMIC_RELAXED, __HIP_MEMORY_SCOPE_AGENT
#define LDS_WAIT() asm volatile("s_waitcnt lgkmcnt(0)" ::: "memory")
#define VM_WAIT() asm volatile("s_waitcnt vmcnt(0)" ::: "memory")
DI unsigned f2bf(float f) { unsigned u = __builtin_bit_cast(unsigned, f); return (u + 0x7fffu + ((u >> 16) & 1u)) >> 16; }
DI unsigned pk2(float lo, float hi) { return f2bf(lo) | (f2bf(hi) << 16); }
DI float bflo(unsigned w) { return __builtin_bit_cast(float, w << 16); }
DI float bfhi(unsigned w) { return __builtin_bit_cast(float, w & 0xffff0000u); }
DI float bf2f(bf16 h) { return __builtin_bit_cast(float, ((unsigned)h) << 16); }
DI float wave_sum(float v) {
#pragma unroll
    for (int o = 1; o < 64; o <<= 1) v += __shfl_xor(v, o);
    return v;
}
DI float logsig(float z) { return fminf(z, 0.f) - log1pf(__expf(-fabsf(z))); }
#define MFMA16(a, b, c) __builtin_amdgcn_mfma_f32_16x16x32_bf16((a), (b), (c), 0, 0, 0)
DI bf16x8 ldsfrag(LAS const unsigned char* p) { return *(LAS const bf16x8*)p; }
typedef short s16x4 __attribute__((ext_vector_type(4)));
DI bf16x8 tr_frag(LAS const unsigned char* p0, LAS const unsigned char* p1) {
    const s16x4 a = __builtin_amdgcn_ds_read_tr16_b64_v4i16((LAS s16x4*)p0), b = __builtin_amdgcn_ds_read_tr16_b64_v4i16((LAS s16x4*)p1);
    return __builtin_shufflevector(a, b, 0, 1, 2, 3, 4, 5, 6, 7);
}
#define XB_TMO      128
#define XB_XCNT(j)  (256  + 64 * (j))
#define XB_XSUB(j)  (1280 + 64 * (j))
#define XB_XGEN(j)  (2304 + 64 * (j))
#define XB_TOP      3328
#define XB_TOPGEN   3392
#define XCD_BAR_WORDS 3456
#define XB_SPIN_CAP (1u << 18)

__device__ __forceinline__ unsigned xb_ld(unsigned* p)              { return __hip_atomic_load(p, __ATOMIC_RELAXED, __HIP_MEMORY_SCOPE_AGENT); }
__device__ __forceinline__ unsigned xb_add(unsigned* p, unsigned v) { return __hip_atomic_fetch_add(p, v, __ATOMIC_RELAXED, __HIP_MEMORY_SCOPE_AGENT); }
__device__ __forceinline__ unsigned xb_xcc_id() { return (unsigned)__builtin_amdgcn_s_getreg((3 << 11) | 20) & 0xFu; }
#define XB_SPIN(cond, bar) do { unsigned _sp = 0; while (cond) { __builtin_amdgcn_s_sleep(1); \
    if ((++_sp & 255u) == 0u) { if (xb_ld(&(bar)[XB_TMO])) break; if (_sp > XB_SPIN_CAP) { atomicAdd(&(bar)[XB_TMO], 1u); break; } } } } while (0)

struct XcdBarrier {
    unsigned* bar; unsigned x;
    volatile LAS unsigned* st;
};

__device__ __forceinline__ XcdBarrier xcd_barrier_post(unsigned* bar, volatile LAS unsigned* st) {
    XcdBarrier b; b.bar = bar; b.x = xb_xcc_id(); b.st = st;
    if (threadIdx.x == 0) (void)xb_add(&bar[XB_XCNT(b.x)], 1u);
    return b;
}
__device__ __forceinline__ void xcd_barrier_complete(unsigned* bar, unsigned x, unsigned& nloc, unsigned& nx) {
    const unsigned G = gridDim.x * gridDim.y * gridDim.z;
    unsigned sum, cnt, mine, sp = 0u;
    for (;;) {
        sum = 0u; cnt = 0u; mine = 0u;
#pragma unroll
        for (unsigned j = 0; j < 16; ++j) { const unsigned c = xb_ld(&bar[XB_XCNT(j)]); sum += c; cnt += (c > 0u) ? 1u : 0u; mine = (j == x) ? c : mine; }
        if (sum == G) break;
        __builtin_amdgcn_s_sleep(1);
        if ((++sp & 255u) == 0u) { if (xb_ld(&bar[XB_TMO])) break; if (sp > XB_SPIN_CAP) { atomicAdd(&bar[XB_TMO], 1u); break; } }
    }
    nloc = mine > 0u ? mine : 1u; nx = cnt > 0u ? cnt : 1u;
}

__device__ __forceinline__ void xcd_barrier(const XcdBarrier& b) {
    asm volatile("s_waitcnt vmcnt(0)" ::: "memory");
    __syncthreads();
    if (threadIdx.x == 0) {
        unsigned* bar = b.bar;
        __builtin_amdgcn_s_waitcnt(0);
        unsigned nloc = b.st[0], nx = b.st[1];
        if (nloc == 0u) { xcd_barrier_complete(bar, b.x, nloc, nx); b.st[0] = nloc; b.st[1] = nx; }
        const unsigned old = xb_add(&bar[XB_XSUB(b.x)], 1u);
        const unsigned gen = old / nloc;
        if (old + 1u == (gen + 1u) * nloc) {
            __builtin_amdgcn_fence(__ATOMIC_RELEASE, "agent");
            asm volatile("s_waitcnt vmcnt(0)" ::: "memory");
            const unsigned og = xb_add(&bar[XB_TOP], 1u);
            const unsigned tg = og / nx;
            if (og + 1u == (tg + 1u) * nx) xb_add(&bar[XB_TOPGEN], 1u);
            else XB_SPIN(xb_ld(&bar[XB_TOPGEN]) == tg, bar);
            __builtin_amdgcn_fence(__ATOMIC_ACQUIRE, "agent");
            xb_add(&bar[XB_XGEN(b.x)], 1u);
            asm volatile("s_waitcnt vmcnt(0)" ::: "memory");
        } else {
            XB_SPIN(xb_ld(&bar[XB_XGEN(b.x)]) == gen, bar);
            __builtin_amdgcn_fence(__ATOMIC_ACQUIRE, "agent");
            asm volatile("s_waitcnt vmcnt(0)" ::: "memory");
        }
    }
    __syncthreads();
}

__device__ __forceinline__ void xcd_barrier_local(const XcdBarrier& b) {
    asm volatile("s_waitcnt vmcnt(0)" ::: "memory");
    __syncthreads();
    if (threadIdx.x == 0) {
        unsigned* bar = b.bar;
        __builtin_amdgcn_s_waitcnt(0);
        const unsigned nloc = b.st[0];
        const unsigned old = xb_add(&bar[XB_XSUB(b.x)], 1u);
        const unsigned gen = old / nloc;
        if (old + 1u == (gen + 1u) * nloc) xb_add(&bar[XB_XGEN(b.x)], 1u);
        else XB_SPIN(xb_ld(&bar[XB_XGEN(b.x)]) == gen, bar);
        __builtin_amdgcn_fence(__ATOMIC_ACQUIRE, "agent");
        asm volatile("s_waitcnt vmcnt(0)" ::: "memory");
    }
    __syncthreads();
}

struct Frame {
    LAS unsigned char* lds;
    volatile LAS unsigned* MISC;
    gu32* ctl;
    int tid, lane, wave;
    int vcu, G;
    float* out; unsigned char* ws;
};
template <class T> DI T* wsp(const Frame& F, size_t off) { return (T*)(F.ws + off); }

struct MatDesc { const float* W; int ldw, K, N; bf16* WT; int mode; const float* gain; int f8; };
template <class A> DI MatDesc get_mat(const Frame& F, const A& P, int idx) {
    MatDesc d; d.f8 = 0;
    if (idx < 2)        { const int j = idx;      d.W = P.in[3] + (size_t)j * 1024 * 4096; d.ldw = 4096; d.K = 1024; d.N = 4096; d.f8 = (j == 1 && AIN_F8) ? 1 : 0; d.WT = wsp<bf16>(F, WS_WA_IN) + (size_t)j * 4096 * 1024; d.mode = 0; d.gain = P.in[1] + (j ? 3 : 0) * 1024; }
    else if (idx < 4)   { const int j = idx - 2;  d.W = P.in[7] + (size_t)j * 2048 * 1024; d.ldw = 1024; d.K = 2048; d.N = 1024; d.f8 = (AOUT_F8 >> j) & 1; d.WT = wsp<bf16>(F, WS_WA_OUT) + (size_t)j * 1024 * 2048; d.mode = 0; d.gain = nullptr; }
    else if (idx == 4)  { d.W = P.in[8];  d.ldw = 3088; d.K = 1024; d.N = 3072; d.WT = wsp<bf16>(F, WS_WB_IN);  d.mode = 0; d.gain = P.in[1] + 1 * 1024; }
    else if (idx == 5)  { d.W = P.in[12]; d.ldw = 1024; d.K = 1024; d.N = 1024; d.WT = wsp<bf16>(F, WS_WB_OUT); d.mode = 0; d.gain = nullptr; d.f8 = BOUT_F8; }
    else if (idx == 6)  { d.W = P.in[13]; d.ldw = 3080; d.K = 1024; d.N = 3072; d.WT = wsp<bf16>(F, WS_WC_IN);  d.mode = 0; d.gain = P.in[1] + 2 * 1024; d.f8 = CIN_F8; }
    else if (idx == 7)  { d.W = P.in[15]; d.ldw = 1024; d.K = 1024; d.N = 1024; d.WT = wsp<bf16>(F, WS_WC_OUT); d.mode = 0; d.gain = nullptr; d.f8 = COUT_F8; }
    else if (idx < 10)  { const int i = idx - 8;  d.W = P.in[16] + (size_t)i * 1024 * 7168; d.ldw = 7168; d.K = 1024; d.N = 7168; d.f8 = (DENSE_F8 >> i) & 1; d.WT = d.f8 ? (bf16*)(wsp<unsigned char>(F, WS_WF_IN) + (size_t)i * 2 * 7168 * 1024) : wsp<bf16>(F, WS_WF_IN) + (size_t)i * 7168 * 1024; d.mode = 1; d.gain = P.in[2] + (2 * i) * 1024; }
    else if (idx < 12)  { const int i = idx - 10; d.W = P.in[17] + (size_t)i * 3584 * 1024; d.ldw = 1024; d.K = 3584; d.N = 1024; d.f8 = (DENSE_F8 >> i) & 1; d.WT = d.f8 ? (bf16*)(wsp<unsigned char>(F, WS_WF_OUT) + (size_t)i * 2 * 1024 * 3584) : wsp<bf16>(F, WS_WF_OUT) + (size_t)i * 1024 * 3584; d.mode = 0; d.gain = nullptr; }
    else if (idx < 28)  { const int q = idx - 12; d.W = P.in[19] + (size_t)q * 1024 * 7168; d.ldw = 7168; d.K = 1024; d.N = 7168; d.WT = MOE_F8 ? (bf16*)(wsp<unsigned char>(F, WS_WM_IN) + (size_t)q * 7168 * 1024) : wsp<bf16>(F, WS_WM_IN) + (size_t)q * 7168 * 1024; d.mode = 1; d.gain = P.in[2] + (2 * (q >> 3) + 1) * 1024; d.f8 = MOE_F8; }
    else                { const int q = idx - 28; d.W = P.in[20] + (size_t)q * 3584 * 1024; d.ldw = 1024; d.K = 3584; d.N = 1024; d.WT = MOE_F8 ? (bf16*)(wsp<unsigned char>(F, WS_WM_OUT) + (size_t)q * 1024 * 3584) : wsp<bf16>(F, WS_WM_OUT) + (size_t)q * 1024 * 3584; d.mode = 0; d.gain = nullptr; d.f8 = MOE_F8; }
    return d;
}
constexpr int NMATS = 44;
constexpr int P0_ST = 129;
struct P0Dst { bf16* base; int K; int f8; };
DI int p0_ntiles(const MatDesc& d) { return (d.K / 128) * (d.N / 128); }
DI P0Dst p0_load(const MatDesc& d, int tile, int tid, f32x4 (&r)[8], float (&g)[8]) {
    const int ntn = d.N / 128, kb = tile / ntn, nb = tile % ntn, k0 = 128 * kb, n0 = 128 * nb;
#pragma unroll
    for (int p = 0; p < 8; ++p) { const int k = k0 + p * 16 + (tid >> 5); r[p] = *(const f32x4*)(d.W + (size_t)k * d.ldw + n0 + 4 * (tid & 31)); g[p] = d.gain ? d.gain[k] : 1.0f; }
    int drow0 = n0;
    if (d.mode == 1) drow0 = (n0 < FF) ? (n0 >> 7) * 256 : ((n0 - FF) >> 7) * 256 + 128;
    P0Dst o; o.K = d.K; o.f8 = d.f8;
    if (d.f8) { o.base = (bf16*)((unsigned char*)d.WT + (size_t)drow0 * d.K + k0);
#pragma unroll
        for (int p = 0; p < 8; ++p) g[p] *= 64.0f; }
    else o.base = d.WT + (size_t)drow0 * d.K + k0;
    return o;
}
constexpr int N_EARLY = 6;
DI int morder(int i) { return i == 0 ? 0 : i == 1 ? 2 : i == 2 ? 4 : i == 3 ? 5 : i == 4 ? 8 : i == 5 ? 10 : i == 6 ? 1 : i == 7 ? 3 : i == 8 ? 6 : i == 9 ? 7 : i == 10 ? 9 : i == 11 ? 11 : i; }
struct P0State { int mi, i_hi, base, nt, T, stride; MatDesc d; };
template <class A> DI void p0_init(P0State& s, Frame& F, const A& P, int i_lo, int i_hi, int worker, int nworkers) { s.mi = i_lo; s.i_hi = i_hi; s.base = 0; s.T = worker; s.stride = nworkers; s.d = get_mat(F, P, morder(i_lo)); s.nt = p0_ntiles(s.d); }
#define P0_NEXT(st, r, g, dst, have) do { have = false; while (st.mi < st.i_hi && st.T >= st.base + st.nt) { st.base += st.nt; ++st.mi; if (st.mi < st.i_hi) { st.d = get_mat(F, P, morder(st.mi)); st.nt = p0_ntiles(st.d); } } \
        if (st.mi < st.i_hi) { dst = p0_load(st.d, st.T - st.base, tid, r, g); have = true; } st.T += st.stride; } while (0)
constexpr int P0_TST = 272;
#define P0_WRITE(S, r, g, dst) do { \
        _Pragma("unroll") for (int p = 0; p < 8; ++p) { f32x4 v_ = r[p] * g[p]; \
            if (dst.f8) { v_[0] = pg8::c8(v_[0]); v_[1] = pg8::c8(v_[1]); v_[2] = pg8::c8(v_[2]); v_[3] = pg8::c8(v_[3]); } \
            v2u w_; w_.x = pg8::cvt_pk_bf16(v_[0], v_[1]); w_.y = pg8::cvt_pk_bf16(v_[2], v_[3]); \
            *(LAS v2u*)((S) + (p * 16 + (tid >> 5)) * P0_TST + 8 * (tid & 31)) = w_; } \
        } while (0)
#define P0_STORE(S, dst) do { const int w_ = tid >> 6, fr_ = tid & 15, fq_ = (tid >> 4) & 3; \
        LAS const unsigned char* tp_ = (S) + (fr_ >> 2) * P0_TST + (16 * w_ + 4 * (fr_ & 3)) * 2; \
        if (dst.f8) { _Pragma("unroll") for (int kk = 0; kk < 2; ++kk) { const int kb_ = 64 * kk + 16 * fq_; \
            const bf16x8 a0_ = tr_frag(tp_ + kb_ * P0_TST, tp_ + (kb_ + 4) * P0_TST), a1_ = tr_frag(tp_ + (kb_ + 8) * P0_TST, tp_ + (kb_ + 12) * P0_TST); \
            const v4u x0_ = __builtin_bit_cast(v4u, a0_), x1_ = __builtin_bit_cast(v4u, a1_); v4u o; \
            { int q_ = __builtin_amdgcn_cvt_pk_fp8_f32(bflo(x0_.x), bfhi(x0_.x), 0, false); q_ = __builtin_amdgcn_cvt_pk_fp8_f32(bflo(x0_.y), bfhi(x0_.y), q_, true); o.x = (unsigned)q_; } \
            { int q_ = __builtin_amdgcn_cvt_pk_fp8_f32(bflo(x0_.z), bfhi(x0_.z), 0, false); q_ = __builtin_amdgcn_cvt_pk_fp8_f32(bflo(x0_.w), bfhi(x0_.w), q_, true); o.y = (unsigned)q_; } \
            { int q_ = __builtin_amdgcn_cvt_pk_fp8_f32(bflo(x1_.x), bfhi(x1_.x), 0, false); q_ = __builtin_amdgcn_cvt_pk_fp8_f32(bflo(x1_.y), bfhi(x1_.y), q_, true); o.z = (unsigned)q_; } \
            { int q_ = __builtin_amdgcn_cvt_pk_fp8_f32(bflo(x1_.z), bfhi(x1_.z), 0, false); q_ = __builtin_amdgcn_cvt_pk_fp8_f32(bflo(x1_.w), bfhi(x1_.w), q_, true); o.w = (unsigned)q_; } \
            *(v4u*)((unsigned char*)dst.base + (size_t)(16 * w_ + fr_) * dst.K + kb_) = o; } } \
        else { _Pragma("unroll") for (int kk = 0; kk < 4; ++kk) { const int kb_ = 32 * kk + 8 * fq_; \
            const bf16x8 a_ = tr_frag(tp_ + kb_ * P0_TST, tp_ + (kb_ + 4) * P0_TST); \
            *(v4u*)(dst.base + (size_t)(16 * w_ + fr_) * dst.K + kb_) = __builtin_bit_cast(v4u, a_); } } \
        } while (0)
template <class A> DI void p0_convert(Frame& F, const A& P, int i_lo, int i_hi, int worker, int nworkers) {
    LAS unsigned char* S = F.lds;
    const int tid = F.tid;
    P0State st; p0_init(st, F, P, i_lo, i_hi, worker, nworkers);
    f32x4 rA[8], rB[8]; float gA[8], gB[8]; P0Dst dA, dB; dA.base = nullptr; dA.K = 0; dA.f8 = 0; dB = dA; bool hA = false, hB = false;
    P0_NEXT(st, rA, gA, dA, hA);
    while (hA) {
        P0_NEXT(st, rB, gB, dB, hB);
        P0_WRITE(S, rA, gA, dA); __syncthreads(); P0_STORE(S, dA); __syncthreads();
        if (!hB) break;
        P0_NEXT(st, rA, gA, dA, hA);
        P0_WRITE(S, rB, gB, dB); __syncthreads(); P0_STORE(S, dB); __syncthreads();
    }
}
template <class A> DI void p0_prologue(Frame& F, const A& P) {
    const int gw = F.vcu * NWAVES + F.wave, NGW = F.G * NWAVES;
    { const float* x = P.in[0]; bf16* xb = wsp<bf16>(F, WS_XB); float* ssq = wsp<float>(F, WS_SSQ);
      for (int m = gw; m < M; m += NGW) {
        const f32x4* xr = (const f32x4*)(x + (size_t)m * D) + F.lane; f32x4 v[4]; float s = 0.f;
#pragma unroll
        for (int j = 0; j < 4; ++j) { v[j] = xr[64 * j]; s += (v[j][0] * v[j][0] + v[j][1] * v[j][1]) + (v[j][2] * v[j][2] + v[j][3] * v[j][3]); }
        s = wave_sum(s);
        v2u* o8 = (v2u*)(xb + (size_t)m * D) + F.lane;
#pragma unroll
        for (int j = 0; j < 4; ++j) { v2u w; w.x = pk2(v[j][0], v[j][1]); w.y = pk2(v[j][2], v[j][3]); o8[64 * j] = w; }
        if (F.lane < 4) { f32x4 z = {0.f, 0.f, 0.f, 0.f}; if (F.lane == 0) z[0] = s; *((f32x4*)(ssq + (size_t)m * 16) + F.lane) = z; }
      } }
    p0_convert(F, P, 0, N_EARLY, F.vcu, F.G);
}

constexpr int TH_ST = 2064, TH_WL = 16 * TH_ST;
template <int NOUT> DI void thin_stage(Frame& F, const float* gain, const float* W, int ldw, int c0) {
    LAS unsigned char* lds = F.lds;
    for (int i = F.tid; i < 1024 * 16; i += NWAVES * 64) { const int n = i & 15, k = i >> 4; const float v = (n < NOUT) ? gain[k] * W[(size_t)k * ldw + c0 + n] : 0.f;
        const unsigned hi = f2bf(v); const float r = v - __builtin_bit_cast(float, hi << 16);
        *(LAS unsigned short*)(lds + n * TH_ST + k * 2) = (unsigned short)hi; *(LAS unsigned short*)(lds + TH_WL + n * TH_ST + k * 2) = (unsigned short)f2bf(r); }
    __syncthreads();
}
DI void thin_tile(const bf16* x, int row0, LAS const unsigned char* lds, int lane, float& ss, f32x4& out) {
    const int fr = lane & 15, fq = lane >> 4; const bf16* xr = x + (size_t)(row0 + fr) * D + 8 * fq; LAS const unsigned char* wp = lds + fr * TH_ST + 16 * fq;
    f32x4 acc = {0.f, 0.f, 0.f, 0.f}; float s = 0.f;
#pragma unroll 1
    for (int kb = 0; kb < 4; ++kb) { v4u a[8];
#pragma unroll
        for (int i = 0; i < 8; ++i) a[i] = *(const v4u*)(xr + 32 * (8 * kb + i));
#pragma unroll
        for (int i = 0; i < 8; ++i) { const v4u q = a[i];
            s += (bflo(q.x) * bflo(q.x) + bfhi(q.x) * bfhi(q.x)) + (bflo(q.y) * bflo(q.y) + bfhi(q.y) * bfhi(q.y)) + (bflo(q.z) * bflo(q.z) + bfhi(q.z) * bfhi(q.z)) + (bflo(q.w) * bflo(q.w) + bfhi(q.w) * bfhi(q.w));
            const bf16x8 xa = __builtin_bit_cast(bf16x8, q); const bf16x8 wh = ldsfrag(wp + 64 * (8 * kb + i)), wl = ldsfrag(wp + TH_WL + 64 * (8 * kb + i));
            acc = MFMA16(wh, xa, acc); acc = MFMA16(wl, xa, acc); } }
    s += __shfl_xor(s, 16); s += __shfl_xor(s, 32);
    ss = s; out = acc;
}
DI void glow_phase(Frame& F, const bf16* x, const float* gain, const float* Wb) {
    thin_stage<16>(F, gain, Wb, 3088, 3072);
    float* glow = wsp<float>(F, WS_GLOW);
    const int gw = F.vcu * NWAVES + F.wave, NGW = F.G * NWAVES, fr = F.lane & 15, fq = F.lane >> 4;
    for (int t = gw; t < M / 16; t += NGW) { float ss; f32x4 o; thin_tile(x, 16 * t, F.lds, F.lane, ss, o);
        const float rs = 1.0f / sqrtf(ss * (1.0f / D) + EPS);
        *(f32x4*)(glow + (size_t)(16 * t + fr) * 16 + 4 * fq) = o * rs; }
    __syncthreads();
}
DI void logf_phase(Frame& F, const bf16* x, const float* gain, const float* Wc, const float* fb) {
    thin_stage<8>(F, gain, Wc, 3080, 3072);
    float* logf = wsp<float>(F, WS_LOGF);
    const int gw = F.vcu * NWAVES + F.wave, NGW = F.G * NWAVES, fr = F.lane & 15, fq = F.lane >> 4;
    const f32x4 fb4 = *(const f32x4*)(fb + 4 * (fq & 1));
    for (int t = gw; t < M / 16; t += NGW) { float ss; f32x4 o; thin_tile(x, 16 * t, F.lds, F.lane, ss, o);
        const float rs = 1.0f / sqrtf(ss * (1.0f / D) + EPS);
        if (fq < 2) { f32x4 r;
#pragma unroll
            for (int e = 0; e < 4; ++e) r[e] = logsig(o[e] * rs + fb4[e]);
            *(f32x4*)(logf + (size_t)(16 * t + fr) * 8 + 4 * fq) = r; } }
    __syncthreads();
}
DI void router_phase(Frame& F, const bf16* x, const float* gain, const float* Wr, unsigned* gcnt) {
    thin_stage<8>(F, gain, Wr, 8, 0);
    LAS unsigned* lcnt = (LAS unsigned*)(F.lds + 2 * TH_WL);
    if (F.tid < 8) lcnt[F.tid] = 0u;
    __syncthreads();
    int* tok_e = wsp<int>(F, WS_TOKE); int* tok_p = wsp<int>(F, WS_TOKP); float* tok_g = wsp<float>(F, WS_TOKG); float* tok_rs = wsp<float>(F, WS_TOKRS); int* blkb = wsp<int>(F, WS_BLKB);
    const int gw = F.vcu * NWAVES + F.wave, NGW = F.G * NWAVES, fr = F.lane & 15, fq = F.lane >> 4;
    for (int t = gw; t < M / 16; t += NGW) { float ss; f32x4 o; thin_tile(x, 16 * t, F.lds, F.lane, ss, o);
        const float rs = 1.0f / sqrtf(ss * (1.0f / D) + EPS);
        f32x4 o2; o2[0] = __shfl_xor(o[0], 16); o2[1] = __shfl_xor(o[1], 16); o2[2] = __shfl_xor(o[2], 16); o2[3] = __shfl_xor(o[3], 16);
        if (fq == 0) { const int row = 16 * t + fr;
            const float lg[8] = {o[0] * rs, o[1] * rs, o[2] * rs, o[3] * rs, o2[0] * rs, o2[1] * rs, o2[2] * rs, o2[3] * rs};
            float v1 = lg[0]; int i1 = 0;
#pragma unroll
            for (int e = 1; e < 8; ++e) { if (lg[e] > v1) { v1 = lg[e]; i1 = e; } }
            float v2 = -3.0e38f; int i2 = 0;
#pragma unroll
            for (int e = 0; e < 8; ++e) { if (e != i1 && lg[e] > v2) { v2 = lg[e]; i2 = e; } }
            const float g1 = 1.0f / (1.0f + __expf(v2 - v1)), g2 = 1.0f - g1;
            const unsigned p1 = __hip_atomic_fetch_add(lcnt + i1, 1u, __ATOMIC_RELAXED, __HIP_MEMORY_SCOPE_WORKGROUP);
            const unsigned p2 = __hip_atomic_fetch_add(lcnt + i2, 1u, __ATOMIC_RELAXED, __HIP_MEMORY_SCOPE_WORKGROUP);
            tok_e[2 * row] = i1; tok_e[2 * row + 1] = i2; tok_p[2 * row] = (int)p1; tok_p[2 * row + 1] = (int)p2; tok_g[2 * row] = g1; tok_g[2 * row + 1] = g2; tok_rs[row] = rs; } }
    __syncthreads();
    if (F.tid < 8) { const unsigned b = __hip_atomic_fetch_add(gcnt + F.tid, lcnt[F.tid], __ATOMIC_RELAXED, __HIP_MEMORY_SCOPE_AGENT); blkb[F.vcu * 8 + F.tid] = (int)b; }
    __syncthreads();
}
template <bool F8> DI void gather_phase(Frame& F, const unsigned* gcnt) {
    LAS int* seg = (LAS int*)(F.lds); LAS int* cntl = seg + 16;
    if (F.tid == 0) { int t = 0; for (int e = 0; e < 8; ++e) { const int c = (int)gcnt[e]; seg[e] = t; cntl[e] = c; t += (c + 255) & ~255; } seg[8] = t; }
    __syncthreads();
    const int* tok_e = wsp<int>(F, WS_TOKE); const int* tok_p = wsp<int>(F, WS_TOKP); const float* tok_g = wsp<float>(F, WS_TOKG); const float* tok_rs = wsp<float>(F, WS_TOKRS); const int* blkb = wsp<int>(F, WS_BLKB);
    int* rtok = wsp<int>(F, WS_ROWT); float* rgate = wsp<float>(F, WS_ROWG); float* rrs = wsp<float>(F, WS_ROWRS);
    const bf16* xb = wsp<bf16>(F, WS_XB); bf16* XS = wsp<bf16>(F, WS_XS);
    const int gw = F.vcu * NWAVES + F.wave, NGW = F.G * NWAVES;
    for (int row = gw; row < M; row += NGW) { const int owner = ((row >> 4) % NGW) / NWAVES;
        const v4u* src = (const v4u*)(xb + (size_t)row * D); v4u a, b;
        if constexpr (F8) { a = src[2 * F.lane]; b = src[2 * F.lane + 1];
            int w0 = __builtin_amdgcn_cvt_pk_fp8_f32(pg8::c8(bflo(a.x)), pg8::c8(bfhi(a.x)), 0, false); w0 = __builtin_amdgcn_cvt_pk_fp8_f32(pg8::c8(bflo(a.y)), pg8::c8(bfhi(a.y)), w0, true); int w1 = __builtin_amdgcn_cvt_pk_fp8_f32(pg8::c8(bflo(a.z)), pg8::c8(bfhi(a.z)), 0, false); w1 = __builtin_amdgcn_cvt_pk_fp8_f32(pg8::c8(bflo(a.w)), pg8::c8(bfhi(a.w)), w1, true);
            int w2 = __builtin_amdgcn_cvt_pk_fp8_f32(pg8::c8(bflo(b.x)), pg8::c8(bfhi(b.x)), 0, false); w2 = __builtin_amdgcn_cvt_pk_fp8_f32(pg8::c8(bflo(b.y)), pg8::c8(bfhi(b.y)), w2, true); int w3 = __builtin_amdgcn_cvt_pk_fp8_f32(pg8::c8(bflo(b.z)), pg8::c8(bfhi(b.z)), 0, false); w3 = __builtin_amdgcn_cvt_pk_fp8_f32(pg8::c8(bflo(b.w)), pg8::c8(bfhi(b.w)), w3, true);
            a = (v4u){(unsigned)w0, (unsigned)w1, (unsigned)w2, (unsigned)w3}; b = a; }
        else { a = src[F.lane]; b = src[64 + F.lane]; }
#pragma unroll
        for (int slot = 0; slot < 2; ++slot) { const int e = tok_e[2 * row + slot]; const int r = seg[e] + blkb[owner * 8 + e] + tok_p[2 * row + slot];
            if constexpr (F8) { *((v4u*)((unsigned char*)XS + (size_t)r * D) + F.lane) = a; }
            else { v4u* dst = (v4u*)(XS + (size_t)r * D); dst[F.lane] = a; dst[64 + F.lane] = b; }
            if (F.lane == 0) { rtok[r] = 2 * row + slot; rgate[r] = tok_g[2 * row + slot]; rrs[r] = tok_rs[row]; } } }
    if (F.vcu == 0) { for (int e = 0; e < 8; ++e) for (int r = seg[e] + cntl[e] + F.tid; r < seg[e + 1]; r += NWAVES * 64) rtok[r] = -1; }
    __syncthreads();
}
DI void rowtable_phase(Frame& F, const unsigned* gcnt) {
    LAS int* seg = (LAS int*)(F.lds); LAS int* cntl = seg + 16;
    if (F.tid == 0) { int t = 0; for (int e = 0; e < 8; ++e) { const int c = (int)gcnt[e]; seg[e] = t; cntl[e] = c; t += (c + 255) & ~255; } seg[8] = t; }
    __syncthreads();
    const int* tok_e = wsp<int>(F, WS_TOKE); const int* tok_p = wsp<int>(F, WS_TOKP); const float* tok_g = wsp<float>(F, WS_TOKG); const float* tok_rs = wsp<float>(F, WS_TOKRS); const int* blkb = wsp<int>(F, WS_BLKB);
    int* rtok = wsp<int>(F, WS_ROWT); float* rgate = wsp<float>(F, WS_ROWG); float* rrs = wsp<float>(F, WS_ROWRS);
    const int NGW = F.G * NWAVES;
    for (int j = F.vcu * (NWAVES * 64) + F.tid; j < 2 * M; j += F.G * NWAVES * 64) { const int row = j >> 1, owner = ((row >> 4) % NGW) / NWAVES;
        const int e = tok_e[j]; const int r = seg[e] + blkb[owner * 8 + e] + tok_p[j];
        rtok[r] = j; rgate[r] = tok_g[j]; rrs[r] = tok_rs[row]; }
    if (F.vcu == 0) { for (int e = 0; e < 8; ++e) for (int r = seg[e] + cntl[e] + F.tid; r < seg[e + 1]; r += NWAVES * 64) rtok[r] = -1; }
    __syncthreads();
}
DI void combine_phase(Frame& F, bool fin, const float* fg, unsigned char* x8) {
    bf16* xb = wsp<bf16>(F, WS_XB); float* ssq = wsp<float>(F, WS_SSQ); const bf16* OS = wsp<bf16>(F, WS_OS);
    const int gw = F.vcu * NWAVES + F.wave, NGW = F.G * NWAVES;
    constexpr int RB = 2;
    for (int m0 = gw; m0 < M; m0 += RB * NGW) {
        v2u cx[RB][4], ca[RB][4], cb[RB][4];
#pragma unroll
        for (int i = 0; i < RB; ++i) { const int r_ = m0 + i * NGW, m = ((r_ & 2047) >> 8) * 4096 + (r_ & 255) + 256 * (r_ >> 11); if (r_ < M) {
                const v2u* xr = (const v2u*)(xb + (size_t)m * D) + F.lane; const v2u* o0 = (const v2u*)(OS + (size_t)m * D) + F.lane; const v2u* o1 = (const v2u*)(OS + ((size_t)M + m) * D) + F.lane;
#pragma unroll
                for (int j = 0; j < 4; ++j) { cx[i][j] = xr[64 * j]; ca[i][j] = o0[64 * j]; cb[i][j] = o1[64 * j]; } } }
#pragma unroll
        for (int i = 0; i < RB; ++i) { const int r_ = m0 + i * NGW, m = ((r_ & 2047) >> 8) * 4096 + (r_ & 255) + 256 * (r_ >> 11); if (r_ < M) {
        f32x4 v[4]; float s = 0.f;
#pragma unroll
        for (int j = 0; j < 4; ++j) { const v2u c = cx[i][j], a = ca[i][j], b = cb[i][j];
            v[j][0] = bflo(c.x) + (bflo(a.x) + bflo(b.x)); v[j][1] = bfhi(c.x) + (bfhi(a.x) + bfhi(b.x)); v[j][2] = bflo(c.y) + (bflo(a.y) + bflo(b.y)); v[j][3] = bfhi(c.y) + (bfhi(a.y) + bfhi(b.y));
            s += (v[j][0] * v[j][0] + v[j][1] * v[j][1]) + (v[j][2] * v[j][2] + v[j][3] * v[j][3]); }
        s = wave_sum(s);
        if (!fin) {
            v2u* o8 = (v2u*)(xb + (size_t)m * D) + F.lane;
#pragma unroll
            for (int j = 0; j < 4; ++j) { v2u w; w.x = pk2(v[j][0], v[j][1]); w.y = pk2(v[j][2], v[j][3]); o8[64 * j] = w; }
            if (x8) {
#pragma unroll
                for (int j = 0; j < 4; ++j) { int p = __builtin_amdgcn_cvt_pk_fp8_f32(pg8::c8(v[j][0]), pg8::c8(v[j][1]), 0, false); p = __builtin_amdgcn_cvt_pk_fp8_f32(pg8::c8(v[j][2]), pg8::c8(v[j][3]), p, true); *((unsigned*)(x8 + (size_t)m * D) + F.lane + 64 * j) = (unsigned)p; } }
            if (F.lane < 4) { f32x4 z = {0.f, 0.f, 0.f, 0.f}; if (F.lane == 0) z[0] = s; *((f32x4*)(ssq + (size_t)m * 16) + F.lane) = z; }
        } else {
            const float rs = 1.0f / sqrtf(s * (1.0f / D) + EPS); f32x4* ow = (f32x4*)(F.out + (size_t)m * D) + F.lane; const f32x4* g4 = (const f32x4*)fg + F.lane;
#pragma unroll
            for (int j = 0; j < 4; ++j) { const f32x4 g = g4[64 * j]; ow[64 * j] = v[j] * rs * g; }
        } } }
    }
}
DI void final_norm_phase(Frame& F, const bf16* x, const float* fg) {
    const int gw = F.vcu * NWAVES + F.wave, NGW = F.G * NWAVES;
    for (int m = gw; m < M; m += NGW) {
        const v2u* xr = (const v2u*)(x + (size_t)m * D) + F.lane; f32x4 v[4]; float s = 0.f;
#pragma unroll
        for (int j = 0; j < 4; ++j) { const v2u c = xr[64 * j]; v[j] = (f32x4){bflo(c.x), bfhi(c.x), bflo(c.y), bfhi(c.y)}; s += (v[j][0] * v[j][0] + v[j][1] * v[j][1]) + (v[j][2] * v[j][2] + v[j][3] * v[j][3]); }
        s = wave_sum(s);
        const float rs = 1.0f / sqrtf(s * (1.0f / D) + EPS); f32x4* ow = (f32x4*)(F.out + (size_t)m * D) + F.lane; const f32x4* g4 = (const f32x4*)fg + F.lane;
#pragma unroll
        for (int j = 0; j < 4; ++j) { const f32x4 g = g4[64 * j]; ow[64 * j] = v[j] * rs * g; }
    }
}


typedef __amdgpu_buffer_rsrc_t brsrc;
DI brsrc mk_rsrc(const void* p, unsigned bytes) { return __builtin_amdgcn_make_buffer_rsrc((void*)p, 0, bytes, 0x00020000); }
DI v4u bld128(brsrc r, unsigned voff, unsigned soff) { return __builtin_bit_cast(v4u, __builtin_amdgcn_raw_buffer_load_b128(r, voff, soff, 0)); }
DI v2u bld64(brsrc r, unsigned voff, unsigned soff) { return __builtin_bit_cast(v2u, __builtin_amdgcn_raw_buffer_load_b64(r, voff, soff, 0)); }
DI void bst64(brsrc r, unsigned voff, unsigned soff, v2u v) { __builtin_amdgcn_raw_buffer_store_b64(v, r, voff, soff, 0); }

template <bool Y8> DI void mix_phase(Frame& F, const float* ws_, const float* bs, const float* vg) {
    constexpr int WT_OFF = 0, WT_ST = 272, V_OFF = 34816, V_ST = 544, RS_OFF = 104448, BS_OFF = 105472, VG_OFF = 109568;
    const bf16* U = wsp<bf16>(F, WS_U); const bf16* V = wsp<bf16>(F, WS_V); bf16* Y = wsp<bf16>(F, WS_Y); const float* vssq = wsp<float>(F, WS_VSSQ);
    LAS unsigned char* lds = F.lds; LAS float* rsv = (LAS float*)(lds + RS_OFF); LAS float* bsl = (LAS float*)(lds + BS_OFF); LAS float* vgl = (LAS float*)(lds + VG_OFF);
    { const f32x4 b4 = (F.tid < 256) ? *(const f32x4*)(bs + 4 * F.tid) : (f32x4){0.f, 0.f, 0.f, 0.f}; const f32x4 g4 = *(const f32x4*)(vg + 4 * F.tid);
      if (F.tid < 256) *(LAS f32x4*)(bsl + 4 * F.tid) = b4; *(LAS f32x4*)(vgl + 4 * F.tid) = g4; }
    const int tid = F.tid, lane = F.lane, w = F.wave, fr = lane & 15, fq = lane >> 4;
    const int wfo = WT_OFF + fr * WT_ST + fq * 8;
    const int vfo = V_OFF + (4 * fq + (fr >> 2)) * V_ST + (32 * w + 4 * (fr & 3)) * 2;
    const brsrc rW = mk_rsrc(ws_, 8u * 128 * 128 * 4), rV = mk_rsrc(V, (unsigned)M * AW * 2), rU = mk_rsrc(U, (unsigned)M * AW * 2), rY = mk_rsrc(Y, (unsigned)M * AW * 2);
    const unsigned ulo8 = (unsigned)(fr * AW + 32 * w + 4 * fq);
    for (int c = F.vcu; c < 256; c += F.G) {
        const int tok0 = c * 128;
        if (tid < 128) { const f32x4* p = (const f32x4*)(vssq + (size_t)(tok0 + tid) * 32); float s = 0.f;
#pragma unroll
            for (int q = 0; q < 8; ++q) { const f32x4 a = p[q]; s += (a[0] + a[1]) + (a[2] + a[3]); }
            rsv[tid] = 1.0f / sqrtf(s * (1.0f / AW) + EPS); }
        f32x4 wreg[8]; v4u vreg[8];
        const unsigned wlo = (unsigned)((tid >> 5) * 512 + (tid & 31) * 16), vlo = (unsigned)((tid >> 5) * (AW * 2) + (tid & 31) * 16);
#define MIX_LOAD(gg) do { const unsigned ws_o = (unsigned)(gg) * 65536u, vs_o = (unsigned)tok0 * (AW * 2) + (unsigned)(gg) * 512u; \
            _Pragma("unroll") for (int it = 0; it < 8; ++it) { wreg[it] = __builtin_bit_cast(f32x4, bld128(rW, wlo, ws_o + (unsigned)(it * 16 * 512))); vreg[it] = bld128(rV, vlo, vs_o + (unsigned)(it * 16 * AW * 2)); } } while (0)
        MIX_LOAD(0);
        __syncthreads();
#pragma unroll 1
        for (int g = 0; g < 8; ++g) {
            const unsigned us_o = (unsigned)tok0 * (AW * 2) + (unsigned)g * 512u;
            const unsigned ulo = (unsigned)(fr * (AW * 2) + (32 * w + 4 * fq) * 2);
            v2u ureg[2][4][2];
#pragma unroll
            for (int hf = 0; hf < 2; ++hf)
#pragma unroll
                for (int m4 = 0; m4 < 4; ++m4)
#pragma unroll
                    for (int n2 = 0; n2 < 2; ++n2) ureg[hf][m4][n2] = bld64(rU, ulo, us_o + (unsigned)((16 * (4 * hf + m4)) * AW * 2 + 32 * n2));
#pragma unroll
            for (int it = 0; it < 8; ++it) { const int idx = it * 512 + tid, t = idx >> 5, s4 = (idx & 31) * 4; const f32x4 wv = wreg[it];
                const float a0 = (s4 + 0 <= t) ? wv[0] * rsv[s4 + 0] : 0.f, a1 = (s4 + 1 <= t) ? wv[1] * rsv[s4 + 1] : 0.f, a2 = (s4 + 2 <= t) ? wv[2] * rsv[s4 + 2] : 0.f, a3 = (s4 + 3 <= t) ? wv[3] * rsv[s4 + 3] : 0.f;
                v2u o; o.x = pk2(a0, a1); o.y = pk2(a2, a3); *(LAS v2u*)(lds + WT_OFF + t * WT_ST + s4 * 2) = o;
                *(LAS v4u*)(lds + V_OFF + (idx >> 5) * V_ST + (idx & 31) * 16) = vreg[it]; }
            __syncthreads();
            if (g + 1 < 8) MIX_LOAD(g + 1);
#pragma unroll
            for (int hf = 0; hf < 2; ++hf) {
                f32x4 acc[4][2];
#pragma unroll
                for (int m4 = 0; m4 < 4; ++m4) { acc[m4][0] = (f32x4){0.f, 0.f, 0.f, 0.f}; acc[m4][1] = (f32x4){0.f, 0.f, 0.f, 0.f}; }
#pragma unroll
                for (int ks = 0; ks < 4; ++ks) { if (32 * ks > 16 * (4 * hf + 3) + 15) continue;
                    const bf16x8 b0 = tr_frag(lds + vfo + (32 * ks) * V_ST, lds + vfo + (32 * ks + 16) * V_ST), b1 = tr_frag(lds + vfo + (32 * ks) * V_ST + 32, lds + vfo + (32 * ks + 16) * V_ST + 32);
#pragma unroll
                    for (int m4 = 0; m4 < 4; ++m4) { const int mt = 4 * hf + m4; if (32 * ks > 16 * mt + 15) continue;
                        const v2u lo = *(const LAS v2u*)(lds + wfo + mt * 16 * WT_ST + ks * 64), hi = *(const LAS v2u*)(lds + wfo + mt * 16 * WT_ST + ks * 64 + 32);
                        const v4u av = {lo.x, lo.y, hi.x, hi.y}; const bf16x8 a = __builtin_bit_cast(bf16x8, av);
                        acc[m4][0] = MFMA16(b0, a, acc[m4][0]); acc[m4][1] = MFMA16(b1, a, acc[m4][1]); }
                    __builtin_amdgcn_sched_barrier(0); }
#pragma unroll
                for (int m4 = 0; m4 < 4; ++m4) { const int t = 16 * (4 * hf + m4) + fr; const float bt = bsl[g * 128 + t];
#pragma unroll
                    for (int n2 = 0; n2 < 2; ++n2) { const int col = g * 256 + 32 * w + 16 * n2 + 4 * fq;
                        const v2u uu = ureg[hf][m4][n2]; const f32x4 gg = *(const LAS f32x4*)(vgl + col); const f32x4 a = acc[m4][n2];
                        v2u r; r.x = pk2(bflo(uu.x) * (a[0] * gg[0] + bt), bfhi(uu.x) * (a[1] * gg[1] + bt)); r.y = pk2(bflo(uu.y) * (a[2] * gg[2] + bt), bfhi(uu.y) * (a[3] * gg[3] + bt));
                        if constexpr (Y8) { int p8 = __builtin_amdgcn_cvt_pk_fp8_f32(pg8::c8(4.0f * bflo(uu.x) * (a[0] * gg[0] + bt)), pg8::c8(4.0f * bfhi(uu.x) * (a[1] * gg[1] + bt)), 0, false);
                            p8 = __builtin_amdgcn_cvt_pk_fp8_f32(pg8::c8(4.0f * bflo(uu.y) * (a[2] * gg[2] + bt)), pg8::c8(4.0f * bfhi(uu.y) * (a[3] * gg[3] + bt)), p8, true);
                            __builtin_amdgcn_raw_buffer_store_b32((unsigned)p8, rY, ulo8, (unsigned)tok0 * AW + (unsigned)g * 256u + (unsigned)((16 * (4 * hf + m4)) * AW + 16 * n2), 0); }
                        else bst64(rY, ulo, us_o + (unsigned)((16 * (4 * hf + m4)) * AW * 2 + 32 * n2), r); }
                    __builtin_amdgcn_sched_barrier(0); }
            }
            __syncthreads();
        }
#undef MIX_LOAD
    }
}

DI void gla_prep_phase(Frame& F, const float* wg2, const float* gb) {
    constexpr int GL_OFF = 0, SEG_OFF = 4096, OFFS_OFF = 6144, EBL_OFF = 8192, BC_OFF = 8704, KETL_OFF = 41472, VTL_OFF = 59904, TST = 144;
    const bf16* QKVR = wsp<bf16>(F, WS_QKVR); const float* glow = wsp<float>(F, WS_GLOW);
    bf16* QD = wsp<bf16>(F, WS_QD); bf16* KD = wsp<bf16>(F, WS_KD); bf16* KET = wsp<bf16>(F, WS_KET); bf16* VT = wsp<bf16>(F, WS_VT); float* DEC = wsp<float>(F, WS_DEC);
    LAS unsigned char* lds = F.lds;
    LAS float* gl = (LAS float*)(lds + GL_OFF); LAS float* segs = (LAS float*)(lds + SEG_OFF); LAS float* offs = (LAS float*)(lds + OFFS_OFF); LAS float* ebl = (LAS float*)(lds + EBL_OFF); LAS float* bcl = (LAS float*)(lds + BC_OFF);
    const int tid = F.tid;
    const int t2 = tid >> 3, kb = (tid & 7) * 16, dvb = (tid & 7) * 32, k = tid & 127, tq = tid >> 7;
    float wv[16]; float bias = 0.f; int hcur = -1;
    v4u q0, q1, k0, k1, vv[4]; f32x4 gv = {0.f, 0.f, 0.f, 0.f};
#define PREP_LOAD(uu) do { const int h_ = (uu) & 3, n_ = ((uu) >> 2) & 63, b_ = (uu) >> 8; const int t0_ = b_ * SEQ + n_ * 64; const bf16* rowp = QKVR + (size_t)(t0_ + t2) * 3072; \
        q0 = *(const v4u*)(rowp + h_ * 128 + kb); q1 = *(const v4u*)(rowp + h_ * 128 + kb + 8); k0 = *(const v4u*)(rowp + 512 + h_ * 128 + kb); k1 = *(const v4u*)(rowp + 512 + h_ * 128 + kb + 8); \
        _Pragma("unroll") for (int i = 0; i < 4; ++i) vv[i] = *(const v4u*)(rowp + 1024 + h_ * 256 + dvb + 8 * i); \
        if (tid < 256) gv = *((const f32x4*)(glow + (size_t)t0_ * 16) + tid); } while (0)
#define PREP_MAP(s) ((((s) & 255) >> 5) * 256 + ((s) & 31) + 32 * ((s) >> 8))
    if (F.vcu < 2048) PREP_LOAD(PREP_MAP(F.vcu));
    for (int sidx = F.vcu; sidx < 2048; sidx += F.G) { const int uidx = PREP_MAP(sidx);
        const int h = uidx & 3, n = (uidx >> 2) & 63, b = uidx >> 8; const int t0 = b * SEQ + n * 64; const int bhn = (b * 4 + h) * 64 + n;
        if (h != hcur) { hcur = h;
#pragma unroll
            for (int r = 0; r < 16; ++r) wv[r] = wg2[r * 512 + h * 128 + k];
            bias = gb[h * 128 + k]; }
        if (tid < 256) *((LAS f32x4*)gl + tid) = gv;
        __syncthreads();
        { float cum = 0.f;
#pragma unroll
          for (int i = 0; i < 16; ++i) { const LAS f32x4* gp = (const LAS f32x4*)(gl + (tq * 16 + i) * 16); float z = bias;
#pragma unroll
              for (int q = 0; q < 4; ++q) { const f32x4 g4 = gp[q]; z += g4[0] * wv[4 * q] + g4[1] * wv[4 * q + 1] + g4[2] * wv[4 * q + 2] + g4[3] * wv[4 * q + 3]; }
              cum += (fminf(z, 0.f) - __logf(1.0f + __expf(-fabsf(z)))) * (1.0f / 16.0f); bcl[(tq * 16 + i) * 128 + k] = cum; }
          segs[tq * 128 + k] = cum; }
        __syncthreads();
        if (tid < 128) { const float s0 = segs[tid], s1 = segs[128 + tid], s2 = segs[256 + tid], s3 = segs[384 + tid];
            offs[tid] = 0.f; offs[128 + tid] = s0; offs[256 + tid] = s0 + s1; offs[384 + tid] = (s0 + s1) + s2;
            const float eb = __expf(((s0 + s1) + s2) + s3); ebl[tid] = eb; DEC[(size_t)bhn * 128 + tid] = eb; }
        __syncthreads();
        { const int tq2 = t2 >> 4; unsigned qo[8], ko[8]; const unsigned qw[8] = {q0.x, q0.y, q0.z, q0.w, q1.x, q1.y, q1.z, q1.w}, kw[8] = {k0.x, k0.y, k0.z, k0.w, k1.x, k1.y, k1.z, k1.w};
          LAS unsigned short* kt = (LAS unsigned short*)(lds + KETL_OFF); const int rot = ((t2 * 2 + 16 * (tid & 7)) & 127) >> 1;
#pragma unroll
          for (int e = 0; e < 16; e += 2) { float qd2[2], kd2[2];
#pragma unroll
              for (int u = 0; u < 2; ++u) { const int kk = kb + e + u; const float bcum = bcl[t2 * 128 + kk] + offs[tq2 * 128 + kk];
                  const float e1 = __expf(bcum), e2 = __builtin_amdgcn_rcpf(e1);
                  const float qv = u ? bfhi(qw[e >> 1]) : bflo(qw[e >> 1]), kv = u ? bfhi(kw[e >> 1]) : bflo(kw[e >> 1]);
                  qd2[u] = qv * 0.08838834764831845f * e1; kd2[u] = kv * e2;
                  kt[kk * (TST / 2) + rot] = (unsigned short)f2bf(kv * e2 * ebl[kk]); }
              qo[e >> 1] = pk2(qd2[0], qd2[1]); ko[e >> 1] = pk2(kd2[0], kd2[1]); }
          bf16* qdp = QD + (size_t)(t0 + t2) * 512 + h * 128 + kb; bf16* kdp = KD + (size_t)(t0 + t2) * 512 + h * 128 + kb;
          { v4u a = {qo[0], qo[1], qo[2], qo[3]}, c = {qo[4], qo[5], qo[6], qo[7]}; *(v4u*)qdp = a; *(v4u*)(qdp + 8) = c; }
          { v4u a = {ko[0], ko[1], ko[2], ko[3]}, c = {ko[4], ko[5], ko[6], ko[7]}; *(v4u*)kdp = a; *(v4u*)(kdp + 8) = c; }
          LAS unsigned short* vt = (LAS unsigned short*)(lds + VTL_OFF);
#pragma unroll
          for (int i = 0; i < 4; ++i) { const unsigned w4[4] = {vv[i].x, vv[i].y, vv[i].z, vv[i].w};
#pragma unroll
              for (int e = 0; e < 4; ++e) { const int dv = dvb + 8 * i + 2 * e; vt[dv * (TST / 2) + rot] = (unsigned short)(w4[e] & 0xffffu); vt[(dv + 1) * (TST / 2) + rot] = (unsigned short)(w4[e] >> 16); } } }
        if (sidx + F.G < 2048) PREP_LOAD(PREP_MAP(sidx + F.G));
        __syncthreads();
#pragma unroll
        for (int i = 0; i < 2; ++i) { const int c = tid + 512 * i, r = c >> 3, ch = c & 7;
            *(v4u*)(KET + ((size_t)bhn * 128 + r) * 64 + ch * 8) = *(const LAS v4u*)(lds + KETL_OFF + r * TST + (((ch + (r >> 4)) & 7) * 16)); }
#pragma unroll
        for (int i = 0; i < 4; ++i) { const int c = tid + 512 * i, r = c >> 3, ch = c & 7;
            *(v4u*)(VT + ((size_t)bhn * 256 + r) * 64 + ch * 8) = *(const LAS v4u*)(lds + VTL_OFF + r * TST + (((ch + (r >> 5)) & 7) * 16)); }
        __syncthreads();
    }
#undef PREP_LOAD
#undef PREP_MAP
}

template <class A> DI void gla_scan_phase(Frame& F, const A& P) {
    constexpr int QD_OFF = 0, KD_OFF = 17408, KET_OFF = 34816, VT_OFF = 53248, ATT_OFF = 57856, ST_OFF = 67072, ST272 = 272, ST144 = 144;
    const bf16* QD = wsp<bf16>(F, WS_QD); const bf16* KD = wsp<bf16>(F, WS_KD); const bf16* KET = wsp<bf16>(F, WS_KET); const bf16* VT = wsp<bf16>(F, WS_VT); const float* DEC = wsp<float>(F, WS_DEC);
    bf16* GO = wsp<bf16>(F, WS_GO); float* ossq = wsp<float>(F, WS_OSSQ);
    LAS unsigned char* lds = F.lds;
    const int tid = F.tid, lane = F.lane, w = F.wave, fr = lane & 15, fq = lane >> 4;
    LAS unsigned char* SC = lds + 76800;
    P0State cst; p0_init(cst, F, P, N_EARLY, NMATS, F.vcu, F.G);
    f32x4 rC[8]; float gC[8]; P0Dst dC; dC.base = nullptr; dC.K = 0; dC.f8 = 0; bool hC = false;
    P0_NEXT(cst, rC, gC, dC, hC);
    for (int uidx = F.vcu; uidx < 256; uidx += F.G) {
        const int vb = uidx & 7, h = (uidx >> 3) & 3, b = uidx >> 5;
        for (int i = tid; i < (32 * ST272) / 4; i += NWAVES * 64) ((LAS unsigned*)(lds + ST_OFF))[i] = 0u;
        f32x4 st[2] = {(f32x4){0.f, 0.f, 0.f, 0.f}, (f32x4){0.f, 0.f, 0.f, 0.f}};
        v4u pq[2], pk[2], pe[2], pv; float pdec;
#define GLA_LOAD(nn) do { const int bhn_ = (b * 4 + h) * 64 + (nn); const size_t t0_ = (size_t)b * SEQ + (size_t)(nn) * 64; \
            _Pragma("unroll") for (int i_ = 0; i_ < 2; ++i_) { const int c_ = tid + 512 * i_; const int r_ = c_ >> 4, ch_ = c_ & 15; \
                pq[i_] = *(const v4u*)(QD + (t0_ + r_) * 512 + h * 128 + ch_ * 8); pk[i_] = *(const v4u*)(KD + (t0_ + r_) * 512 + h * 128 + ch_ * 8); \
                pe[i_] = *(const v4u*)(KET + (size_t)bhn_ * 8192 + (size_t)c_ * 8); } \
            if (tid < 256) pv = *(const v4u*)(VT + ((size_t)bhn_ * 256 + vb * 32) * 64 + (size_t)tid * 8); \
            pdec = DEC[(size_t)bhn_ * 128 + 16 * w + fr]; } while (0)
        GLA_LOAD(0);
        for (int n = 0; n < 64; ++n) {
#pragma unroll
            for (int i = 0; i < 2; ++i) { const int c = tid + 512 * i; const int r = c >> 4, ch = c & 15;
                *(LAS v4u*)(lds + QD_OFF + r * ST272 + ch * 16) = pq[i]; *(LAS v4u*)(lds + KD_OFF + r * ST272 + ch * 16) = pk[i];
                const int rk = c >> 3, ck = c & 7; *(LAS v4u*)(lds + KET_OFF + rk * ST144 + ck * 16) = pe[i]; }
            if (tid < 256) { const int rv = tid >> 3, cv = tid & 7; *(LAS v4u*)(lds + VT_OFF + rv * ST144 + cv * 16) = pv; }
            const float dec = pdec;
            __syncthreads();
            if (n + 1 < 64) GLA_LOAD(n + 1);
            const int mt = w & 3, nt = w >> 2;
            const size_t tok0 = (size_t)b * SEQ + (size_t)n * 64;
            f32x4 oacc = {0.f, 0.f, 0.f, 0.f};
#pragma unroll
            for (int ks = 0; ks < 4; ++ks) { const bf16x8 a = ldsfrag(lds + QD_OFF + (16 * mt + fr) * ST272 + (32 * ks + 8 * fq) * 2), bb = ldsfrag(lds + ST_OFF + (16 * nt + fr) * ST272 + (32 * ks + 8 * fq) * 2);
                oacc = MFMA16(bb, a, oacc); }
#pragma unroll
            for (int q = 0; q < 2; ++q) { const int stile = 2 * nt + q; f32x4 sacc = {0.f, 0.f, 0.f, 0.f};
                if (stile <= mt) {
#pragma unroll
                    for (int ks = 0; ks < 4; ++ks) { const bf16x8 a = ldsfrag(lds + QD_OFF + (16 * mt + fr) * ST272 + (32 * ks + 8 * fq) * 2), bb = ldsfrag(lds + KD_OFF + (16 * stile + fr) * ST272 + (32 * ks + 8 * fq) * 2);
                        sacc = MFMA16(bb, a, sacc); } }
                const int t = 16 * mt + fr, s0 = 16 * stile + 4 * fq;
                const float a0 = (s0 + 0 <= t) ? sacc[0] : 0.f, a1 = (s0 + 1 <= t) ? sacc[1] : 0.f, a2 = (s0 + 2 <= t) ? sacc[2] : 0.f, a3 = (s0 + 3 <= t) ? sacc[3] : 0.f;
                v2u o; o.x = pk2(a0, a1); o.y = pk2(a2, a3); *(LAS v2u*)(lds + ATT_OFF + t * ST144 + s0 * 2) = o; }
#pragma unroll
            for (int vt = 0; vt < 2; ++vt) { st[vt] = st[vt] * dec;
#pragma unroll
                for (int ks = 0; ks < 2; ++ks) { const bf16x8 a = ldsfrag(lds + VT_OFF + (16 * vt + fr) * ST144 + (32 * ks + 8 * fq) * 2), bb = ldsfrag(lds + KET_OFF + (16 * w + fr) * ST144 + (32 * ks + 8 * fq) * 2);
                    st[vt] = MFMA16(a, bb, st[vt]); } }
            const bool cw = hC; const P0Dst dW = dC;
            if (cw) { P0_WRITE(SC, rC, gC, dC); P0_NEXT(cst, rC, gC, dC, hC); }
            __syncthreads();
            if (cw) { P0_STORE(SC, dW); }
#pragma unroll
            for (int vt = 0; vt < 2; ++vt)
#pragma unroll
                for (int j = 0; j < 4; ++j) *(LAS unsigned short*)(lds + ST_OFF + (16 * vt + 4 * fq + j) * ST272 + (16 * w + fr) * 2) = (unsigned short)f2bf(st[vt][j]);
#pragma unroll
            for (int ks = 0; ks < 2; ++ks) { const bf16x8 a = ldsfrag(lds + ATT_OFF + (16 * mt + fr) * ST144 + (32 * ks + 8 * fq) * 2), bb = ldsfrag(lds + VT_OFF + (16 * nt + fr) * ST144 + (32 * ks + 8 * fq) * 2);
                oacc = MFMA16(bb, a, oacc); }
            { const size_t tok = tok0 + 16 * mt + fr; const int col = h * 256 + vb * 32 + 16 * nt + 4 * fq;
              v2u o; o.x = pk2(oacc[0], oacc[1]); o.y = pk2(oacc[2], oacc[3]); *(v2u*)(GO + tok * 1024 + col) = o;
              float sq = (oacc[0] * oacc[0] + oacc[1] * oacc[1]) + (oacc[2] * oacc[2] + oacc[3] * oacc[3]); sq += __shfl_xor(sq, 16); sq += __shfl_xor(sq, 32);
              if (fq == 0) ossq[(tok * 4 + h) * 16 + vb * 2 + nt] = sq; }
            __syncthreads();
        }
#undef GLA_LOAD
    }
    while (hC) { const P0Dst dW = dC; P0_WRITE(SC, rC, gC, dC); P0_NEXT(cst, rC, gC, dC, hC); __syncthreads(); P0_STORE(SC, dW); __syncthreads(); }
}
DI void gla_gate_phase(Frame& F, const float* og) {
    const bf16* GO = wsp<bf16>(F, WS_GO); const bf16* QKVR = wsp<bf16>(F, WS_QKVR); const float* ossq = wsp<float>(F, WS_OSSQ); bf16* GG = wsp<bf16>(F, WS_GG);
    const int gw = F.vcu * NWAVES + F.wave, NGW = F.G * NWAVES, lane = F.lane;
    const int c0 = 16 * lane, hh = lane >> 4;
    f32x4 g4[4];
#pragma unroll
    for (int q = 0; q < 4; ++q) g4[q] = *(const f32x4*)(og + (c0 & 255) + 4 * q);
    constexpr int RB = 4;
#define GATE_MAP(r) ((((r) & 2047) >> 8) * 4096 + ((r) & 255) + 256 * ((r) >> 11))
    for (int m0 = gw; m0 < M; m0 += RB * NGW) {
        f32x4 sv[RB][4]; v4u ov[RB][2], rv[RB][2];
#pragma unroll
        for (int i = 0; i < RB; ++i) { const int r_ = m0 + i * NGW, m = GATE_MAP(r_); if (r_ < M) { const f32x4* sp = (const f32x4*)(ossq + ((size_t)m * 4 + hh) * 16);
#pragma unroll
                for (int q = 0; q < 4; ++q) sv[i][q] = sp[q];
                const v4u* op = (const v4u*)(GO + (size_t)m * 1024 + c0); const v4u* rp = (const v4u*)(QKVR + (size_t)m * 3072 + 2048 + c0);
                ov[i][0] = op[0]; ov[i][1] = op[1]; rv[i][0] = rp[0]; rv[i][1] = rp[1]; } }
#pragma unroll
        for (int i = 0; i < RB; ++i) { const int r_ = m0 + i * NGW, m = GATE_MAP(r_); if (r_ < M) { float s = 0.f;
#pragma unroll
                for (int q = 0; q < 4; ++q) { const f32x4 a = sv[i][q]; s += (a[0] + a[1]) + (a[2] + a[3]); }
                const float rs = 1.0f / sqrtf(s * (1.0f / 256.0f) + EPS);
                v4u* dp = (v4u*)(GG + (size_t)m * 1024 + c0);
                if constexpr (BOUT_F8 != 0) { const float r8 = 8.0f * rs; unsigned w8[4];
#pragma unroll
                    for (int q = 0; q < 2; ++q) { const v4u o = ov[i][q], r = rv[i][q]; const f32x4 ga = g4[2 * q], gb = g4[2 * q + 1];
                        int a_ = __builtin_amdgcn_cvt_pk_fp8_f32(pg8::c8(bflo(o.x) * r8 * ga[0] * pg8::silu_f(bflo(r.x))), pg8::c8(bfhi(o.x) * r8 * ga[1] * pg8::silu_f(bfhi(r.x))), 0, false);
                        a_ = __builtin_amdgcn_cvt_pk_fp8_f32(pg8::c8(bflo(o.y) * r8 * ga[2] * pg8::silu_f(bflo(r.y))), pg8::c8(bfhi(o.y) * r8 * ga[3] * pg8::silu_f(bfhi(r.y))), a_, true);
                        int b_ = __builtin_amdgcn_cvt_pk_fp8_f32(pg8::c8(bflo(o.z) * r8 * gb[0] * pg8::silu_f(bflo(r.z))), pg8::c8(bfhi(o.z) * r8 * gb[1] * pg8::silu_f(bfhi(r.z))), 0, false);
                        b_ = __builtin_amdgcn_cvt_pk_fp8_f32(pg8::c8(bflo(o.w) * r8 * gb[2] * pg8::silu_f(bflo(r.w))), pg8::c8(bfhi(o.w) * r8 * gb[3] * pg8::silu_f(bfhi(r.w))), b_, true);
                        w8[2 * q] = (unsigned)a_; w8[2 * q + 1] = (unsigned)b_; }
                    *(v4u*)((unsigned char*)GG + (size_t)m * 1024 + c0) = (v4u){w8[0], w8[1], w8[2], w8[3]}; }
                else
#pragma unroll
                for (int q = 0; q < 2; ++q) { const v4u o = ov[i][q], r = rv[i][q]; v4u d; const f32x4 ga = g4[2 * q], gb = g4[2 * q + 1];
                    d.x = pk2(bflo(o.x) * rs * ga[0] * pg8::silu_f(bflo(r.x)), bfhi(o.x) * rs * ga[1] * pg8::silu_f(bfhi(r.x)));
                    d.y = pk2(bflo(o.y) * rs * ga[2] * pg8::silu_f(bflo(r.y)), bfhi(o.y) * rs * ga[3] * pg8::silu_f(bfhi(r.y)));
                    d.z = pk2(bflo(o.z) * rs * gb[0] * pg8::silu_f(bflo(r.z)), bfhi(o.z) * rs * gb[1] * pg8::silu_f(bfhi(r.z)));
                    d.w = pk2(bflo(o.w) * rs * gb[2] * pg8::silu_f(bflo(r.w)), bfhi(o.w) * rs * gb[3] * pg8::silu_f(bfhi(r.w)));
                    dp[q] = d; } } }
    }
}
#undef GATE_MAP

DI void fox_attn_phase(Frame& F, const unsigned* knb) {
    constexpr int KST = 272, VST = 288, STAGE = 64 * KST + 64 * VST, V_OFF = 64 * KST, C_OFF = 2 * STAGE, WS_OFF = C_OFF + 16384;
    const bf16* QKV = wsp<bf16>(F, WS_QKVR); const float* logf = wsp<float>(F, WS_LOGF); bf16* AO = wsp<bf16>(F, WS_AO);
    LAS unsigned char* lds = F.lds; LAS float* cl = (LAS float*)(lds + C_OFF); LAS float* wsum = (LAS float*)(lds + WS_OFF); LAS unsigned* dflag = (LAS unsigned*)(lds + WS_OFF + 64);
    const int tid = F.tid, lane = F.lane, w = F.wave, fr = lane & 15, fq = lane >> 4;
    constexpr float SC2 = 0.08838834764831845f * 1.4426950408889634f, L2E = 1.4426950408889634f, THR = 8.0f;
    const int kfo = fr * KST + fq * 16;
    const int vfo = (4 * fq + (fr >> 2)) * VST + (fr & 3) * 8;
    int cur_bh = -1;
    for (int U = F.vcu; U < 1024; U += F.G) {
        const int r_ = U >> 8, v_ = U & 255, bh = v_ >> 2, i_ = v_ & 3; const int b = bh >> 3, h = bh & 7;
        const int qt = (r_ == 0) ? i_ : (r_ == 1) ? 7 - i_ : (r_ == 2) ? 8 + i_ : 15 - i_;
        if (bh != cur_bh) { cur_bh = bh;
          __syncthreads();
          float v8[8]; float tot = 0.f; const int p0 = tid * 8;
          { const float* lp = logf + ((size_t)b * SEQ + p0) * 8 + h;
#pragma unroll
              for (int e = 0; e < 8; ++e) v8[e] = lp[8 * e]; }
#pragma unroll
          for (int e = 0; e < 8; ++e) { tot += v8[e]; v8[e] = tot; }
          float inc = tot;
#pragma unroll
          for (int o = 1; o < 64; o <<= 1) { const float t = __shfl_up(inc, o); if (lane >= o) inc += t; }
          if (lane == 63) wsum[w] = inc;
          __syncthreads();
          float woff = 0.f;
#pragma unroll
          for (int q = 0; q < 8; ++q) woff += (q < w) ? wsum[q] : 0.f;
          const float excl = woff + inc - tot;
#pragma unroll
          for (int e = 0; e < 8; ++e) cl[p0 + e] = -L2E * (excl + v8[e]);
        }
        const int q0 = qt * 256 + 32 * w;
        bf16x8 qf[2][4]; float mrow[2], lrow[2]; f32x4 oacc[2][8];
#pragma unroll
        for (int mt = 0; mt < 2; ++mt) { const size_t tok = (size_t)b * SEQ + q0 + 16 * mt + fr;
#pragma unroll
            for (int ks = 0; ks < 4; ++ks) qf[mt][ks] = *(const bf16x8*)(QKV + tok * 3072 + h * 128 + 32 * ks + 8 * fq);
            mrow[mt] = -1.0e30f; lrow[mt] = 0.f;
#pragma unroll
            for (int dt = 0; dt < 8; ++dt) oacc[mt][dt] = (f32x4){0.f, 0.f, 0.f, 0.f}; }
        const int ntiles = 4 * (qt + 1);
        float qk_bound;
        { float q2 = 0.f;
#pragma unroll
          for (int mt = 0; mt < 2; ++mt) { float s = 0.f;
#pragma unroll
              for (int ks = 0; ks < 4; ++ks) { const v4u qq = __builtin_bit_cast(v4u, qf[mt][ks]);
                  s += (bflo(qq.x) * bflo(qq.x) + bfhi(qq.x) * bfhi(qq.x)) + (bflo(qq.y) * bflo(qq.y) + bfhi(qq.y) * bfhi(qq.y)) + (bflo(qq.z) * bflo(qq.z) + bfhi(qq.z) * bfhi(qq.z)) + (bflo(qq.w) * bflo(qq.w) + bfhi(qq.w) * bfhi(qq.w)); }
              s += __shfl_xor(s, 16); s += __shfl_xor(s, 32); q2 = fmaxf(q2, s); }
#pragma unroll
          for (int o = 1; o < 16; o <<= 1) q2 = fmaxf(q2, __shfl_xor(q2, o));
          const unsigned* kp = knb + (b * 8 + h) * 4; const float k2 = (__builtin_bit_cast(float, kp[0]) + __builtin_bit_cast(float, kp[1])) + (__builtin_bit_cast(float, kp[2]) + __builtin_bit_cast(float, kp[3]));
          qk_bound = sqrtf(q2 * k2) * (SC2 * 1.02f); }
        bool wdone = false;
        if (tid < 8) dflag[tid] = 0u;
        v4u pk_[2], pv_[2];
#define FOX_LOAD(jj) do { _Pragma("unroll") for (int i2 = 0; i2 < 2; ++i2) { const int c2 = tid + 512 * i2; const bf16* rp = QKV + ((size_t)b * SEQ + 64 * (jj) + (c2 >> 4)) * 3072 + h * 128 + (c2 & 15) * 8; \
            pk_[i2] = *(const v4u*)(rp + 1024); pv_[i2] = *(const v4u*)(rp + 2048); } } while (0)
#define FOX_STORE(st) do { _Pragma("unroll") for (int i2 = 0; i2 < 2; ++i2) { const int c2 = tid + 512 * i2; \
            *(LAS v4u*)(lds + (st) * STAGE + (c2 >> 4) * KST + (c2 & 15) * 16) = pk_[i2]; *(LAS v4u*)(lds + (st) * STAGE + V_OFF + (c2 >> 4) * VST + (c2 & 15) * 16) = pv_[i2]; } } while (0)
        FOX_LOAD(ntiles - 1);
        FOX_STORE(0);
        __syncthreads();
        for (int it = 0; it < ntiles; ++it) {
            const int j = ntiles - 1 - it, cur = it & 1; const int key0 = 64 * j;
            if (it + 1 < ntiles) FOX_LOAD(j - 1);
            if (!wdone && key0 <= q0 + 31) {
                LAS const unsigned char* kb = lds + cur * STAGE + kfo; LAS const unsigned char* vb = lds + cur * STAGE + V_OFF + vfo;
                f32x4 sacc[4][2];
#pragma unroll
                for (int nt = 0; nt < 4; ++nt) { sacc[nt][0] = (f32x4){0.f, 0.f, 0.f, 0.f}; sacc[nt][1] = (f32x4){0.f, 0.f, 0.f, 0.f}; }
                { bf16x8 ka[2][4];
#pragma unroll
                  for (int nt = 0; nt < 4; ++nt) ka[0][nt] = ldsfrag(kb + nt * 16 * KST);
#pragma unroll
                  for (int ks = 0; ks < 4; ++ks) {
                    if (ks + 1 < 4) {
#pragma unroll
                        for (int nt = 0; nt < 4; ++nt) ka[(ks + 1) & 1][nt] = ldsfrag(kb + nt * 16 * KST + (ks + 1) * 64); }
#pragma unroll
                    for (int nt = 0; nt < 4; ++nt) { sacc[nt][0] = MFMA16(ka[ks & 1][nt], qf[0][ks], sacc[nt][0]); sacc[nt][1] = MFMA16(ka[ks & 1][nt], qf[1][ks], sacc[nt][1]); } } }
                float mx0 = -__builtin_inff(), mx1 = -__builtin_inff();
#pragma unroll
                for (int nt = 0; nt < 4; ++nt) { const f32x4 ck = *(const LAS f32x4*)(cl + key0 + 16 * nt + 4 * fq);
                    sacc[nt][0] = sacc[nt][0] * SC2 + ck; sacc[nt][1] = sacc[nt][1] * SC2 + ck; }
                if (key0 + 63 > q0) {
#pragma unroll
                    for (int nt = 0; nt < 4; ++nt)
#pragma unroll
                        for (int e = 0; e < 4; ++e) { const int key = key0 + 16 * nt + 4 * fq + e;
                            if (key > q0 + fr) sacc[nt][0][e] = -__builtin_inff();
                            if (key > q0 + 16 + fr) sacc[nt][1][e] = -__builtin_inff(); } }
#pragma unroll
                for (int nt = 0; nt < 4; ++nt) { mx0 = fmaxf(mx0, fmaxf(fmaxf(sacc[nt][0][0], sacc[nt][0][1]), fmaxf(sacc[nt][0][2], sacc[nt][0][3])));
                    mx1 = fmaxf(mx1, fmaxf(fmaxf(sacc[nt][1][0], sacc[nt][1][1]), fmaxf(sacc[nt][1][2], sacc[nt][1][3]))); }
                mx0 = fmaxf(mx0, __shfl_xor(mx0, 16)); mx0 = fmaxf(mx0, __shfl_xor(mx0, 32)); mx1 = fmaxf(mx1, __shfl_xor(mx1, 16)); mx1 = fmaxf(mx1, __shfl_xor(mx1, 32));
                if (__any((mx0 > mrow[0] + THR) || (mx1 > mrow[1] + THR))) {
                    const float n0 = fmaxf(mrow[0], mx0), n1 = fmaxf(mrow[1], mx1);
                    const float a0 = __builtin_amdgcn_exp2f(mrow[0] - n0), a1 = __builtin_amdgcn_exp2f(mrow[1] - n1);
                    mrow[0] = n0; mrow[1] = n1; lrow[0] *= a0; lrow[1] *= a1;
#pragma unroll
                    for (int dt = 0; dt < 8; ++dt) { oacc[0][dt] = oacc[0][dt] * a0; oacc[1][dt] = oacc[1][dt] * a1; } }
                bf16x8 pf[2][2];
#pragma unroll
                for (int mt = 0; mt < 2; ++mt) { const float mm = mrow[mt]; float ls = 0.f; unsigned pw[8];
#pragma unroll
                    for (int nt = 0; nt < 4; ++nt) { const f32x4 t = sacc[nt][mt] - mm;
                        const float p0 = __builtin_amdgcn_exp2f(t[0]), p1 = __builtin_amdgcn_exp2f(t[1]), p2 = __builtin_amdgcn_exp2f(t[2]), p3 = __builtin_amdgcn_exp2f(t[3]);
                        ls += (p0 + p1) + (p2 + p3); pw[2 * nt] = pg8::cvt_pk_bf16(p0, p1); pw[2 * nt + 1] = pg8::cvt_pk_bf16(p2, p3); }
                    lrow[mt] += ls;
                    { v4u t0 = {pw[0], pw[1], pw[2], pw[3]}, t1 = {pw[4], pw[5], pw[6], pw[7]}; pf[mt][0] = __builtin_bit_cast(bf16x8, t0); pf[mt][1] = __builtin_bit_cast(bf16x8, t1); } }
                { bf16x8 va[2][4];
#pragma unroll
                  for (int i = 0; i < 4; ++i) va[0][i] = tr_frag(vb + i * 32, vb + 16 * VST + i * 32);
#pragma unroll
                  for (int g = 0; g < 4; ++g) { const int ks2 = g >> 1, d0 = (g & 1) * 4;
                    if (g + 1 < 4) { const int ks2n = (g + 1) >> 1, d0n = ((g + 1) & 1) * 4;
#pragma unroll
                        for (int i = 0; i < 4; ++i) va[(g + 1) & 1][i] = tr_frag(vb + (32 * ks2n) * VST + (d0n + i) * 32, vb + (32 * ks2n + 16) * VST + (d0n + i) * 32); }
#pragma unroll
                    for (int i = 0; i < 4; ++i) { oacc[0][d0 + i] = MFMA16(va[g & 1][i], pf[0][ks2], oacc[0][d0 + i]); oacc[1][d0 + i] = MFMA16(va[g & 1][i], pf[1][ks2], oacc[1][d0 + i]); } } }
            }
            if (!wdone && j > 0) {
                const float mmin = fminf(mrow[0], mrow[1]); float mm = mmin; mm = fminf(mm, __shfl_xor(mm, 1)); mm = fminf(mm, __shfl_xor(mm, 2)); mm = fminf(mm, __shfl_xor(mm, 4)); mm = fminf(mm, __shfl_xor(mm, 8));
                if (key0 - 1 <= q0 + 31 && __all(qk_bound + cl[key0 - 1] - mm < -40.0f)) { wdone = true; if (lane == 0) dflag[w] = 1u; } }
            if (it + 1 < ntiles) FOX_STORE(cur ^ 1);
            __syncthreads();
            { unsigned alld = 1u;
#pragma unroll
              for (int q = 0; q < 8; ++q) alld &= dflag[q];
              if (alld) break; }
        }
        __syncthreads();
#undef FOX_LOAD
#undef FOX_STORE
#pragma unroll
        for (int mt = 0; mt < 2; ++mt) { float l = lrow[mt]; l += __shfl_xor(l, 16); l += __shfl_xor(l, 32); const float inv = 1.0f / l;
            const size_t tok = (size_t)b * SEQ + q0 + 16 * mt + fr;
#pragma unroll
            for (int dt = 0; dt < 8; ++dt) {
                if constexpr (COUT_F8 != 0) { const f32x4 o = oacc[mt][dt] * (8.0f * inv);
                    int q_ = __builtin_amdgcn_cvt_pk_fp8_f32(pg8::c8(o[0]), pg8::c8(o[1]), 0, false); q_ = __builtin_amdgcn_cvt_pk_fp8_f32(pg8::c8(o[2]), pg8::c8(o[3]), q_, true);
                    *(unsigned*)((unsigned char*)AO + tok * 1024 + h * 128 + 16 * dt + 4 * fq) = (unsigned)q_; }
                else { const f32x4 o = oacc[mt][dt] * inv; v2u r; r.x = pg8::cvt_pk_bf16(o[0], o[1]); r.y = pg8::cvt_pk_bf16(o[2], o[3]); *(v2u*)(AO + tok * 1024 + h * 128 + 16 * dt + 4 * fq) = r; } } }
    }
}

constexpr int N_PHASES = 2 + 10 * MK_LAYERS;
__host__ __device__ constexpr bool phase_active(int id) {
    if (id == 0) return true;
    if (id == 1 + 10 * MK_LAYERS) return (MK_LAYERS % 2) == 1;
    const int l = (id - 1) / 10, s = (id - 1) % 10, mixer = l % 3; const bool moe = (l % 2) == 1;
    if (s == 0 || s == 1 || s == 4) return true;
    if (s == 2 || s == 3) return mixer == 1;
    if (s == 5 || s == 6) return true;
    return moe;
}
struct Args { const float* in[22]; float* out; unsigned char* ws; int ph_lo, ph_hi; };
#define IN(k) (lo <= (k) && (k) < hi)
#ifndef PROBE_MASK
#define PROBE_MASK 0
#endif
#define REPS(bit) _Pragma("unroll 1") for (int r_ = 0; r_ < ((PROBE_MASK & (bit)) ? 2 : 1); ++r_)
#define TWICE(bit, ...) do { if constexpr ((PROBE_MASK & (bit)) != 0) { __VA_ARGS__ xcd_barrier(bar); } __VA_ARGS__ } while (0)
#define SEAM(k) do { if ((k) + 1 < hi) xcd_barrier(bar); } while (0)
#define SEAML(k) do { if ((k) + 1 < hi) { if (F.MISC[10]) xcd_barrier_local(bar); else xcd_barrier(bar); } } while (0)
template <int L> DI void run_layer(Frame& F, const Args& args, const XcdBarrier& bar, const int lo, const int hi) {
    constexpr int l = L, mixer = L % 3, jm = L / 3, fi = L / 2, pb = 1 + 10 * L; constexpr bool moe = (L & 1) != 0;
    bf16* XB = wsp<bf16>(F, WS_XB); float* SSQ = wsp<float>(F, WS_SSQ);
    if (IN(pb + 0)) {
        if constexpr (mixer == 0) {
            if constexpr (l == 3 && AIN_F8 != 0) {
                pg8::Gemm g{(const bf16*)wsp<unsigned char>(F, WS_X8), wsp<bf16>(F, WS_WA_IN) + (size_t)jm * 4096 * 1024, M, 4096, D / 2}; pg8::StaticOrder S; S.init(M, 4096, F.G, (int)blockIdx.x);
                pg8::EpiAin E{SSQ, wsp<bf16>(F, WS_U), wsp<bf16>(F, WS_V), wsp<float>(F, WS_VSSQ), 1.0f / 64.0f};
                pg8::gemm_phase<pg8::EpiAin, pg8::StaticOrder, true, true, true>(F.lds + RING_OFF, g, S, E);
            } else {
                pg8::Gemm g{XB, wsp<bf16>(F, WS_WA_IN) + (size_t)jm * 4096 * 1024, M, 4096, D}; pg8::StaticOrder S; S.init(M, 4096, F.G, (int)blockIdx.x);
                pg8::EpiAin E{SSQ, wsp<bf16>(F, WS_U), wsp<bf16>(F, WS_V), wsp<float>(F, WS_VSSQ), 1.0f};
                pg8::gemm_phase<pg8::EpiAin, pg8::StaticOrder, true, true>(F.lds + RING_OFF, g, S, E);
            }
        } else {
            REPS(128) { if constexpr (mixer == 1) glow_phase(F, XB, args.in[1] + l * 1024, args.in[8]); else logf_phase(F, XB, args.in[1] + l * 1024, args.in[13], args.in[14]); }
            if constexpr (mixer == 2 && CIN_F8 != 0) {
                pg8::Gemm g{(const bf16*)wsp<unsigned char>(F, WS_X8), wsp<bf16>(F, WS_WC_IN), M, 3072, D / 2}; pg8::StaticOrder S; S.init(M, 3072, F.G, (int)blockIdx.x);
                pg8::EpiRow<true> E{SSQ, wsp<bf16>(F, WS_QKVR), 3072, (unsigned*)(F.ctl + CW_KNB), 1.0f / 64.0f};
                pg8::gemm_phase<pg8::EpiRow<true>, pg8::StaticOrder, true, true, true>(F.lds + RING_OFF, g, S, E);
            } else {
                pg8::Gemm g{XB, mixer == 1 ? wsp<bf16>(F, WS_WB_IN) : wsp<bf16>(F, WS_WC_IN), M, 3072, D}; pg8::StaticOrder S; S.init(M, 3072, F.G, (int)blockIdx.x);
                pg8::EpiRow<mixer == 2> E{SSQ, wsp<bf16>(F, WS_QKVR), 3072, (unsigned*)(F.ctl + CW_KNB), 1.0f};
                pg8::gemm_phase<pg8::EpiRow<mixer == 2>, pg8::StaticOrder, true, true>(F.lds + RING_OFF, g, S, E);
            }
        }
        SEAML(pb + 0);
    }
    if (IN(pb + 1)) { REPS(mixer == 0 ? 2 : mixer == 1 ? 4 : 32) {
        if constexpr (mixer == 0) mix_phase<(((AOUT_F8 >> jm) & 1) != 0)>(F, args.in[5] + (size_t)jm * 8 * 128 * 128, args.in[6] + (size_t)jm * 8 * 128, args.in[4] + (size_t)jm * AW);
        else if constexpr (mixer == 1) gla_prep_phase(F, args.in[9], args.in[10]);
        else fox_attn_phase(F, (const unsigned*)(F.ctl + CW_KNB));
        SEAML(pb + 1); } }
    if constexpr (mixer == 1) {
        if (IN(pb + 2)) { REPS(8) { gla_scan_phase(F, args); SEAML(pb + 2); } }
        if (IN(pb + 3)) { REPS(16) { gla_gate_phase(F, args.in[11]); SEAML(pb + 3); } }
    }
    if (IN(pb + 4)) {
        const bf16* A = mixer == 0 ? wsp<bf16>(F, WS_Y) : mixer == 1 ? wsp<bf16>(F, WS_GG) : wsp<bf16>(F, WS_AO);
        const bf16* Bt = mixer == 0 ? wsp<bf16>(F, WS_WA_OUT) + (size_t)jm * 1024 * 2048 : mixer == 1 ? wsp<bf16>(F, WS_WB_OUT) : wsp<bf16>(F, WS_WC_OUT);
        constexpr bool w8 = moe ? (MOE_F8 != 0) : ((DENSE_F8 >> fi) & 1) != 0;
        if constexpr ((mixer == 2 && COUT_F8 != 0) || (mixer == 1 && BOUT_F8 != 0)) {
            pg8::Gemm g{A, Bt, M, D, 512}; pg8::StaticOrder S; S.init(M, D, F.G, (int)blockIdx.x);
            pg8::EpiResid<false, w8> E{(const void*)XB, XB, SSQ, wsp<unsigned char>(F, WS_X8), 1.0f / 512.0f};
            pg8::gemm_phase<pg8::EpiResid<false, w8>, pg8::StaticOrder, true, true, true>(F.lds + RING_OFF, g, S, E);
        } else if constexpr (mixer == 0 && ((AOUT_F8 >> jm) & 1) != 0) {
            pg8::Gemm g{A, Bt, M, D, 1024}; pg8::StaticOrder S; S.init(M, D, F.G, (int)blockIdx.x);
            pg8::EpiResid<l == 0, w8> E{l == 0 ? (const void*)args.in[0] : (const void*)XB, XB, SSQ, wsp<unsigned char>(F, WS_X8), 1.0f / 256.0f};
            pg8::gemm_phase<pg8::EpiResid<l == 0, w8>, pg8::StaticOrder, true, true, true>(F.lds + RING_OFF, g, S, E);
        } else {
            pg8::Gemm g{A, Bt, M, D, mixer == 0 ? 2048 : 1024}; pg8::StaticOrder S; S.init(M, D, F.G, (int)blockIdx.x);
            pg8::EpiResid<l == 0, w8> E{l == 0 ? (const void*)args.in[0] : (const void*)XB, XB, SSQ, wsp<unsigned char>(F, WS_X8), 1.0f};
            pg8::gemm_phase<pg8::EpiResid<l == 0, w8>, pg8::StaticOrder, true, true>(F.lds + RING_OFF, g, S, E);
        }
        SEAML(pb + 4);
    }
    if constexpr (!moe) {
        constexpr bool f8 = ((DENSE_F8 >> fi) & 1) != 0;
        if (IN(pb + 5)) {
            if constexpr (f8) {
                pg8::Gemm g{(const bf16*)wsp<unsigned char>(F, WS_X8), (const bf16*)(wsp<unsigned char>(F, WS_WF_IN) + (size_t)fi * 2 * 7168 * 1024), M, 7168, D / 2}; pg8::StaticOrder S; S.init(M, 7168, F.G, (int)blockIdx.x);
                pg8::EpiSwiGLU8<0> E{SSQ, wsp<unsigned char>(F, WS_HF)};
                pg8::gemm_phase<pg8::EpiSwiGLU8<0>, pg8::StaticOrder, true, true, true>(F.lds + RING_OFF, g, S, E);
            } else {
                pg8::Gemm g{XB, wsp<bf16>(F, WS_WF_IN) + (size_t)fi * 7168 * 1024, M, 7168, D}; pg8::StaticOrder S; S.init(M, 7168, F.G, (int)blockIdx.x);
                pg8::EpiSwiGLU<0> E{SSQ, wsp<bf16>(F, WS_HF)};
                pg8::gemm_phase<pg8::EpiSwiGLU<0>, pg8::StaticOrder, true, true>(F.lds + RING_OFF, g, S, E);
            }
            SEAML(pb + 5);
        }
        if (IN(pb + 6)) {
            if constexpr (f8) {
                pg8::Gemm g{(const bf16*)wsp<unsigned char>(F, WS_HF), (const bf16*)(wsp<unsigned char>(F, WS_WF_OUT) + (size_t)fi * 2 * 1024 * 3584), M, D, FF / 2}; pg8::StaticOrder S; S.init(M, D, F.G, (int)blockIdx.x, 1);
                constexpr bool w8n = (l == 2 && AIN_F8 != 0);
                pg8::EpiResid<false, w8n> E{(const void*)XB, XB, SSQ, wsp<unsigned char>(F, WS_X8), 1.0f / 512.0f};
                pg8::gemm_phase<pg8::EpiResid<false, w8n>, pg8::StaticOrder, true, true, true>(F.lds + RING_OFF, g, S, E);
            } else {
                pg8::Gemm g{wsp<bf16>(F, WS_HF), wsp<bf16>(F, WS_WF_OUT) + (size_t)fi * 1024 * 3584, M, D, FF}; pg8::StaticOrder S; S.init(M, D, F.G, (int)blockIdx.x, 1);
                pg8::EpiResid<false> E{(const void*)XB, XB, SSQ, nullptr, 1.0f};
                pg8::gemm_phase<pg8::EpiResid<false>, pg8::StaticOrder, true, true>(F.lds + RING_OFF, g, S, E);
            }
            SEAML(pb + 6);
        }
    } else {
        unsigned* gcnt = (unsigned*)(F.ctl + CW_CNT + 64 * l);
        if (IN(pb + 5)) { router_phase(F, XB, args.in[2] + l * 1024, args.in[18] + (size_t)fi * 1024 * 8, gcnt); SEAM(pb + 5); }
        if (IN(pb + 6)) { REPS(64) { if constexpr (MOE_F8 != 0) rowtable_phase(F, gcnt); else gather_phase<false>(F, gcnt); SEAM(pb + 6); } }
        if (IN(pb + 7)) {
            if constexpr (MOE_F8 != 0) {
                pg8::Gemm g{(const bf16*)wsp<unsigned char>(F, WS_X8), (const bf16*)(wsp<unsigned char>(F, WS_WM_IN) + (size_t)fi * 8 * 7168 * 1024), MROWS, 7168, D / 2, wsp<int>(F, WS_ROWT)}; pg8::GroupedOrder S; S.init(gcnt, 28, F.G, (int)blockIdx.x);
                pg8::EpiSwiGLU8<1> E{wsp<float>(F, WS_ROWRS), wsp<unsigned char>(F, WS_HM)};
                TWICE(256, pg8::gemm_phase<pg8::EpiSwiGLU8<1>, pg8::GroupedOrder, true, true, true, true>(F.lds + RING_OFF, g, S, E););
            } else {
                pg8::Gemm g{wsp<bf16>(F, WS_XS), wsp<bf16>(F, WS_WM_IN) + (size_t)fi * 8 * 7168 * 1024, MROWS, 7168, D}; pg8::GroupedOrder S; S.init(gcnt, 28, F.G, (int)blockIdx.x);
                pg8::EpiSwiGLU<1> E{wsp<float>(F, WS_ROWRS), wsp<bf16>(F, WS_HM)};
                pg8::gemm_phase<pg8::EpiSwiGLU<1>, pg8::GroupedOrder, true, true>(F.lds + RING_OFF, g, S, E);
            }
            SEAM(pb + 7);
        }
        if (IN(pb + 8)) {
            if constexpr (MOE_F8 != 0) {
                pg8::Gemm g{(const bf16*)wsp<unsigned char>(F, WS_HM), (const bf16*)(wsp<unsigned char>(F, WS_WM_OUT) + (size_t)fi * 8 * 1024 * 3584), MROWS, D, FF / 2}; pg8::GroupedOrder S; S.init(gcnt, 4, F.G, (int)blockIdx.x, 1);
                pg8::EpiMoeOut E{wsp<int>(F, WS_ROWT), wsp<float>(F, WS_ROWG), wsp<bf16>(F, WS_OS), M, 1.0f / 512.0f};
                pg8::gemm_phase<pg8::EpiMoeOut, pg8::GroupedOrder, true, true, true>(F.lds + RING_OFF, g, S, E);
            } else {
                pg8::Gemm g{wsp<bf16>(F, WS_HM), wsp<bf16>(F, WS_WM_OUT) + (size_t)fi * 8 * 1024 * 3584, MROWS, D, FF}; pg8::GroupedOrder S; S.init(gcnt, 4, F.G, (int)blockIdx.x, 1);
                pg8::EpiMoeOut E{wsp<int>(F, WS_ROWT), wsp<float>(F, WS_ROWG), wsp<bf16>(F, WS_OS), M, 1.0f};
                pg8::gemm_phase<pg8::EpiMoeOut, pg8::GroupedOrder, true, true>(F.lds + RING_OFF, g, S, E);
            }
            SEAM(pb + 8);
        }
        if (IN(pb + 9)) { combine_phase(F, l == MK_LAYERS - 1, args.in[21], (l == 1 && CIN_F8 != 0) ? wsp<unsigned char>(F, WS_X8) : nullptr); if constexpr (l != MK_LAYERS - 1) SEAML(pb + 9); }
    }
}
__global__ void __launch_bounds__(NWAVES * 64, 2) trunk_fwd(Args args) {
    extern __shared__ __attribute__((aligned(16))) unsigned char lds[];
    Frame F;
    F.lds = (LAS unsigned char*)lds;
    F.MISC = (volatile LAS unsigned*)(F.lds + MISC_OFF);
    F.tid = threadIdx.x; F.lane = F.tid & 63; F.wave = __builtin_amdgcn_readfirstlane(F.tid >> 6);
    F.G = gridDim.x; { const int bx = blockIdx.x; F.vcu = (F.G % 8 == 0) ? (bx % 8) * (F.G / 8) + bx / 8 : bx; }
    F.out = args.out; F.ws = args.ws;
    F.ctl = (gu32*)(args.ws + WS_CTL);
    for (int u = F.tid; u < (LDS_BYTES - LDSCTL_OFF) / 4; u += NWAVES * 64) ((LAS unsigned*)(F.lds + LDSCTL_OFF))[u] = 0u;
    __syncthreads();
    XcdBarrier bar = xcd_barrier_post((unsigned*)(F.ctl + CW_BAR), F.MISC + 8);
    if (F.tid == 0 && (bar.x != (blockIdx.x & 7u) || gridDim.x != 256u)) __hip_atomic_fetch_or(F.ctl + CW_XMIS, 1u, __ATOMIC_RELAXED, __HIP_MEMORY_SCOPE_AGENT);
    const int lo = args.ph_lo, hi = args.ph_hi;
    if (IN(0)) { REPS(1) { p0_prologue(F, args); SEAM(0); } }
    if (F.tid == 0) F.MISC[10] = (MK_ONE_LAUNCH != 0 && lo == 0 && __hip_atomic_load(F.ctl + CW_XMIS, __ATOMIC_RELAXED, __HIP_MEMORY_SCOPE_AGENT) == 0u) ? 1u : 0u;
    __syncthreads();
    run_layer<0>(F, args, bar, lo, hi);
    if constexpr (MK_LAYERS > 1) run_layer<1>(F, args, bar, lo, hi);
    if constexpr (MK_LAYERS > 2) run_layer<2>(F, args, bar, lo, hi);
    if constexpr (MK_LAYERS > 3) run_layer<3>(F, args, bar, lo, hi);
    if ((MK_LAYERS % 2) == 1 && IN(1 + 10 * MK_LAYERS)) final_norm_phase(F, wsp<bf16>(F, WS_XB), args.in[21]);
}
#undef IN
#undef SEAM

extern "C" void kernel_launch(void* const* d_in, const int* in_sizes, int n_in, void* d_out, int out_size, void* d_ws, size_t ws_size, hipStream_t stream) {
    static int grid = 0;
    if (grid == 0) {
        if (n_in != 22 || in_sizes[0] != M * D || out_size != M * D || ws_size < WS_END) { fprintf(stderr, "kernel_launch: unexpected shapes / workspace (n_in %d, in0 %d, out %d, ws %zu, need %zu)\n", n_in, n_in > 0 ? in_sizes[0] : -1, out_size, ws_size, (size_t)WS_END); grid = -1; return; }
        int dev = 0, cus = 0, per_cu = 0;
        if (hipGetDevice(&dev) != hipSuccess || hipDeviceGetAttribute(&cus, hipDeviceAttributeMultiprocessorCount, dev) != hipSuccess) { grid = -1; return; }
        if (hipFuncSetAttribute((const void*)trunk_fwd, hipFuncAttributeMaxDynamicSharedMemorySize, LDS_BYTES) != hipSuccess) { fprintf(stderr, "kernel_launch: hipFuncSetAttribute failed\n"); grid = -1; return; }
        if (hipOccupancyMaxActiveBlocksPerMultiprocessor(&per_cu, (const void*)trunk_fwd, NWAVES * 64, LDS_BYTES) != hipSuccess || per_cu < 1) { fprintf(stderr, "kernel_launch: occupancy query reports %d workgroups per CU\n", per_cu); }
        (void)hipGetLastError();
        grid = cus;
    }
    if (grid < 0) return;
    if (hipMemsetAsync((char*)d_ws + WS_CTL, 0, CTL_ZERO_BYTES, stream) != hipSuccess) return;
    Args a{};
    for (int i = 0; i < 22; ++i) a.in[i] = (const float*)d_in[i];
    a.out = (float*)d_out; a.ws = (unsigned char*)d_ws;
#if MK_ONE_LAUNCH
    a.ph_lo = 0; a.ph_hi = N_PHASES;
    hipLaunchKernelGGL(trunk_fwd, dim3(grid), dim3(NWAVES * 64), LDS_BYTES, stream, a);
#else
    for (int p = 0; p < N_PHASES; ++p) { if (!phase_active(p)) continue; a.ph_lo = p; a.ph_hi = p + 1; hipLaunchKernelGGL(trunk_fwd, dim3(grid), dim3(NWAVES * 64), LDS_BYTES, stream, a); }
#endif
}
```

```cpp
#include <hip/hip_runtime.h>
#include <cstdio>
#include <cstdint>
namespace pg8 {
#define PG8_LAS __attribute__((address_space(3)))
typedef unsigned short bf16_t;
typedef short bf16x8 __attribute__((ext_vector_type(8)));
typedef float f32x4 __attribute__((ext_vector_type(4)));
typedef unsigned u32x4 __attribute__((ext_vector_type(4)));
typedef int i32x8 __attribute__((ext_vector_type(8)));
constexpr int BM = 256, BK = 64, HALF = 128, HTB = HALF * BK * 2  , STAGE_BYTES = 8 * HTB, NXCD = 8, WGM = 8;

__host__ __device__ __forceinline__ int lds_byte(int r, int c) { const int st = (r >> 4) * 2 + (c >> 5), rr = r & 15, cc = c & 31, ob = rr * 64 + cc * 2; return st * 1024 + (ob ^ (((ob >> 9) & 1) << 5)); }
__host__ __device__ __forceinline__ void stage_rc(int b, int& R, int& C) { const int st = b / 1024, sb = b % 1024, swz = sb ^ (((sb >> 9) & 1) << 5); R = (st >> 1) * 16 + swz / 64; C = (st & 1) * 32 + (swz % 64) / 2; }
__host__ __device__ __forceinline__ int perm32(int rho) { const int n = rho >> 4, i = rho & 15; return 8 * (i >> 2) + 4 * n + (i & 3); }

struct Unit { int pm, pn; };
struct Gemm { const bf16_t* A; const bf16_t* Bt; int M, N, K; const int* rowmap = nullptr; };

struct StaticOrder {
    int nM, nN, nwg, G, c, rev;
    __host__ __device__ void init(int M, int N, int G_, int c_, int rev_ = 0) { nM = M / BM; nN = N / BM; nwg = nM * nN; G = G_; c = c_; rev = rev_; }
    __host__ __device__ bool next(int i, Unit& u) const {
        const long L = (long)i * G + c; if (L >= nwg) return false;
        int wgid = (int)L; { const int q = nwg / NXCD, r = nwg % NXCD, xcd = wgid % NXCD, off = wgid / NXCD; const int cnt = q + (xcd < r ? 1 : 0); wgid = (xcd < r ? xcd * (q + 1) : r * (q + 1) + (xcd - r) * q) + (rev ? cnt - 1 - off : off); }
        const int nig = WGM * nN, gid = wgid / nig, fm = gid * WGM, gsz = (nM - fm) < WGM ? (nM - fm) : WGM;
        u.pm = fm + ((wgid % nig) % gsz); u.pn = (wgid % nig) / gsz; return true;
    }
    __device__ __forceinline__ void a_ready(const Unit&) const {}
    __device__ __forceinline__ void done(const Unit&) const {}
};

struct GroupedOrder {
    int nN, nM, nwg, G, c, rev; int s1, s2, s3, s4, s5, s6, s7;
    __device__ __forceinline__ void init(const unsigned* cnt, int nN_, int G_, int c_, int rev_ = 0) {
        nN = nN_; G = G_; c = c_; rev = rev_; int t = 0;
        t += (int)((cnt[0] + 255u) >> 8); s1 = t; t += (int)((cnt[1] + 255u) >> 8); s2 = t; t += (int)((cnt[2] + 255u) >> 8); s3 = t; t += (int)((cnt[3] + 255u) >> 8); s4 = t;
        t += (int)((cnt[4] + 255u) >> 8); s5 = t; t += (int)((cnt[5] + 255u) >> 8); s6 = t; t += (int)((cnt[6] + 255u) >> 8); s7 = t; t += (int)((cnt[7] + 255u) >> 8);
        nM = t; nwg = nM * nN;
    }
    __device__ __forceinline__ bool next(int i, Unit& u) const {
        const long L = (long)i * G + c; if (L >= nwg) return false;
        int wgid = (int)L; { const int q = nwg / NXCD, r = nwg % NXCD, xcd = wgid % NXCD, off = wgid / NXCD; const int cnt = q + (xcd < r ? 1 : 0); wgid = (xcd < r ? xcd * (q + 1) : r * (q + 1) + (xcd - r) * q) + (rev ? cnt - 1 - off : off); }
        const int nig = WGM * nN, gid = wgid / nig, fm = gid * WGM, gsz = (nM - fm) < WGM ? (nM - fm) : WGM;
        const int pm = fm + ((wgid % nig) % gsz), pnl = (wgid % nig) / gsz;
        const int e = (pm >= s1) + (pm >= s2) + (pm >= s3) + (pm >= s4) + (pm >= s5) + (pm >= s6) + (pm >= s7);
        u.pm = pm; u.pn = e * nN + pnl; return true;
    }
    __device__ __forceinline__ void a_ready(const Unit&) const {}
    __device__ __forceinline__ void done(const Unit&) const {}
};

__device__ __forceinline__ unsigned cvt_pk_bf16(float lo, float hi) { unsigned r; asm volatile("v_cvt_pk_bf16_f32 %0, %1, %2" : "=v"(r) : "v"(lo), "v"(hi)); return r; }
typedef unsigned u32x2 __attribute__((ext_vector_type(2)));
__device__ __forceinline__ float c8(float v) { return __builtin_amdgcn_fmed3f(v, -448.0f, 448.0f); }
constexpr float RMS_EPS = 1e-6f;
__device__ __forceinline__ float rs16(const float* ssq, int row, int fq) {
    const f32x4 a = *(const f32x4*)(ssq + (size_t)row * 16 + 4 * fq);
    float s = (a[0] + a[1]) + (a[2] + a[3]); s += __shfl_xor(s, 16); s += __shfl_xor(s, 32);
    return __builtin_amdgcn_rsqf(s * (1.0f / 1024.0f) + RMS_EPS);
}
__device__ __forceinline__ float gelu_t(float x) {
    const float t = x * (1.0f + 0.044715f * x * x);
    return x * __builtin_amdgcn_rcpf(1.0f + __builtin_amdgcn_exp2f(-2.302208198f * t));
}
__device__ __forceinline__ float silu_f(float x) { return x * __builtin_amdgcn_rcpf(1.0f + __builtin_amdgcn_exp2f(-1.4426950409f * x)); }
__device__ __forceinline__ f32x4 sig4(f32x4 a) {
    f32x4 e; e[0] = __builtin_amdgcn_exp2f(a[0]); e[1] = __builtin_amdgcn_exp2f(a[1]); e[2] = __builtin_amdgcn_exp2f(a[2]); e[3] = __builtin_amdgcn_exp2f(a[3]);
    e = e + 1.0f; f32x4 r; r[0] = __builtin_amdgcn_rcpf(e[0]); r[1] = __builtin_amdgcn_rcpf(e[1]); r[2] = __builtin_amdgcn_rcpf(e[2]); r[3] = __builtin_amdgcn_rcpf(e[3]); return r;
}
__device__ __forceinline__ f32x4 swiglu4(f32x4 g, f32x4 u, float ca, float ch) { return ((g * u) * ch) * sig4(g * ca); }
__device__ __forceinline__ f32x4 gelu4(f32x4 x) { const f32x4 p = (x * x) * (-2.302208198f * 0.044715f) + (-2.302208198f); return x * sig4(x * p); }

struct EpiAin {
    static constexpr bool PERM = true, AFTER_DRAIN = false, RS_LDS = false;
    const float* ssq; bf16_t* U; bf16_t* V; float* vssq; float sc;
    __device__ __forceinline__ void operator()(const f32x4 (&acc)[2][2][4][2], const Unit& u, int wr, int wc, int fr, int fq) const {
        const bool isv = u.pn >= 8; bf16_t* base = isv ? V : U;
        const int row0 = u.pm * BM + wr * 64 + fr, col0 = (u.pn & 7) * BM + wc * 32 + 8 * fq;
        float rsv[2][4];
#pragma unroll
        for (int ai = 0; ai < 2; ++ai)
#pragma unroll
            for (int m = 0; m < 4; ++m) rsv[ai][m] = rs16(ssq, row0 + ai * HALF + m * 16, fq) * sc;
#pragma unroll
        for (int ai = 0; ai < 2; ++ai)
#pragma unroll
            for (int m = 0; m < 4; ++m) { const int row = row0 + ai * HALF + m * 16; const float rs = rsv[ai][m]; float sq = 0.f; bf16_t* rowp = base + (size_t)row * 2048 + col0;
#pragma unroll
                for (int bj = 0; bj < 2; ++bj) { const f32x4 v0 = gelu4(acc[ai][bj][m][0] * rs), v1 = gelu4(acc[ai][bj][m][1] * rs);
                    { const f32x4 q = v0 * v0 + v1 * v1; sq += (q[0] + q[1]) + (q[2] + q[3]); }
                    u32x4 w; w.x = cvt_pk_bf16(v0[0], v0[1]); w.y = cvt_pk_bf16(v0[2], v0[3]); w.z = cvt_pk_bf16(v1[0], v1[1]); w.w = cvt_pk_bf16(v1[2], v1[3]);
                    *(u32x4*)(rowp + bj * HALF) = w; }
                if (isv) { sq += __shfl_xor(sq, 16); sq += __shfl_xor(sq, 32); if (fq == 0) vssq[(size_t)row * 32 + (u.pn - 8) * 4 + wc] = sq; } }
    }
};
template <bool KN> struct EpiRow {
    static constexpr bool PERM = true, AFTER_DRAIN = false, RS_LDS = false;
    const float* ssq; bf16_t* O; int ldc; unsigned* knb; float sc;
    __device__ __forceinline__ void operator()(const f32x4 (&acc)[2][2][4][2], const Unit& u, int wr, int wc, int fr, int fq) const {
        const int row0 = u.pm * BM + wr * 64 + fr, col0 = u.pn * BM + wc * 32 + 8 * fq;
        float kmx0 = 0.f, kmx1 = 0.f;
#pragma unroll
        for (int ai = 0; ai < 2; ++ai)
#pragma unroll
            for (int m = 0; m < 4; ++m) { const int row = row0 + ai * HALF + m * 16; const float rs = rs16(ssq, row, fq) * sc; bf16_t* rowp = O + (size_t)row * ldc + col0;
#pragma unroll
                for (int bj = 0; bj < 2; ++bj) { const f32x4 v0 = acc[ai][bj][m][0] * rs, v1 = acc[ai][bj][m][1] * rs;
                    u32x4 w; w.x = cvt_pk_bf16(v0[0], v0[1]); w.y = cvt_pk_bf16(v0[2], v0[3]); w.z = cvt_pk_bf16(v1[0], v1[1]); w.w = cvt_pk_bf16(v1[2], v1[3]);
                    *(u32x4*)(rowp + bj * HALF) = w;
                    if constexpr (KN) { float sq = ((v0[0] * v0[0] + v0[1] * v0[1]) + (v0[2] * v0[2] + v0[3] * v0[3])) + ((v1[0] * v1[0] + v1[1] * v1[1]) + (v1[2] * v1[2] + v1[3] * v1[3]));
                        sq += __shfl_xor(sq, 16); sq += __shfl_xor(sq, 32); if (bj == 0) kmx0 = fmaxf(kmx0, sq); else kmx1 = fmaxf(kmx1, sq); } } }
        if constexpr (KN) { if (u.pn >= 4 && u.pn < 8) {
#pragma unroll
                for (int o = 1; o < 16; o <<= 1) { kmx0 = fmaxf(kmx0, __shfl_xor(kmx0, o)); kmx1 = fmaxf(kmx1, __shfl_xor(kmx1, o)); }
                if ((threadIdx.x & 63) == 0) { const int bb = (u.pm * BM) >> 12, hd = 2 * (u.pn - 4);
                    __hip_atomic_fetch_max(knb + ((bb * 8 + hd) * 4 + wc), __builtin_bit_cast(unsigned, kmx0), __ATOMIC_RELAXED, __HIP_MEMORY_SCOPE_AGENT);
                    __hip_atomic_fetch_max(knb + ((bb * 8 + hd + 1) * 4 + wc), __builtin_bit_cast(unsigned, kmx1), __ATOMIC_RELAXED, __HIP_MEMORY_SCOPE_AGENT); } } }
    }
};
template <bool F32IN, bool W8 = false> struct EpiResid {
    static constexpr bool PERM = true, AFTER_DRAIN = false, RS_LDS = false;
    const void* xin; bf16_t* xb; float* ssq; unsigned char* x8; float oscale;
    __device__ __forceinline__ void operator()(const f32x4 (&acc)[2][2][4][2], const Unit& u, int wr, int wc, int fr, int fq) const {
        const int row0 = u.pm * BM + wr * 64 + fr, col0 = u.pn * BM + wc * 32 + 8 * fq;
        constexpr int MB = F32IN ? 2 : 4;
#pragma unroll
        for (int ai = 0; ai < 2; ++ai)
#pragma unroll
            for (int mb = 0; mb < 4; mb += MB) { u32x4 xr[MB][2][F32IN ? 2 : 1];
#pragma unroll
                for (int mi = 0; mi < MB; ++mi)
#pragma unroll
                    for (int bj = 0; bj < 2; ++bj) { const size_t o = (size_t)(row0 + ai * HALF + (mb + mi) * 16) * 1024 + col0 + bj * HALF;
                        if constexpr (F32IN) { xr[mi][bj][0] = *(const u32x4*)((const float*)xin + o); xr[mi][bj][1] = *(const u32x4*)((const float*)xin + o + 4); }
                        else xr[mi][bj][0] = *(const u32x4*)((const bf16_t*)xin + o); }
#pragma unroll
                for (int mi = 0; mi < MB; ++mi) { const int m = mb + mi; const int row = row0 + ai * HALF + m * 16; const size_t off = (size_t)row * 1024 + col0; float sq = 0.f;
#pragma unroll
                    for (int bj = 0; bj < 2; ++bj) { const size_t o = off + bj * HALF; f32x4 v0, v1;
                        if constexpr (F32IN) { v0 = __builtin_bit_cast(f32x4, xr[mi][bj][0]); v1 = __builtin_bit_cast(f32x4, xr[mi][bj][F32IN ? 1 : 0]); }
                        else { const u32x4 xw = xr[mi][bj][0];
                            v0 = (f32x4){__builtin_bit_cast(float, xw.x << 16), __builtin_bit_cast(float, xw.x & 0xffff0000u), __builtin_bit_cast(float, xw.y << 16), __builtin_bit_cast(float, xw.y & 0xffff0000u)};
                            v1 = (f32x4){__builtin_bit_cast(float, xw.z << 16), __builtin_bit_cast(float, xw.z & 0xffff0000u), __builtin_bit_cast(float, xw.w << 16), __builtin_bit_cast(float, xw.w & 0xffff0000u)}; }
                        v0 += acc[ai][bj][m][0] * oscale; v1 += acc[ai][bj][m][1] * oscale;
                        u32x4 w; w.x = cvt_pk_bf16(v0[0], v0[1]); w.y = cvt_pk_bf16(v0[2], v0[3]); w.z = cvt_pk_bf16(v1[0], v1[1]); w.w = cvt_pk_bf16(v1[2], v1[3]);
                        *(u32x4*)(xb + o) = w;
                        if constexpr (W8) { int p0 = __builtin_amdgcn_cvt_pk_fp8_f32(c8(v0[0]), c8(v0[1]), 0, false); p0 = __builtin_amdgcn_cvt_pk_fp8_f32(c8(v0[2]), c8(v0[3]), p0, true); int p1 = __builtin_amdgcn_cvt_pk_fp8_f32(c8(v1[0]), c8(v1[1]), 0, false); p1 = __builtin_amdgcn_cvt_pk_fp8_f32(c8(v1[2]), c8(v1[3]), p1, true);
                            u32x2 w8; w8.x = (unsigned)p0; w8.y = (unsigned)p1; *(u32x2*)(x8 + o) = w8; }
                        sq += ((v0[0] * v0[0] + v0[1] * v0[1]) + (v0[2] * v0[2] + v0[3] * v0[3])) + ((v1[0] * v1[0] + v1[1] * v1[1]) + (v1[2] * v1[2] + v1[3] * v1[3])); }
                    sq += __shfl_xor(sq, 16); sq += __shfl_xor(sq, 32); if (fq == 0) ssq[(size_t)row * 16 + u.pn * 4 + wc] = sq; }
                asm volatile("" ::: "memory"); }
    }
};
template <int MODE> struct EpiSwiGLU {
    static constexpr bool PERM = true, AFTER_DRAIN = false, RS_LDS = false;
    const float* ssq; bf16_t* H;
    __device__ __forceinline__ void operator()(const f32x4 (&acc)[2][2][4][2], const Unit& u, int wr, int wc, int fr, int fq) const {
        const int row0 = u.pm * BM + wr * 64 + fr, col0 = (u.pn % 28) * HALF + wc * 32 + 8 * fq;
#pragma unroll
        for (int ai = 0; ai < 2; ++ai)
#pragma unroll
            for (int m = 0; m < 4; ++m) { const int row = row0 + ai * HALF + m * 16; const float rs = MODE == 0 ? rs16(ssq, row, fq) : ssq[row];
                const float ca = rs * -1.4426950409f, ch = rs * rs;
                const f32x4 h0 = swiglu4(acc[ai][0][m][0], acc[ai][1][m][0], ca, ch), h1 = swiglu4(acc[ai][0][m][1], acc[ai][1][m][1], ca, ch);
                u32x4 w; w.x = cvt_pk_bf16(h0[0], h0[1]); w.y = cvt_pk_bf16(h0[2], h0[3]); w.z = cvt_pk_bf16(h1[0], h1[1]); w.w = cvt_pk_bf16(h1[2], h1[3]);
                *(u32x4*)(H + (size_t)row * 3584 + col0) = w; }
    }
};
template <int MODE> struct EpiSwiGLU8 {
    static constexpr bool PERM = true, AFTER_DRAIN = false, RS_LDS = (MODE == 1);
    const float* rrs; unsigned char* H8;
    __device__ __forceinline__ void operator()(const f32x4 (&acc)[2][2][4][2], const Unit& u, int wr, int wc, int fr, int fq, const PG8_LAS float* rsl = nullptr) const {
        const int row0 = u.pm * BM + wr * 64 + fr, col0 = (u.pn % 28) * HALF + wc * 32 + 8 * fq;
#pragma unroll
        for (int ai = 0; ai < 2; ++ai)
#pragma unroll
            for (int m = 0; m < 4; ++m) { const int row = row0 + ai * HALF + m * 16; const float rs = (MODE == 0 ? rs16(rrs, row, fq) : rsl[ai * 64 + m * 16 + fr]) * (1.0f / 64.0f);
                const float ca = rs * -1.4426950409f, ch = rs * rs * 8.0f;
                const f32x4 h0 = swiglu4(acc[ai][0][m][0], acc[ai][1][m][0], ca, ch), h1 = swiglu4(acc[ai][0][m][1], acc[ai][1][m][1], ca, ch);
                int w0 = __builtin_amdgcn_cvt_pk_fp8_f32(c8(h0[0]), c8(h0[1]), 0, false); w0 = __builtin_amdgcn_cvt_pk_fp8_f32(c8(h0[2]), c8(h0[3]), w0, true);
                int w1 = __builtin_amdgcn_cvt_pk_fp8_f32(c8(h1[0]), c8(h1[1]), 0, false); w1 = __builtin_amdgcn_cvt_pk_fp8_f32(c8(h1[2]), c8(h1[3]), w1, true);
                u32x2 w; w.x = (unsigned)w0; w.y = (unsigned)w1; *(u32x2*)(H8 + (size_t)row * 3584 + col0) = w; }
    }
};
struct EpiMoeOut {
    static constexpr bool PERM = true, AFTER_DRAIN = false, RS_LDS = false;
    const int* rtok; const float* rgate; bf16_t* OS; int M; float oscale;
    __device__ __forceinline__ void operator()(const f32x4 (&acc)[2][2][4][2], const Unit& u, int wr, int wc, int fr, int fq) const {
        const int row0 = u.pm * BM + wr * 64 + fr, col0 = (u.pn & 3) * BM + wc * 32 + 8 * fq;
        int tkv[2][4]; float gtv[2][4];
#pragma unroll
        for (int ai = 0; ai < 2; ++ai)
#pragma unroll
            for (int m = 0; m < 4; ++m) { const int row = row0 + ai * HALF + m * 16; tkv[ai][m] = rtok[row]; gtv[ai][m] = rgate[row]; }
#pragma unroll
        for (int ai = 0; ai < 2; ++ai)
#pragma unroll
            for (int m = 0; m < 4; ++m) { const int tk = tkv[ai][m]; const float gt = gtv[ai][m] * oscale;
                if (tk >= 0) { bf16_t* rowp = OS + ((size_t)(tk & 1) * M + (tk >> 1)) * 1024 + col0;
#pragma unroll
                    for (int bj = 0; bj < 2; ++bj) { const f32x4 v0 = acc[ai][bj][m][0] * gt, v1 = acc[ai][bj][m][1] * gt;
                        u32x4 w; w.x = cvt_pk_bf16(v0[0], v0[1]); w.y = cvt_pk_bf16(v0[2], v0[3]); w.z = cvt_pk_bf16(v1[0], v1[1]); w.w = cvt_pk_bf16(v1[2], v1[3]);
                        *(u32x4*)(rowp + bj * HALF) = w; } } }
    }
};

template <class Epi, class Sched, bool ALIGN_EPI = false, bool SP2 = false, bool F8 = false, bool GA = false>
__device__ __forceinline__ void gemm_phase(PG8_LAS unsigned char* lds, const Gemm g, const Sched& S, const Epi& E) {
    static_assert(!GA || SP2, "gathered A rows: SP2 path only");
    const int tid = threadIdx.x, wid = __builtin_amdgcn_readfirstlane(tid >> 6), lane = tid & 63, wr = wid >> 2, wc = wid & 3, fr = lane & 15, fq = lane >> 4;
    const int K = g.K, nt = K / BK;
    unsigned voffA[2], voffB[2];
#pragma unroll
    for (int i = 0; i < 2; ++i) { int R, C; stage_rc(tid * 16 + i * 8192, R, C); const int Rb = Epi::PERM ? ((R & ~31) + perm32(R & 31)) : R;
        voffA[i] = (unsigned)(R * K + C) * 2u; voffB[i] = (unsigned)(Rb * K + C) * 2u; }
    PG8_LAS unsigned char* const rowbuf = lds + STAGE_BYTES + 1024 + wid * 256;
    const unsigned cbA = voffA[0] - (unsigned)(((wid >> 1) * 16 + (lane >> 2)) * K) * 2u;
#define PG8_ROWDMA(u, par) do { const int* rp_ = g.rowmap + (size_t)(u).pm * BM + (lane >> 5) * 128 + ((lane >> 4) & 1) * 64 + (wid >> 1) * 16 + (lane & 15); \
        const unsigned la_ = __builtin_amdgcn_readfirstlane((unsigned)(unsigned long)(rowbuf + (par) * 2048)); unsigned keep_; \
        asm volatile("s_mov_b32 %0, m0\n\ts_mov_b32 m0, %2\n\ts_nop 0\n\tglobal_load_lds_dword %1, off\n\ts_mov_b32 m0, %0" : "=&s"(keep_) : "v"(rp_), "s"(la_) : "memory"); } while (0)
#define PG8_ROWGET(dst, par) do { _Pragma("unroll") for (int h_ = 0; h_ < 2; ++h_) _Pragma("unroll") for (int i_ = 0; i_ < 2; ++i_) { \
        const int t_ = *(const PG8_LAS int*)(rowbuf + (par) * 2048 + ((2 * h_ + i_) * 16 + (lane >> 2)) * 4); dst[h_][i_] = (unsigned)((t_ < 0 ? 0 : t_) >> 1) * (unsigned)(K * 2) + cbA; } } while (0)
    PG8_LAS unsigned char* const rsbuf = lds + STAGE_BYTES + 1024 + 4096 + wid * 512;
#define PG8_RSDMA(u) do { _Pragma("unroll") for (int ai_ = 0; ai_ < 2; ++ai_) { const float* rp_ = E.rrs + (size_t)(u).pm * BM + ai_ * HALF + wr * 64 + lane; \
        const unsigned la_ = __builtin_amdgcn_readfirstlane((unsigned)(unsigned long)(rsbuf + ai_ * 256)); unsigned keep_; \
        asm volatile("s_mov_b32 %0, m0\n\ts_mov_b32 m0, %2\n\ts_nop 0\n\tglobal_load_lds_dword %1, off\n\ts_mov_b32 m0, %0" : "=&s"(keep_) : "v"(rp_), "s"(la_) : "memory"); } } while (0)
    unsigned vGc[2][2], vS[2][2];
    const auto rsA = __builtin_amdgcn_make_buffer_rsrc((void*)g.A, 0, 0x40000000u, 0x00020000);
    const size_t kstep = (size_t)(BK * 2);
    const size_t hstep = (size_t)HALF * K * 2;
    const size_t tstep = 2 * hstep;
    const unsigned ldsw = (unsigned)wid * 1024u;
    const int aoff = lds_byte(wr * 64 + fr, fq * 8), boff = lds_byte(wc * 32 + fr, fq * 8);
#define PG8_SA(b, h) (((b) * 2 + (h)) * HTB)
#define PG8_SB(b, h) ((4 + (b) * 2 + (h)) * HTB)
#define PG8_STAGE(bufoff, gbase, voff) do { _Pragma("unroll") for (int _i = 0; _i < 2; ++_i) \
        __builtin_amdgcn_global_load_lds((const unsigned*)((const char*)(gbase) + (voff)[_i]), (PG8_LAS unsigned*)(lds + (bufoff) + ldsw + _i * 8192), 16, 0, 0); } while (0)
#define PG8_STAGE_A(bufoff, ptr, h, vsel) do { if constexpr (GA) { _Pragma("unroll") for (int _i = 0; _i < 2; ++_i)     \
            __builtin_amdgcn_raw_ptr_buffer_load_lds(rsA, (PG8_LAS void*)(lds + (bufoff) + ldsw + _i * 8192), 16, (int)vsel[h][_i], (int)((ptr) - (const char*)g.A), 0, 0); } \
        else PG8_STAGE(bufoff, (ptr) + ((h) ? hstep : 0), voffA); } while (0)
#define PG8_CAT8(p0_) __builtin_bit_cast(i32x8, __builtin_shufflevector(*(const PG8_LAS bf16x8*)(p0_), *(const PG8_LAS bf16x8*)((p0_) + 1024), 0, 1, 2, 3, 4, 5, 6, 7, 8, 9, 10, 11, 12, 13, 14, 15))
#define PG8_LDA(dst, b, h) do { if constexpr (F8) { _Pragma("unroll") for (int m = 0; m < 4; ++m) dst##8[m] = PG8_CAT8(lds + PG8_SA(b, h) + aoff + m * 2048); } \
        else { _Pragma("unroll") for (int m = 0; m < 4; ++m) _Pragma("unroll") for (int k = 0; k < 2; ++k) dst[m][k] = *(const PG8_LAS bf16x8*)(lds + PG8_SA(b, h) + aoff + m * 2048 + k * 1024); } } while (0)
#define PG8_LDB(dst, b, h) do { if constexpr (F8) { _Pragma("unroll") for (int n = 0; n < 2; ++n) dst##8[n] = PG8_CAT8(lds + PG8_SB(b, h) + boff + n * 2048); } \
        else { _Pragma("unroll") for (int n = 0; n < 2; ++n) _Pragma("unroll") for (int k = 0; k < 2; ++k) dst[n][k] = *(const PG8_LAS bf16x8*)(lds + PG8_SB(b, h) + boff + n * 2048 + k * 1024); } } while (0)
#define PG8_MMA(ai, bj, At, Bt) do { __builtin_amdgcn_s_setprio(1); \
        if constexpr (F8) { _Pragma("unroll") for (int m = 0; m < 4; ++m) _Pragma("unroll") for (int n = 0; n < 2; ++n) \
            asm volatile("v_mfma_scale_f32_16x16x128_f8f6f4 %0, %1, %2, %0, %3, %3 op_sel_hi:[0,0,0]" : "+v"(acc[ai][bj][m][n]) : "v"(Bt##8[n]), "v"(At##8[m]), "v"(f8one)); } \
        else { _Pragma("unroll") for (int m = 0; m < 4; ++m) _Pragma("unroll") for (int n = 0; n < 2; ++n) _Pragma("unroll") for (int k = 0; k < 2; ++k) \
            acc[ai][bj][m][n] = __builtin_amdgcn_mfma_f32_16x16x32_bf16(Bt[n][k], At[m][k], acc[ai][bj][m][n], 0, 0, 0); } \
        __builtin_amdgcn_s_setprio(0); } while (0)
#define PG8_WAIT_V(n) asm volatile("s_waitcnt vmcnt(" #n ")" ::: "memory")
#define PG8_WAIT_L(n) asm volatile("s_waitcnt lgkmcnt(" #n ")" ::: "memory")
#define PG8_BAR __builtin_amdgcn_s_barrier()
#define PG8_SCHED __builtin_amdgcn_sched_barrier(0)
    Unit cur, nxt; int ui = 0;
    if (!S.next(0, cur)) return;
#if defined(PG8_STAGGER_TICKS)
    if ((blockIdx.x >> 3) & 1) { const unsigned long long t0_ = __builtin_amdgcn_s_memrealtime(); while (__builtin_amdgcn_s_memrealtime() - t0_ < PG8_STAGGER_TICKS) __builtin_amdgcn_s_sleep(8); }
#endif
    f32x4 acc[2][2][4][2];
#pragma unroll
    for (int a = 0; a < 2; ++a)
#pragma unroll
        for (int b = 0; b < 2; ++b)
#pragma unroll
            for (int m = 0; m < 4; ++m)
#pragma unroll
                for (int n = 0; n < 2; ++n) acc[a][b][m][n] = (f32x4){0.f, 0.f, 0.f, 0.f};
    const int f8one = 0x7f7f7f7f;
    bf16x8 At[4][2], B0[2][2], B1[2][2]; i32x8 At8[4], B08[2], B18[2];
    const char* cA = GA ? (const char*)g.A : (const char*)g.A + (size_t)cur.pm * tstep; const char* cB = (const char*)g.Bt + (size_t)cur.pn * tstep;
    S.a_ready(cur);
    if constexpr (Epi::RS_LDS) PG8_RSDMA(cur);
    if constexpr (GA) { PG8_ROWDMA(cur, 0); asm volatile("s_waitcnt vmcnt(0)" ::: "memory"); PG8_ROWGET(vGc, 0); }
    if constexpr (SP2) {
        PG8_STAGE(PG8_SB(0, 0), cB, voffB); PG8_STAGE(PG8_SB(0, 1), cB + hstep, voffB); PG8_STAGE_A(PG8_SA(0, 0), cA, 0, vGc); PG8_STAGE_A(PG8_SA(0, 1), cA, 1, vGc);
        if (wr == 1) PG8_BAR;
        PG8_WAIT_V(2); PG8_BAR;
        PG8_STAGE(PG8_SB(1, 0), cB + kstep, voffB); PG8_STAGE_A(PG8_SA(1, 0), cA + kstep, 0, vGc); PG8_STAGE(PG8_SB(1, 1), cB + hstep + kstep, voffB);
        PG8_WAIT_V(6); PG8_BAR;
    } else {
        PG8_STAGE(PG8_SB(0, 0), cB, voffB); PG8_STAGE(PG8_SA(0, 0), cA, voffA); PG8_STAGE(PG8_SB(0, 1), cB + hstep, voffB); PG8_STAGE(PG8_SA(0, 1), cA + hstep, voffA);
        if (wr == 1) PG8_BAR;
        PG8_WAIT_V(4); PG8_BAR;
        PG8_STAGE(PG8_SB(1, 0), cB + kstep, voffB); PG8_STAGE(PG8_SA(1, 0), cA + kstep, voffA); PG8_STAGE(PG8_SB(1, 1), cB + hstep + kstep, voffB);
        PG8_WAIT_V(6); PG8_BAR;
    }
    for (;;) {
        const bool has_next = S.next(ui + 1, nxt);
        const char* nA = GA ? cA : has_next ? (const char*)g.A + (size_t)nxt.pm * tstep : cA; const char* nB = has_next ? (const char*)g.Bt + (size_t)nxt.pn * tstep : cB;
        if constexpr (GA) { if (has_next) PG8_ROWDMA(nxt, (ui + 1) & 1); }
        for (int t = 0; t < nt; t += 2) {
            const bool last = (t == nt - 2);
            const char* a1 = cA + (size_t)(t + 1) * kstep;
            const char* a2 = last ? nA : cA + (size_t)(t + 2) * kstep; const char* b2 = last ? nB : cB + (size_t)(t + 2) * kstep;
            const char* a3 = a2 + kstep; const char* b3 = b2 + kstep;
            if (last && has_next) S.a_ready(nxt);
            if constexpr (GA) { if (last && has_next) PG8_ROWGET(vS, (ui + 1) & 1);
                else { vS[0][0] = vGc[0][0]; vS[0][1] = vGc[0][1]; vS[1][0] = vGc[1][0]; vS[1][1] = vGc[1][1]; } }
            if constexpr (SP2) {
            PG8_LDB(B0, 0, 0); PG8_LDB(B1, 0, 1); PG8_SCHED; PG8_LDA(At, 0, 0); PG8_STAGE_A(PG8_SA(1, 1), a1, 1, vGc);
            PG8_WAIT_V(8); PG8_WAIT_L(0); PG8_BAR; PG8_MMA(0, 0, At, B0); PG8_MMA(0, 1, At, B1); PG8_BAR; PG8_SCHED;
            PG8_LDA(At, 0, 1); PG8_STAGE(PG8_SB(0, 0), b2, voffB); PG8_STAGE(PG8_SB(0, 1), b2 + hstep, voffB); PG8_STAGE_A(PG8_SA(0, 0), a2, 0, vS);
            PG8_WAIT_V(8); PG8_WAIT_L(0); PG8_BAR; PG8_MMA(1, 0, At, B0); PG8_MMA(1, 1, At, B1); PG8_BAR; PG8_SCHED;
            PG8_LDB(B0, 1, 0); PG8_LDB(B1, 1, 1); PG8_SCHED; PG8_LDA(At, 1, 0); PG8_STAGE_A(PG8_SA(0, 1), a2, 1, vS);
            PG8_WAIT_V(8); PG8_WAIT_L(0); PG8_BAR; PG8_MMA(0, 0, At, B0); PG8_MMA(0, 1, At, B1); PG8_BAR; PG8_SCHED;
            PG8_LDA(At, 1, 1); PG8_STAGE(PG8_SB(1, 0), b3, voffB); PG8_STAGE(PG8_SB(1, 1), b3 + hstep, voffB); PG8_STAGE_A(PG8_SA(1, 0), a3, 0, vS);
            PG8_WAIT_V(8); PG8_WAIT_L(0); PG8_BAR; PG8_MMA(1, 0, At, B0); PG8_MMA(1, 1, At, B1); PG8_BAR; PG8_SCHED;
            } else {
            PG8_LDB(B0, 0, 0); PG8_SCHED; PG8_LDA(At, 0, 0); PG8_STAGE(PG8_SA(1, 1), a1 + hstep, voffA);
            PG8_WAIT_L(8); PG8_BAR; PG8_WAIT_L(0); PG8_MMA(0, 0, At, B0); PG8_BAR; PG8_SCHED;
            PG8_LDB(B1, 0, 1); PG8_STAGE(PG8_SB(0, 0), b2, voffB);
            PG8_BAR; PG8_WAIT_L(0); PG8_MMA(0, 1, At, B1); PG8_BAR;
            PG8_LDA(At, 0, 1); PG8_STAGE(PG8_SA(0, 0), a2, voffA);
            PG8_BAR; PG8_WAIT_L(0); PG8_MMA(1, 0, At, B0); PG8_BAR; PG8_SCHED;
            PG8_STAGE(PG8_SB(0, 1), b2 + hstep, voffB);
            PG8_WAIT_V(6); PG8_BAR; PG8_MMA(1, 1, At, B1); PG8_BAR;
            PG8_LDB(B0, 1, 0); PG8_SCHED; PG8_LDA(At, 1, 0); PG8_STAGE(PG8_SA(0, 1), a2 + hstep, voffA);
            PG8_WAIT_L(8); PG8_BAR; PG8_WAIT_L(0); PG8_MMA(0, 0, At, B0); PG8_BAR; PG8_SCHED;
            PG8_LDB(B1, 1, 1); PG8_STAGE(PG8_SB(1, 0), b3, voffB);
            PG8_BAR; PG8_WAIT_L(0); PG8_MMA(0, 1, At, B1); PG8_BAR;
            PG8_LDA(At, 1, 1); PG8_STAGE(PG8_SA(1, 0), a3, voffA);
            PG8_BAR; PG8_WAIT_L(0); PG8_MMA(1, 0, At, B0); PG8_BAR; PG8_SCHED;
            PG8_STAGE(PG8_SB(1, 1), b3 + hstep, voffB);
            PG8_WAIT_V(6); PG8_BAR; PG8_MMA(1, 1, At, B1); PG8_BAR;
            }
        }
        if constexpr (F8) { asm volatile("s_nop 15\n\ts_nop 15" ::: "memory"); }
        if constexpr (ALIGN_EPI) { if (wr == 0) PG8_BAR; }
        if constexpr (!Epi::AFTER_DRAIN) { if constexpr (Epi::RS_LDS) E(acc, cur, wr, wc, fr, fq, (const PG8_LAS float*)rsbuf); else E(acc, cur, wr, wc, fr, fq); S.done(cur); }
        if (!has_next) break;
#pragma unroll
        for (int a = 0; a < 2; ++a)
#pragma unroll
            for (int b = 0; b < 2; ++b)
#pragma unroll
                for (int m = 0; m < 4; ++m)
#pragma unroll
                    for (int n = 0; n < 2; ++n) acc[a][b][m][n] = (f32x4){0.f, 0.f, 0.f, 0.f};
        cur = nxt; cA = nA; cB = nB; ++ui;
        if constexpr (Epi::RS_LDS) PG8_RSDMA(cur);
        if constexpr (GA) { vGc[0][0] = vS[0][0]; vGc[0][1] = vS[0][1]; vGc[1][0] = vS[1][0]; vGc[1][1] = vS[1][1]; }
        if constexpr (ALIGN_EPI) { if (wr == 1) PG8_BAR; }
    }
    PG8_WAIT_V(0);
    if constexpr (!ALIGN_EPI) { if (wr == 0) PG8_BAR; }
    PG8_BAR;
    if constexpr (Epi::AFTER_DRAIN) { E.fused(acc, cur, wr, wc, fr, fq, lds, wid, lane); S.done(cur); }
#undef PG8_SA
#undef PG8_SB
#undef PG8_STAGE
#undef PG8_STAGE_A
#undef PG8_ROWDMA
#undef PG8_RSDMA
#undef PG8_ROWGET
#undef PG8_LDA
#undef PG8_CAT8
#undef PG8_LDB
#undef PG8_MMA
#undef PG8_WAIT_V
#undef PG8_WAIT_L
#undef PG8_BAR
#undef PG8_SCHED
}
}

constexpr int NWAVES = 8;
constexpr int BATCH = 8, SEQ = 4096, D = 1024, M = BATCH * SEQ;
constexpr int AW = 2048, FF = 3584, NE = 8;
constexpr int MROWS = 2 * M + NE * 256;
constexpr float EPS = 1e-6f;
#ifndef MK_ONE_LAUNCH
#define MK_ONE_LAUNCH 1
#endif
#ifndef MK_LAYERS
#define MK_LAYERS 4
#endif
#ifndef MK_AIN_F8
#define MK_AIN_F8 1
#endif
constexpr int AIN_F8 = MK_AIN_F8;
#ifndef MK_AOUT_F8
#define MK_AOUT_F8 2
#endif
constexpr int AOUT_F8 = MK_AOUT_F8;
#ifndef MK_BOUT_F8
#define MK_BOUT_F8 0
#endif
constexpr int BOUT_F8 = MK_BOUT_F8;
#ifndef MK_COUT_F8
#define MK_COUT_F8 1
#endif
constexpr int COUT_F8 = MK_COUT_F8;
#ifndef MK_CIN_F8
#define MK_CIN_F8 1
#endif
constexpr int CIN_F8 = MK_CIN_F8;
#ifndef MK_MOE_F8
#define MK_MOE_F8 1
#endif
#ifndef MK_DENSE_F8
#define MK_DENSE_F8 2
#endif
constexpr int DENSE_F8 = MK_DENSE_F8;
constexpr int MOE_F8 = MK_MOE_F8;

constexpr size_t MiB = 1u << 20;
constexpr size_t WS_CTL = 0, CTL_ZERO_BYTES = 1 * MiB;
constexpr size_t WS_WA_IN = 2 * MiB, WS_WA_OUT = 18 * MiB, WS_WB_IN = 26 * MiB, WS_WB_OUT = 32 * MiB, WS_WC_IN = 34 * MiB, WS_WC_OUT = 40 * MiB;
constexpr size_t WS_WF_IN = 42 * MiB, WS_WF_OUT = 70 * MiB, WS_WM_IN = 84 * MiB, WS_WM_OUT = 308 * MiB;
constexpr size_t WS_X = 420 * MiB, WS_XB = 548 * MiB, WS_SSQ = 612 * MiB, WS_VSSQ = 614 * MiB, WS_GLOW = 618 * MiB, WS_LOGF = 620 * MiB, WS_OSSQ = 621 * MiB, WS_DEC = 629 * MiB;
constexpr size_t WS_TOKE = 630 * MiB, WS_TOKP = WS_TOKE + 256 * 1024, WS_TOKG = WS_TOKP + 256 * 1024, WS_TOKRS = WS_TOKG + 256 * 1024, WS_BLKB = WS_TOKRS + 128 * 1024;
constexpr size_t WS_ROWT = 632 * MiB, WS_ROWG = WS_ROWT + 512 * 1024, WS_ROWRS = WS_ROWG + 512 * 1024;
constexpr size_t WS_ACT = 640 * MiB;
constexpr size_t WS_U = WS_ACT, WS_V = WS_ACT + 128 * MiB, WS_Y = WS_ACT + 256 * MiB;
constexpr size_t WS_X8 = WS_X;
constexpr size_t WS_HF = WS_ACT;
constexpr size_t WS_QKVR = WS_ACT, WS_QD = WS_ACT + 192 * MiB, WS_KD = WS_ACT + 224 * MiB, WS_KET = WS_ACT + 256 * MiB, WS_VT = WS_ACT + 288 * MiB, WS_GO = WS_ACT + 352 * MiB, WS_GG = WS_ACT + 416 * MiB;
constexpr size_t WS_AO = WS_ACT + 192 * MiB;
constexpr size_t WS_XS = WS_ACT, WS_HM = WS_ACT + 132 * MiB, WS_OS = WS_ACT + 594 * MiB;
constexpr size_t WS_END = WS_ACT + 722 * MiB;
static_assert((size_t)MROWS * 1024 * 2 <= 132 * MiB && (size_t)MROWS * FF * 2 <= 462 * MiB, "MoE buffers");
constexpr int CW_TMO = 0, CW_CODE = 1, CW_XMIS = 2, CW_BAR = 4096, CW_CNT = 8192, CW_KNB = 12288;

constexpr int RING_OFF = 0, RING_BYTES = 131072;
constexpr int LDSCTL_OFF = RING_BYTES, MISC_OFF = LDSCTL_OFF + 320;
constexpr int LDS_BYTES = 147456;
static_assert(MISC_OFF + 128 <= LDS_BYTES, "LDS map");

#define GAS __attribute__((address_space(1)))
#define LAS __attribute__((address_space(3)))
#define DI __device__ __forceinline__
typedef unsigned short bf16;
typedef unsigned v4u __attribute__((ext_vector_type(4)));
typedef unsigned v2u __attribute__((ext_vector_type(2)));
typedef float f32x4 __attribute__((ext_vector_type(4)));
typedef short bf16x8 __attribute__((ext_vector_type(8)));
typedef short bf16x4 __attribute__((ext_vector_type(4)));
typedef GAS unsigned gu32;
#define RLX_AGENT __ATOMIC_RELAXED, __HIP_MEMORY_SCOPE_AGENT
#define LDS_WAIT() asm volatile("s_waitcnt lgkmcnt(0)" ::: "memory")
#define VM_WAIT() asm volatile("s_waitcnt vmcnt(0)" ::: "memory")
DI unsigned f2bf(float f) { unsigned u = __builtin_bit_cast(unsigned, f); return (u + 0x7fffu + ((u >> 16) & 1u)) >> 16; }
DI unsigned pk2(float lo, float hi) { return f2bf(lo) | (f2bf(hi) << 16); }
DI float bflo(unsigned w) { return __builtin_bit_cast(float, w << 16); }
DI float bfhi(unsigned w) { return __builtin_bit_cast(float, w & 0xffff0000u); }
DI float bf2f(bf16 h) { return __builtin_bit_cast(float, ((unsigned)h) << 16); }
DI float wave_sum(float v) {
#pragma unroll
    for (int o = 1; o < 64; o <<= 1) v += __shfl_xor(v, o);
    return v;
}
DI float logsig(float z) { return fminf(z, 0.f) - log1pf(__expf(-fabsf(z))); }
#define MFMA16(a, b, c) __builtin_amdgcn_mfma_f32_16x16x32_bf16((a), (b), (c), 0, 0, 0)
DI bf16x8 ldsfrag(LAS const unsigned char* p) { return *(LAS const bf16x8*)p; }
typedef short s16x4 __attribute__((ext_vector_type(4)));
DI bf16x8 tr_frag(LAS const unsigned char* p0, LAS const unsigned char* p1) {
    const s16x4 a = __builtin_amdgcn_ds_read_tr16_b64_v4i16((LAS s16x4*)p0), b = __builtin_amdgcn_ds_read_tr16_b64_v4i16((LAS s16x4*)p1);
    return __builtin_shufflevector(a, b, 0, 1, 2, 3, 4, 5, 6, 7);
}
#define XB_TMO      128
#define XB_XCNT(j)  (256  + 64 * (j))
#define XB_XSUB(j)  (1280 + 64 * (j))
#define XB_XGEN(j)  (2304 + 64 * (j))
#define XB_TOP      3328
#define XB_TOPGEN   3392
#define XCD_BAR_WORDS 3456
#define XB_SPIN_CAP (1u << 18)

__device__ __forceinline__ unsigned xb_ld(unsigned* p)              { return __hip_atomic_load(p, __ATOMIC_RELAXED, __HIP_MEMORY_SCOPE_AGENT); }
__device__ __forceinline__ unsigned xb_add(unsigned* p, unsigned v) { return __hip_atomic_fetch_add(p, v, __ATOMIC_RELAXED, __HIP_MEMORY_SCOPE_AGENT); }
__device__ __forceinline__ unsigned xb_xcc_id() { return (unsigned)__builtin_amdgcn_s_getreg((3 << 11) | 20) & 0xFu; }
#define XB_SPIN(cond, bar) do { unsigned _sp = 0; while (cond) { __builtin_amdgcn_s_sleep(1); \
    if ((++_sp & 255u) == 0u) { if (xb_ld(&(bar)[XB_TMO])) break; if (_sp > XB_SPIN_CAP) { atomicAdd(&(bar)[XB_TMO], 1u); break; } } } } while (0)

struct XcdBarrier {
    unsigned* bar; unsigned x;
    volatile LAS unsigned* st;
};

__device__ __forceinline__ XcdBarrier xcd_barrier_post(unsigned* bar, volatile LAS unsigned* st) {
    XcdBarrier b; b.bar = bar; b.x = xb_xcc_id(); b.st = st;
    if (threadIdx.x == 0) (void)xb_add(&bar[XB_XCNT(b.x)], 1u);
    return b;
}
__device__ __forceinline__ void xcd_barrier_complete(unsigned* bar, unsigned x, unsigned& nloc, unsigned& nx) {
    const unsigned G = gridDim.x * gridDim.y * gridDim.z;
    unsigned sum, cnt, mine, sp = 0u;
    for (;;) {
        sum = 0u; cnt = 0u; mine = 0u;
#pragma unroll
        for (unsigned j = 0; j < 16; ++j) { const unsigned c = xb_ld(&bar[XB_XCNT(j)]); sum += c; cnt += (c > 0u) ? 1u : 0u; mine = (j == x) ? c : mine; }
        if (sum == G) break;
        __builtin_amdgcn_s_sleep(1);
        if ((++sp & 255u) == 0u) { if (xb_ld(&bar[XB_TMO])) break; if (sp > XB_SPIN_CAP) { atomicAdd(&bar[XB_TMO], 1u); break; } }
    }
    nloc = mine > 0u ? mine : 1u; nx = cnt > 0u ? cnt : 1u;
}

__device__ __forceinline__ void xcd_barrier(const XcdBarrier& b) {
    asm volatile("s_waitcnt vmcnt(0)" ::: "memory");
    __syncthreads();
    if (threadIdx.x == 0) {
        unsigned* bar = b.bar;
        __builtin_amdgcn_s_waitcnt(0);
        unsigned nloc = b.st[0], nx = b.st[1];
        if (nloc == 0u) { xcd_barrier_complete(bar, b.x, nloc, nx); b.st[0] = nloc; b.st[1] = nx; }
        const unsigned old = xb_add(&bar[XB_XSUB(b.x)], 1u);
        const unsigned gen = old / nloc;
        if (old + 1u == (gen + 1u) * nloc) {
            __builtin_amdgcn_fence(__ATOMIC_RELEASE, "agent");
            asm volatile("s_waitcnt vmcnt(0)" ::: "memory");
            const unsigned og = xb_add(&bar[XB_TOP], 1u);
            const unsigned tg = og / nx;
            if (og + 1u == (tg + 1u) * nx) xb_add(&bar[XB_TOPGEN], 1u);
            else XB_SPIN(xb_ld(&bar[XB_TOPGEN]) == tg, bar);
            __builtin_amdgcn_fence(__ATOMIC_ACQUIRE, "agent");
            xb_add(&bar[XB_XGEN(b.x)], 1u);
            asm volatile("s_waitcnt vmcnt(0)" ::: "memory");
        } else {
            XB_SPIN(xb_ld(&bar[XB_XGEN(b.x)]) == gen, bar);
            __builtin_amdgcn_fence(__ATOMIC_ACQUIRE, "agent");
            asm volatile("s_waitcnt vmcnt(0)" ::: "memory");
        }
    }
    __syncthreads();
}

__device__ __forceinline__ void xcd_barrier_local(const XcdBarrier& b) {
    asm volatile("s_waitcnt vmcnt(0)" ::: "memory");
    __syncthreads();
    if (threadIdx.x == 0) {
        unsigned* bar = b.bar;
        __builtin_amdgcn_s_waitcnt(0);
        const unsigned nloc = b.st[0];
        const unsigned old = xb_add(&bar[XB_XSUB(b.x)], 1u);
        const unsigned gen = old / nloc;
        if (old + 1u == (gen + 1u) * nloc) xb_add(&bar[XB_XGEN(b.x)], 1u);
        else XB_SPIN(xb_ld(&bar[XB_XGEN(b.x)]) == gen, bar);
        __builtin_amdgcn_fence(__ATOMIC_ACQUIRE, "agent");
        asm volatile("s_waitcnt vmcnt(0)" ::: "memory");
    }
    __syncthreads();
}

struct Frame {
    LAS unsigned char* lds;
    volatile LAS unsigned* MISC;
    gu32* ctl;
    int tid, lane, wave;
    int vcu, G;
    float* out; unsigned char* ws;
};
template <class T> DI T* wsp(const Frame& F, size_t off) { return (T*)(F.ws + off); }

struct MatDesc { const float* W; int ldw, K, N; bf16* WT; int mode; const float* gain; int f8; };
template <class A> DI MatDesc get_mat(const Frame& F, const A& P, int idx) {
    MatDesc d; d.f8 = 0;
    if (idx < 2)        { const int j = idx;      d.W = P.in[3] + (size_t)j * 1024 * 4096; d.ldw = 4096; d.K = 1024; d.N = 4096; d.f8 = (j == 1 && AIN_F8) ? 1 : 0; d.WT = wsp<bf16>(F, WS_WA_IN) + (size_t)j * 4096 * 1024; d.mode = 0; d.gain = P.in[1] + (j ? 3 : 0) * 1024; }
    else if (idx < 4)   { const int j = idx - 2;  d.W = P.in[7] + (size_t)j * 2048 * 1024; d.ldw = 1024; d.K = 2048; d.N = 1024; d.f8 = (AOUT_F8 >> j) & 1; d.WT = wsp<bf16>(F, WS_WA_OUT) + (size_t)j * 1024 * 2048; d.mode = 0; d.gain = nullptr; }
    else if (idx == 4)  { d.W = P.in[8];  d.ldw = 3088; d.K = 1024; d.N = 3072; d.WT = wsp<bf16>(F, WS_WB_IN);  d.mode = 0; d.gain = P.in[1] + 1 * 1024; }
    else if (idx == 5)  { d.W = P.in[12]; d.ldw = 1024; d.K = 1024; d.N = 1024; d.WT = wsp<bf16>(F, WS_WB_OUT); d.mode = 0; d.gain = nullptr; d.f8 = BOUT_F8; }
    else if (idx == 6)  { d.W = P.in[13]; d.ldw = 3080; d.K = 1024; d.N = 3072; d.WT = wsp<bf16>(F, WS_WC_IN);  d.mode = 0; d.gain = P.in[1] + 2 * 1024; d.f8 = CIN_F8; }
    else if (idx == 7)  { d.W = P.in[15]; d.ldw = 1024; d.K = 1024; d.N = 1024; d.WT = wsp<bf16>(F, WS_WC_OUT); d.mode = 0; d.gain = nullptr; d.f8 = COUT_F8; }
    else if (idx < 10)  { const int i = idx - 8;  d.W = P.in[16] + (size_t)i * 1024 * 7168; d.ldw = 7168; d.K = 1024; d.N = 7168; d.f8 = (DENSE_F8 >> i) & 1; d.WT = d.f8 ? (bf16*)(wsp<unsigned char>(F, WS_WF_IN) + (size_t)i * 2 * 7168 * 1024) : wsp<bf16>(F, WS_WF_IN) + (size_t)i * 7168 * 1024; d.mode = 1; d.gain = P.in[2] + (2 * i) * 1024; }
    else if (idx < 12)  { const int i = idx - 10; d.W = P.in[17] + (size_t)i * 3584 * 1024; d.ldw = 1024; d.K = 3584; d.N = 1024; d.f8 = (DENSE_F8 >> i) & 1; d.WT = d.f8 ? (bf16*)(wsp<unsigned char>(F, WS_WF_OUT) + (size_t)i * 2 * 1024 * 3584) : wsp<bf16>(F, WS_WF_OUT) + (size_t)i * 1024 * 3584; d.mode = 0; d.gain = nullptr; }
    else if (idx < 28)  { const int q = idx - 12; d.W = P.in[19] + (size_t)q * 1024 * 7168; d.ldw = 7168; d.K = 1024; d.N = 7168; d.WT = MOE_F8 ? (bf16*)(wsp<unsigned char>(F, WS_WM_IN) + (size_t)q * 7168 * 1024) : wsp<bf16>(F, WS_WM_IN) + (size_t)q * 7168 * 1024; d.mode = 1; d.gain = P.in[2] + (2 * (q >> 3) + 1) * 1024; d.f8 = MOE_F8; }
    else                { const int q = idx - 28; d.W = P.in[20] + (size_t)q * 3584 * 1024; d.ldw = 1024; d.K = 3584; d.N = 1024; d.WT = MOE_F8 ? (bf16*)(wsp<unsigned char>(F, WS_WM_OUT) + (size_t)q * 1024 * 3584) : wsp<bf16>(F, WS_WM_OUT) + (size_t)q * 1024 * 3584; d.mode = 0; d.gain = nullptr; d.f8 = MOE_F8; }
    return d;
}
constexpr int NMATS = 44;
constexpr int P0_ST = 129;
struct P0Dst { bf16* base; int K; int f8; };
DI int p0_ntiles(const MatDesc& d) { return (d.K / 128) * (d.N / 128); }
DI P0Dst p0_load(const MatDesc& d, int tile, int tid, f32x4 (&r)[8], float (&g)[8]) {
    const int ntn = d.N / 128, kb = tile / ntn, nb = tile % ntn, k0 = 128 * kb, n0 = 128 * nb;
#pragma unroll
    for (int p = 0; p < 8; ++p) { const int k = k0 + p * 16 + (tid >> 5); r[p] = *(const f32x4*)(d.W + (size_t)k * d.ldw + n0 + 4 * (tid & 31)); g[p] = d.gain ? d.gain[k] : 1.0f; }
    int drow0 = n0;
    if (d.mode == 1) drow0 = (n0 < FF) ? (n0 >> 7) * 256 : ((n0 - FF) >> 7) * 256 + 128;
    P0Dst o; o.K = d.K; o.f8 = d.f8;
    if (d.f8) { o.base = (bf16*)((unsigned char*)d.WT + (size_t)drow0 * d.K + k0);
#pragma unroll
        for (int p = 0; p < 8; ++p) g[p] *= 64.0f; }
    else o.base = d.WT + (size_t)drow0 * d.K + k0;
    return o;
}
constexpr int N_EARLY = 6;
DI int morder(int i) { return i == 0 ? 0 : i == 1 ? 2 : i == 2 ? 4 : i == 3 ? 5 : i == 4 ? 8 : i == 5 ? 10 : i == 6 ? 1 : i == 7 ? 3 : i == 8 ? 6 : i == 9 ? 7 : i == 10 ? 9 : i == 11 ? 11 : i; }
struct P0State { int mi, i_hi, base, nt, T, stride; MatDesc d; };
template <class A> DI void p0_init(P0State& s, Frame& F, const A& P, int i_lo, int i_hi, int worker, int nworkers) { s.mi = i_lo; s.i_hi = i_hi; s.base = 0; s.T = worker; s.stride = nworkers; s.d = get_mat(F, P, morder(i_lo)); s.nt = p0_ntiles(s.d); }
#define P0_NEXT(st, r, g, dst, have) do { have = false; while (st.mi < st.i_hi && st.T >= st.base + st.nt) { st.base += st.nt; ++st.mi; if (st.mi < st.i_hi) { st.d = get_mat(F, P, morder(st.mi)); st.nt = p0_ntiles(st.d); } } \
        if (st.mi < st.i_hi) { dst = p0_load(st.d, st.T - st.base, tid, r, g); have = true; } st.T += st.stride; } while (0)
constexpr int P0_TST = 272;
#define P0_WRITE(S, r, g, dst) do { \
        _Pragma("unroll") for (int p = 0; p < 8; ++p) { f32x4 v_ = r[p] * g[p]; \
            if (dst.f8) { v_[0] = pg8::c8(v_[0]); v_[1] = pg8::c8(v_[1]); v_[2] = pg8::c8(v_[2]); v_[3] = pg8::c8(v_[3]); } \
            v2u w_; w_.x = pg8::cvt_pk_bf16(v_[0], v_[1]); w_.y = pg8::cvt_pk_bf16(v_[2], v_[3]); \
            *(LAS v2u*)((S) + (p * 16 + (tid >> 5)) * P0_TST + 8 * (tid & 31)) = w_; } \
        } while (0)
#define P0_STORE(S, dst) do { const int w_ = tid >> 6, fr_ = tid & 15, fq_ = (tid >> 4) & 3; \
        LAS const unsigned char* tp_ = (S) + (fr_ >> 2) * P0_TST + (16 * w_ + 4 * (fr_ & 3)) * 2; \
        if (dst.f8) { _Pragma("unroll") for (int kk = 0; kk < 2; ++kk) { const int kb_ = 64 * kk + 16 * fq_; \
            const bf16x8 a0_ = tr_frag(tp_ + kb_ * P0_TST, tp_ + (kb_ + 4) * P0_TST), a1_ = tr_frag(tp_ + (kb_ + 8) * P0_TST, tp_ + (kb_ + 12) * P0_TST); \
            const v4u x0_ = __builtin_bit_cast(v4u, a0_), x1_ = __builtin_bit_cast(v4u, a1_); v4u o; \
            { int q_ = __builtin_amdgcn_cvt_pk_fp8_f32(bflo(x0_.x), bfhi(x0_.x), 0, false); q_ = __builtin_amdgcn_cvt_pk_fp8_f32(bflo(x0_.y), bfhi(x0_.y), q_, true); o.x = (unsigned)q_; } \
            { int q_ = __builtin_amdgcn_cvt_pk_fp8_f32(bflo(x0_.z), bfhi(x0_.z), 0, false); q_ = __builtin_amdgcn_cvt_pk_fp8_f32(bflo(x0_.w), bfhi(x0_.w), q_, true); o.y = (unsigned)q_; } \
            { int q_ = __builtin_amdgcn_cvt_pk_fp8_f32(bflo(x1_.x), bfhi(x1_.x), 0, false); q_ = __builtin_amdgcn_cvt_pk_fp8_f32(bflo(x1_.y), bfhi(x1_.y), q_, true); o.z = (unsigned)q_; } \
            { int q_ = __builtin_amdgcn_cvt_pk_fp8_f32(bflo(x1_.z), bfhi(x1_.z), 0, false); q_ = __builtin_amdgcn_cvt_pk_fp8_f32(bflo(x1_.w), bfhi(x1_.w), q_, true); o.w = (unsigned)q_; } \
            *(v4u*)((unsigned char*)dst.base + (size_t)(16 * w_ + fr_) * dst.K + kb_) = o; } } \
        else { _Pragma("unroll") for (int kk = 0; kk < 4; ++kk) { const int kb_ = 32 * kk + 8 * fq_; \
            const bf16x8 a_ = tr_frag(tp_ + kb_ * P0_TST, tp_ + (kb_ + 4) * P0_TST); \
            *(v4u*)(dst.base + (size_t)(16 * w_ + fr_) * dst.K + kb_) = __builtin_bit_cast(v4u, a_); } } \
        } while (0)
template <class A> DI void p0_convert(Frame& F, const A& P, int i_lo, int i_hi, int worker, int nworkers) {
    LAS unsigned char* S = F.lds;
    const int tid = F.tid;
    P0State st; p0_init(st, F, P, i_lo, i_hi, worker, nworkers);
    f32x4 rA[8], rB[8]; float gA[8], gB[8]; P0Dst dA, dB; dA.base = nullptr; dA.K = 0; dA.f8 = 0; dB = dA; bool hA = false, hB = false;
    P0_NEXT(st, rA, gA, dA, hA);
    while (hA) {
        P0_NEXT(st, rB, gB, dB, hB);
        P0_WRITE(S, rA, gA, dA); __syncthreads(); P0_STORE(S, dA); __syncthreads();
        if (!hB) break;
        P0_NEXT(st, rA, gA, dA, hA);
        P0_WRITE(S, rB, gB, dB); __syncthreads(); P0_STORE(S, dB); __syncthreads();
    }
}
template <class A> DI void p0_prologue(Frame& F, const A& P) {
    const int gw = F.vcu * NWAVES + F.wave, NGW = F.G * NWAVES;
    { const float* x = P.in[0]; bf16* xb = wsp<bf16>(F, WS_XB); float* ssq = wsp<float>(F, WS_SSQ);
      for (int m = gw; m < M; m += NGW) {
        const f32x4* xr = (const f32x4*)(x + (size_t)m * D) + F.lane; f32x4 v[4]; float s = 0.f;
#pragma unroll
        for (int j = 0; j < 4; ++j) { v[j] = xr[64 * j]; s += (v[j][0] * v[j][0] + v[j][1] * v[j][1]) + (v[j][2] * v[j][2] + v[j][3] * v[j][3]); }
        s = wave_sum(s);
        v2u* o8 = (v2u*)(xb + (size_t)m * D) + F.lane;
#pragma unroll
        for (int j = 0; j < 4; ++j) { v2u w; w.x = pk2(v[j][0], v[j][1]); w.y = pk2(v[j][2], v[j][3]); o8[64 * j] = w; }
        if (F.lane < 4) { f32x4 z = {0.f, 0.f, 0.f, 0.f}; if (F.lane == 0) z[0] = s; *((f32x4*)(ssq + (size_t)m * 16) + F.lane) = z; }
      } }
    p0_convert(F, P, 0, N_EARLY, F.vcu, F.G);
}

constexpr int TH_ST = 2064, TH_WL = 16 * TH_ST;
template <int NOUT> DI void thin_stage(Frame& F, const float* gain, const float* W, int ldw, int c0) {
    LAS unsigned char* lds = F.lds;
    const int n = F.tid & 15;
#pragma unroll 1
    for (int ib = 0; ib < 4; ++ib) { float wv[8], gv[8];
#pragma unroll
        for (int j = 0; j < 8; ++j) { const int k = (F.tid >> 4) + 32 * (8 * ib + j); gv[j] = gain[k]; wv[j] = (n < NOUT) ? W[(size_t)k * ldw + c0 + n] : 0.f; }
#pragma unroll
        for (int j = 0; j < 8; ++j) { const int k = (F.tid >> 4) + 32 * (8 * ib + j); const float v = gv[j] * wv[j];
            const unsigned hi = f2bf(v); const float r = v - __builtin_bit_cast(float, hi << 16);
            *(LAS unsigned short*)(lds + n * TH_ST + k * 2) = (unsigned short)hi; *(LAS unsigned short*)(lds + TH_WL + n * TH_ST + k * 2) = (unsigned short)f2bf(r); } }
    __syncthreads();
}
DI void thin_tile(const bf16* x, int row0, LAS const unsigned char* lds, int lane, float& ss, f32x4& out) {
    const int fr = lane & 15, fq = lane >> 4; const bf16* xr = x + (size_t)(row0 + fr) * D + 8 * fq; LAS const unsigned char* wp = lds + fr * TH_ST + 16 * fq;
    f32x4 acc = {0.f, 0.f, 0.f, 0.f}; float s = 0.f;
#pragma unroll 1
    for (int kb = 0; kb < 4; ++kb) { v4u a[8];
#pragma unroll
        for (int i = 0; i < 8; ++i) a[i] = *(const v4u*)(xr + 32 * (8 * kb + i));
#pragma unroll
        for (int i = 0; i < 8; ++i) { const v4u q = a[i];
            s += (bflo(q.x) * bflo(q.x) + bfhi(q.x) * bfhi(q.x)) + (bflo(q.y) * bflo(q.y) + bfhi(q.y) * bfhi(q.y)) + (bflo(q.z) * bflo(q.z) + bfhi(q.z) * bfhi(q.z)) + (bflo(q.w) * bflo(q.w) + bfhi(q.w) * bfhi(q.w));
            const bf16x8 xa = __builtin_bit_cast(bf16x8, q); const bf16x8 wh = ldsfrag(wp + 64 * (8 * kb + i)), wl = ldsfrag(wp + TH_WL + 64 * (8 * kb + i));
            acc = MFMA16(wh, xa, acc); acc = MFMA16(wl, xa, acc); } }
    s += __shfl_xor(s, 16); s += __shfl_xor(s, 32);
    ss = s; out = acc;
}
DI void glow_phase(Frame& F, const bf16* x, const float* gain, const float* Wb) {
    thin_stage<16>(F, gain, Wb, 3088, 3072);
    float* glow = wsp<float>(F, WS_GLOW);
    const int gw = F.vcu * NWAVES + F.wave, NGW = F.G * NWAVES, fr = F.lane & 15, fq = F.lane >> 4;
    for (int t = gw; t < M / 16; t += NGW) { float ss; f32x4 o; thin_tile(x, 16 * t, F.lds, F.lane, ss, o);
        const float rs = 1.0f / sqrtf(ss * (1.0f / D) + EPS);
        *(f32x4*)(glow + (size_t)(16 * t + fr) * 16 + 4 * fq) = o * rs; }
    __syncthreads();
}
DI void logf_phase(Frame& F, const bf16* x, const float* gain, const float* Wc, const float* fb) {
    thin_stage<8>(F, gain, Wc, 3080, 3072);
    float* logf = wsp<float>(F, WS_LOGF);
    const int gw = F.vcu * NWAVES + F.wave, NGW = F.G * NWAVES, fr = F.lane & 15, fq = F.lane >> 4;
    const f32x4 fb4 = *(const f32x4*)(fb + 4 * (fq & 1));
    for (int t = gw; t < M / 16; t += NGW) { float ss; f32x4 o; thin_tile(x, 16 * t, F.lds, F.lane, ss, o);
        const float rs = 1.0f / sqrtf(ss * (1.0f / D) + EPS);
        if (fq < 2) { f32x4 r;
#pragma unroll
            for (int e = 0; e < 4; ++e) r[e] = logsig(o[e] * rs + fb4[e]);
            *(f32x4*)(logf + (size_t)(16 * t + fr) * 8 + 4 * fq) = r; } }
    __syncthreads();
}
DI void router_phase(Frame& F, const bf16* x, const float* gain, const float* Wr, unsigned* gcnt) {
    thin_stage<8>(F, gain, Wr, 8, 0);
    LAS unsigned* lcnt = (LAS unsigned*)(F.lds + 2 * TH_WL);
    if (F.tid < 8) lcnt[F.tid] = 0u;
    __syncthreads();
    int* tok_e = wsp<int>(F, WS_TOKE); int* tok_p = wsp<int>(F, WS_TOKP); float* tok_g = wsp<float>(F, WS_TOKG); float* tok_rs = wsp<float>(F, WS_TOKRS); int* blkb = wsp<int>(F, WS_BLKB);
    const int gw = F.vcu * NWAVES + F.wave, NGW = F.G * NWAVES, fr = F.lane & 15, fq = F.lane >> 4;
    for (int t = gw; t < M / 16; t += NGW) { float ss; f32x4 o; thin_tile(x, 16 * t, F.lds, F.lane, ss, o);
        const float rs = 1.0f / sqrtf(ss * (1.0f / D) + EPS);
        f32x4 o2; o2[0] = __shfl_xor(o[0], 16); o2[1] = __shfl_xor(o[1], 16); o2[2] = __shfl_xor(o[2], 16); o2[3] = __shfl_xor(o[3], 16);
        if (fq == 0) { const int row = 16 * t + fr;
            const float lg[8] = {o[0] * rs, o[1] * rs, o[2] * rs, o[3] * rs, o2[0] * rs, o2[1] * rs, o2[2] * rs, o2[3] * rs};
            float v1 = lg[0]; int i1 = 0;
#pragma unroll
            for (int e = 1; e < 8; ++e) { if (lg[e] > v1) { v1 = lg[e]; i1 = e; } }
            float v2 = -3.0e38f; int i2 = 0;
#pragma unroll
            for (int e = 0; e < 8; ++e) { if (e != i1 && lg[e] > v2) { v2 = lg[e]; i2 = e; } }
            const float g1 = 1.0f / (1.0f + __expf(v2 - v1)), g2 = 1.0f - g1;
            const unsigned p1 = __hip_atomic_fetch_add(lcnt + i1, 1u, __ATOMIC_RELAXED, __HIP_MEMORY_SCOPE_WORKGROUP);
            const unsigned p2 = __hip_atomic_fetch_add(lcnt + i2, 1u, __ATOMIC_RELAXED, __HIP_MEMORY_SCOPE_WORKGROUP);
            tok_e[2 * row] = i1; tok_e[2 * row + 1] = i2; tok_p[2 * row] = (int)p1; tok_p[2 * row + 1] = (int)p2; tok_g[2 * row] = g1; tok_g[2 * row + 1] = g2; tok_rs[row] = rs; } }
    __syncthreads();
    if (F.tid < 8) { const unsigned b = __hip_atomic_fetch_add(gcnt + F.tid, lcnt[F.tid], __ATOMIC_RELAXED, __HIP_MEMORY_SCOPE_AGENT); blkb[F.vcu * 8 + F.tid] = (int)b; }
    __syncthreads();
}
template <bool F8> DI void gather_phase(Frame& F, const unsigned* gcnt) {
    LAS int* seg = (LAS int*)(F.lds); LAS int* cntl = seg + 16;
    if (F.tid == 0) { int t = 0; for (int e = 0; e < 8; ++e) { const int c = (int)gcnt[e]; seg[e] = t; cntl[e] = c; t += (c + 255) & ~255; } seg[8] = t; }
    __syncthreads();
    const int* tok_e = wsp<int>(F, WS_TOKE); const int* tok_p = wsp<int>(F, WS_TOKP); const float* tok_g = wsp<float>(F, WS_TOKG); const float* tok_rs = wsp<float>(F, WS_TOKRS); const int* blkb = wsp<int>(F, WS_BLKB);
    int* rtok = wsp<int>(F, WS_ROWT); float* rgate = wsp<float>(F, WS_ROWG); float* rrs = wsp<float>(F, WS_ROWRS);
    const bf16* xb = wsp<bf16>(F, WS_XB); bf16* XS = wsp<bf16>(F, WS_XS);
    const int gw = F.vcu * NWAVES + F.wave, NGW = F.G * NWAVES;
    for (int row = gw; row < M; row += NGW) { const int owner = ((row >> 4) % NGW) / NWAVES;
        const v4u* src = (const v4u*)(xb + (size_t)row * D); v4u a, b;
        if constexpr (F8) { a = src[2 * F.lane]; b = src[2 * F.lane + 1];
            int w0 = __builtin_amdgcn_cvt_pk_fp8_f32(pg8::c8(bflo(a.x)), pg8::c8(bfhi(a.x)), 0, false); w0 = __builtin_amdgcn_cvt_pk_fp8_f32(pg8::c8(bflo(a.y)), pg8::c8(bfhi(a.y)), w0, true); int w1 = __builtin_amdgcn_cvt_pk_fp8_f32(pg8::c8(bflo(a.z)), pg8::c8(bfhi(a.z)), 0, false); w1 = __builtin_amdgcn_cvt_pk_fp8_f32(pg8::c8(bflo(a.w)), pg8::c8(bfhi(a.w)), w1, true);
            int w2 = __builtin_amdgcn_cvt_pk_fp8_f32(pg8::c8(bflo(b.x)), pg8::c8(bfhi(b.x)), 0, false); w2 = __builtin_amdgcn_cvt_pk_fp8_f32(pg8::c8(bflo(b.y)), pg8::c8(bfhi(b.y)), w2, true); int w3 = __builtin_amdgcn_cvt_pk_fp8_f32(pg8::c8(bflo(b.z)), pg8::c8(bfhi(b.z)), 0, false); w3 = __builtin_amdgcn_cvt_pk_fp8_f32(pg8::c8(bflo(b.w)), pg8::c8(bfhi(b.w)), w3, true);
            a = (v4u){(unsigned)w0, (unsigned)w1, (unsigned)w2, (unsigned)w3}; b = a; }
        else { a = src[F.lane]; b = src[64 + F.lane]; }
#pragma unroll
        for (int slot = 0; slot < 2; ++slot) { const int e = tok_e[2 * row + slot]; const int r = seg[e] + blkb[owner * 8 + e] + tok_p[2 * row + slot];
            if constexpr (F8) { *((v4u*)((unsigned char*)XS + (size_t)r * D) + F.lane) = a; }
            else { v4u* dst = (v4u*)(XS + (size_t)r * D); dst[F.lane] = a; dst[64 + F.lane] = b; }
            if (F.lane == 0) { rtok[r] = 2 * row + slot; rgate[r] = tok_g[2 * row + slot]; rrs[r] = tok_rs[row]; } } }
    if (F.vcu == 0) { for (int e = 0; e < 8; ++e) for (int r = seg[e] + cntl[e] + F.tid; r < seg[e + 1]; r += NWAVES * 64) rtok[r] = -1; }
    __syncthreads();
}
DI void rowtable_phase(Frame& F, const unsigned* gcnt) {
    LAS int* seg = (LAS int*)(F.lds); LAS int* cntl = seg + 16;
    if (F.tid == 0) { int t = 0; for (int e = 0; e < 8; ++e) { const int c = (int)gcnt[e]; seg[e] = t; cntl[e] = c; t += (c + 255) & ~255; } seg[8] = t; }
    __syncthreads();
    const int* tok_e = wsp<int>(F, WS_TOKE); const int* tok_p = wsp<int>(F, WS_TOKP); const float* tok_g = wsp<float>(F, WS_TOKG); const float* tok_rs = wsp<float>(F, WS_TOKRS); const int* blkb = wsp<int>(F, WS_BLKB);
    int* rtok = wsp<int>(F, WS_ROWT); float* rgate = wsp<float>(F, WS_ROWG); float* rrs = wsp<float>(F, WS_ROWRS);
    const int NGW = F.G * NWAVES;
    for (int j = F.vcu * (NWAVES * 64) + F.tid; j < 2 * M; j += F.G * NWAVES * 64) { const int row = j >> 1, owner = ((row >> 4) % NGW) / NWAVES;
        const int e = tok_e[j]; const int r = seg[e] + blkb[owner * 8 + e] + tok_p[j];
        rtok[r] = j; rgate[r] = tok_g[j]; rrs[r] = tok_rs[row]; }
    if (F.vcu == 0) { for (int e = 0; e < 8; ++e) for (int r = seg[e] + cntl[e] + F.tid; r < seg[e + 1]; r += NWAVES * 64) rtok[r] = -1; }
    __syncthreads();
}
DI void combine_phase(Frame& F, bool fin, const float* fg, unsigned char* x8) {
    bf16* xb = wsp<bf16>(F, WS_XB); float* ssq = wsp<float>(F, WS_SSQ); const bf16* OS = wsp<bf16>(F, WS_OS);
    const int gw = F.vcu * NWAVES + F.wave, NGW = F.G * NWAVES;
    constexpr int RB = 2;
    for (int m0 = gw; m0 < M; m0 += RB * NGW) {
        v2u cx[RB][4], ca[RB][4], cb[RB][4];
#pragma unroll
        for (int i = 0; i < RB; ++i) { const int r_ = m0 + i * NGW, m = ((r_ & 2047) >> 8) * 4096 + (r_ & 255) + 256 * (r_ >> 11); if (r_ < M) {
                const v2u* xr = (const v2u*)(xb + (size_t)m * D) + F.lane; const v2u* o0 = (const v2u*)(OS + (size_t)m * D) + F.lane; const v2u* o1 = (const v2u*)(OS + ((size_t)M + m) * D) + F.lane;
#pragma unroll
                for (int j = 0; j < 4; ++j) { cx[i][j] = xr[64 * j]; ca[i][j] = o0[64 * j]; cb[i][j] = o1[64 * j]; } } }
#pragma unroll
        for (int i = 0; i < RB; ++i) { const int r_ = m0 + i * NGW, m = ((r_ & 2047) >> 8) * 4096 + (r_ & 255) + 256 * (r_ >> 11); if (r_ < M) {
        f32x4 v[4]; float s = 0.f;
#pragma unroll
        for (int j = 0; j < 4; ++j) { const v2u c = cx[i][j], a = ca[i][j], b = cb[i][j];
            v[j][0] = bflo(c.x) + (bflo(a.x) + bflo(b.x)); v[j][1] = bfhi(c.x) + (bfhi(a.x) + bfhi(b.x)); v[j][2] = bflo(c.y) + (bflo(a.y) + bflo(b.y)); v[j][3] = bfhi(c.y) + (bfhi(a.y) + bfhi(b.y));
            s += (v[j][0] * v[j][0] + v[j][1] * v[j][1]) + (v[j][2] * v[j][2] + v[j][3] * v[j][3]); }
        s = wave_sum(s);
        if (!fin) {
            v2u* o8 = (v2u*)(xb + (size_t)m * D) + F.lane;
#pragma unroll
            for (int j = 0; j < 4; ++j) { v2u w; w.x = pk2(v[j][0], v[j][1]); w.y = pk2(v[j][2], v[j][3]); o8[64 * j] = w; }
            if (x8) {
#pragma unroll
                for (int j = 0; j < 4; ++j) { int p = __builtin_amdgcn_cvt_pk_fp8_f32(pg8::c8(v[j][0]), pg8::c8(v[j][1]), 0, false); p = __builtin_amdgcn_cvt_pk_fp8_f32(pg8::c8(v[j][2]), pg8::c8(v[j][3]), p, true); *((unsigned*)(x8 + (size_t)m * D) + F.lane + 64 * j) = (unsigned)p; } }
            if (F.lane < 4) { f32x4 z = {0.f, 0.f, 0.f, 0.f}; if (F.lane == 0) z[0] = s; *((f32x4*)(ssq + (size_t)m * 16) + F.lane) = z; }
        } else {
            const float rs = 1.0f / sqrtf(s * (1.0f / D) + EPS); f32x4* ow = (f32x4*)(F.out + (size_t)m * D) + F.lane; const f32x4* g4 = (const f32x4*)fg + F.lane;
#pragma unroll
            for (int j = 0; j < 4; ++j) { const f32x4 g = g4[64 * j]; ow[64 * j] = v[j] * rs * g; }
        } } }
    }
}
DI void final_norm_phase(Frame& F, const bf16* x, const float* fg) {
    const int gw = F.vcu * NWAVES + F.wave, NGW = F.G * NWAVES;
    for (int m = gw; m < M; m += NGW) {
        const v2u* xr = (const v2u*)(x + (size_t)m * D) + F.lane; f32x4 v[4]; float s = 0.f;
#pragma unroll
        for (int j = 0; j < 4; ++j) { const v2u c = xr[64 * j]; v[j] = (f32x4){bflo(c.x), bfhi(c.x), bflo(c.y), bfhi(c.y)}; s += (v[j][0] * v[j][0] + v[j][1] * v[j][1]) + (v[j][2] * v[j][2] + v[j][3] * v[j][3]); }
        s = wave_sum(s);
        const float rs = 1.0f / sqrtf(s * (1.0f / D) + EPS); f32x4* ow = (f32x4*)(F.out + (size_t)m * D) + F.lane; const f32x4* g4 = (const f32x4*)fg + F.lane;
#pragma unroll
        for (int j = 0; j < 4; ++j) { const f32x4 g = g4[64 * j]; ow[64 * j] = v[j] * rs * g; }
    }
}


typedef __amdgpu_buffer_rsrc_t brsrc;
DI brsrc mk_rsrc(const void* p, unsigned bytes) { return __builtin_amdgcn_make_buffer_rsrc((void*)p, 0, bytes, 0x00020000); }
DI v4u bld128(brsrc r, unsigned voff, unsigned soff) { return __builtin_bit_cast(v4u, __builtin_amdgcn_raw_buffer_load_b128(r, voff, soff, 0)); }
DI v2u bld64(brsrc r, unsigned voff, unsigned soff) { return __builtin_bit_cast(v2u, __builtin_amdgcn_raw_buffer_load_b64(r, voff, soff, 0)); }
DI void bst64(brsrc r, unsigned voff, unsigned soff, v2u v) { __builtin_amdgcn_raw_buffer_store_b64(v, r, voff, soff, 0); }

template <bool Y8> DI void mix_phase(Frame& F, const float* ws_, const float* bs, const float* vg) {
    constexpr int WT_OFF = 0, WT_ST = 272, V_OFF = 34816, V_ST = 544, RS_OFF = 104448, BS_OFF = 105472, VG_OFF = 109568;
    const bf16* U = wsp<bf16>(F, WS_U); const bf16* V = wsp<bf16>(F, WS_V); bf16* Y = wsp<bf16>(F, WS_Y); const float* vssq = wsp<float>(F, WS_VSSQ);
    LAS unsigned char* lds = F.lds; LAS float* rsv = (LAS float*)(lds + RS_OFF); LAS float* bsl = (LAS float*)(lds + BS_OFF); LAS float* vgl = (LAS float*)(lds + VG_OFF);
    { const f32x4 b4 = (F.tid < 256) ? *(const f32x4*)(bs + 4 * F.tid) : (f32x4){0.f, 0.f, 0.f, 0.f}; const f32x4 g4 = *(const f32x4*)(vg + 4 * F.tid);
      if (F.tid < 256) *(LAS f32x4*)(bsl + 4 * F.tid) = b4; *(LAS f32x4*)(vgl + 4 * F.tid) = g4; }
    const int tid = F.tid, lane = F.lane, w = F.wave, fr = lane & 15, fq = lane >> 4;
    const int wfo = WT_OFF + fr * WT_ST + fq * 8;
    const int vfo = V_OFF + (4 * fq + (fr >> 2)) * V_ST + (32 * w + 4 * (fr & 3)) * 2;
    const brsrc rW = mk_rsrc(ws_, 8u * 128 * 128 * 4), rV = mk_rsrc(V, (unsigned)M * AW * 2), rU = mk_rsrc(U, (unsigned)M * AW * 2), rY = mk_rsrc(Y, (unsigned)M * AW * 2);
    const unsigned ulo8 = (unsigned)(fr * AW + 32 * w + 4 * fq);
    for (int c = F.vcu; c < 256; c += F.G) {
        const int tok0 = c * 128;
        if (tid < 128) { const f32x4* p = (const f32x4*)(vssq + (size_t)(tok0 + tid) * 32); float s = 0.f;
#pragma unroll
            for (int q = 0; q < 8; ++q) { const f32x4 a = p[q]; s += (a[0] + a[1]) + (a[2] + a[3]); }
            rsv[tid] = 1.0f / sqrtf(s * (1.0f / AW) + EPS); }
        f32x4 wreg[8]; v4u vreg[8];
        const unsigned wlo = (unsigned)((tid >> 5) * 512 + (tid & 31) * 16), vlo = (unsigned)((tid >> 5) * (AW * 2) + (tid & 31) * 16);
#define MIX_LOAD(gg) do { const unsigned ws_o = (unsigned)(gg) * 65536u, vs_o = (unsigned)tok0 * (AW * 2) + (unsigned)(gg) * 512u; \
            _Pragma("unroll") for (int it = 0; it < 8; ++it) { wreg[it] = __builtin_bit_cast(f32x4, bld128(rW, wlo, ws_o + (unsigned)(it * 16 * 512))); vreg[it] = bld128(rV, vlo, vs_o + (unsigned)(it * 16 * AW * 2)); } } while (0)
        MIX_LOAD(0);
        __syncthreads();
#pragma unroll 1
        for (int g = 0; g < 8; ++g) {
            const unsigned us_o = (unsigned)tok0 * (AW * 2) + (unsigned)g * 512u;
            const unsigned ulo = (unsigned)(fr * (AW * 2) + (32 * w + 4 * fq) * 2);
            v2u ureg[2][4][2];
#pragma unroll
            for (int hf = 0; hf < 2; ++hf)
#pragma unroll
                for (int m4 = 0; m4 < 4; ++m4)
#pragma unroll
                    for (int n2 = 0; n2 < 2; ++n2) ureg[hf][m4][n2] = bld64(rU, ulo, us_o + (unsigned)((16 * (4 * hf + m4)) * AW * 2 + 32 * n2));
#pragma unroll
            for (int it = 0; it < 8; ++it) { const int idx = it * 512 + tid, t = idx >> 5, s4 = (idx & 31) * 4; const f32x4 wv = wreg[it];
                const float a0 = (s4 + 0 <= t) ? wv[0] * rsv[s4 + 0] : 0.f, a1 = (s4 + 1 <= t) ? wv[1] * rsv[s4 + 1] : 0.f, a2 = (s4 + 2 <= t) ? wv[2] * rsv[s4 + 2] : 0.f, a3 = (s4 + 3 <= t) ? wv[3] * rsv[s4 + 3] : 0.f;
                v2u o; o.x = pk2(a0, a1); o.y = pk2(a2, a3); *(LAS v2u*)(lds + WT_OFF + t * WT_ST + s4 * 2) = o;
                *(LAS v4u*)(lds + V_OFF + (idx >> 5) * V_ST + (idx & 31) * 16) = vreg[it]; }
            __syncthreads();
            if (g + 1 < 8) MIX_LOAD(g + 1);
#pragma unroll
            for (int hf = 0; hf < 2; ++hf) {
                f32x4 acc[4][2];
#pragma unroll
                for (int m4 = 0; m4 < 4; ++m4) { acc[m4][0] = (f32x4){0.f, 0.f, 0.f, 0.f}; acc[m4][1] = (f32x4){0.f, 0.f, 0.f, 0.f}; }
#pragma unroll
                for (int ks = 0; ks < 4; ++ks) { if (32 * ks > 16 * (4 * hf + 3) + 15) continue;
                    const bf16x8 b0 = tr_frag(lds + vfo + (32 * ks) * V_ST, lds + vfo + (32 * ks + 16) * V_ST), b1 = tr_frag(lds + vfo + (32 * ks) * V_ST + 32, lds + vfo + (32 * ks + 16) * V_ST + 32);
#pragma unroll
                    for (int m4 = 0; m4 < 4; ++m4) { const int mt = 4 * hf + m4; if (32 * ks > 16 * mt + 15) continue;
                        const v2u lo = *(const LAS v2u*)(lds + wfo + mt * 16 * WT_ST + ks * 64), hi = *(const LAS v2u*)(lds + wfo + mt * 16 * WT_ST + ks * 64 + 32);
                        const v4u av = {lo.x, lo.y, hi.x, hi.y}; const bf16x8 a = __builtin_bit_cast(bf16x8, av);
                        acc[m4][0] = MFMA16(b0, a, acc[m4][0]); acc[m4][1] = MFMA16(b1, a, acc[m4][1]); }
                    __builtin_amdgcn_sched_barrier(0); }
#pragma unroll
                for (int m4 = 0; m4 < 4; ++m4) { const int t = 16 * (4 * hf + m4) + fr; const float bt = bsl[g * 128 + t];
#pragma unroll
                    for (int n2 = 0; n2 < 2; ++n2) { const int col = g * 256 + 32 * w + 16 * n2 + 4 * fq;
                        const v2u uu = ureg[hf][m4][n2]; const f32x4 gg = *(const LAS f32x4*)(vgl + col); const f32x4 a = acc[m4][n2];
                        v2u r; r.x = pk2(bflo(uu.x) * (a[0] * gg[0] + bt), bfhi(uu.x) * (a[1] * gg[1] + bt)); r.y = pk2(bflo(uu.y) * (a[2] * gg[2] + bt), bfhi(uu.y) * (a[3] * gg[3] + bt));
                        if constexpr (Y8) { int p8 = __builtin_amdgcn_cvt_pk_fp8_f32(pg8::c8(4.0f * bflo(uu.x) * (a[0] * gg[0] + bt)), pg8::c8(4.0f * bfhi(uu.x) * (a[1] * gg[1] + bt)), 0, false);
                            p8 = __builtin_amdgcn_cvt_pk_fp8_f32(pg8::c8(4.0f * bflo(uu.y) * (a[2] * gg[2] + bt)), pg8::c8(4.0f * bfhi(uu.y) * (a[3] * gg[3] + bt)), p8, true);
                            __builtin_amdgcn_raw_buffer_store_b32((unsigned)p8, rY, ulo8, (unsigned)tok0 * AW + (unsigned)g * 256u + (unsigned)((16 * (4 * hf + m4)) * AW + 16 * n2), 0); }
                        else bst64(rY, ulo, us_o + (unsigned)((16 * (4 * hf + m4)) * AW * 2 + 32 * n2), r); }
                    __builtin_amdgcn_sched_barrier(0); }
            }
            __syncthreads();
        }
#undef MIX_LOAD
    }
}

DI void gla_prep_phase(Frame& F, const float* wg2, const float* gb) {
    constexpr int GL_OFF = 0, SEG_OFF = 4096, OFFS_OFF = 6144, EBL_OFF = 8192, BC_OFF = 8704, KETL_OFF = 41472, VTL_OFF = 59904, TST = 144;
    const bf16* QKVR = wsp<bf16>(F, WS_QKVR); const float* glow = wsp<float>(F, WS_GLOW);
    bf16* QD = wsp<bf16>(F, WS_QD); bf16* KD = wsp<bf16>(F, WS_KD); bf16* KET = wsp<bf16>(F, WS_KET); bf16* VT = wsp<bf16>(F, WS_VT); float* DEC = wsp<float>(F, WS_DEC);
    LAS unsigned char* lds = F.lds;
    LAS float* gl = (LAS float*)(lds + GL_OFF); LAS float* segs = (LAS float*)(lds + SEG_OFF); LAS float* offs = (LAS float*)(lds + OFFS_OFF); LAS float* ebl = (LAS float*)(lds + EBL_OFF); LAS float* bcl = (LAS float*)(lds + BC_OFF);
    const int tid = F.tid;
    const int t2 = tid >> 3, kb = (tid & 7) * 16, dvb = (tid & 7) * 32, k = tid & 127, tq = tid >> 7;
    float wv[16]; float bias = 0.f; int hcur = -1;
    v4u q0, q1, k0, k1, vv[4]; f32x4 gv = {0.f, 0.f, 0.f, 0.f};
#define PREP_LOAD(uu) do { const int h_ = (uu) & 3, n_ = ((uu) >> 2) & 63, b_ = (uu) >> 8; const int t0_ = b_ * SEQ + n_ * 64; const bf16* rowp = QKVR + (size_t)(t0_ + t2) * 3072; \
        q0 = *(const v4u*)(rowp + h_ * 128 + kb); q1 = *(const v4u*)(rowp + h_ * 128 + kb + 8); k0 = *(const v4u*)(rowp + 512 + h_ * 128 + kb); k1 = *(const v4u*)(rowp + 512 + h_ * 128 + kb + 8); \
        _Pragma("unroll") for (int i = 0; i < 4; ++i) vv[i] = *(const v4u*)(rowp + 1024 + h_ * 256 + dvb + 8 * i); \
        if (tid < 256) gv = *((const f32x4*)(glow + (size_t)t0_ * 16) + tid); } while (0)
#define PREP_MAP(s) ((((s) & 255) >> 5) * 256 + ((s) & 31) + 32 * ((s) >> 8))
    if (F.vcu < 2048) PREP_LOAD(PREP_MAP(F.vcu));
    for (int sidx = F.vcu; sidx < 2048; sidx += F.G) { const int uidx = PREP_MAP(sidx);
        const int h = uidx & 3, n = (uidx >> 2) & 63, b = uidx >> 8; const int t0 = b * SEQ + n * 64; const int bhn = (b * 4 + h) * 64 + n;
        if (h != hcur) { hcur = h;
#pragma unroll
            for (int r = 0; r < 16; ++r) wv[r] = wg2[r * 512 + h * 128 + k];
            bias = gb[h * 128 + k]; }
        if (tid < 256) *((LAS f32x4*)gl + tid) = gv;
        __syncthreads();
        { float cum = 0.f;
#pragma unroll
          for (int i = 0; i < 16; ++i) { const LAS f32x4* gp = (const LAS f32x4*)(gl + (tq * 16 + i) * 16); float z = bias;
#pragma unroll
              for (int q = 0; q < 4; ++q) { const f32x4 g4 = gp[q]; z += g4[0] * wv[4 * q] + g4[1] * wv[4 * q + 1] + g4[2] * wv[4 * q + 2] + g4[3] * wv[4 * q + 3]; }
              cum += (fminf(z, 0.f) - __logf(1.0f + __expf(-fabsf(z)))) * (1.0f / 16.0f); bcl[(tq * 16 + i) * 128 + k] = cum; }
          segs[tq * 128 + k] = cum; }
        __syncthreads();
        if (tid < 128) { const float s0 = segs[tid], s1 = segs[128 + tid], s2 = segs[256 + tid], s3 = segs[384 + tid];
            offs[tid] = 0.f; offs[128 + tid] = s0; offs[256 + tid] = s0 + s1; offs[384 + tid] = (s0 + s1) + s2;
            const float eb = __expf(((s0 + s1) + s2) + s3); ebl[tid] = eb; DEC[(size_t)bhn * 128 + tid] = eb; }
        __syncthreads();
        { const int tq2 = t2 >> 4; unsigned qo[8], ko[8]; const unsigned qw[8] = {q0.x, q0.y, q0.z, q0.w, q1.x, q1.y, q1.z, q1.w}, kw[8] = {k0.x, k0.y, k0.z, k0.w, k1.x, k1.y, k1.z, k1.w};
          LAS unsigned short* kt = (LAS unsigned short*)(lds + KETL_OFF); const int rot = ((t2 * 2 + 16 * (tid & 7)) & 127) >> 1;
#pragma unroll
          for (int e = 0; e < 16; e += 2) { float qd2[2], kd2[2];
#pragma unroll
              for (int u = 0; u < 2; ++u) { const int kk = kb + e + u; const float bcum = bcl[t2 * 128 + kk] + offs[tq2 * 128 + kk];
                  const float e1 = __expf(bcum), e2 = __builtin_amdgcn_rcpf(e1);
                  const float qv = u ? bfhi(qw[e >> 1]) : bflo(qw[e >> 1]), kv = u ? bfhi(kw[e >> 1]) : bflo(kw[e >> 1]);
                  qd2[u] = qv * 0.08838834764831845f * e1; kd2[u] = kv * e2;
                  kt[kk * (TST / 2) + rot] = (unsigned short)f2bf(kv * e2 * ebl[kk]); }
              qo[e >> 1] = pk2(qd2[0], qd2[1]); ko[e >> 1] = pk2(kd2[0], kd2[1]); }
          bf16* qdp = QD + (size_t)(t0 + t2) * 512 + h * 128 + kb; bf16* kdp = KD + (size_t)(t0 + t2) * 512 + h * 128 + kb;
          { v4u a = {qo[0], qo[1], qo[2], qo[3]}, c = {qo[4], qo[5], qo[6], qo[7]}; *(v4u*)qdp = a; *(v4u*)(qdp + 8) = c; }
          { v4u a = {ko[0], ko[1], ko[2], ko[3]}, c = {ko[4], ko[5], ko[6], ko[7]}; *(v4u*)kdp = a; *(v4u*)(kdp + 8) = c; }
          LAS unsigned short* vt = (LAS unsigned short*)(lds + VTL_OFF);
#pragma unroll
          for (int i = 0; i < 4; ++i) { const unsigned w4[4] = {vv[i].x, vv[i].y, vv[i].z, vv[i].w};
#pragma unroll
              for (int e = 0; e < 4; ++e) { const int dv = dvb + 8 * i + 2 * e; vt[dv * (TST / 2) + rot] = (unsigned short)(w4[e] & 0xffffu); vt[(dv + 1) * (TST / 2) + rot] = (unsigned short)(w4[e] >> 16); } } }
        if (sidx + F.G < 2048) PREP_LOAD(PREP_MAP(sidx + F.G));
        __syncthreads();
#pragma unroll
        for (int i = 0; i < 2; ++i) { const int c = tid + 512 * i, r = c >> 3, ch = c & 7;
            *(v4u*)(KET + ((size_t)bhn * 128 + r) * 64 + ch * 8) = *(const LAS v4u*)(lds + KETL_OFF + r * TST + (((ch + (r >> 4)) & 7) * 16)); }
#pragma unroll
        for (int i = 0; i < 4; ++i) { const int c = tid + 512 * i, r = c >> 3, ch = c & 7;
            *(v4u*)(VT + ((size_t)bhn * 256 + r) * 64 + ch * 8) = *(const LAS v4u*)(lds + VTL_OFF + r * TST + (((ch + (r >> 5)) & 7) * 16)); }
        __syncthreads();
    }
#undef PREP_LOAD
#undef PREP_MAP
}

template <class A> DI void gla_scan_phase(Frame& F, const A& P) {
    constexpr int QD_OFF = 0, KD_OFF = 17408, KET_OFF = 34816, VT_OFF = 53248, ATT_OFF = 57856, ST_OFF = 67072, ST272 = 272, ST144 = 144;
    const bf16* QD = wsp<bf16>(F, WS_QD); const bf16* KD = wsp<bf16>(F, WS_KD); const bf16* KET = wsp<bf16>(F, WS_KET); const bf16* VT = wsp<bf16>(F, WS_VT); const float* DEC = wsp<float>(F, WS_DEC);
    bf16* GO = wsp<bf16>(F, WS_GO); float* ossq = wsp<float>(F, WS_OSSQ);
    LAS unsigned char* lds = F.lds;
    const int tid = F.tid, lane = F.lane, w = F.wave, fr = lane & 15, fq = lane >> 4;
    LAS unsigned char* SC = lds + 76800;
    P0State cst; p0_init(cst, F, P, N_EARLY, NMATS, F.vcu, F.G);
    f32x4 rC[8]; float gC[8]; P0Dst dC; dC.base = nullptr; dC.K = 0; dC.f8 = 0; bool hC = false;
    P0_NEXT(cst, rC, gC, dC, hC);
    for (int uidx = F.vcu; uidx < 256; uidx += F.G) {
        const int vb = uidx & 7, h = (uidx >> 3) & 3, b = uidx >> 5;
        for (int i = tid; i < (32 * ST272) / 4; i += NWAVES * 64) ((LAS unsigned*)(lds + ST_OFF))[i] = 0u;
        f32x4 st[2] = {(f32x4){0.f, 0.f, 0.f, 0.f}, (f32x4){0.f, 0.f, 0.f, 0.f}};
        v4u pq[2], pk[2], pe[2], pv; float pdec;
#define GLA_LOAD(nn) do { const int bhn_ = (b * 4 + h) * 64 + (nn); const size_t t0_ = (size_t)b * SEQ + (size_t)(nn) * 64; \
            _Pragma("unroll") for (int i_ = 0; i_ < 2; ++i_) { const int c_ = tid + 512 * i_; const int r_ = c_ >> 4, ch_ = c_ & 15; \
                pq[i_] = *(const v4u*)(QD + (t0_ + r_) * 512 + h * 128 + ch_ * 8); pk[i_] = *(const v4u*)(KD + (t0_ + r_) * 512 + h * 128 + ch_ * 8); \
                pe[i_] = *(const v4u*)(KET + (size_t)bhn_ * 8192 + (size_t)c_ * 8); } \
            if (tid < 256) pv = *(const v4u*)(VT + ((size_t)bhn_ * 256 + vb * 32) * 64 + (size_t)tid * 8); \
            pdec = DEC[(size_t)bhn_ * 128 + 16 * w + fr]; } while (0)
        GLA_LOAD(0);
        for (int n = 0; n < 64; ++n) {
#pragma unroll
            for (int i = 0; i < 2; ++i) { const int c = tid + 512 * i; const int r = c >> 4, ch = c & 15;
                *(LAS v4u*)(lds + QD_OFF + r * ST272 + ch * 16) = pq[i]; *(LAS v4u*)(lds + KD_OFF + r * ST272 + ch * 16) = pk[i];
                const int rk = c >> 3, ck = c & 7; *(LAS v4u*)(lds + KET_OFF + rk * ST144 + ck * 16) = pe[i]; }
            if (tid < 256) { const int rv = tid >> 3, cv = tid & 7; *(LAS v4u*)(lds + VT_OFF + rv * ST144 + cv * 16) = pv; }
            const float dec = pdec;
            __syncthreads();
            if (n + 1 < 64) GLA_LOAD(n + 1);
            const int mt = w & 3, nt = w >> 2;
            const size_t tok0 = (size_t)b * SEQ + (size_t)n * 64;
            f32x4 oacc = {0.f, 0.f, 0.f, 0.f};
#pragma unroll
            for (int ks = 0; ks < 4; ++ks) { const bf16x8 a = ldsfrag(lds + QD_OFF + (16 * mt + fr) * ST272 + (32 * ks + 8 * fq) * 2), bb = ldsfrag(lds + ST_OFF + (16 * nt + fr) * ST272 + (32 * ks + 8 * fq) * 2);
                oacc = MFMA16(bb, a, oacc); }
#pragma unroll
            for (int q = 0; q < 2; ++q) { const int stile = 2 * nt + q; f32x4 sacc = {0.f, 0.f, 0.f, 0.f};
                if (stile <= mt) {
#pragma unroll
                    for (int ks = 0; ks < 4; ++ks) { const bf16x8 a = ldsfrag(lds + QD_OFF + (16 * mt + fr) * ST272 + (32 * ks + 8 * fq) * 2), bb = ldsfrag(lds + KD_OFF + (16 * stile + fr) * ST272 + (32 * ks + 8 * fq) * 2);
                        sacc = MFMA16(bb, a, sacc); } }
                const int t = 16 * mt + fr, s0 = 16 * stile + 4 * fq;
                const float a0 = (s0 + 0 <= t) ? sacc[0] : 0.f, a1 = (s0 + 1 <= t) ? sacc[1] : 0.f, a2 = (s0 + 2 <= t) ? sacc[2] : 0.f, a3 = (s0 + 3 <= t) ? sacc[3] : 0.f;
                v2u o; o.x = pk2(a0, a1); o.y = pk2(a2, a3); *(LAS v2u*)(lds + ATT_OFF + t * ST144 + s0 * 2) = o; }
#pragma unroll
            for (int vt = 0; vt < 2; ++vt) { st[vt] = st[vt] * dec;
#pragma unroll
                for (int ks = 0; ks < 2; ++ks) { const bf16x8 a = ldsfrag(lds + VT_OFF + (16 * vt + fr) * ST144 + (32 * ks + 8 * fq) * 2), bb = ldsfrag(lds + KET_OFF + (16 * w + fr) * ST144 + (32 * ks + 8 * fq) * 2);
                    st[vt] = MFMA16(a, bb, st[vt]); } }
            const bool cw = hC; const P0Dst dW = dC;
            if (cw) { P0_WRITE(SC, rC, gC, dC); P0_NEXT(cst, rC, gC, dC, hC); }
            __syncthreads();
            if (cw) { P0_STORE(SC, dW); }
#pragma unroll
            for (int vt = 0; vt < 2; ++vt)
#pragma unroll
                for (int j = 0; j < 4; ++j) *(LAS unsigned short*)(lds + ST_OFF + (16 * vt + 4 * fq + j) * ST272 + (16 * w + fr) * 2) = (unsigned short)f2bf(st[vt][j]);
#pragma unroll
            for (int ks = 0; ks < 2; ++ks) { const bf16x8 a = ldsfrag(lds + ATT_OFF + (16 * mt + fr) * ST144 + (32 * ks + 8 * fq) * 2), bb = ldsfrag(lds + VT_OFF + (16 * nt + fr) * ST144 + (32 * ks + 8 * fq) * 2);
                oacc = MFMA16(bb, a, oacc); }
            { const size_t tok = tok0 + 16 * mt + fr; const int col = h * 256 + vb * 32 + 16 * nt + 4 * fq;
              v2u o; o.x = pk2(oacc[0], oacc[1]); o.y = pk2(oacc[2], oacc[3]); *(v2u*)(GO + tok * 1024 + col) = o;
              float sq = (oacc[0] * oacc[0] + oacc[1] * oacc[1]) + (oacc[2] * oacc[2] + oacc[3] * oacc[3]); sq += __shfl_xor(sq, 16); sq += __shfl_xor(sq, 32);
              if (fq == 0) ossq[(tok * 4 + h) * 16 + vb * 2 + nt] = sq; }
            __syncthreads();
        }
#undef GLA_LOAD
    }
    while (hC) { const P0Dst dW = dC; P0_WRITE(SC, rC, gC, dC); P0_NEXT(cst, rC, gC, dC, hC); __syncthreads(); P0_STORE(SC, dW); __syncthreads(); }
}
DI void gla_gate_phase(Frame& F, const float* og) {
    const bf16* GO = wsp<bf16>(F, WS_GO); const bf16* QKVR = wsp<bf16>(F, WS_QKVR); const float* ossq = wsp<float>(F, WS_OSSQ); bf16* GG = wsp<bf16>(F, WS_GG);
    const int gw = F.vcu * NWAVES + F.wave, NGW = F.G * NWAVES, lane = F.lane;
    const int c0 = 16 * lane, hh = lane >> 4;
    f32x4 g4[4];
#pragma unroll
    for (int q = 0; q < 4; ++q) g4[q] = *(const f32x4*)(og + (c0 & 255) + 4 * q);
    constexpr int RB = 4;
#define GATE_MAP(r) ((((r) & 2047) >> 8) * 4096 + ((r) & 255) + 256 * ((r) >> 11))
    for (int m0 = gw; m0 < M; m0 += RB * NGW) {
        f32x4 sv[RB][4]; v4u ov[RB][2], rv[RB][2];
#pragma unroll
        for (int i = 0; i < RB; ++i) { const int r_ = m0 + i * NGW, m = GATE_MAP(r_); if (r_ < M) { const f32x4* sp = (const f32x4*)(ossq + ((size_t)m * 4 + hh) * 16);
#pragma unroll
                for (int q = 0; q < 4; ++q) sv[i][q] = sp[q];
                const v4u* op = (const v4u*)(GO + (size_t)m * 1024 + c0); const v4u* rp = (const v4u*)(QKVR + (size_t)m * 3072 + 2048 + c0);
                ov[i][0] = op[0]; ov[i][1] = op[1]; rv[i][0] = rp[0]; rv[i][1] = rp[1]; } }
#pragma unroll
        for (int i = 0; i < RB; ++i) { const int r_ = m0 + i * NGW, m = GATE_MAP(r_); if (r_ < M) { float s = 0.f;
#pragma unroll
                for (int q = 0; q < 4; ++q) { const f32x4 a = sv[i][q]; s += (a[0] + a[1]) + (a[2] + a[3]); }
                const float rs = 1.0f / sqrtf(s * (1.0f / 256.0f) + EPS);
                v4u* dp = (v4u*)(GG + (size_t)m * 1024 + c0);
                if constexpr (BOUT_F8 != 0) { const float r8 = 8.0f * rs; unsigned w8[4];
#pragma unroll
                    for (int q = 0; q < 2; ++q) { const v4u o = ov[i][q], r = rv[i][q]; const f32x4 ga = g4[2 * q], gb = g4[2 * q + 1];
                        int a_ = __builtin_amdgcn_cvt_pk_fp8_f32(pg8::c8(bflo(o.x) * r8 * ga[0] * pg8::silu_f(bflo(r.x))), pg8::c8(bfhi(o.x) * r8 * ga[1] * pg8::silu_f(bfhi(r.x))), 0, false);
                        a_ = __builtin_amdgcn_cvt_pk_fp8_f32(pg8::c8(bflo(o.y) * r8 * ga[2] * pg8::silu_f(bflo(r.y))), pg8::c8(bfhi(o.y) * r8 * ga[3] * pg8::silu_f(bfhi(r.y))), a_, true);
                        int b_ = __builtin_amdgcn_cvt_pk_fp8_f32(pg8::c8(bflo(o.z) * r8 * gb[0] * pg8::silu_f(bflo(r.z))), pg8::c8(bfhi(o.z) * r8 * gb[1] * pg8::silu_f(bfhi(r.z))), 0, false);
                        b_ = __builtin_amdgcn_cvt_pk_fp8_f32(pg8::c8(bflo(o.w) * r8 * gb[2] * pg8::silu_f(bflo(r.w))), pg8::c8(bfhi(o.w) * r8 * gb[3] * pg8::silu_f(bfhi(r.w))), b_, true);
                        w8[2 * q] = (unsigned)a_; w8[2 * q + 1] = (unsigned)b_; }
                    *(v4u*)((unsigned char*)GG + (size_t)m * 1024 + c0) = (v4u){w8[0], w8[1], w8[2], w8[3]}; }
                else
#pragma unroll
                for (int q = 0; q < 2; ++q) { const v4u o = ov[i][q], r = rv[i][q]; v4u d; const f32x4 ga = g4[2 * q], gb = g4[2 * q + 1];
                    d.x = pk2(bflo(o.x) * rs * ga[0] * pg8::silu_f(bflo(r.x)), bfhi(o.x) * rs * ga[1] * pg8::silu_f(bfhi(r.x)));
                    d.y = pk2(bflo(o.y) * rs * ga[2] * pg8::silu_f(bflo(r.y)), bfhi(o.y) * rs * ga[3] * pg8::silu_f(bfhi(r.y)));
                    d.z = pk2(bflo(o.z) * rs * gb[0] * pg8::silu_f(bflo(r.z)), bfhi(o.z) * rs * gb[1] * pg8::silu_f(bfhi(r.z)));
                    d.w = pk2(bflo(o.w) * rs * gb[2] * pg8::silu_f(bflo(r.w)), bfhi(o.w) * rs * gb[3] * pg8::silu_f(bfhi(r.w)));
                    dp[q] = d; } } }
    }
}
#undef GATE_MAP

DI void fox_attn_phase(Frame& F, const unsigned* knb) {
    constexpr int KST = 272, VST = 288, STAGE = 64 * KST + 64 * VST, V_OFF = 64 * KST, C_OFF = 2 * STAGE, WS_OFF = C_OFF + 16384;
    const bf16* QKV = wsp<bf16>(F, WS_QKVR); const float* logf = wsp<float>(F, WS_LOGF); bf16* AO = wsp<bf16>(F, WS_AO);
    LAS unsigned char* lds = F.lds; LAS float* cl = (LAS float*)(lds + C_OFF); LAS float* wsum = (LAS float*)(lds + WS_OFF); LAS unsigned* dflag = (LAS unsigned*)(lds + WS_OFF + 64);
    const int tid = F.tid, lane = F.lane, w = F.wave, fr = lane & 15, fq = lane >> 4;
    constexpr float SC2 = 0.08838834764831845f * 1.4426950408889634f, L2E = 1.4426950408889634f, THR = 8.0f;
    const int kfo = fr * KST + fq * 16;
    const int vfo = (4 * fq + (fr >> 2)) * VST + (fr & 3) * 8;
    int cur_bh = -1;
    for (int U = F.vcu; U < 1024; U += F.G) {
        const int r_ = U >> 8, v_ = U & 255, bh = v_ >> 2, i_ = v_ & 3; const int b = bh >> 3, h = bh & 7;
        const int qt = (r_ == 0) ? i_ : (r_ == 1) ? 7 - i_ : (r_ == 2) ? 8 + i_ : 15 - i_;
        if (bh != cur_bh) { cur_bh = bh;
          __syncthreads();
          float v8[8]; float tot = 0.f; const int p0 = tid * 8;
          { const float* lp = logf + ((size_t)b * SEQ + p0) * 8 + h;
#pragma unroll
              for (int e = 0; e < 8; ++e) v8[e] = lp[8 * e]; }
#pragma unroll
          for (int e = 0; e < 8; ++e) { tot += v8[e]; v8[e] = tot; }
          float inc = tot;
#pragma unroll
          for (int o = 1; o < 64; o <<= 1) { const float t = __shfl_up(inc, o); if (lane >= o) inc += t; }
          if (lane == 63) wsum[w] = inc;
          __syncthreads();
          float woff = 0.f;
#pragma unroll
          for (int q = 0; q < 8; ++q) woff += (q < w) ? wsum[q] : 0.f;
          const float excl = woff + inc - tot;
#pragma unroll
          for (int e = 0; e < 8; ++e) cl[p0 + e] = -L2E * (excl + v8[e]);
        }
        const int q0 = qt * 256 + 32 * w;
        bf16x8 qf[2][4]; float mrow[2], lrow[2]; f32x4 oacc[2][8];
#pragma unroll
        for (int mt = 0; mt < 2; ++mt) { const size_t tok = (size_t)b * SEQ + q0 + 16 * mt + fr;
#pragma unroll
            for (int ks = 0; ks < 4; ++ks) qf[mt][ks] = *(const bf16x8*)(QKV + tok * 3072 + h * 128 + 32 * ks + 8 * fq);
            mrow[mt] = -1.0e30f; lrow[mt] = 0.f;
#pragma unroll
            for (int dt = 0; dt < 8; ++dt) oacc[mt][dt] = (f32x4){0.f, 0.f, 0.f, 0.f}; }
        const int ntiles = 4 * (qt + 1);
        float qk_bound;
        { float q2 = 0.f;
#pragma unroll
          for (int mt = 0; mt < 2; ++mt) { float s = 0.f;
#pragma unroll
              for (int ks = 0; ks < 4; ++ks) { const v4u qq = __builtin_bit_cast(v4u, qf[mt][ks]);
                  s += (bflo(qq.x) * bflo(qq.x) + bfhi(qq.x) * bfhi(qq.x)) + (bflo(qq.y) * bflo(qq.y) + bfhi(qq.y) * bfhi(qq.y)) + (bflo(qq.z) * bflo(qq.z) + bfhi(qq.z) * bfhi(qq.z)) + (bflo(qq.w) * bflo(qq.w) + bfhi(qq.w) * bfhi(qq.w)); }
              s += __shfl_xor(s, 16); s += __shfl_xor(s, 32); q2 = fmaxf(q2, s); }
#pragma unroll
          for (int o = 1; o < 16; o <<= 1) q2 = fmaxf(q2, __shfl_xor(q2, o));
          const unsigned* kp = knb + (b * 8 + h) * 4; const float k2 = (__builtin_bit_cast(float, kp[0]) + __builtin_bit_cast(float, kp[1])) + (__builtin_bit_cast(float, kp[2]) + __builtin_bit_cast(float, kp[3]));
          qk_bound = sqrtf(q2 * k2) * (SC2 * 1.02f); }
        bool wdone = false;
        if (tid < 8) dflag[tid] = 0u;
        v4u pk_[2], pv_[2];
#define FOX_LOAD(jj) do { _Pragma("unroll") for (int i2 = 0; i2 < 2; ++i2) { const int c2 = tid + 512 * i2; const bf16* rp = QKV + ((size_t)b * SEQ + 64 * (jj) + (c2 >> 4)) * 3072 + h * 128 + (c2 & 15) * 8; \
            pk_[i2] = *(const v4u*)(rp + 1024); pv_[i2] = *(const v4u*)(rp + 2048); } } while (0)
#define FOX_STORE(st) do { _Pragma("unroll") for (int i2 = 0; i2 < 2; ++i2) { const int c2 = tid + 512 * i2; \
            *(LAS v4u*)(lds + (st) * STAGE + (c2 >> 4) * KST + (c2 & 15) * 16) = pk_[i2]; *(LAS v4u*)(lds + (st) * STAGE + V_OFF + (c2 >> 4) * VST + (c2 & 15) * 16) = pv_[i2]; } } while (0)
        FOX_LOAD(ntiles - 1);
        FOX_STORE(0);
        __syncthreads();
        for (int it = 0; it < ntiles; ++it) {
            const int j = ntiles - 1 - it, cur = it & 1; const int key0 = 64 * j;
            if (it + 1 < ntiles) FOX_LOAD(j - 1);
            if (!wdone && key0 <= q0 + 31) {
                LAS const unsigned char* kb = lds + cur * STAGE + kfo; LAS const unsigned char* vb = lds + cur * STAGE + V_OFF + vfo;
                f32x4 sacc[4][2];
#pragma unroll
                for (int nt = 0; nt < 4; ++nt) { sacc[nt][0] = (f32x4){0.f, 0.f, 0.f, 0.f}; sacc[nt][1] = (f32x4){0.f, 0.f, 0.f, 0.f}; }
                { bf16x8 ka[2][4];
#pragma unroll
                  for (int nt = 0; nt < 4; ++nt) ka[0][nt] = ldsfrag(kb + nt * 16 * KST);
#pragma unroll
                  for (int ks = 0; ks < 4; ++ks) {
                    if (ks + 1 < 4) {
#pragma unroll
                        for (int nt = 0; nt < 4; ++nt) ka[(ks + 1) & 1][nt] = ldsfrag(kb + nt * 16 * KST + (ks + 1) * 64); }
#pragma unroll
                    for (int nt = 0; nt < 4; ++nt) { sacc[nt][0] = MFMA16(ka[ks & 1][nt], qf[0][ks], sacc[nt][0]); sacc[nt][1] = MFMA16(ka[ks & 1][nt], qf[1][ks], sacc[nt][1]); } } }
                float mx0 = -__builtin_inff(), mx1 = -__builtin_inff();
#pragma unroll
                for (int nt = 0; nt < 4; ++nt) { const f32x4 ck = *(const LAS f32x4*)(cl + key0 + 16 * nt + 4 * fq);
                    sacc[nt][0] = sacc[nt][0] * SC2 + ck; sacc[nt][1] = sacc[nt][1] * SC2 + ck; }
                if (key0 + 63 > q0) {
#pragma unroll
                    for (int nt = 0; nt < 4; ++nt)
#pragma unroll
                        for (int e = 0; e < 4; ++e) { const int key = key0 + 16 * nt + 4 * fq + e;
                            if (key > q0 + fr) sacc[nt][0][e] = -__builtin_inff();
                            if (key > q0 + 16 + fr) sacc[nt][1][e] = -__builtin_inff(); } }
#pragma unroll
                for (int nt = 0; nt < 4; ++nt) { mx0 = fmaxf(mx0, fmaxf(fmaxf(sacc[nt][0][0], sacc[nt][0][1]), fmaxf(sacc[nt][0][2], sacc[nt][0][3])));
                    mx1 = fmaxf(mx1, fmaxf(fmaxf(sacc[nt][1][0], sacc[nt][1][1]), fmaxf(sacc[nt][1][2], sacc[nt][1][3]))); }
                mx0 = fmaxf(mx0, __shfl_xor(mx0, 16)); mx0 = fmaxf(mx0, __shfl_xor(mx0, 32)); mx1 = fmaxf(mx1, __shfl_xor(mx1, 16)); mx1 = fmaxf(mx1, __shfl_xor(mx1, 32));
                if (__any((mx0 > mrow[0] + THR) || (mx1 > mrow[1] + THR))) {
                    const float n0 = fmaxf(mrow[0], mx0), n1 = fmaxf(mrow[1], mx1);
                    const float a0 = __builtin_amdgcn_exp2f(mrow[0] - n0), a1 = __builtin_amdgcn_exp2f(mrow[1] - n1);
                    mrow[0] = n0; mrow[1] = n1; lrow[0] *= a0; lrow[1] *= a1;
#pragma unroll
                    for (int dt = 0; dt < 8; ++dt) { oacc[0][dt] = oacc[0][dt] * a0; oacc[1][dt] = oacc[1][dt] * a1; } }
                bf16x8 pf[2][2];
#pragma unroll
                for (int mt = 0; mt < 2; ++mt) { const float mm = mrow[mt]; float ls = 0.f; unsigned pw[8];
#pragma unroll
                    for (int nt = 0; nt < 4; ++nt) { const f32x4 t = sacc[nt][mt] - mm;
                        const float p0 = __builtin_amdgcn_exp2f(t[0]), p1 = __builtin_amdgcn_exp2f(t[1]), p2 = __builtin_amdgcn_exp2f(t[2]), p3 = __builtin_amdgcn_exp2f(t[3]);
                        ls += (p0 + p1) + (p2 + p3); pw[2 * nt] = pg8::cvt_pk_bf16(p0, p1); pw[2 * nt + 1] = pg8::cvt_pk_bf16(p2, p3); }
                    lrow[mt] += ls;
                    { v4u t0 = {pw[0], pw[1], pw[2], pw[3]}, t1 = {pw[4], pw[5], pw[6], pw[7]}; pf[mt][0] = __builtin_bit_cast(bf16x8, t0); pf[mt][1] = __builtin_bit_cast(bf16x8, t1); } }
                { bf16x8 va[2][4];
#pragma unroll
                  for (int i = 0; i < 4; ++i) va[0][i] = tr_frag(vb + i * 32, vb + 16 * VST + i * 32);
#pragma unroll
                  for (int g = 0; g < 4; ++g) { const int ks2 = g >> 1, d0 = (g & 1) * 4;
                    if (g + 1 < 4) { const int ks2n = (g + 1) >> 1, d0n = ((g + 1) & 1) * 4;
#pragma unroll
                        for (int i = 0; i < 4; ++i) va[(g + 1) & 1][i] = tr_frag(vb + (32 * ks2n) * VST + (d0n + i) * 32, vb + (32 * ks2n + 16) * VST + (d0n + i) * 32); }
#pragma unroll
                    for (int i = 0; i < 4; ++i) { oacc[0][d0 + i] = MFMA16(va[g & 1][i], pf[0][ks2], oacc[0][d0 + i]); oacc[1][d0 + i] = MFMA16(va[g & 1][i], pf[1][ks2], oacc[1][d0 + i]); } } }
            }
            if (!wdone && j > 0) {
                const float mmin = fminf(mrow[0], mrow[1]); float mm = mmin; mm = fminf(mm, __shfl_xor(mm, 1)); mm = fminf(mm, __shfl_xor(mm, 2)); mm = fminf(mm, __shfl_xor(mm, 4)); mm = fminf(mm, __shfl_xor(mm, 8));
                if (key0 - 1 <= q0 + 31 && __all(qk_bound + cl[key0 - 1] - mm < -40.0f)) { wdone = true; if (lane == 0) dflag[w] = 1u; } }
            if (it + 1 < ntiles) FOX_STORE(cur ^ 1);
            __syncthreads();
            { unsigned alld = 1u;
#pragma unroll
              for (int q = 0; q < 8; ++q) alld &= dflag[q];
              if (alld) break; }
        }
        __syncthreads();
#undef FOX_LOAD
#undef FOX_STORE
#pragma unroll
        for (int mt = 0; mt < 2; ++mt) { float l = lrow[mt]; l += __shfl_xor(l, 16); l += __shfl_xor(l, 32); const float inv = 1.0f / l;
            const size_t tok = (size_t)b * SEQ + q0 + 16 * mt + fr;
#pragma unroll
            for (int dt = 0; dt < 8; ++dt) {
                if constexpr (COUT_F8 != 0) { const f32x4 o = oacc[mt][dt] * (8.0f * inv);
                    int q_ = __builtin_amdgcn_cvt_pk_fp8_f32(pg8::c8(o[0]), pg8::c8(o[1]), 0, false); q_ = __builtin_amdgcn_cvt_pk_fp8_f32(pg8::c8(o[2]), pg8::c8(o[3]), q_, true);
                    *(unsigned*)((unsigned char*)AO + tok * 1024 + h * 128 + 16 * dt + 4 * fq) = (unsigned)q_; }
                else { const f32x4 o = oacc[mt][dt] * inv; v2u r; r.x = pg8::cvt_pk_bf16(o[0], o[1]); r.y = pg8::cvt_pk_bf16(o[2], o[3]); *(v2u*)(AO + tok * 1024 + h * 128 + 16 * dt + 4 * fq) = r; } } }
    }
}

constexpr int N_PHASES = 2 + 10 * MK_LAYERS;
__host__ __device__ constexpr bool phase_active(int id) {
    if (id == 0) return true;
    if (id == 1 + 10 * MK_LAYERS) return (MK_LAYERS % 2) == 1;
    const int l = (id - 1) / 10, s = (id - 1) % 10, mixer = l % 3; const bool moe = (l % 2) == 1;
    if (s == 0 || s == 1 || s == 4) return true;
    if (s == 2 || s == 3) return mixer == 1;
    if (s == 5 || s == 6) return true;
    return moe;
}
struct Args { const float* in[22]; float* out; unsigned char* ws; int ph_lo, ph_hi; };
#define IN(k) (lo <= (k) && (k) < hi)
#ifndef PROBE_MASK
#define PROBE_MASK 0
#endif
#define REPS(bit) _Pragma("unroll 1") for (int r_ = 0; r_ < ((PROBE_MASK & (bit)) ? 2 : 1); ++r_)
#define TWICE(bit, ...) do { if constexpr ((PROBE_MASK & (bit)) != 0) { __VA_ARGS__ xcd_barrier(bar); } __VA_ARGS__ } while (0)
#define SEAM(k) do { if ((k) + 1 < hi) xcd_barrier(bar); } while (0)
#define SEAML(k) do { if ((k) + 1 < hi) { if (F.MISC[10]) xcd_barrier_local(bar); else xcd_barrier(bar); } } while (0)
template <int L> DI void run_layer(Frame& F, const Args& args, const XcdBarrier& bar, const int lo, const int hi) {
    constexpr int l = L, mixer = L % 3, jm = L / 3, fi = L / 2, pb = 1 + 10 * L; constexpr bool moe = (L & 1) != 0;
    bf16* XB = wsp<bf16>(F, WS_XB); float* SSQ = wsp<float>(F, WS_SSQ);
    if (IN(pb + 0)) {
        if constexpr (mixer == 0) {
            if constexpr (l == 3 && AIN_F8 != 0) {
                pg8::Gemm g{(const bf16*)wsp<unsigned char>(F, WS_X8), wsp<bf16>(F, WS_WA_IN) + (size_t)jm * 4096 * 1024, M, 4096, D / 2}; pg8::StaticOrder S; S.init(M, 4096, F.G, (int)blockIdx.x);
                pg8::EpiAin E{SSQ, wsp<bf16>(F, WS_U), wsp<bf16>(F, WS_V), wsp<float>(F, WS_VSSQ), 1.0f / 64.0f};
                pg8::gemm_phase<pg8::EpiAin, pg8::StaticOrder, true, true, true>(F.lds + RING_OFF, g, S, E);
            } else {
                pg8::Gemm g{XB, wsp<bf16>(F, WS_WA_IN) + (size_t)jm * 4096 * 1024, M, 4096, D}; pg8::StaticOrder S; S.init(M, 4096, F.G, (int)blockIdx.x);
                pg8::EpiAin E{SSQ, wsp<bf16>(F, WS_U), wsp<bf16>(F, WS_V), wsp<float>(F, WS_VSSQ), 1.0f};
                pg8::gemm_phase<pg8::EpiAin, pg8::StaticOrder, true, true>(F.lds + RING_OFF, g, S, E);
            }
        } else {
            REPS(128) { if constexpr (mixer == 1) glow_phase(F, XB, args.in[1] + l * 1024, args.in[8]); else logf_phase(F, XB, args.in[1] + l * 1024, args.in[13], args.in[14]); }
            if constexpr (mixer == 2 && CIN_F8 != 0) {
                pg8::Gemm g{(const bf16*)wsp<unsigned char>(F, WS_X8), wsp<bf16>(F, WS_WC_IN), M, 3072, D / 2}; pg8::StaticOrder S; S.init(M, 3072, F.G, (int)blockIdx.x);
                pg8::EpiRow<true> E{SSQ, wsp<bf16>(F, WS_QKVR), 3072, (unsigned*)(F.ctl + CW_KNB), 1.0f / 64.0f};
                pg8::gemm_phase<pg8::EpiRow<true>, pg8::StaticOrder, true, true, true>(F.lds + RING_OFF, g, S, E);
            } else {
                pg8::Gemm g{XB, mixer == 1 ? wsp<bf16>(F, WS_WB_IN) : wsp<bf16>(F, WS_WC_IN), M, 3072, D}; pg8::StaticOrder S; S.init(M, 3072, F.G, (int)blockIdx.x);
                pg8::EpiRow<mixer == 2> E{SSQ, wsp<bf16>(F, WS_QKVR), 3072, (unsigned*)(F.ctl + CW_KNB), 1.0f};
                pg8::gemm_phase<pg8::EpiRow<mixer == 2>, pg8::StaticOrder, true, true>(F.lds + RING_OFF, g, S, E);
            }
        }
        SEAML(pb + 0);
    }
    if (IN(pb + 1)) { REPS(mixer == 0 ? 2 : mixer == 1 ? 4 : 32) {
        if constexpr (mixer == 0) mix_phase<(((AOUT_F8 >> jm) & 1) != 0)>(F, args.in[5] + (size_t)jm * 8 * 128 * 128, args.in[6] + (size_t)jm * 8 * 128, args.in[4] + (size_t)jm * AW);
        else if constexpr (mixer == 1) gla_prep_phase(F, args.in[9], args.in[10]);
        else fox_attn_phase(F, (const unsigned*)(F.ctl + CW_KNB));
        SEAML(pb + 1); } }
    if constexpr (mixer == 1) {
        if (IN(pb + 2)) { REPS(8) { gla_scan_phase(F, args); SEAML(pb + 2); } }
        if (IN(pb + 3)) { REPS(16) { gla_gate_phase(F, args.in[11]); SEAML(pb + 3); } }
    }
    if (IN(pb + 4)) {
        const bf16* A = mixer == 0 ? wsp<bf16>(F, WS_Y) : mixer == 1 ? wsp<bf16>(F, WS_GG) : wsp<bf16>(F, WS_AO);
        const bf16* Bt = mixer == 0 ? wsp<bf16>(F, WS_WA_OUT) + (size_t)jm * 1024 * 2048 : mixer == 1 ? wsp<bf16>(F, WS_WB_OUT) : wsp<bf16>(F, WS_WC_OUT);
        constexpr bool w8 = moe ? (MOE_F8 != 0) : ((DENSE_F8 >> fi) & 1) != 0;
        if constexpr ((mixer == 2 && COUT_F8 != 0) || (mixer == 1 && BOUT_F8 != 0)) {
            pg8::Gemm g{A, Bt, M, D, 512}; pg8::StaticOrder S; S.init(M, D, F.G, (int)blockIdx.x);
            pg8::EpiResid<false, w8> E{(const void*)XB, XB, SSQ, wsp<unsigned char>(F, WS_X8), 1.0f / 512.0f};
            pg8::gemm_phase<pg8::EpiResid<false, w8>, pg8::StaticOrder, true, true, true>(F.lds + RING_OFF, g, S, E);
        } else if constexpr (mixer == 0 && ((AOUT_F8 >> jm) & 1) != 0) {
            pg8::Gemm g{A, Bt, M, D, 1024}; pg8::StaticOrder S; S.init(M, D, F.G, (int)blockIdx.x);
            pg8::EpiResid<l == 0, w8> E{l == 0 ? (const void*)args.in[0] : (const void*)XB, XB, SSQ, wsp<unsigned char>(F, WS_X8), 1.0f / 256.0f};
            pg8::gemm_phase<pg8::EpiResid<l == 0, w8>, pg8::StaticOrder, true, true, true>(F.lds + RING_OFF, g, S, E);
        } else {
            pg8::Gemm g{A, Bt, M, D, mixer == 0 ? 2048 : 1024}; pg8::StaticOrder S; S.init(M, D, F.G, (int)blockIdx.x);
            pg8::EpiResid<l == 0, w8> E{l == 0 ? (const void*)args.in[0] : (const void*)XB, XB, SSQ, wsp<unsigned char>(F, WS_X8), 1.0f};
            pg8::gemm_phase<pg8::EpiResid<l == 0, w8>, pg8::StaticOrder, true, true>(F.lds + RING_OFF, g, S, E);
        }
        SEAML(pb + 4);
    }
    if constexpr (!moe) {
        constexpr bool f8 = ((DENSE_F8 >> fi) & 1) != 0;
        if (IN(pb + 5)) {
            if constexpr (f8) {
                pg8::Gemm g{(const bf16*)wsp<unsigned char>(F, WS_X8), (const bf16*)(wsp<unsigned char>(F, WS_WF_IN) + (size_t)fi * 2 * 7168 * 1024), M, 7168, D / 2}; pg8::StaticOrder S; S.init(M, 7168, F.G, (int)blockIdx.x);
                pg8::EpiSwiGLU8<0> E{SSQ, wsp<unsigned char>(F, WS_HF)};
                pg8::gemm_phase<pg8::EpiSwiGLU8<0>, pg8::StaticOrder, true, true, true>(F.lds + RING_OFF, g, S, E);
            } else {
                pg8::Gemm g{XB, wsp<bf16>(F, WS_WF_IN) + (size_t)fi * 7168 * 1024, M, 7168, D}; pg8::StaticOrder S; S.init(M, 7168, F.G, (int)blockIdx.x);
                pg8::EpiSwiGLU<0> E{SSQ, wsp<bf16>(F, WS_HF)};
                pg8::gemm_phase<pg8::EpiSwiGLU<0>, pg8::StaticOrder, true, true>(F.lds + RING_OFF, g, S, E);
            }
            SEAML(pb + 5);
        }
        if (IN(pb + 6)) {
            if constexpr (f8) {
                pg8::Gemm g{(const bf16*)wsp<unsigned char>(F, WS_HF), (const bf16*)(wsp<unsigned char>(F, WS_WF_OUT) + (size_t)fi * 2 * 1024 * 3584), M, D, FF / 2}; pg8::StaticOrder S; S.init(M, D, F.G, (int)blockIdx.x, 1);
                constexpr bool w8n = (l == 2 && AIN_F8 != 0);
                pg8::EpiResid<false, w8n> E{(const void*)XB, XB, SSQ, wsp<unsigned char>(F, WS_X8), 1.0f / 512.0f};
                pg8::gemm_phase<pg8::EpiResid<false, w8n>, pg8::StaticOrder, true, true, true>(F.lds + RING_OFF, g, S, E);
            } else {
                pg8::Gemm g{wsp<bf16>(F, WS_HF), wsp<bf16>(F, WS_WF_OUT) + (size_t)fi * 1024 * 3584, M, D, FF}; pg8::StaticOrder S; S.init(M, D, F.G, (int)blockIdx.x, 1);
                pg8::EpiResid<false> E{(const void*)XB, XB, SSQ, nullptr, 1.0f};
                pg8::gemm_phase<pg8::EpiResid<false>, pg8::StaticOrder, true, true>(F.lds + RING_OFF, g, S, E);
            }
            SEAML(pb + 6);
        }
    } else {
        unsigned* gcnt = (unsigned*)(F.ctl + CW_CNT + 64 * l);
        if (IN(pb + 5)) { router_phase(F, XB, args.in[2] + l * 1024, args.in[18] + (size_t)fi * 1024 * 8, gcnt); SEAM(pb + 5); }
        if (IN(pb + 6)) { REPS(64) { if constexpr (MOE_F8 != 0) rowtable_phase(F, gcnt); else gather_phase<false>(F, gcnt); SEAM(pb + 6); } }
        if (IN(pb + 7)) {
            if constexpr (MOE_F8 != 0) {
                pg8::Gemm g{(const bf16*)wsp<unsigned char>(F, WS_X8), (const bf16*)(wsp<unsigned char>(F, WS_WM_IN) + (size_t)fi * 8 * 7168 * 1024), MROWS, 7168, D / 2, wsp<int>(F, WS_ROWT)}; pg8::GroupedOrder S; S.init(gcnt, 28, F.G, (int)blockIdx.x);
                pg8::EpiSwiGLU8<1> E{wsp<float>(F, WS_ROWRS), wsp<unsigned char>(F, WS_HM)};
                TWICE(256, pg8::gemm_phase<pg8::EpiSwiGLU8<1>, pg8::GroupedOrder, true, true, true, true>(F.lds + RING_OFF, g, S, E););
            } else {
                pg8::Gemm g{wsp<bf16>(F, WS_XS), wsp<bf16>(F, WS_WM_IN) + (size_t)fi * 8 * 7168 * 1024, MROWS, 7168, D}; pg8::GroupedOrder S; S.init(gcnt, 28, F.G, (int)blockIdx.x);
                pg8::EpiSwiGLU<1> E{wsp<float>(F, WS_ROWRS), wsp<bf16>(F, WS_HM)};
                pg8::gemm_phase<pg8::EpiSwiGLU<1>, pg8::GroupedOrder, true, true>(F.lds + RING_OFF, g, S, E);
            }
            SEAM(pb + 7);
        }
        if (IN(pb + 8)) {
            if constexpr (MOE_F8 != 0) {
                pg8::Gemm g{(const bf16*)wsp<unsigned char>(F, WS_HM), (const bf16*)(wsp<unsigned char>(F, WS_WM_OUT) + (size_t)fi * 8 * 1024 * 3584), MROWS, D, FF / 2}; pg8::GroupedOrder S; S.init(gcnt, 4, F.G, (int)blockIdx.x, 1);
                pg8::EpiMoeOut E{wsp<int>(F, WS_ROWT), wsp<float>(F, WS_ROWG), wsp<bf16>(F, WS_OS), M, 1.0f / 512.0f};
                pg8::gemm_phase<pg8::EpiMoeOut, pg8::GroupedOrder, true, true, true>(F.lds + RING_OFF, g, S, E);
            } else {
                pg8::Gemm g{wsp<bf16>(F, WS_HM), wsp<bf16>(F, WS_WM_OUT) + (size_t)fi * 8 * 1024 * 3584, MROWS, D, FF}; pg8::GroupedOrder S; S.init(gcnt, 4, F.G, (int)blockIdx.x, 1);
                pg8::EpiMoeOut E{wsp<int>(F, WS_ROWT), wsp<float>(F, WS_ROWG), wsp<bf16>(F, WS_OS), M, 1.0f};
                pg8::gemm_phase<pg8::EpiMoeOut, pg8::GroupedOrder, true, true>(F.lds + RING_OFF, g, S, E);
            }
            SEAM(pb + 8);
        }
        if (IN(pb + 9)) { combine_phase(F, l == MK_LAYERS - 1, args.in[21], (l == 1 && CIN_F8 != 0) ? wsp<unsigned char>(F, WS_X8) : nullptr); if constexpr (l != MK_LAYERS - 1) SEAML(pb + 9); }
    }
}
__global__ void __launch_bounds__(NWAVES * 64, 2) trunk_fwd(Args args) {
    extern __shared__ __attribute__((aligned(16))) unsigned char lds[];
    Frame F;
    F.lds = (LAS unsigned char*)lds;
    F.MISC = (volatile LAS unsigned*)(F.lds + MISC_OFF);
    F.tid = threadIdx.x; F.lane = F.tid & 63; F.wave = __builtin_amdgcn_readfirstlane(F.tid >> 6);
    F.G = gridDim.x; { const int bx = blockIdx.x; F.vcu = (F.G % 8 == 0) ? (bx % 8) * (F.G / 8) + bx / 8 : bx; }
    F.out = args.out; F.ws = args.ws;
    F.ctl = (gu32*)(args.ws + WS_CTL);
    for (int u = F.tid; u < (LDS_BYTES - LDSCTL_OFF) / 4; u += NWAVES * 64) ((LAS unsigned*)(F.lds + LDSCTL_OFF))[u] = 0u;
    __syncthreads();
    XcdBarrier bar = xcd_barrier_post((unsigned*)(F.ctl + CW_BAR), F.MISC + 8);
    if (F.tid == 0 && (bar.x != (blockIdx.x & 7u) || gridDim.x != 256u)) __hip_atomic_fetch_or(F.ctl + CW_XMIS, 1u, __ATOMIC_RELAXED, __HIP_MEMORY_SCOPE_AGENT);
    const int lo = args.ph_lo, hi = args.ph_hi;
    if (IN(0)) { REPS(1) { p0_prologue(F, args); SEAM(0); } }
    if (F.tid == 0) F.MISC[10] = (MK_ONE_LAUNCH != 0 && lo == 0 && __hip_atomic_load(F.ctl + CW_XMIS, __ATOMIC_RELAXED, __HIP_MEMORY_SCOPE_AGENT) == 0u) ? 1u : 0u;
    __syncthreads();
    run_layer<0>(F, args, bar, lo, hi);
    if constexpr (MK_LAYERS > 1) run_layer<1>(F, args, bar, lo, hi);
    if constexpr (MK_LAYERS > 2) run_layer<2>(F, args, bar, lo, hi);
    if constexpr (MK_LAYERS > 3) run_layer<3>(F, args, bar, lo, hi);
    if ((MK_LAYERS % 2) == 1 && IN(1 + 10 * MK_LAYERS)) final_norm_phase(F, wsp<bf16>(F, WS_XB), args.in[21]);
}
#undef IN
#undef SEAM

extern "C" void kernel_launch(void* const* d_in, const int* in_sizes, int n_in, void* d_out, int out_size, void* d_ws, size_t ws_size, hipStream_t stream) {
    static int grid = 0;
    if (grid == 0) {
        if (n_in != 22 || in_sizes[0] != M * D || out_size != M * D || ws_size < WS_END) { fprintf(stderr, "kernel_launch: unexpected shapes / workspace (n_in %d, in0 %d, out %d, ws %zu, need %zu)\n", n_in, n_in > 0 ? in_sizes[0] : -1, out_size, ws_size, (size_t)WS_END); grid = -1; return; }
        int dev = 0, cus = 0, per_cu = 0;
        if (hipGetDevice(&dev) != hipSuccess || hipDeviceGetAttribute(&cus, hipDeviceAttributeMultiprocessorCount, dev) != hipSuccess) { grid = -1; return; }
        if (hipFuncSetAttribute((const void*)trunk_fwd, hipFuncAttributeMaxDynamicSharedMemorySize, LDS_BYTES) != hipSuccess) { fprintf(stderr, "kernel_launch: hipFuncSetAttribute failed\n"); grid = -1; return; }
        if (hipOccupancyMaxActiveBlocksPerMultiprocessor(&per_cu, (const void*)trunk_fwd, NWAVES * 64, LDS_BYTES) != hipSuccess || per_cu < 1) { fprintf(stderr, "kernel_launch: occupancy query reports %d workgroups per CU\n", per_cu); }
        (void)hipGetLastError();
        grid = cus;
    }
    if (grid < 0) return;
    if (hipMemsetAsync((char*)d_ws + WS_CTL, 0, CTL_ZERO_BYTES, stream) != hipSuccess) return;
    Args a{};
    for (int i = 0; i < 22; ++i) a.in[i] = (const float*)d_in[i];
    a.out = (float*)d_out; a.ws = (unsigned char*)d_ws;
#if MK_ONE_LAUNCH
    a.ph_lo = 0; a.ph_hi = N_PHASES;
    hipLaunchKernelGGL(trunk_fwd, dim3(grid), dim3(NWAVES * 64), LDS_BYTES, stream, a);
#else
    for (int p = 0; p < N_PHASES; ++p) { if (!phase_active(p)) continue; a.ph_lo = p; a.ph_hi = p + 1; hipLaunchKernelGGL(trunk_fwd, dim3(grid), dim3(NWAVES * 64), LDS_BYTES, stream, a); }
#endif
}
```
